# Optimizing an MI355X kernel written in HIP

```python
import math
import jax, jax.numpy as jnp
from jax import lax
import numpy as np

D_MODEL = 1024
BATCH = 32
SEQ = 2048
DEPTH = 2

CTX_LEN = 256
GRID_W = 64
RMS_EPS = 1e-6

D_HY = 512
HY_ORDER = 2
HY_DIRS = 2
HY_SHORT = 3
HY_BANDS = 8
HY_EMB = 1 + 2 * HY_BANDS
HY_FH = 64
HY_DECAY_TARGET = 1e-2
HY_FAST_DECAY = 0.3
HY_SLOW_DECAY = 1.5
HY_FILTER_SCALE = 0.02

GLA_HEADS = 4
GLA_DK = 64
GLA_DV = 128
D_GLA_K = GLA_HEADS * GLA_DK
D_GLA_V = GLA_HEADS * GLA_DV
GLA_GATE_RANK = 16
GLA_GATE_NORM = 16.0
GLA_CHUNK = 64

POOL_WINDOWS = (2, 4, 8, 16)
POOL_GROUPS = 4
POOL_GROUP = 128
D_POOL = POOL_GROUPS * POOL_GROUP

D_FF = 4 * D_MODEL
N_BRANCH = 3

HY_COLS = 3 * D_HY
GLA_COLS = 2 * D_GLA_K + 2 * D_GLA_V + 2 * GLA_GATE_RANK
POOL_COLS = D_POOL
GATE_COLS = N_BRANCH * D_MODEL
GLA_OFF = HY_COLS
POOL_OFF = GLA_OFF + GLA_COLS
GATE_OFF = POOL_OFF + POOL_COLS
N_IN = GATE_OFF + GATE_COLS

kernel_name = "hybrid_hyena_gla_pool_dit_trunk"


def rms_norm(x, g):
    xf = x.astype(jnp.float32)
    y = xf * lax.rsqrt(jnp.mean(xf * xf, axis=-1, keepdims=True) + RMS_EPS)
    return (y * g.astype(jnp.float32)).astype(x.dtype)


def ada_norm(x, g, shift, scale):
    return rms_norm(x, g) * (1.0 + scale) + shift


def short_conv(u, w, b):
    k = w.shape[0]
    pad = k // 2
    y = lax.conv_general_dilated(u, w[:, None, :].astype(u.dtype), window_strides=(1,),
                                 padding=((pad, k - 1 - pad),),
                                 dimension_numbers=("NWC", "WIO", "NWC"),
                                 feature_group_count=u.shape[-1])
    return y + b


def hyena_filters(L, w1, b1, freq, w2, b2, w3):
    f32 = jnp.float32
    t = jnp.arange(L, dtype=f32)[:, None]
    bands = jnp.arange(1, HY_BANDS + 1, dtype=f32)[None, :]
    ang = (2.0 * math.pi / L) * t * bands
    z = jnp.concatenate([t / L, jnp.cos(ang), jnp.sin(ang)], axis=-1)
    a = jnp.sin(freq * (z @ w1 + b1))
    a = jnp.sin(freq * (a @ w2 + b2))
    h = (a @ w3).astype(f32).reshape(L, HY_DIRS, HY_ORDER, D_HY)
    deltas = jnp.abs(jnp.linspace(math.log(HY_DECAY_TARGET) / HY_SLOW_DECAY,
                                  math.log(HY_DECAY_TARGET) / HY_FAST_DECAY, D_HY, dtype=f32))
    window = jnp.exp(-(t / L) * deltas[None, :])
    return h * window[:, None, None, :]


def bidir_long_conv(u, h_fwd, h_bwd, skip):
    L = u.shape[1]
    n = 2 * L
    k = jnp.concatenate([h_fwd, jnp.zeros_like(h_fwd[:1]), h_bwd[:0:-1]], axis=0)
    kf = jnp.fft.rfft(k, n=n, axis=0)
    uf32 = u.astype(jnp.float32)
    uf = jnp.fft.rfft(uf32, n=n, axis=1)
    y = jnp.fft.irfft(uf * kf[None], n=n, axis=1)[:, :L]
    return (y + uf32 * skip.astype(jnp.float32)).astype(u.dtype)


def hyena_branch(u, p):
    L = u.shape[1]
    u = short_conv(u, p["hy_short_w"], p["hy_short_b"])
    x1, x2, v = jnp.split(u, 3, axis=-1)
    h = hyena_filters(L, p["hy_f_w1"], p["hy_f_b1"], p["hy_f_freq"], p["hy_f_w2"], p["hy_f_b2"], p["hy_f_w3"])
    z = x1 * bidir_long_conv(v, h[:, 0, 0], h[:, 1, 0], p["hy_skip"][0])
    z = x2 * bidir_long_conv(z, h[:, 0, 1], h[:, 1, 1], p["hy_skip"][1])
    return z


def gla_chunked(q, k, v, log_a, s0):
    B, L, H, DK = q.shape
    DV = v.shape[-1]
    C = GLA_CHUNK
    N = L // C
    q = q.reshape(B, N, C, H, DK)
    k = k.reshape(B, N, C, H, DK)
    v = v.reshape(B, N, C, H, DV)
    b = jnp.cumsum(log_a.reshape(B, N, C, H, DK), axis=2)
    b_last = b[:, :, -1:]
    q_dec = q * jnp.exp(b)
    k_inv = k * jnp.exp(-b)
    k_end = k * jnp.exp(b_last - b)
    tri = jnp.tril(jnp.ones((C, C), jnp.float32))
    scores = jnp.einsum("bnihd,bnjhd->bnhij", q_dec, k_inv) * tri
    o = jnp.einsum("bnhij,bnjhv->bnihv", scores, v)
    kv = jnp.einsum("bnjhd,bnjhv->bnhdv", k_end, v)
    decay = jnp.exp(b_last[:, :, 0])

    def step(s, inp):
        dec, kv_n = inp
        return dec[..., None] * s + kv_n, s

    s_fin, s_prev = lax.scan(step, s0, (jnp.moveaxis(decay, 1, 0), jnp.moveaxis(kv, 1, 0)))
    o = o + jnp.einsum("bnihd,nbhdv->bnihv", q_dec, s_prev)
    return o.reshape(B, L, H, DV), s_fin


def gla_branch(u, p, s_f0, s_b0):
    f32 = jnp.float32
    B, L, _ = u.shape
    idx = (D_GLA_K, 2 * D_GLA_K, 2 * D_GLA_K + D_GLA_V, 2 * D_GLA_K + 2 * D_GLA_V,
           2 * D_GLA_K + 2 * D_GLA_V + GLA_GATE_RANK)
    q, k, v, r, gf, gb = jnp.split(u, idx, axis=-1)
    q = q.reshape(B, L, GLA_HEADS, GLA_DK).astype(f32) * (GLA_DK ** -0.5)
    k = k.reshape(B, L, GLA_HEADS, GLA_DK).astype(f32)
    v = v.reshape(B, L, GLA_HEADS, GLA_DV).astype(f32)
    la_f = (jax.nn.log_sigmoid((gf @ p["gla_wa_f"] + p["gla_ba_f"]).astype(f32)) / GLA_GATE_NORM
            ).reshape(B, L, GLA_HEADS, GLA_DK)
    la_b = (jax.nn.log_sigmoid((gb @ p["gla_wa_b"] + p["gla_ba_b"]).astype(f32)) / GLA_GATE_NORM
            ).reshape(B, L, GLA_HEADS, GLA_DK)
    o_f, s_f = gla_chunked(q, k, v, la_f, s_f0)
    o_b, s_b = gla_chunked(q[:, ::-1], k[:, ::-1], v[:, ::-1], la_b[:, ::-1], s_b0)
    o = o_f + o_b[:, ::-1]
    o = o * lax.rsqrt(jnp.mean(o * o, axis=-1, keepdims=True) + RMS_EPS) * p["gla_norm_w"].astype(f32)
    y = o.reshape(B, L, D_GLA_V).astype(u.dtype) * jax.nn.silu(r)
    return y, s_f, s_b


def window_bounds(n, w):
    t = jnp.arange(n)
    return jnp.clip(t - w // 2, 0, n), jnp.clip(t - w // 2 + w, 0, n)


def mean_pool_1d(u, w):
    L = u.shape[1]
    cs = jnp.pad(jnp.cumsum(u, axis=1), ((0, 0), (1, 0), (0, 0)))
    lo, hi = window_bounds(L, w)
    s = jnp.take(cs, hi, axis=1) - jnp.take(cs, lo, axis=1)
    return s / (hi - lo).astype(u.dtype)[None, :, None]


def mean_pool_2d(u, w):
    R, W = u.shape[1], u.shape[2]
    sat = jnp.pad(jnp.cumsum(jnp.cumsum(u, axis=1), axis=2), ((0, 0), (1, 0), (1, 0), (0, 0)))
    rl, rh = window_bounds(R, w)
    cl, ch = window_bounds(W, w)
    top = jnp.take(sat, rl, axis=1)
    bot = jnp.take(sat, rh, axis=1)
    s = (jnp.take(bot, ch, axis=2) - jnp.take(bot, cl, axis=2)
         - jnp.take(top, ch, axis=2) + jnp.take(top, cl, axis=2))
    cnt = ((rh - rl)[:, None] * (ch - cl)[None, :]).astype(u.dtype)
    return s / cnt[None, :, :, None]


def pool_branch(u, p, grid):
    B, L, _ = u.shape
    uf = u.astype(jnp.float32)
    outs = []
    for g, w in enumerate(POOL_WINDOWS):
        ug = uf[..., g * POOL_GROUP:(g + 1) * POOL_GROUP]
        if grid:
            rows = L // GRID_W
            m = mean_pool_2d(ug.reshape(B, rows, GRID_W, POOL_GROUP), w).reshape(B, L, POOL_GROUP)
        else:
            m = mean_pool_1d(ug, w)
        outs.append(m - ug)
    y = jnp.stack(outs, axis=2).astype(u.dtype)
    y = jnp.einsum("blgc,gcd->blgd", y, p["pool_w"]).reshape(B, L, D_POOL)
    return y * p["pool_scale"]


def token_mixers(proj, p, grid, s_f0, s_b0):
    y_hy = hyena_branch(proj[..., :GLA_OFF], p)
    y_gla, s_f, s_b = gla_branch(proj[..., GLA_OFF:POOL_OFF], p, s_f0, s_b0)
    y_pool = pool_branch(proj[..., POOL_OFF:GATE_OFF], p, grid)
    g_hy, g_gla, g_pool = jnp.split(jax.nn.sigmoid(proj[..., GATE_OFF:]), N_BRANCH, axis=-1)
    merged = (g_hy * (y_hy @ p["w_br_hy"]) + g_gla * (y_gla @ p["w_br_gla"])
              + g_pool * (y_pool @ p["w_br_pool"]))
    return merged @ p["w_out"], s_f, s_b


def sqrelu_mlp(h, w_up, w_down):
    return jnp.square(jax.nn.relu(h @ w_up)) @ w_down


def setup_inputs(seed: int = 0) -> dict:
    key = jax.random.key(seed)
    ks = jax.random.split(key, 40)
    f32 = jnp.float32

    def nrm(k, shape, scale):
        return jax.random.normal(k, shape, f32) * scale

    return {
        "x": nrm(ks[0], (BATCH, SEQ, D_MODEL), 1.0),
        "c": nrm(ks[1], (BATCH, D_MODEL), 1.0),
        "ctx": nrm(ks[2], (BATCH, CTX_LEN, D_MODEL), 1.0),
        "c_ctx": nrm(ks[3], (D_MODEL,), 1.0),
        "w_mod": nrm(ks[4], (DEPTH, D_MODEL, 6 * D_MODEL), D_MODEL ** -0.5),
        "b_mod": nrm(ks[5], (DEPTH, 6 * D_MODEL), 0.02),
        "norm_mix": 1.0 + nrm(ks[6], (DEPTH, D_MODEL), 0.02),
        "norm_ffn": 1.0 + nrm(ks[7], (DEPTH, D_MODEL), 0.02),
        "w_in": nrm(ks[8], (DEPTH, D_MODEL, N_IN), D_MODEL ** -0.5),
        "b_in": nrm(ks[9], (DEPTH, N_IN), 0.02),
        "hy_short_w": nrm(ks[10], (DEPTH, HY_SHORT, HY_COLS), HY_SHORT ** -0.5),
        "hy_short_b": nrm(ks[11], (DEPTH, HY_COLS), 0.02),
        "hy_f_w1": nrm(ks[12], (DEPTH, HY_EMB, HY_FH), HY_EMB ** -0.5),
        "hy_f_b1": nrm(ks[13], (DEPTH, HY_FH), 0.02),
        "hy_f_freq": 1.0 + nrm(ks[14], (DEPTH, HY_FH), 0.02),
        "hy_f_w2": nrm(ks[15], (DEPTH, HY_FH, HY_FH), HY_FH ** -0.5),
        "hy_f_b2": nrm(ks[16], (DEPTH, HY_FH), 0.02),
        "hy_f_w3": nrm(ks[17], (DEPTH, HY_FH, HY_DIRS * HY_ORDER * D_HY), HY_FILTER_SCALE),
        "hy_skip": nrm(ks[18], (DEPTH, HY_ORDER, D_HY), 0.5),
        "gla_wa_f": nrm(ks[19], (DEPTH, GLA_GATE_RANK, D_GLA_K), GLA_GATE_RANK ** -0.5),
        "gla_ba_f": nrm(ks[20], (DEPTH, D_GLA_K), 0.02),
        "gla_wa_b": nrm(ks[21], (DEPTH, GLA_GATE_RANK, D_GLA_K), GLA_GATE_RANK ** -0.5),
        "gla_ba_b": nrm(ks[22], (DEPTH, D_GLA_K), 0.02),
        "gla_norm_w": 1.0 + nrm(ks[23], (DEPTH, GLA_DV), 0.02),
        "pool_w": nrm(ks[24], (DEPTH, POOL_GROUPS, POOL_GROUP, POOL_GROUP), POOL_GROUP ** -0.5),
        "pool_scale": 1.0 + nrm(ks[25], (DEPTH, D_POOL), 0.02),
        "w_br_hy": nrm(ks[26], (DEPTH, D_HY, D_MODEL), D_HY ** -0.5),
        "w_br_gla": nrm(ks[27], (DEPTH, D_GLA_V, D_MODEL), D_GLA_V ** -0.5),
        "w_br_pool": nrm(ks[28], (DEPTH, D_POOL, D_MODEL), D_POOL ** -0.5),
        "w_out": nrm(ks[29], (DEPTH, D_MODEL, D_MODEL), D_MODEL ** -0.5),
        "w_up": nrm(ks[30], (DEPTH, D_MODEL, D_FF), D_MODEL ** -0.5),
        "w_down": nrm(ks[31], (DEPTH, D_FF, D_MODEL), D_FF ** -0.5),
        "norm_final": 1.0 + nrm(ks[32], (D_MODEL,), 0.02),
    }


def reference(x, c, ctx, c_ctx, w_mod, b_mod, norm_mix, norm_ffn, w_in, b_in,
              hy_short_w, hy_short_b, hy_f_w1, hy_f_b1, hy_f_freq, hy_f_w2, hy_f_b2, hy_f_w3, hy_skip,
              gla_wa_f, gla_ba_f, gla_wa_b, gla_ba_b, gla_norm_w,
              pool_w, pool_scale, w_br_hy, w_br_gla, w_br_pool, w_out, w_up, w_down, norm_final):
    B = x.shape[0]
    s_zero = jnp.zeros((B, GLA_HEADS, GLA_DK, GLA_DV), jnp.float32)
    for l in range(DEPTH):
        p = {
            "hy_short_w": hy_short_w[l], "hy_short_b": hy_short_b[l],
            "hy_f_w1": hy_f_w1[l], "hy_f_b1": hy_f_b1[l], "hy_f_freq": hy_f_freq[l],
            "hy_f_w2": hy_f_w2[l], "hy_f_b2": hy_f_b2[l], "hy_f_w3": hy_f_w3[l], "hy_skip": hy_skip[l],
            "gla_wa_f": gla_wa_f[l], "gla_ba_f": gla_ba_f[l], "gla_wa_b": gla_wa_b[l], "gla_ba_b": gla_ba_b[l],
            "gla_norm_w": gla_norm_w[l], "pool_w": pool_w[l], "pool_scale": pool_scale[l],
            "w_br_hy": w_br_hy[l], "w_br_gla": w_br_gla[l], "w_br_pool": w_br_pool[l], "w_out": w_out[l],
        }
        mod_x = (jax.nn.silu(c) @ w_mod[l] + b_mod[l])[:, None, :]
        mod_c = (jax.nn.silu(c_ctx) @ w_mod[l] + b_mod[l])[None, None, :]
        sh1x, sc1x, g1x, sh2x, sc2x, g2x = jnp.split(mod_x, 6, axis=-1)
        sh1c, sc1c, g1c, sh2c, sc2c, g2c = jnp.split(mod_c, 6, axis=-1)

        hc = ada_norm(ctx, norm_mix[l], sh1c, sc1c)
        if l == DEPTH - 1:
            pc = hc @ w_in[l][:, GLA_OFF:POOL_OFF] + b_in[l][GLA_OFF:POOL_OFF]
            _, s_f, s_b = gla_branch(pc, p, s_zero, s_zero)
        else:
            pc = hc @ w_in[l] + b_in[l]
            mix_c, s_f, s_b = token_mixers(pc, p, False, s_zero, s_zero)
            ctx = ctx + g1c * mix_c
            ctx = ctx + g2c * sqrelu_mlp(ada_norm(ctx, norm_ffn[l], sh2c, sc2c), w_up[l], w_down[l])

        hx = ada_norm(x, norm_mix[l], sh1x, sc1x)
        px = hx @ w_in[l] + b_in[l]
        mix_x, _, _ = token_mixers(px, p, True, s_f, s_b)
        x = x + g1x * mix_x
        x = x + g2x * sqrelu_mlp(ada_norm(x, norm_ffn[l], sh2x, sc2x), w_up[l], w_down[l])
    return rms_norm(x, norm_final)
```

```cpp
#include <hip/hip_runtime.h>
#include <hip/hip_cooperative_groups.h>
#include <cstdio>
#include <cstdint>
namespace cg = cooperative_groups;

#define LAS __attribute__((address_space(3)))
typedef unsigned short bf16_t;
typedef short bf16x8 __attribute__((ext_vector_type(8)));
typedef float f32x4 __attribute__((ext_vector_type(4)));
typedef unsigned u32x2 __attribute__((ext_vector_type(2)));
typedef unsigned u32x4 __attribute__((ext_vector_type(4)));

constexpr int NTHREADS = 512;
constexpr int LDS_BYTES = 147456;
constexpr int D = 1024, NB = 32, SEQ = 2048, CTXL = 256;
constexpr int TOKL = NB * SEQ, TOKC = NB * CTXL, TOK = TOKL + TOKC;
constexpr int N_IN = 6688, GLA_OFF = 1536, POOL_OFF = 3104, GATE_OFF = 3616;
constexpr int NTR = 2048, NG = 1792, NGV = 1568, DFF = 4096;
constexpr float EPS = 1e-6f;

constexpr size_t SZ_WT = (size_t)NTR * D * 2, SZ_WG = (size_t)NG * D * 2, SZ_WGATE = (size_t)3072 * D * 2, SZ_WBR = (size_t)1024 * 512 * 2;
constexpr size_t SZ_WOUT = (size_t)D * D * 2, SZ_WUP = (size_t)DFF * D * 2, SZ_WDN = (size_t)D * DFF * 2;
constexpr size_t WS_WT = 0;
constexpr size_t WS_WG = WS_WT + 2 * SZ_WT;
constexpr size_t WS_WGATE = WS_WG + 2 * SZ_WG;
constexpr size_t WS_WBR = WS_WGATE + 2 * SZ_WGATE;
constexpr size_t WS_WOUT = WS_WBR + 6 * SZ_WBR;
constexpr size_t WS_WUP = WS_WOUT + 2 * SZ_WOUT;
constexpr size_t WS_WDN = WS_WUP + 2 * SZ_WUP;
constexpr size_t WS_BIAS = WS_WDN + 2 * SZ_WDN;
constexpr size_t WS_MOD = WS_BIAS + 32768;
constexpr size_t WS_HFL = WS_MOD + (size_t)2 * 33 * 6144 * 4;
constexpr size_t WS_HFC = WS_HFL + (size_t)2 * 4 * 512 * 2048 * 2;
constexpr size_t WS_CTX = WS_HFC + (size_t)4 * 512 * 256 * 2;
constexpr size_t WS_HX = WS_CTX + (size_t)TOKC * D * 4;
constexpr size_t WS_T = WS_HX + (size_t)TOK * D * 2;
constexpr size_t WS_YG = WS_T + (size_t)NTR * TOK * 2;
constexpr size_t WS_PG = WS_YG + (size_t)TOK * 512 * 2;
constexpr size_t WS_OF = WS_PG + (size_t)TOK * NG * 2;
constexpr size_t WS_END = WS_OF + (size_t)2 * TOK * 512 * 2;
constexpr size_t WS_SCR = WS_PG;
constexpr size_t SCR_PER = 1572864;
constexpr size_t SC_MERGED = 0, SC_TRY = 524288, SC_TRP = 786432, SC_SG = 1048576, SC_ST = 1310720, SC_HID = 524288;
static_assert(WS_SCR + 256 * SCR_PER <= WS_END, "scratch");
static_assert(WS_END <= (size_t)1073741824, "ws");

struct Params { const float* in[33]; float* out; unsigned char* ws; };
enum { I_X = 0, I_C, I_CTX, I_CCTX, I_WMOD, I_BMOD, I_NMIX, I_NFFN, I_WIN, I_BIN, I_HSW, I_HSB, I_FW1, I_FB1, I_FFREQ, I_FW2, I_FB2, I_FW3, I_HSKIP,
       I_WAF, I_BAF, I_WAB, I_BAB, I_GNW, I_PW, I_PSC, I_WBH, I_WBG, I_WBP, I_WOUT, I_WUP, I_WDN, I_NFIN };

__device__ __forceinline__ float bf2f(bf16_t h) { return __uint_as_float((unsigned)h << 16); }
__device__ __forceinline__ unsigned cvt_pk_bf16(float lo, float hi) { unsigned r; asm volatile("v_cvt_pk_bf16_f32 %0, %1, %2" : "=v"(r) : "v"(lo), "v"(hi)); return r; }
__device__ __forceinline__ bf16_t f2bf(float f) { return (bf16_t)(cvt_pk_bf16(f, 0.f) & 0xffffu); }
__device__ __forceinline__ float lo16(unsigned u) { return __uint_as_float(u << 16); }
__device__ __forceinline__ float hi16(unsigned u) { return __uint_as_float(u & 0xffff0000u); }
__device__ __forceinline__ float sigmoidf_(float v) { return 1.f / (1.f + __expf(-v)); }
__device__ __forceinline__ unsigned char* opq(unsigned char* p) { asm volatile("" : "+s"(p)); return p; }
__device__ __forceinline__ int tidx() { int t = threadIdx.x; asm volatile("" : "+v"(t)); return t; }
__device__ __forceinline__ int opqi(int v) { asm volatile("" : "+s"(v)); return v; }
__device__ __forceinline__ float wave_sum(float v) {
#pragma unroll
    for (int o = 32; o >= 1; o >>= 1) v += __shfl_xor(v, o);
    return v;
}

constexpr int BK = 64, HALF = 128, HTB = HALF * BK * 2;
__device__ __forceinline__ int lds_byte(int r, int c) { const int st = (r >> 4) * 2 + (c >> 5), rr = r & 15, cc = c & 31, ob = rr * 64 + cc * 2; return st * 1024 + (ob ^ (((ob >> 9) & 1) << 5)); }
__device__ __forceinline__ void stage_rc(int b, int& R, int& C) { const int st = b / 1024, sb = b % 1024, swz = sb ^ (((sb >> 9) & 1) << 5); R = (st >> 1) * 16 + swz / 64; C = (st & 1) * 32 + (swz % 64) / 2; }

template <class Epi>
__device__ __forceinline__ void gemm_unit(LAS unsigned char* lds, const bf16_t* A, int lda, const bf16_t* Bt, int ldb, int K, const Epi& E) {
    const int tid = tidx(), wid = __builtin_amdgcn_readfirstlane(tid >> 6), lane = tid & 63, wr = wid >> 2, wc = wid & 3, fr = lane & 15, fq = lane >> 4;
    const int nt = K / BK;
    unsigned voffA[2], voffB[2];
#pragma unroll
    for (int i = 0; i < 2; ++i) { int R, C; stage_rc(tid * 16 + i * 8192, R, C); voffA[i] = (unsigned)(R * lda + C) * 2u; voffB[i] = (unsigned)(R * ldb + C) * 2u; }
    const size_t kstep = (size_t)(BK * 2);
    const size_t hstepA = (size_t)HALF * lda * 2, hstepB = (size_t)HALF * ldb * 2;
    const unsigned ldsw = (unsigned)wid * 1024u;
    const int aoff = lds_byte(wr * 64 + fr, fq * 8), boff = lds_byte(wc * 32 + fr, fq * 8);
#define G_SA(b, h) (((b) * 2 + (h)) * HTB)
#define G_SB(b, h) ((4 + (b) * 2 + (h)) * HTB)
#define G_STAGE(bufoff, gbase, voff) do { _Pragma("unroll") for (int _i = 0; _i < 2; ++_i) \
        __builtin_amdgcn_global_load_lds((const unsigned*)((const char*)(gbase) + (voff)[_i]), (LAS unsigned*)(lds + (bufoff) + ldsw + _i * 8192), 16, 0, 0); } while (0)
#define G_LDA(dst, b, h) do { _Pragma("unroll") for (int m = 0; m < 4; ++m) _Pragma("unroll") for (int k = 0; k < 2; ++k) dst[m][k] = *(const LAS bf16x8*)(lds + G_SA(b, h) + aoff + m * 2048 + k * 1024); } while (0)
#define G_LDB(dst, b, h) do { _Pragma("unroll") for (int n = 0; n < 2; ++n) _Pragma("unroll") for (int k = 0; k < 2; ++k) dst[n][k] = *(const LAS bf16x8*)(lds + G_SB(b, h) + boff + n * 2048 + k * 1024); } while (0)
#define G_MMA(ai, bj, At, Bt_) do { __builtin_amdgcn_s_setprio(1); _Pragma("unroll") for (int m = 0; m < 4; ++m) _Pragma("unroll") for (int n = 0; n < 2; ++n) _Pragma("unroll") for (int k = 0; k < 2; ++k) \
        acc[ai][bj][m][n] = __builtin_amdgcn_mfma_f32_16x16x32_bf16(Bt_[n][k], At[m][k], acc[ai][bj][m][n], 0, 0, 0); __builtin_amdgcn_s_setprio(0); } while (0)
#define G_WAIT_V(n) asm volatile("s_waitcnt vmcnt(" #n ")" ::: "memory")
#define G_WAIT_L(n) asm volatile("s_waitcnt lgkmcnt(" #n ")" ::: "memory")
#define G_BAR __builtin_amdgcn_s_barrier()
#define G_SCHED __builtin_amdgcn_sched_barrier(0)
    __syncthreads();
    f32x4 acc[2][2][4][2];
#pragma unroll
    for (int a = 0; a < 2; ++a)
#pragma unroll
        for (int b = 0; b < 2; ++b)
#pragma unroll
            for (int m = 0; m < 4; ++m)
#pragma unroll
                for (int n = 0; n < 2; ++n) acc[a][b][m][n] = (f32x4){0.f, 0.f, 0.f, 0.f};
    bf16x8 At[4][2], B0[2][2], B1[2][2];
    const char* cA = (const char*)A; const char* cB = (const char*)Bt;
    G_STAGE(G_SB(0, 0), cB, voffB); G_STAGE(G_SA(0, 0), cA, voffA); G_STAGE(G_SB(0, 1), cB + hstepB, voffB); G_STAGE(G_SA(0, 1), cA + hstepA, voffA);
    if (wr == 1) G_BAR;
    G_WAIT_V(4); G_BAR;
    G_STAGE(G_SB(1, 0), cB + kstep, voffB); G_STAGE(G_SA(1, 0), cA + kstep, voffA); G_STAGE(G_SB(1, 1), cB + hstepB + kstep, voffB);
    G_WAIT_V(6); G_BAR;
    for (int t = 0; t < nt; t += 2) {
        const bool last = (t == nt - 2);
        const char* a1 = cA + (size_t)(t + 1) * kstep;
        const char* a2 = last ? cA : cA + (size_t)(t + 2) * kstep; const char* b2 = last ? cB : cB + (size_t)(t + 2) * kstep;
        const char* a3 = a2 + kstep; const char* b3 = b2 + kstep;
        G_LDB(B0, 0, 0); G_SCHED; G_LDA(At, 0, 0); G_STAGE(G_SA(1, 1), a1 + hstepA, voffA);
        G_WAIT_L(8); G_BAR; G_WAIT_L(0); G_MMA(0, 0, At, B0); G_BAR; G_SCHED;
        G_LDB(B1, 0, 1); G_STAGE(G_SB(0, 0), b2, voffB);
        G_BAR; G_WAIT_L(0); G_MMA(0, 1, At, B1); G_BAR;
        G_LDA(At, 0, 1); G_STAGE(G_SA(0, 0), a2, voffA);
        G_BAR; G_WAIT_L(0); G_MMA(1, 0, At, B0); G_BAR; G_SCHED;
        G_STAGE(G_SB(0, 1), b2 + hstepB, voffB);
        G_WAIT_V(6); G_BAR; G_MMA(1, 1, At, B1); G_BAR;
        G_LDB(B0, 1, 0); G_SCHED; G_LDA(At, 1, 0); G_STAGE(G_SA(0, 1), a2 + hstepA, voffA);
        G_WAIT_L(8); G_BAR; G_WAIT_L(0); G_MMA(0, 0, At, B0); G_BAR; G_SCHED;
        G_LDB(B1, 1, 1); G_STAGE(G_SB(1, 0), b3, voffB);
        G_BAR; G_WAIT_L(0); G_MMA(0, 1, At, B1); G_BAR;
        G_LDA(At, 1, 1); G_STAGE(G_SA(1, 0), a3, voffA);
        G_BAR; G_WAIT_L(0); G_MMA(1, 0, At, B0); G_BAR; G_SCHED;
        G_STAGE(G_SB(1, 1), b3 + hstepB, voffB);
        G_WAIT_V(6); G_BAR; G_MMA(1, 1, At, B1); G_BAR;
    }
    E(acc, wr, wc, fr, fq);
    G_WAIT_V(0);
    if (wr == 0) G_BAR;
    G_BAR;
    __syncthreads();
}

typedef f32x4 AccT[2][2][4][2];
#define EPI_LOOP _Pragma("unroll") for (int ai = 0; ai < 2; ++ai) _Pragma("unroll") for (int m = 0; m < 4; ++m) _Pragma("unroll") for (int bj = 0; bj < 2; ++bj) _Pragma("unroll") for (int n = 0; n < 2; ++n)
#define EPI_ROW (ai * 128 + wr * 64 + m * 16 + fr)
#define EPI_COL (bj * 128 + wc * 32 + n * 16 + 4 * fq)

struct EpiStoreBf16 {
    bf16_t* O; size_t ldo; const float* bias; bool rowb;
    __device__ __forceinline__ void operator()(const AccT& acc, int wr, int wc, int fr, int fq) const {
        EPI_LOOP { const int r = EPI_ROW, c = EPI_COL; f32x4 v = acc[ai][bj][m][n];
            if (rowb) { const float b = bias[r]; v += b; } else { v += *(const f32x4*)(bias + c); }
            u32x2 w; w.x = cvt_pk_bf16(v[0], v[1]); w.y = cvt_pk_bf16(v[2], v[3]); *(u32x2*)(O + (size_t)r * ldo + c) = w; }
    }
};
struct EpiGate {
    f32x4* SG; const float* bias;
    __device__ __forceinline__ void operator()(const AccT& acc, int wr, int wc, int fr, int fq) const {
        int i = 0; f32x4* SGt = SG + (size_t)tidx() * 32;
        EPI_LOOP { const int c = EPI_COL; f32x4 v = acc[ai][bj][m][n] + *(const f32x4*)(bias + c);
            v[0] = sigmoidf_(v[0]); v[1] = sigmoidf_(v[1]); v[2] = sigmoidf_(v[2]); v[3] = sigmoidf_(v[3]);
            SGt[i] = v; ++i; }
    }
};
struct EpiBranch {
    const f32x4* SG; f32x4* ST; bf16_t* MG; int first, last;
    __device__ __forceinline__ void operator()(const AccT& acc, int wr, int wc, int fr, int fq) const {
        int i = 0; const f32x4* SGt = SG + (size_t)tidx() * 32; f32x4* STt = ST + (size_t)tidx() * 32;
        EPI_LOOP { const int r = EPI_ROW, c = EPI_COL;
            f32x4 v = acc[ai][bj][m][n] * SGt[i];
            if (!first) v += STt[i];
            if (last) { u32x2 w; w.x = cvt_pk_bf16(v[0], v[1]); w.y = cvt_pk_bf16(v[2], v[3]); *(u32x2*)(MG + (size_t)r * 1024 + c) = w; }
            else STt[i] = v;
            ++i; }
    }
};
struct EpiResid {
    const float* xsrc; float* xdst; const float* gate;
    __device__ __forceinline__ void operator()(const AccT& acc, int wr, int wc, int fr, int fq) const {
        EPI_LOOP { const int r = EPI_ROW, c = EPI_COL; const f32x4 g = *(const f32x4*)(gate + c); const f32x4 xo = *(const f32x4*)(xsrc + (size_t)r * 1024 + c);
            *(f32x4*)(xdst + (size_t)r * 1024 + c) = xo + g * acc[ai][bj][m][n]; }
    }
};
struct EpiSqrelu {
    bf16_t* H; int ldh;
    __device__ __forceinline__ void operator()(const AccT& acc, int wr, int wc, int fr, int fq) const {
        EPI_LOOP { const int r = EPI_ROW, c = EPI_COL; f32x4 v = acc[ai][bj][m][n];
#pragma unroll
            for (int j = 0; j < 4; ++j) { const float t = fmaxf(v[j], 0.f); v[j] = t * t; }
            u32x2 w; w.x = cvt_pk_bf16(v[0], v[1]); w.y = cvt_pk_bf16(v[2], v[3]); *(u32x2*)(H + (size_t)r * ldh + c) = w; }
    }
};

__device__ void tconv(const float* src, int ld, int c0, int nvalid, int ncols, int K, bf16_t* dst, LAS float* tile) {
    const int tid = tidx(), ntn = ncols / 64, ntile = ntn * (K / 64);
    for (int t = blockIdx.x; t < ntile; t += gridDim.x) {
        const int k0 = (t / ntn) * 64, n0 = (t % ntn) * 64;
        __syncthreads();
#pragma unroll
        for (int i = 0; i < 8; ++i) { const int k = i * 8 + (tid >> 6), n = tid & 63;
            tile[k * 65 + n] = (n0 + n < nvalid) ? src[(size_t)(k0 + k) * ld + c0 + n0 + n] : 0.f; }
        __syncthreads();
        const int n = tid >> 3, kc = (tid & 7) * 8;
        u32x4 w;
        w.x = cvt_pk_bf16(tile[(kc + 0) * 65 + n], tile[(kc + 1) * 65 + n]); w.y = cvt_pk_bf16(tile[(kc + 2) * 65 + n], tile[(kc + 3) * 65 + n]);
        w.z = cvt_pk_bf16(tile[(kc + 4) * 65 + n], tile[(kc + 5) * 65 + n]); w.w = cvt_pk_bf16(tile[(kc + 6) * 65 + n], tile[(kc + 7) * 65 + n]);
        *(u32x4*)(dst + (size_t)(n0 + n) * K + k0 + kc) = w;
    }
    __syncthreads();
}

__device__ void job_poolcomb(const Params& p, int l) {
    const float* pw = p.in[I_PW] + (size_t)l * 4 * 128 * 128; const float* sc = p.in[I_PSC] + l * 512; const float* wb = p.in[I_WBP] + (size_t)l * 512 * 1024;
    bf16_t* dst = (bf16_t*)(p.ws + WS_WBR + (size_t)(l * 3 + 2) * SZ_WBR);
    for (int idx = blockIdx.x * NTHREADS + tidx(); idx < 512 * 1024; idx += gridDim.x * NTHREADS) {
        const int n = idx & 1023, k = idx >> 10, g = k >> 7, c = k & 127;
        float a = 0.f;
        for (int d = 0; d < 128; ++d) a += pw[(g * 128 + c) * 128 + d] * sc[g * 128 + d] * wb[(size_t)(g * 128 + d) * 1024 + n];
        dst[(size_t)n * 512 + k] = f2bf(a);
    }
}

__device__ void job_bias(const Params& p) {
    float* bias = (float*)(p.ws + WS_BIAS);
    for (int idx = blockIdx.x * NTHREADS + tidx(); idx < 2 * (NTR + NG); idx += gridDim.x * NTHREADS) {
        const int l = idx / (NTR + NG), j = idx % (NTR + NG); const float* b = p.in[I_BIN] + l * N_IN;
        float v;
        if (j < 1536) v = b[j]; else if (j < NTR) v = b[POOL_OFF + (j - 1536)]; else { const int q = j - NTR; v = q < NGV ? b[GLA_OFF + q] : 0.f; }
        bias[idx] = v;
    }
}

__device__ void job_mod(const Params& p, LAS float* sil) {
    if (blockIdx.x >= 192) return;
    const int tid = tidx();
    __syncthreads();
    for (int idx = tid; idx < 33 * 1024; idx += NTHREADS) { const int r = idx >> 10, k = idx & 1023; const float v = r < 32 ? p.in[I_C][r * 1024 + k] : p.in[I_CCTX][k]; sil[idx] = v / (1.f + expf(-v)); }
    __syncthreads();
    float* mod = (float*)(p.ws + WS_MOD);
    for (int it = blockIdx.x; it < 192; it += gridDim.x) {
        const int l = it / 96, n = (it % 96) * 64 + (tid & 63), rg = tid >> 6;
        const float* w = p.in[I_WMOD] + (size_t)l * 1024 * 6144 + n;
        float a0 = 0.f, a1 = 0.f, a2 = 0.f, a3 = 0.f, a4 = 0.f; const int r4 = (rg == 0) ? 32 : 0;
#pragma unroll 8
        for (int k = 0; k < 1024; ++k) { const float wv = w[(size_t)k * 6144];
            a0 += sil[rg * 1024 + k] * wv; a1 += sil[(rg + 8) * 1024 + k] * wv; a2 += sil[(rg + 16) * 1024 + k] * wv; a3 += sil[(rg + 24) * 1024 + k] * wv; a4 += sil[r4 * 1024 + k] * wv; }
        const float bm = p.in[I_BMOD][l * 6144 + n];
        float* o = mod + (size_t)l * 33 * 6144 + n;
        o[(size_t)rg * 6144] = a0 + bm; o[(size_t)(rg + 8) * 6144] = a1 + bm; o[(size_t)(rg + 16) * 6144] = a2 + bm; o[(size_t)(rg + 24) * 6144] = a3 + bm;
        if (rg == 0) o[(size_t)32 * 6144] = a4 + bm;
    }
    __syncthreads();
}

__device__ void job_filters(const Params& p, LAS unsigned char* lds) {
    LAS float* a1 = (LAS float*)lds;
    LAS float* a2 = (LAS float*)(lds + 16384);
    LAS bf16_t* oT = (LAS bf16_t*)(lds + 16384 + 16640);
    const int tid = tidx();
    const int nitems = (32 + 4 + 32) * 4;
    for (int it = blockIdx.x; it < nitems; it += gridDim.x) {
        const int oc = it & 3; int rt = it >> 2; int l, L, t0; bf16_t* dst;
        if (rt < 32) { l = 0; L = 2048; t0 = rt * 64; dst = (bf16_t*)(p.ws + WS_HFL); }
        else if (rt < 36) { l = 0; L = 256; t0 = (rt - 32) * 64; dst = (bf16_t*)(p.ws + WS_HFC); }
        else { l = 1; L = 2048; t0 = (rt - 36) * 64; dst = (bf16_t*)(p.ws + WS_HFL) + (size_t)4 * 512 * 2048; }
        const float* w1 = p.in[I_FW1] + l * 17 * 64; const float* b1 = p.in[I_FB1] + l * 64; const float* fq = p.in[I_FFREQ] + l * 64;
        const float* w2 = p.in[I_FW2] + l * 64 * 64; const float* b2 = p.in[I_FB2] + l * 64; const float* w3 = p.in[I_FW3] + (size_t)l * 64 * 2048;
        __syncthreads();
        { const int row = tid >> 3, jg = (tid & 7) * 8; const float t = (float)(t0 + row); float z[17];
          z[0] = t / (float)L;
#pragma unroll
          for (int bnd = 1; bnd <= 8; ++bnd) { const float ang = (6.283185307179586f / (float)L) * t * (float)bnd; z[bnd] = cosf(ang); z[8 + bnd] = sinf(ang); }
#pragma unroll
          for (int j = 0; j < 8; ++j) { float s = b1[jg + j];
#pragma unroll
              for (int i = 0; i < 17; ++i) s += z[i] * w1[i * 64 + jg + j];
              a1[row * 64 + jg + j] = sinf(fq[jg + j] * s); } }
        __syncthreads();
        { const int row = tid >> 3, jg = (tid & 7) * 8;
#pragma unroll
          for (int j = 0; j < 8; ++j) { float s = b2[jg + j];
              for (int i = 0; i < 64; ++i) s += a1[row * 64 + i] * w2[i * 64 + jg + j];
              a2[row * 65 + jg + j] = sinf(fq[jg + j] * s); } }
        __syncthreads();
        { const int o = oc * 512 + tid, c = o & 511; float wreg[64];
#pragma unroll
          for (int j = 0; j < 64; ++j) wreg[j] = w3[(size_t)j * 2048 + o];
          const float delta = 3.0701134573253943f + (float)c * ((15.350567286626972f - 3.0701134573253943f) / 511.f);
          for (int row = 0; row < 64; ++row) { float s = 0.f;
#pragma unroll
              for (int j = 0; j < 64; ++j) s += a2[row * 65 + j] * wreg[j];
              const float win = expf(-((float)(t0 + row) / (float)L) * delta);
              oT[tid * 72 + row] = f2bf(s * win); } }
        __syncthreads();
        for (int q = tid; q < 4096; q += NTHREADS) { const int ol = q >> 3, ch = (q & 7) * 8; const int o = oc * 512 + ol, dir = o >> 10, ord = (o >> 9) & 1, c = o & 511;
            const u32x4 w = *(const LAS u32x4*)(oT + ol * 72 + ch);
            *(u32x4*)(dst + ((size_t)((ord * 2 + dir) * 512 + c)) * L + t0 + ch) = w; }
    }
    __syncthreads();
}

__device__ __forceinline__ void ada_row(const float* x, const float* g, const float* sh, const float* sc, bf16_t* dst, float* fdst, int lane) {
    f32x4 v[4]; float ss = 0.f;
#pragma unroll
    for (int i = 0; i < 4; ++i) { v[i] = *(const f32x4*)(x + i * 256 + lane * 4); ss += v[i][0] * v[i][0] + v[i][1] * v[i][1] + v[i][2] * v[i][2] + v[i][3] * v[i][3]; }
    ss = wave_sum(ss);
    const float inv = rsqrtf(ss * (1.f / 1024.f) + EPS);
#pragma unroll
    for (int i = 0; i < 4; ++i) { const int c = i * 256 + lane * 4; const f32x4 gg = *(const f32x4*)(g + c); f32x4 y = v[i] * inv * gg;
        if (sh) { const f32x4 s1 = *(const f32x4*)(sc + c), s0 = *(const f32x4*)(sh + c); y = y * (1.f + s1) + s0;
            u32x2 w; w.x = cvt_pk_bf16(y[0], y[1]); w.y = cvt_pk_bf16(y[2], y[3]); *(u32x2*)(dst + c) = w; }
        else *(f32x4*)(fdst + c) = y; }
}

__device__ void hyena_item(const Params& p, int l, int c, int b, bool ctx, LAS float* lf) {
    const int L = ctx ? 256 : 2048, tid = tidx();
    LAS float* g0 = lf; LAS float* g1 = lf + 2 * L; LAS float* u = lf + 4 * L; LAS float* x1c = lf + 5 * L; LAS float* x2c = lf + 6 * L; LAS float* z1 = lf + 7 * L;
    const bf16_t* hf = ctx ? (const bf16_t*)(p.ws + WS_HFC) : (const bf16_t*)(p.ws + WS_HFL) + (size_t)l * 4 * 512 * 2048;
    bf16_t* T = (bf16_t*)(p.ws + WS_T);
    const size_t tokb = ctx ? (size_t)TOKL + (size_t)b * 256 : (size_t)b * 2048;
    __syncthreads();
    for (int t = tid; t < L; t += NTHREADS) {
#pragma unroll
        for (int ord = 0; ord < 2; ++ord) { LAS float* g = ord ? g1 : g0;
            g[L + t] = bf2f(hf[((size_t)((ord * 2 + 0) * 512 + c)) * L + t]);
            if (t >= 1) g[L - t] = bf2f(hf[((size_t)((ord * 2 + 1) * 512 + c)) * L + t]); }
        if (t == 0) { g0[0] = 0.f; g1[0] = 0.f; }
#pragma unroll
        for (int part = 0; part < 3; ++part) { const int cc = part * 512 + c; const bf16_t* row = T + (size_t)cc * TOK + tokb;
            const float* sw = p.in[I_HSW] + (size_t)l * 3 * 1536; const float bb = p.in[I_HSB][l * 1536 + cc];
            const float xm = t > 0 ? bf2f(row[t - 1]) : 0.f, x0 = bf2f(row[t]), xp = t < L - 1 ? bf2f(row[t + 1]) : 0.f;
            const float v = sw[cc] * xm + sw[1536 + cc] * x0 + sw[3072 + cc] * xp + bb;
            if (part == 0) x1c[t] = v; else if (part == 1) x2c[t] = v; else u[t] = v; }
    }
    __syncthreads();
    const float sk0 = p.in[I_HSKIP][(l * 2 + 0) * 512 + c], sk1 = p.in[I_HSKIP][(l * 2 + 1) * 512 + c];
    if (tid < L) {
        const int nq = ctx ? 1 : 4;
        float acc[4] = {0.f, 0.f, 0.f, 0.f};
        for (int s = 0; s < L; ++s) { const float us = u[s];
#pragma unroll
            for (int q = 0; q < 4; ++q) if (q < nq) acc[q] += g0[L + tid + q * 512 - s] * us; }
#pragma unroll
        for (int q = 0; q < 4; ++q) if (q < nq) { const int t = tid + q * 512; z1[t] = x1c[t] * (acc[q] + sk0 * u[t]); }
    }
    __syncthreads();
    if (tid < L) {
        const int nq = ctx ? 1 : 4;
        float acc[4] = {0.f, 0.f, 0.f, 0.f};
        for (int s = 0; s < L; ++s) { const float us = z1[s];
#pragma unroll
            for (int q = 0; q < 4; ++q) if (q < nq) acc[q] += g1[L + tid + q * 512 - s] * us; }
        bf16_t* orow = T + (size_t)c * TOK + tokb;
#pragma unroll
        for (int q = 0; q < 4; ++q) if (q < nq) { const int t = tid + q * 512; orow[t] = f2bf(x2c[t] * (acc[q] + sk1 * z1[t])); }
    }
    __syncthreads();
}

__device__ void gla_item(const Params& p, int l, int b, int h, int dir, LAS float* lf) {
    const int tid = tidx(), qd = tid & 3, dv = tid >> 2;
    LAS float* qL = lf; LAS float* kL = lf + 2048; LAS float* aL = lf + 4096; LAS float* vL = lf + 6144; LAS float* oL = lf + 10240; LAS float* waL = lf + 14336; LAS float* baL = lf + 15360;
    const bf16_t* PG = (const bf16_t*)(p.ws + WS_PG);
    bf16_t* O = (bf16_t*)(p.ws + WS_OF) + (size_t)dir * TOK * 512;
    const float* wa = (dir ? p.in[I_WAB] : p.in[I_WAF]) + l * 16 * 256; const float* ba = (dir ? p.in[I_BAB] : p.in[I_BAF]) + l * 256;
    __syncthreads();
    for (int i = tid; i < 1024; i += NTHREADS) waL[i] = wa[(i >> 6) * 256 + h * 64 + (i & 63)];
    if (tid < 64) baL[tid] = ba[h * 64 + tid];
    float S[16];
#pragma unroll
    for (int i = 0; i < 16; ++i) S[i] = 0.f;
    const int sp = tid >> 4, sc4 = (tid & 15) * 4, sc8 = (tid & 15) * 8;
    for (int ck = 0; ck < 72; ++ck) {
        const int P = ck * 32 + sp; size_t row;
        if (P < 256) row = (size_t)TOKL + b * 256 + (dir ? 255 - P : P); else { const int tl = P - 256; row = (size_t)b * 2048 + (dir ? 2047 - tl : tl); }
        const bf16_t* pr = PG + row * NG;
        __syncthreads();
        { const u32x2 wq = *(const u32x2*)(pr + h * 64 + sc4), wk = *(const u32x2*)(pr + 256 + h * 64 + sc4);
          *(LAS f32x4*)(qL + sp * 64 + sc4) = (f32x4){lo16(wq.x) * 0.125f, hi16(wq.x) * 0.125f, lo16(wq.y) * 0.125f, hi16(wq.y) * 0.125f};
          *(LAS f32x4*)(kL + sp * 64 + sc4) = (f32x4){lo16(wk.x), hi16(wk.x), lo16(wk.y), hi16(wk.y)};
          const u32x4 wv = *(const u32x4*)(pr + 512 + h * 128 + sc8);
          *(LAS f32x4*)(vL + sp * 128 + sc8) = (f32x4){lo16(wv.x), hi16(wv.x), lo16(wv.y), hi16(wv.y)};
          *(LAS f32x4*)(vL + sp * 128 + sc8 + 4) = (f32x4){lo16(wv.z), hi16(wv.z), lo16(wv.w), hi16(wv.w)};
          const u32x4 g0 = *(const u32x4*)(pr + 1536 + dir * 16), g1 = *(const u32x4*)(pr + 1536 + dir * 16 + 8);
          float gt[16] = {lo16(g0.x), hi16(g0.x), lo16(g0.y), hi16(g0.y), lo16(g0.z), hi16(g0.z), lo16(g0.w), hi16(g0.w),
                          lo16(g1.x), hi16(g1.x), lo16(g1.y), hi16(g1.y), lo16(g1.z), hi16(g1.z), lo16(g1.w), hi16(g1.w)};
#pragma unroll
          for (int j = 0; j < 4; ++j) { float z = baL[sc4 + j];
#pragma unroll
              for (int r = 0; r < 16; ++r) z += gt[r] * waL[r * 64 + sc4 + j];
              const float ls = -(fmaxf(-z, 0.f) + log1pf(expf(-fabsf(z))));
              aL[sp * 64 + sc4 + j] = expf(ls * (1.f / 16.f)); } }
        __syncthreads();
        for (int pos = 0; pos < 32; ++pos) {
            const float vv = vL[pos * 128 + dv]; float part = 0.f;
#pragma unroll
            for (int i4 = 0; i4 < 4; ++i4) { const f32x4 aa = *(const LAS f32x4*)(aL + pos * 64 + qd * 16 + i4 * 4), kk = *(const LAS f32x4*)(kL + pos * 64 + qd * 16 + i4 * 4), qq = *(const LAS f32x4*)(qL + pos * 64 + qd * 16 + i4 * 4);
#pragma unroll
                for (int j = 0; j < 4; ++j) { S[i4 * 4 + j] = aa[j] * S[i4 * 4 + j] + kk[j] * vv; part += qq[j] * S[i4 * 4 + j]; } }
            part += __shfl_xor(part, 1); part += __shfl_xor(part, 2);
            if (qd == 0) oL[pos * 128 + dv] = part;
        }
        __syncthreads();
        { const f32x4 o0 = *(const LAS f32x4*)(oL + sp * 128 + sc8), o1 = *(const LAS f32x4*)(oL + sp * 128 + sc8 + 4);
          u32x4 w; w.x = cvt_pk_bf16(o0[0], o0[1]); w.y = cvt_pk_bf16(o0[2], o0[3]); w.z = cvt_pk_bf16(o1[0], o1[1]); w.w = cvt_pk_bf16(o1[2], o1[3]);
          *(u32x4*)(O + row * 512 + h * 128 + sc8) = w; }
    }
    __syncthreads();
}

template <int W>
__device__ __forceinline__ void pool2d_wave(bf16_t* base, int lane) {
    float u[32], pv[33];
#pragma unroll
    for (int r = 0; r < 32; ++r) u[r] = bf2f(base[r * 64 + lane]);
    pv[0] = 0.f;
#pragma unroll
    for (int r = 0; r < 32; ++r) pv[r + 1] = pv[r] + u[r];
    const int cl = max(lane - W / 2, 0), chh = min(lane - W / 2 + W, 64);
#pragma unroll
    for (int r = 0; r < 32; ++r) {
        const int rl = (r - W / 2) < 0 ? 0 : (r - W / 2), rh = (r - W / 2 + W) > 32 ? 32 : (r - W / 2 + W);
        float x = pv[rh] - pv[rl];
#pragma unroll
        for (int d = 1; d < 64; d <<= 1) { const float y = __shfl_up(x, d); if (lane >= d) x += y; }
        const float hi = __shfl(x, chh - 1), lo = __shfl(x, cl > 0 ? cl - 1 : 0);
        const float s = hi - (cl > 0 ? lo : 0.f);
        const float cnt = (float)((rh - rl) * (chh - cl));
        base[r * 64 + lane] = f2bf(s / cnt - u[r]);
    }
}
__device__ __forceinline__ void pool1d_wave(bf16_t* base, int lane, int W) {
    float u[4], P[4];
#pragma unroll
    for (int j = 0; j < 4; ++j) u[j] = bf2f(base[j * 64 + lane]);
    float off = 0.f;
#pragma unroll
    for (int j = 0; j < 4; ++j) { float x = u[j];
#pragma unroll
        for (int d = 1; d < 64; d <<= 1) { const float y = __shfl_up(x, d); if (lane >= d) x += y; }
        P[j] = x + off; off += __shfl(x, 63); }
#pragma unroll
    for (int j = 0; j < 4; ++j) { const int t = j * 64 + lane; const int lo = max(t - W / 2, 0), hi = min(t - W / 2 + W, 256);
        const int ih = hi - 1, il = lo > 0 ? lo - 1 : 0;
        float vh = 0.f, vl = 0.f;
#pragma unroll
        for (int s = 0; s < 4; ++s) { const float a = __shfl(P[s], ih & 63), bq = __shfl(P[s], il & 63); if ((ih >> 6) == s) vh = a; if ((il >> 6) == s) vl = bq; }
        const float sum = vh - (lo > 0 ? vl : 0.f);
        u[j] = sum / (float)(hi - lo) - u[j]; }
#pragma unroll
    for (int j = 0; j < 4; ++j) base[j * 64 + lane] = f2bf(u[j]);
}

__global__ void __launch_bounds__(NTHREADS, 2) mega(Params p) {
    extern __shared__ __attribute__((aligned(16))) unsigned char lds_raw[];
    LAS unsigned char* lds = (LAS unsigned char*)lds_raw;
    LAS float* lf = (LAS float*)lds;
    cg::grid_group grid = cg::this_grid();
    const int G = gridDim.x, bid = blockIdx.x;
#define WSPTRS const int tid = tidx(), lane = tid & 63, wid = tid >> 6; (void)lane; (void)wid; unsigned char* ws = opq(p.ws); bf16_t* HX = (bf16_t*)(ws + WS_HX); bf16_t* T = (bf16_t*)(ws + WS_T); bf16_t* YG = (bf16_t*)(ws + WS_YG); bf16_t* PG = (bf16_t*)(ws + WS_PG); \
    float* CTXS = (float*)(ws + WS_CTX); const float* MOD = (const float*)(ws + WS_MOD); const float* BIAS = (const float*)(ws + WS_BIAS); (void)HX; (void)T; (void)YG; (void)PG; (void)CTXS; (void)MOD; (void)BIAS;

    for (int l = 0; l < 2; ++l) {
        unsigned char* ws = opq(p.ws);
        const float* win = p.in[I_WIN] + (size_t)l * D * N_IN;
        bf16_t* wt = (bf16_t*)(ws + WS_WT + l * SZ_WT);
        tconv(win, N_IN, 0, 1536, 1536, D, wt, lf);
        tconv(win, N_IN, POOL_OFF, 512, 512, D, wt + (size_t)1536 * D, lf);
        tconv(win, N_IN, GLA_OFF, NGV, NG, D, (bf16_t*)(ws + WS_WG + l * SZ_WG), lf);
        tconv(win, N_IN, GATE_OFF, 3072, 3072, D, (bf16_t*)(ws + WS_WGATE + l * SZ_WGATE), lf);
        tconv(p.in[I_WBH] + (size_t)l * 512 * 1024, 1024, 0, 1024, 1024, 512, (bf16_t*)(ws + WS_WBR + (size_t)(l * 3 + 0) * SZ_WBR), lf);
        tconv(p.in[I_WBG] + (size_t)l * 512 * 1024, 1024, 0, 1024, 1024, 512, (bf16_t*)(ws + WS_WBR + (size_t)(l * 3 + 1) * SZ_WBR), lf);
        tconv(p.in[I_WOUT] + (size_t)l * D * D, D, 0, D, D, D, (bf16_t*)(ws + WS_WOUT + l * SZ_WOUT), lf);
        tconv(p.in[I_WUP] + (size_t)l * D * DFF, DFF, 0, DFF, DFF, D, (bf16_t*)(ws + WS_WUP + l * SZ_WUP), lf);
        tconv(p.in[I_WDN] + (size_t)l * DFF * D, D, 0, D, D, DFF, (bf16_t*)(ws + WS_WDN + l * SZ_WDN), lf);
        job_poolcomb(p, l);
    }
    job_bias(p);
    job_mod(p, lf);
    job_filters(p, lds);
    grid.sync();

    { WSPTRS
    for (int row = bid * 8 + wid; row < TOK; row += G * 8) {
        const bool isl = row < TOKL; const float* x = isl ? p.in[I_X] + (size_t)row * D : p.in[I_CTX] + (size_t)(row - TOKL) * D;
        const float* mr = MOD + (size_t)(isl ? row >> 11 : 32) * 6144;
        ada_row(x, p.in[I_NMIX], mr, mr + 1024, HX + (size_t)row * D, nullptr, lane);
    } }
    grid.sync();

    for (int l_ = 0; l_ < 2; ++l_) {
        const int l = opqi(l_);
        { WSPTRS
            const int ntokt = l == 0 ? 288 : 256;
            const int nA = ntokt * 8, nB = 288 * 7;
            const bf16_t* wt = (const bf16_t*)(ws + WS_WT + l * SZ_WT); const bf16_t* wg = (const bf16_t*)(ws + WS_WG + l * SZ_WG);
            const float* biasT = BIAS + l * (NTR + NG); const float* biasG = biasT + NTR;
            for (int u = bid; u < nA + nB; u += G) {
                if (u < nA) { const int tt = u >> 3, ct = u & 7;
                    EpiStoreBf16 E{T + (size_t)(ct * 256) * TOK + (size_t)tt * 256, (size_t)TOK, biasT + ct * 256, true};
                    gemm_unit(lds, wt + (size_t)(ct * 256) * D, D, HX + (size_t)(tt * 256) * D, D, D, E); }
                else { const int v = u - nA, tt = v / 7, nt = v % 7;
                    EpiStoreBf16 E{PG + (size_t)(tt * 256) * NG + nt * 256, (size_t)NG, biasG + nt * 256, false};
                    gemm_unit(lds, HX + (size_t)(tt * 256) * D, D, wg + (size_t)(nt * 256) * D, D, D, E); }
            }
        }
        grid.sync();
        { WSPTRS
            for (int it = bid; it < 256; it += G) gla_item(p, l, it >> 3, (it >> 1) & 3, it & 1, lf);
            const int nhy = l == 0 ? 32768 : 16384;
            for (int it = bid; it < nhy; it += G) { const bool cx = it >= 16384; const int j = it & 16383; hyena_item(p, l, j >> 5, j & 31, cx, lf); }
            const int npl = l == 0 ? 32768 : 16384;
            for (int it = bid * 8 + wid; it < npl; it += G * 8) { const bool cx = it >= 16384; const int j = it & 16383, ch = j >> 5, b = j & 31, g = ch >> 7;
                bf16_t* base = T + (size_t)(1536 + ch) * TOK + (cx ? (size_t)TOKL + b * 256 : (size_t)b * 2048);
                if (cx) pool1d_wave(base, lane, 2 << g);
                else { if (g == 0) pool2d_wave<2>(base, lane); else if (g == 1) pool2d_wave<4>(base, lane); else if (g == 2) pool2d_wave<8>(base, lane); else pool2d_wave<16>(base, lane); } }
        }
        grid.sync();
        {
            WSPTRS
            const bf16_t* OF = (const bf16_t*)(ws + WS_OF); const bf16_t* OB = OF + (size_t)TOK * 512; const float* nw = p.in[I_GNW] + l * 128;
            const int ntok = l == 0 ? TOK : TOKL;
            for (int row = bid * 8 + wid; row < ntok; row += G * 8) {
                const u32x4 a = *(const u32x4*)(OF + (size_t)row * 512 + lane * 8), bq = *(const u32x4*)(OB + (size_t)row * 512 + lane * 8), rr = *(const u32x4*)(PG + (size_t)row * NG + 1024 + lane * 8);
                float o[8] = {lo16(a.x) + lo16(bq.x), hi16(a.x) + hi16(bq.x), lo16(a.y) + lo16(bq.y), hi16(a.y) + hi16(bq.y), lo16(a.z) + lo16(bq.z), hi16(a.z) + hi16(bq.z), lo16(a.w) + lo16(bq.w), hi16(a.w) + hi16(bq.w)};
                float r[8] = {lo16(rr.x), hi16(rr.x), lo16(rr.y), hi16(rr.y), lo16(rr.z), hi16(rr.z), lo16(rr.w), hi16(rr.w)};
                float ss = 0.f;
#pragma unroll
                for (int j = 0; j < 8; ++j) ss += o[j] * o[j];
                ss += __shfl_xor(ss, 1); ss += __shfl_xor(ss, 2); ss += __shfl_xor(ss, 4); ss += __shfl_xor(ss, 8);
                const float inv = rsqrtf(ss * (1.f / 128.f) + EPS);
                float y[8];
#pragma unroll
                for (int j = 0; j < 8; ++j) y[j] = o[j] * inv * nw[(lane & 15) * 8 + j] * (r[j] * sigmoidf_(r[j]));
                u32x4 w; w.x = cvt_pk_bf16(y[0], y[1]); w.y = cvt_pk_bf16(y[2], y[3]); w.z = cvt_pk_bf16(y[4], y[5]); w.w = cvt_pk_bf16(y[6], y[7]);
                *(u32x4*)(YG + (size_t)row * 512 + lane * 8) = w;
            }
        }
        grid.sync();
        {
            const int ntile = l == 0 ? 288 : 256;
            for (int tt_ = bid; tt_ < ntile; tt_ += G) {
            const int tt = opqi(tt_);
            WSPTRS
            const float* modl = MOD + (size_t)l * 33 * 6144;
            unsigned char* scr = ws + WS_SCR + (size_t)bid * SCR_PER;
            bf16_t* MERGED = (bf16_t*)(scr + SC_MERGED); bf16_t* TRY = (bf16_t*)(scr + SC_TRY); bf16_t* TRP = (bf16_t*)(scr + SC_TRP);
            f32x4* SG = (f32x4*)(scr + SC_SG); f32x4* ST = (f32x4*)(scr + SC_ST); bf16_t* HID = (bf16_t*)(scr + SC_HID);
            const bf16_t* wgate = (const bf16_t*)(ws + WS_WGATE + l * SZ_WGATE); const bf16_t* wbr = (const bf16_t*)(ws + WS_WBR + (size_t)l * 3 * SZ_WBR);
            const bf16_t* wout = (const bf16_t*)(ws + WS_WOUT + l * SZ_WOUT); const bf16_t* wup = (const bf16_t*)(ws + WS_WUP + l * SZ_WUP); const bf16_t* wdn = (const bf16_t*)(ws + WS_WDN + l * SZ_WDN);
            const float* bgate = p.in[I_BIN] + l * N_IN + GATE_OFF;
            {
                const size_t tok0 = (size_t)tt * 256; const bool isl = tt < 256;
                const float* mr = modl + (size_t)(isl ? tt >> 3 : 32) * 6144;
                const float* xsrc = isl ? (l == 0 ? p.in[I_X] + tok0 * D : p.out + tok0 * D) : p.in[I_CTX] + (tok0 - TOKL) * D;
                float* xdst = isl ? p.out + tok0 * D : CTXS + (tok0 - TOKL) * D;
                LAS bf16_t* tl = (LAS bf16_t*)lds;
                for (int which = 0; which < 2; ++which) { const bf16_t* src = T + (size_t)(which ? 1536 : 0) * TOK + tok0; bf16_t* dst = which ? TRP : TRY;
                    for (int ctile = 0; ctile < 8; ++ctile) {
                        __syncthreads();
#pragma unroll
                        for (int i = 0; i < 4; ++i) { const int idx = tid + i * NTHREADS, c = idx >> 5, t8 = (idx & 31) * 8;
                            *(LAS u32x4*)(tl + c * 264 + t8) = *(const u32x4*)(src + (size_t)(ctile * 64 + c) * TOK + t8); }
                        __syncthreads();
#pragma unroll
                        for (int i = 0; i < 4; ++i) { const int idx = tid + i * NTHREADS, tk = idx >> 3, c8 = (idx & 7) * 8; unsigned w[4];
#pragma unroll
                            for (int j = 0; j < 4; ++j) w[j] = (unsigned)tl[(c8 + 2 * j) * 264 + tk] | ((unsigned)tl[(c8 + 2 * j + 1) * 264 + tk] << 16);
                            *(u32x4*)(dst + (size_t)tk * 512 + ctile * 64 + c8) = (u32x4){w[0], w[1], w[2], w[3]}; }
                    } }
                __syncthreads();
                for (int nt = 0; nt < 4; ++nt)
                    for (int X = 0; X < 3; ++X) {
                        EpiGate Eg{SG, bgate + X * 1024 + nt * 256};
                        gemm_unit(lds, HX + tok0 * D, D, wgate + (size_t)(X * 1024 + nt * 256) * D, D, D, Eg);
                        const bf16_t* ya = X == 0 ? TRY : (X == 1 ? YG + tok0 * 512 : TRP);
                        EpiBranch Eb{SG, ST, MERGED + nt * 256, X == 0, X == 2};
                        gemm_unit(lds, ya, 512, wbr + (size_t)X * 1024 * 512 + (size_t)(nt * 256) * 512, 512, 512, Eb);
                    }
                for (int nt = 0; nt < 4; ++nt) { EpiResid Er{xsrc + nt * 256, xdst + nt * 256, mr + 2048 + nt * 256};
                    gemm_unit(lds, MERGED, 1024, wout + (size_t)(nt * 256) * D, D, D, Er); }
                for (int r = wid; r < 256; r += 8) ada_row(xdst + (size_t)r * D, p.in[I_NFFN] + l * D, mr + 3072, mr + 4096, MERGED + (size_t)r * D, nullptr, lane);
                __syncthreads();
                for (int hh = 0; hh < 2; ++hh) {
                    for (int nt = 0; nt < 8; ++nt) { EpiSqrelu Eu{HID + nt * 256, 2048};
                        gemm_unit(lds, MERGED, 1024, wup + (size_t)(hh * 2048 + nt * 256) * D, D, D, Eu); }
                    for (int nt = 0; nt < 4; ++nt) { EpiResid Ed{xdst + nt * 256, xdst + nt * 256, mr + 5120 + nt * 256};
                        gemm_unit(lds, HID, 2048, wdn + (size_t)(nt * 256) * DFF + hh * 2048, DFF, 2048, Ed); }
                }
                if (l == 0) { const float* mr1 = MOD + (size_t)33 * 6144 + (size_t)(isl ? tt >> 3 : 32) * 6144;
                    for (int r = wid; r < 256; r += 8) ada_row(xdst + (size_t)r * D, p.in[I_NMIX] + D, mr1, mr1 + 1024, HX + (tok0 + r) * D, nullptr, lane); }
                else { for (int r = wid; r < 256; r += 8) ada_row(xdst + (size_t)r * D, p.in[I_NFIN], nullptr, nullptr, nullptr, xdst + (size_t)r * D, lane); }
                __syncthreads();
            }
            }
        }
        if (l == 0) grid.sync();
    }
}

extern "C" void kernel_launch(void* const* d_in, const int* in_sizes, int n_in, void* d_out, int out_size,
                              void* d_ws, size_t ws_size, hipStream_t stream) {
    static int grid_blocks = 0;
    if (!grid_blocks) {
        int dev = 0, cus = 0, per_cu = 0;
        (void)hipGetDevice(&dev);
        (void)hipDeviceGetAttribute(&cus, hipDeviceAttributeMultiprocessorCount, dev);
        (void)hipFuncSetAttribute((const void*)mega, hipFuncAttributeMaxDynamicSharedMemorySize, LDS_BYTES);
        (void)hipOccupancyMaxActiveBlocksPerMultiprocessor(&per_cu, (const void*)mega, NTHREADS, LDS_BYTES);
        grid_blocks = cus > 256 ? 256 : cus;
        if (ws_size < WS_END || n_in != 33 || out_size != TOKL * D) { fprintf(stderr, "kernel_launch: unexpected sizes ws=%zu need=%zu n_in=%d out=%d\n", ws_size, (size_t)WS_END, n_in, out_size); grid_blocks = -1; }
    }
    if (grid_blocks < 0) return;
    Params p{};
    for (int i = 0; i < 33; ++i) p.in[i] = (const float*)d_in[i];
    p.out = (float*)d_out; p.ws = (unsigned char*)d_ws;
    void* args[] = {&p};
    hipError_t e = hipLaunchCooperativeKernel((const void*)mega, dim3(grid_blocks), dim3(NTHREADS), args, LDS_BYTES, stream);
    if (e != hipSuccess) fprintf(stderr, "cooperative launch failed: %s (grid %d)\n", hipGetErrorString(e), grid_blocks);
}
```

```cpp
#include <hip/hip_runtime.h>
#include <hip/hip_cooperative_groups.h>
#include <cstdio>
#include <cstdint>
namespace cg = cooperative_groups;

#define LAS __attribute__((address_space(3)))
typedef unsigned short bf16_t;
typedef short bf16x8 __attribute__((ext_vector_type(8)));
typedef float f32x4 __attribute__((ext_vector_type(4)));
typedef unsigned u32x2 __attribute__((ext_vector_type(2)));
typedef unsigned u32x4 __attribute__((ext_vector_type(4)));

constexpr int NTHREADS = 512;
constexpr int LDS_BYTES = 147456;
constexpr int D = 1024, NB = 32, SEQ = 2048, CTXL = 256;
constexpr int TOKL = NB * SEQ, TOKC = NB * CTXL, TOK = TOKL + TOKC;
constexpr int N_IN = 6688, GLA_OFF = 1536, POOL_OFF = 3104, GATE_OFF = 3616;
constexpr int NTR = 2048, NG = 1792, NGV = 1568, DFF = 4096;
constexpr float EPS = 1e-6f;

constexpr size_t SZ_WT = (size_t)NTR * D * 2, SZ_WG = (size_t)NG * D * 2, SZ_WGATE = (size_t)3072 * D * 2, SZ_WBR = (size_t)1024 * 512 * 2;
constexpr size_t SZ_WOUT = (size_t)D * D * 2, SZ_WUP = (size_t)DFF * D * 2, SZ_WDN = (size_t)D * DFF * 2;
constexpr size_t WS_WT = 0;
constexpr size_t WS_WG = WS_WT + 2 * SZ_WT;
constexpr size_t WS_WGATE = WS_WG + 2 * SZ_WG;
constexpr size_t WS_WBR = WS_WGATE + 2 * SZ_WGATE;
constexpr size_t WS_WOUT = WS_WBR + 6 * SZ_WBR;
constexpr size_t WS_WUP = WS_WOUT + 2 * SZ_WOUT;
constexpr size_t WS_WDN = WS_WUP + 2 * SZ_WUP;
constexpr size_t WS_BIAS = WS_WDN + 2 * SZ_WDN;
constexpr size_t WS_MOD = WS_BIAS + 32768;
constexpr size_t WS_HFL = WS_MOD + (size_t)2 * 33 * 6144 * 4;
constexpr size_t WS_HFC = WS_HFL + (size_t)2 * 4 * 512 * 2048 * 2;
constexpr size_t WS_CTX = WS_HFC + (size_t)4 * 512 * 256 * 2;
constexpr size_t WS_HX = WS_CTX + (size_t)TOKC * D * 4;
constexpr size_t WS_T = WS_HX + (size_t)TOK * D * 2;
constexpr size_t WS_YG = WS_T + (size_t)NTR * TOK * 2;
constexpr size_t WS_PG = WS_YG + (size_t)TOK * 512 * 2;
constexpr size_t WS_OF = WS_PG + (size_t)TOK * NG * 2;
constexpr size_t WS_END = WS_OF + (size_t)2 * TOK * 512 * 2;
constexpr size_t WS_SCR = WS_PG;
constexpr size_t SCR_PER = 1572864;
constexpr size_t SC_MERGED = 0, SC_TRY = 524288, SC_TRP = 786432, SC_SG = 1048576, SC_ST = 1310720, SC_HID = 524288;
static_assert(WS_SCR + 256 * SCR_PER <= WS_END, "scratch");
static_assert(WS_END <= (size_t)1073741824, "ws");

struct Params { const float* in[33]; float* out; unsigned char* ws; };
enum { I_X = 0, I_C, I_CTX, I_CCTX, I_WMOD, I_BMOD, I_NMIX, I_NFFN, I_WIN, I_BIN, I_HSW, I_HSB, I_FW1, I_FB1, I_FFREQ, I_FW2, I_FB2, I_FW3, I_HSKIP,
       I_WAF, I_BAF, I_WAB, I_BAB, I_GNW, I_PW, I_PSC, I_WBH, I_WBG, I_WBP, I_WOUT, I_WUP, I_WDN, I_NFIN };

__device__ __forceinline__ float bf2f(bf16_t h) { return __uint_as_float((unsigned)h << 16); }
__device__ __forceinline__ unsigned cvt_pk_bf16(float lo, float hi) { unsigned r; asm volatile("v_cvt_pk_bf16_f32 %0, %1, %2" : "=v"(r) : "v"(lo), "v"(hi)); return r; }
__device__ __forceinline__ bf16_t f2bf(float f) { return (bf16_t)(cvt_pk_bf16(f, 0.f) & 0xffffu); }
__device__ __forceinline__ float lo16(unsigned u) { return __uint_as_float(u << 16); }
__device__ __forceinline__ float hi16(unsigned u) { return __uint_as_float(u & 0xffff0000u); }
__device__ __forceinline__ float sigmoidf_(float v) { return 1.f / (1.f + __expf(-v)); }
__device__ __forceinline__ unsigned char* opq(unsigned char* p) { asm volatile("" : "+s"(p)); return p; }
__device__ __forceinline__ int tidx() { int t = threadIdx.x; asm volatile("" : "+v"(t)); return t; }
__device__ __forceinline__ int opqi(int v) { asm volatile("" : "+s"(v)); return v; }
__device__ __forceinline__ float wave_sum(float v) {
#pragma unroll
    for (int o = 32; o >= 1; o >>= 1) v += __shfl_xor(v, o);
    return v;
}

constexpr int BK = 64, HALF = 128, HTB = HALF * BK * 2;
__device__ __forceinline__ int lds_byte(int r, int c) { const int st = (r >> 4) * 2 + (c >> 5), rr = r & 15, cc = c & 31, ob = rr * 64 + cc * 2; return st * 1024 + (ob ^ (((ob >> 9) & 1) << 5)); }
__device__ __forceinline__ void stage_rc(int b, int& R, int& C) { const int st = b / 1024, sb = b % 1024, swz = sb ^ (((sb >> 9) & 1) << 5); R = (st >> 1) * 16 + swz / 64; C = (st & 1) * 32 + (swz % 64) / 2; }

template <class Epi>
__device__ __forceinline__ void gemm_unit(LAS unsigned char* lds, const bf16_t* A, int lda, const bf16_t* Bt, int ldb, int K, const Epi& E) {
    const int tid = tidx(), wid = __builtin_amdgcn_readfirstlane(tid >> 6), lane = tid & 63, wr = wid >> 2, wc = wid & 3, fr = lane & 15, fq = lane >> 4;
    const int nt = K / BK;
    unsigned voffA[2], voffB[2];
#pragma unroll
    for (int i = 0; i < 2; ++i) { int R, C; stage_rc(tid * 16 + i * 8192, R, C); voffA[i] = (unsigned)(R * lda + C) * 2u; voffB[i] = (unsigned)(R * ldb + C) * 2u; }
    const size_t kstep = (size_t)(BK * 2);
    const size_t hstepA = (size_t)HALF * lda * 2, hstepB = (size_t)HALF * ldb * 2;
    const unsigned ldsw = (unsigned)wid * 1024u;
    const int aoff = lds_byte(wr * 64 + fr, fq * 8), boff = lds_byte(wc * 32 + fr, fq * 8);
#define G_SA(b, h) (((b) * 2 + (h)) * HTB)
#define G_SB(b, h) ((4 + (b) * 2 + (h)) * HTB)
#define G_STAGE(bufoff, gbase, voff) do { _Pragma("unroll") for (int _i = 0; _i < 2; ++_i) \
        __builtin_amdgcn_global_load_lds((const unsigned*)((const char*)(gbase) + (voff)[_i]), (LAS unsigned*)(lds + (bufoff) + ldsw + _i * 8192), 16, 0, 0); } while (0)
#define G_LDA(dst, b, h) do { _Pragma("unroll") for (int m = 0; m < 4; ++m) _Pragma("unroll") for (int k = 0; k < 2; ++k) dst[m][k] = *(const LAS bf16x8*)(lds + G_SA(b, h) + aoff + m * 2048 + k * 1024); } while (0)
#define G_LDB(dst, b, h) do { _Pragma("unroll") for (int n = 0; n < 2; ++n) _Pragma("unroll") for (int k = 0; k < 2; ++k) dst[n][k] = *(const LAS bf16x8*)(lds + G_SB(b, h) + boff + n * 2048 + k * 1024); } while (0)
#define G_MMA(ai, bj, At, Bt_) do { __builtin_amdgcn_s_setprio(1); _Pragma("unroll") for (int m = 0; m < 4; ++m) _Pragma("unroll") for (int n = 0; n < 2; ++n) _Pragma("unroll") for (int k = 0; k < 2; ++k) \
        acc[ai][bj][m][n] = __builtin_amdgcn_mfma_f32_16x16x32_bf16(Bt_[n][k], At[m][k], acc[ai][bj][m][n], 0, 0, 0); __builtin_amdgcn_s_setprio(0); } while (0)
#define G_WAIT_V(n) asm volatile("s_waitcnt vmcnt(" #n ")" ::: "memory")
#define G_WAIT_L(n) asm volatile("s_waitcnt lgkmcnt(" #n ")" ::: "memory")
#define G_BAR __builtin_amdgcn_s_barrier()
#define G_SCHED __builtin_amdgcn_sched_barrier(0)
    __syncthreads();
    f32x4 acc[2][2][4][2];
#pragma unroll
    for (int a = 0; a < 2; ++a)
#pragma unroll
        for (int b = 0; b < 2; ++b)
#pragma unroll
            for (int m = 0; m < 4; ++m)
#pragma unroll
                for (int n = 0; n < 2; ++n) acc[a][b][m][n] = (f32x4){0.f, 0.f, 0.f, 0.f};
    bf16x8 At[4][2], B0[2][2], B1[2][2];
    const char* cA = (const char*)A; const char* cB = (const char*)Bt;
    G_STAGE(G_SB(0, 0), cB, voffB); G_STAGE(G_SA(0, 0), cA, voffA); G_STAGE(G_SB(0, 1), cB + hstepB, voffB); G_STAGE(G_SA(0, 1), cA + hstepA, voffA);
    if (wr == 1) G_BAR;
    G_WAIT_V(4); G_BAR;
    G_STAGE(G_SB(1, 0), cB + kstep, voffB); G_STAGE(G_SA(1, 0), cA + kstep, voffA); G_STAGE(G_SB(1, 1), cB + hstepB + kstep, voffB);
    G_WAIT_V(6); G_BAR;
    for (int t = 0; t < nt; t += 2) {
        const bool last = (t == nt - 2);
        const char* a1 = cA + (size_t)(t + 1) * kstep;
        const char* a2 = last ? cA : cA + (size_t)(t + 2) * kstep; const char* b2 = last ? cB : cB + (size_t)(t + 2) * kstep;
        const char* a3 = a2 + kstep; const char* b3 = b2 + kstep;
        G_LDB(B0, 0, 0); G_SCHED; G_LDA(At, 0, 0); G_STAGE(G_SA(1, 1), a1 + hstepA, voffA);
        G_WAIT_L(8); G_BAR; G_WAIT_L(0); G_MMA(0, 0, At, B0); G_BAR; G_SCHED;
        G_LDB(B1, 0, 1); G_STAGE(G_SB(0, 0), b2, voffB);
        G_BAR; G_WAIT_L(0); G_MMA(0, 1, At, B1); G_BAR;
        G_LDA(At, 0, 1); G_STAGE(G_SA(0, 0), a2, voffA);
        G_BAR; G_WAIT_L(0); G_MMA(1, 0, At, B0); G_BAR; G_SCHED;
        G_STAGE(G_SB(0, 1), b2 + hstepB, voffB);
        G_WAIT_V(6); G_BAR; G_MMA(1, 1, At, B1); G_BAR;
        G_LDB(B0, 1, 0); G_SCHED; G_LDA(At, 1, 0); G_STAGE(G_SA(0, 1), a2 + hstepA, voffA);
        G_WAIT_L(8); G_BAR; G_WAIT_L(0); G_MMA(0, 0, At, B0); G_BAR; G_SCHED;
        G_LDB(B1, 1, 1); G_STAGE(G_SB(1, 0), b3, voffB);
        G_BAR; G_WAIT_L(0); G_MMA(0, 1, At, B1); G_BAR;
        G_LDA(At, 1, 1); G_STAGE(G_SA(1, 0), a3, voffA);
        G_BAR; G_WAIT_L(0); G_MMA(1, 0, At, B0); G_BAR; G_SCHED;
        G_STAGE(G_SB(1, 1), b3 + hstepB, voffB);
        G_WAIT_V(6); G_BAR; G_MMA(1, 1, At, B1); G_BAR;
    }
    E(acc, wr, wc, fr, fq);
    G_WAIT_V(0);
    if (wr == 0) G_BAR;
    G_BAR;
    __syncthreads();
}

typedef f32x4 AccT[2][2][4][2];
#define EPI_LOOP _Pragma("unroll") for (int ai = 0; ai < 2; ++ai) _Pragma("unroll") for (int m = 0; m < 4; ++m) _Pragma("unroll") for (int bj = 0; bj < 2; ++bj) _Pragma("unroll") for (int n = 0; n < 2; ++n)
#define EPI_ROW (ai * 128 + wr * 64 + m * 16 + fr)
#define EPI_COL (bj * 128 + wc * 32 + n * 16 + 4 * fq)

struct EpiStoreBf16 {
    bf16_t* O; size_t ldo; const float* bias; bool rowb;
    __device__ __forceinline__ void operator()(const AccT& acc, int wr, int wc, int fr, int fq) const {
        EPI_LOOP { const int r = EPI_ROW, c = EPI_COL; f32x4 v = acc[ai][bj][m][n];
            if (rowb) { const float b = bias[r]; v += b; } else { v += *(const f32x4*)(bias + c); }
            u32x2 w; w.x = cvt_pk_bf16(v[0], v[1]); w.y = cvt_pk_bf16(v[2], v[3]); *(u32x2*)(O + (size_t)r * ldo + c) = w; }
    }
};
struct EpiGate {
    f32x4* SG; const float* bias;
    __device__ __forceinline__ void operator()(const AccT& acc, int wr, int wc, int fr, int fq) const {
        int i = 0; f32x4* SGt = SG + (size_t)tidx() * 32;
        EPI_LOOP { const int c = EPI_COL; f32x4 v = acc[ai][bj][m][n] + *(const f32x4*)(bias + c);
            v[0] = sigmoidf_(v[0]); v[1] = sigmoidf_(v[1]); v[2] = sigmoidf_(v[2]); v[3] = sigmoidf_(v[3]);
            SGt[i] = v; ++i; }
    }
};
struct EpiBranch {
    const f32x4* SG; f32x4* ST; bf16_t* MG; int first, last;
    __device__ __forceinline__ void operator()(const AccT& acc, int wr, int wc, int fr, int fq) const {
        int i = 0; const f32x4* SGt = SG + (size_t)tidx() * 32; f32x4* STt = ST + (size_t)tidx() * 32;
        EPI_LOOP { const int r = EPI_ROW, c = EPI_COL;
            f32x4 v = acc[ai][bj][m][n] * SGt[i];
            if (!first) v += STt[i];
            if (last) { u32x2 w; w.x = cvt_pk_bf16(v[0], v[1]); w.y = cvt_pk_bf16(v[2], v[3]); *(u32x2*)(MG + (size_t)r * 1024 + c) = w; }
            else STt[i] = v;
            ++i; }
    }
};
struct EpiResid {
    const float* xsrc; float* xdst; const float* gate;
    __device__ __forceinline__ void operator()(const AccT& acc, int wr, int wc, int fr, int fq) const {
        EPI_LOOP { const int r = EPI_ROW, c = EPI_COL; const f32x4 g = *(const f32x4*)(gate + c); const f32x4 xo = *(const f32x4*)(xsrc + (size_t)r * 1024 + c);
            *(f32x4*)(xdst + (size_t)r * 1024 + c) = xo + g * acc[ai][bj][m][n]; }
    }
};
struct EpiSqrelu {
    bf16_t* H; int ldh;
    __device__ __forceinline__ void operator()(const AccT& acc, int wr, int wc, int fr, int fq) const {
        EPI_LOOP { const int r = EPI_ROW, c = EPI_COL; f32x4 v = acc[ai][bj][m][n];
#pragma unroll
            for (int j = 0; j < 4; ++j) { const float t = fmaxf(v[j], 0.f); v[j] = t * t; }
            u32x2 w; w.x = cvt_pk_bf16(v[0], v[1]); w.y = cvt_pk_bf16(v[2], v[3]); *(u32x2*)(H + (size_t)r * ldh + c) = w; }
    }
};

__device__ void tconv(const float* src, int ld, int c0, int nvalid, int ncols, int K, bf16_t* dst, LAS float* tile) {
    const int tid = tidx(), ntn = ncols / 64, ntile = ntn * (K / 64);
    for (int t = blockIdx.x; t < ntile; t += gridDim.x) {
        const int k0 = (t / ntn) * 64, n0 = (t % ntn) * 64;
        __syncthreads();
#pragma unroll
        for (int i = 0; i < 8; ++i) { const int k = i * 8 + (tid >> 6), n = tid & 63;
            tile[k * 65 + n] = (n0 + n < nvalid) ? src[(size_t)(k0 + k) * ld + c0 + n0 + n] : 0.f; }
        __syncthreads();
        const int n = tid >> 3, kc = (tid & 7) * 8;
        u32x4 w;
        w.x = cvt_pk_bf16(tile[(kc + 0) * 65 + n], tile[(kc + 1) * 65 + n]); w.y = cvt_pk_bf16(tile[(kc + 2) * 65 + n], tile[(kc + 3) * 65 + n]);
        w.z = cvt_pk_bf16(tile[(kc + 4) * 65 + n], tile[(kc + 5) * 65 + n]); w.w = cvt_pk_bf16(tile[(kc + 6) * 65 + n], tile[(kc + 7) * 65 + n]);
        *(u32x4*)(dst + (size_t)(n0 + n) * K + k0 + kc) = w;
    }
    __syncthreads();
}

__device__ __forceinline__ void job_poolcomb(const Params& p, int l) {
    const float* pw = p.in[I_PW] + (size_t)l * 4 * 128 * 128; const float* sc = p.in[I_PSC] + l * 512; const float* wb = p.in[I_WBP] + (size_t)l * 512 * 1024;
    bf16_t* dst = (bf16_t*)(p.ws + WS_WBR + (size_t)(l * 3 + 2) * SZ_WBR);
    for (int idx = blockIdx.x * NTHREADS + tidx(); idx < 512 * 1024; idx += gridDim.x * NTHREADS) {
        const int n = idx & 1023, k = idx >> 10, g = k >> 7, c = k & 127;
        float a = 0.f;
        for (int d = 0; d < 128; ++d) a += pw[(g * 128 + c) * 128 + d] * sc[g * 128 + d] * wb[(size_t)(g * 128 + d) * 1024 + n];
        dst[(size_t)n * 512 + k] = f2bf(a);
    }
}

__device__ __forceinline__ void job_bias(const Params& p) {
    float* bias = (float*)(p.ws + WS_BIAS);
    for (int idx = blockIdx.x * NTHREADS + tidx(); idx < 2 * (NTR + NG); idx += gridDim.x * NTHREADS) {
        const int l = idx / (NTR + NG), j = idx % (NTR + NG); const float* b = p.in[I_BIN] + l * N_IN;
        float v;
        if (j < 1536) v = b[j]; else if (j < NTR) v = b[POOL_OFF + (j - 1536)]; else { const int q = j - NTR; v = q < NGV ? b[GLA_OFF + q] : 0.f; }
        bias[idx] = v;
    }
}

__device__ __forceinline__ void job_mod(const Params& p, LAS float* sil) {
    if (blockIdx.x >= 192) return;
    const int tid = tidx();
    __syncthreads();
    for (int idx = tid; idx < 33 * 1024; idx += NTHREADS) { const int r = idx >> 10, k = idx & 1023; const float v = r < 32 ? p.in[I_C][r * 1024 + k] : p.in[I_CCTX][k]; sil[idx] = v / (1.f + expf(-v)); }
    __syncthreads();
    float* mod = (float*)(p.ws + WS_MOD);
    for (int it = blockIdx.x; it < 192; it += gridDim.x) {
        const int l = it / 96, n = (it % 96) * 64 + (tid & 63), rg = tid >> 6;
        const float* w = p.in[I_WMOD] + (size_t)l * 1024 * 6144 + n;
        float a0 = 0.f, a1 = 0.f, a2 = 0.f, a3 = 0.f, a4 = 0.f; const int r4 = (rg == 0) ? 32 : 0;
#pragma unroll 8
        for (int k = 0; k < 1024; ++k) { const float wv = w[(size_t)k * 6144];
            a0 += sil[rg * 1024 + k] * wv; a1 += sil[(rg + 8) * 1024 + k] * wv; a2 += sil[(rg + 16) * 1024 + k] * wv; a3 += sil[(rg + 24) * 1024 + k] * wv; a4 += sil[r4 * 1024 + k] * wv; }
        const float bm = p.in[I_BMOD][l * 6144 + n];
        float* o = mod + (size_t)l * 33 * 6144 + n;
        o[(size_t)rg * 6144] = a0 + bm; o[(size_t)(rg + 8) * 6144] = a1 + bm; o[(size_t)(rg + 16) * 6144] = a2 + bm; o[(size_t)(rg + 24) * 6144] = a3 + bm;
        if (rg == 0) o[(size_t)32 * 6144] = a4 + bm;
    }
    __syncthreads();
}

__device__ __forceinline__ void job_filters(const Params& p, LAS unsigned char* lds) {
    LAS float* a1 = (LAS float*)lds;
    LAS float* a2 = (LAS float*)(lds + 16384);
    LAS bf16_t* oT = (LAS bf16_t*)(lds + 16384 + 16640);
    const int tid = tidx();
    const int nitems = (32 + 4 + 32) * 4;
    for (int it = blockIdx.x; it < nitems; it += gridDim.x) {
        const int oc = it & 3; int rt = it >> 2; int l, L, t0; bf16_t* dst;
        if (rt < 32) { l = 0; L = 2048; t0 = rt * 64; dst = (bf16_t*)(p.ws + WS_HFL); }
        else if (rt < 36) { l = 0; L = 256; t0 = (rt - 32) * 64; dst = (bf16_t*)(p.ws + WS_HFC); }
        else { l = 1; L = 2048; t0 = (rt - 36) * 64; dst = (bf16_t*)(p.ws + WS_HFL) + (size_t)4 * 512 * 2048; }
        const float* w1 = p.in[I_FW1] + l * 17 * 64; const float* b1 = p.in[I_FB1] + l * 64; const float* fq = p.in[I_FFREQ] + l * 64;
        const float* w2 = p.in[I_FW2] + l * 64 * 64; const float* b2 = p.in[I_FB2] + l * 64; const float* w3 = p.in[I_FW3] + (size_t)l * 64 * 2048;
        __syncthreads();
        { const int row = tid >> 3, jg = (tid & 7) * 8; const float t = (float)(t0 + row); float z[17];
          z[0] = t / (float)L;
#pragma unroll
          for (int bnd = 1; bnd <= 8; ++bnd) { const float ang = (6.283185307179586f / (float)L) * t * (float)bnd; z[bnd] = cosf(ang); z[8 + bnd] = sinf(ang); }
#pragma unroll
          for (int j = 0; j < 8; ++j) { float s = b1[jg + j];
#pragma unroll
              for (int i = 0; i < 17; ++i) s += z[i] * w1[i * 64 + jg + j];
              a1[row * 64 + jg + j] = sinf(fq[jg + j] * s); } }
        __syncthreads();
        { const int row = tid >> 3, jg = (tid & 7) * 8;
#pragma unroll
          for (int j = 0; j < 8; ++j) { float s = b2[jg + j];
              for (int i = 0; i < 64; ++i) s += a1[row * 64 + i] * w2[i * 64 + jg + j];
              a2[row * 65 + jg + j] = sinf(fq[jg + j] * s); } }
        __syncthreads();
        { const int o = oc * 512 + tid, c = o & 511; float wreg[64];
#pragma unroll
          for (int j = 0; j < 64; ++j) wreg[j] = w3[(size_t)j * 2048 + o];
          const float delta = 3.0701134573253943f + (float)c * ((15.350567286626972f - 3.0701134573253943f) / 511.f);
          for (int row = 0; row < 64; ++row) { float s = 0.f;
#pragma unroll
              for (int j = 0; j < 64; ++j) s += a2[row * 65 + j] * wreg[j];
              const float win = expf(-((float)(t0 + row) / (float)L) * delta);
              oT[tid * 72 + row] = f2bf(s * win); } }
        __syncthreads();
        for (int q = tid; q < 4096; q += NTHREADS) { const int ol = q >> 3, ch = (q & 7) * 8; const int o = oc * 512 + ol, dir = o >> 10, ord = (o >> 9) & 1, c = o & 511;
            const u32x4 w = *(const LAS u32x4*)(oT + ol * 72 + ch);
            *(u32x4*)(dst + ((size_t)((ord * 2 + dir) * 512 + c)) * L + t0 + ch) = w; }
    }
    __syncthreads();
}

__device__ __forceinline__ void ada_row(const float* x, const float* g, const float* sh, const float* sc, bf16_t* dst, float* fdst, int lane) {
    f32x4 v[4]; float ss = 0.f;
#pragma unroll
    for (int i = 0; i < 4; ++i) { v[i] = *(const f32x4*)(x + i * 256 + lane * 4); ss += v[i][0] * v[i][0] + v[i][1] * v[i][1] + v[i][2] * v[i][2] + v[i][3] * v[i][3]; }
    ss = wave_sum(ss);
    const float inv = rsqrtf(ss * (1.f / 1024.f) + EPS);
#pragma unroll
    for (int i = 0; i < 4; ++i) { const int c = i * 256 + lane * 4; const f32x4 gg = *(const f32x4*)(g + c); f32x4 y = v[i] * inv * gg;
        if (sh) { const f32x4 s1 = *(const f32x4*)(sc + c), s0 = *(const f32x4*)(sh + c); y = y * (1.f + s1) + s0;
            u32x2 w; w.x = cvt_pk_bf16(y[0], y[1]); w.y = cvt_pk_bf16(y[2], y[3]); *(u32x2*)(dst + c) = w; }
        else *(f32x4*)(fdst + c) = y; }
}

typedef float f32x16 __attribute__((ext_vector_type(16)));
template <int L, int NT>
__device__ __forceinline__ void hyena_mfma(const Params& p, int l, int c, bool ctx, LAS unsigned char* lds) {
    LAS unsigned char* U = lds;
    LAS unsigned* F = (LAS unsigned*)(lds + L * 64);
    LAS bf16_t* F16 = (LAS bf16_t*)F;
    const int tid = tidx(), lane = tid & 63, w = __builtin_amdgcn_readfirstlane(tid >> 6), li = lane & 31, kg = lane >> 5;
    bf16_t* T = (bf16_t*)(p.ws + WS_T);
    const size_t tokb = ctx ? (size_t)TOKL : 0;
    const bf16_t* hf = ctx ? (const bf16_t*)(p.ws + WS_HFC) : (const bf16_t*)(p.ws + WS_HFL) + (size_t)l * 4 * 512 * 2048;
    const float* sw = p.in[I_HSW] + (size_t)l * 3 * 1536; const float* sb = p.in[I_HSB] + l * 1536;
    __syncthreads();
    {
        const int cc = 1024 + c; const bf16_t* row = T + (size_t)cc * TOK + tokb;
        const float w0 = sw[cc], w1 = sw[1536 + cc], w2 = sw[3072 + cc], bb = sb[cc];
        for (int idx = tid; idx < L * 4; idx += NTHREADS) { const int b = idx & 31, t8 = idx >> 5; const bf16_t* pr = row + (size_t)b * L + t8 * 8;
            const u32x4 r = *(const u32x4*)pr;
            float x[10]; x[0] = t8 > 0 ? bf2f(pr[-1]) : 0.f; x[9] = t8 < L / 8 - 1 ? bf2f(pr[8]) : 0.f;
            x[1] = lo16(r.x); x[2] = hi16(r.x); x[3] = lo16(r.y); x[4] = hi16(r.y); x[5] = lo16(r.z); x[6] = hi16(r.z); x[7] = lo16(r.w); x[8] = hi16(r.w);
            float y[8];
#pragma unroll
            for (int j = 0; j < 8; ++j) y[j] = w0 * x[j] + w1 * x[j + 1] + w2 * x[j + 2] + bb;
            u32x4 o; o.x = cvt_pk_bf16(y[0], y[1]); o.y = cvt_pk_bf16(y[2], y[3]); o.z = cvt_pk_bf16(y[4], y[5]); o.w = cvt_pk_bf16(y[6], y[7]);
            *(LAS u32x4*)(U + (size_t)idx * 16) = o; }
    }
    const int lane_dw = (li & 1) * L + ((8 * kg - li + L - (li & 1)) >> 1);
#define HY_LOADA(dst, f) do { const LAS unsigned* _q = F + (lane_dw - 8 * (f)); u32x4 _v; _v.x = _q[0]; _v.y = _q[1]; _v.z = _q[2]; _v.w = _q[3]; dst = __builtin_bit_cast(bf16x8, _v); } while (0)
#define HY_LOADB(dst, s0) dst = *(const LAS bf16x8*)(U + ((s0) >> 3) * 512 + lane * 16)
    for (int ord = 0; ord < 2; ++ord) {
        __syncthreads();
        for (int x = tid; x < 2 * L; x += NTHREADS) {
            bf16_t v = 0;
            if (x >= 1 && x <= L) v = hf[((size_t)((ord * 2 + 0) * 512 + c)) * L + (L - x)];
            else if (x > L) v = hf[((size_t)((ord * 2 + 1) * 512 + c)) * L + (x - L)];
            F16[x] = v; if (x >= 1) F16[2 * L + x - 1] = v; if (x == 2 * L - 1) F16[4 * L - 1] = 0; }
        __syncthreads();
        f32x16 acc[NT];
#pragma unroll
        for (int i = 0; i < NT; ++i)
#pragma unroll
            for (int r = 0; r < 16; ++r) acc[i][r] = 0.f;
        bf16x8 E[NT], O[NT];
#pragma unroll
        for (int i = 1; i < NT; ++i) { HY_LOADA(E[i], 2 * (NT * w + i)); HY_LOADA(O[i], 2 * (NT * w + i) - 1); }
        for (int n8 = 0; n8 < L / 32; n8 += 8) {
#pragma unroll
            for (int u = 0; u < 8; ++u) { const int n = n8 + u; const int fe = 2 * (NT * w - n); bf16x8 Bf;
                HY_LOADA(E[(8 - u) & (NT - 1)], fe); HY_LOADB(Bf, 32 * n);
#pragma unroll
                for (int i = 0; i < NT; ++i) acc[i] = __builtin_amdgcn_mfma_f32_32x32x16_bf16(E[(i - u) & (NT - 1)], Bf, acc[i], 0, 0, 0);
                HY_LOADA(O[(8 - u) & (NT - 1)], fe - 1); HY_LOADB(Bf, 32 * n + 16);
#pragma unroll
                for (int i = 0; i < NT; ++i) acc[i] = __builtin_amdgcn_mfma_f32_32x32x16_bf16(O[(i - u) & (NT - 1)], Bf, acc[i], 0, 0, 0);
            }
        }
        __syncthreads();
        const int xc = ord * 512 + c; const bf16_t* xrow = T + (size_t)xc * TOK + tokb + (size_t)li * L;
        bf16_t* orow = T + (size_t)c * TOK + tokb + (size_t)li * L;
        const float w0 = sw[xc], w1 = sw[1536 + xc], w2 = sw[3072 + xc], bb = sb[xc], sk = p.in[I_HSKIP][(l * 2 + ord) * 512 + c];
#pragma unroll
        for (int i = 0; i < NT; ++i)
#pragma unroll
            for (int rg = 0; rg < 4; ++rg) { const int tb = 32 * (NT * w + i) + 8 * rg + 4 * kg;
                const u32x2 xr = *(const u32x2*)(xrow + tb);
                float x[6]; x[0] = tb > 0 ? bf2f(xrow[tb - 1]) : 0.f; x[5] = tb + 4 < L ? bf2f(xrow[tb + 4]) : 0.f;
                x[1] = lo16(xr.x); x[2] = hi16(xr.x); x[3] = lo16(xr.y); x[4] = hi16(xr.y);
                LAS u32x2* up = (LAS u32x2*)(U + ((tb >> 3) * 32 + li) * 16 + (tb & 7) * 2);
                const u32x2 uv = *up; const float uu[4] = {lo16(uv.x), hi16(uv.x), lo16(uv.y), hi16(uv.y)};
                float z[4];
#pragma unroll
                for (int j = 0; j < 4; ++j) z[j] = (w0 * x[j] + w1 * x[j + 1] + w2 * x[j + 2] + bb) * (acc[i][rg * 4 + j] + sk * uu[j]);
                u32x2 o; o.x = cvt_pk_bf16(z[0], z[1]); o.y = cvt_pk_bf16(z[2], z[3]);
                if (ord == 0) *up = o; else *(u32x2*)(orow + tb) = o; }
    }
#undef HY_LOADA
#undef HY_LOADB
    __syncthreads();
}

__device__ __forceinline__ void gla_item(const Params& p, int l, int b, int h, int dir, LAS float* lf) {
    const int tid = tidx(), qd = tid & 3, dv = tid >> 2;
    LAS float* qL = lf; LAS float* kL = lf + 2048; LAS float* aL = lf + 4096; LAS float* vL = lf + 6144; LAS float* oL = lf + 10240; LAS float* waL = lf + 14336; LAS float* baL = lf + 15360;
    const bf16_t* PG = (const bf16_t*)(p.ws + WS_PG);
    bf16_t* O = (bf16_t*)(p.ws + WS_OF) + (size_t)dir * TOK * 512;
    const float* wa = (dir ? p.in[I_WAB] : p.in[I_WAF]) + l * 16 * 256; const float* ba = (dir ? p.in[I_BAB] : p.in[I_BAF]) + l * 256;
    __syncthreads();
    for (int i = tid; i < 1024; i += NTHREADS) waL[i] = wa[(i >> 6) * 256 + h * 64 + (i & 63)];
    if (tid < 64) baL[tid] = ba[h * 64 + tid];
    float S[16];
#pragma unroll
    for (int i = 0; i < 16; ++i) S[i] = 0.f;
    const int sp = tid >> 4, sc4 = (tid & 15) * 4, sc8 = (tid & 15) * 8;
    for (int ck = 0; ck < 72; ++ck) {
        const int P = ck * 32 + sp; size_t row;
        if (P < 256) row = (size_t)TOKL + b * 256 + (dir ? 255 - P : P); else { const int tl = P - 256; row = (size_t)b * 2048 + (dir ? 2047 - tl : tl); }
        const bf16_t* pr = PG + row * NG;
        __syncthreads();
        { const u32x2 wq = *(const u32x2*)(pr + h * 64 + sc4), wk = *(const u32x2*)(pr + 256 + h * 64 + sc4);
          *(LAS f32x4*)(qL + sp * 64 + sc4) = (f32x4){lo16(wq.x) * 0.125f, hi16(wq.x) * 0.125f, lo16(wq.y) * 0.125f, hi16(wq.y) * 0.125f};
          *(LAS f32x4*)(kL + sp * 64 + sc4) = (f32x4){lo16(wk.x), hi16(wk.x), lo16(wk.y), hi16(wk.y)};
          const u32x4 wv = *(const u32x4*)(pr + 512 + h * 128 + sc8);
          *(LAS f32x4*)(vL + sp * 128 + sc8) = (f32x4){lo16(wv.x), hi16(wv.x), lo16(wv.y), hi16(wv.y)};
          *(LAS f32x4*)(vL + sp * 128 + sc8 + 4) = (f32x4){lo16(wv.z), hi16(wv.z), lo16(wv.w), hi16(wv.w)};
          const u32x4 g0 = *(const u32x4*)(pr + 1536 + dir * 16), g1 = *(const u32x4*)(pr + 1536 + dir * 16 + 8);
          float gt[16] = {lo16(g0.x), hi16(g0.x), lo16(g0.y), hi16(g0.y), lo16(g0.z), hi16(g0.z), lo16(g0.w), hi16(g0.w),
                          lo16(g1.x), hi16(g1.x), lo16(g1.y), hi16(g1.y), lo16(g1.z), hi16(g1.z), lo16(g1.w), hi16(g1.w)};
#pragma unroll
          for (int j = 0; j < 4; ++j) { float z = baL[sc4 + j];
#pragma unroll
              for (int r = 0; r < 16; ++r) z += gt[r] * waL[r * 64 + sc4 + j];
              const float ls = -(fmaxf(-z, 0.f) + log1pf(expf(-fabsf(z))));
              aL[sp * 64 + sc4 + j] = expf(ls * (1.f / 16.f)); } }
        __syncthreads();
        for (int pos = 0; pos < 32; ++pos) {
            const float vv = vL[pos * 128 + dv]; float part = 0.f;
#pragma unroll
            for (int i4 = 0; i4 < 4; ++i4) { const f32x4 aa = *(const LAS f32x4*)(aL + pos * 64 + qd * 16 + i4 * 4), kk = *(const LAS f32x4*)(kL + pos * 64 + qd * 16 + i4 * 4), qq = *(const LAS f32x4*)(qL + pos * 64 + qd * 16 + i4 * 4);
#pragma unroll
                for (int j = 0; j < 4; ++j) { S[i4 * 4 + j] = aa[j] * S[i4 * 4 + j] + kk[j] * vv; part += qq[j] * S[i4 * 4 + j]; } }
            part += __shfl_xor(part, 1); part += __shfl_xor(part, 2);
            if (qd == 0) oL[pos * 128 + dv] = part;
        }
        __syncthreads();
        { const f32x4 o0 = *(const LAS f32x4*)(oL + sp * 128 + sc8), o1 = *(const LAS f32x4*)(oL + sp * 128 + sc8 + 4);
          u32x4 w; w.x = cvt_pk_bf16(o0[0], o0[1]); w.y = cvt_pk_bf16(o0[2], o0[3]); w.z = cvt_pk_bf16(o1[0], o1[1]); w.w = cvt_pk_bf16(o1[2], o1[3]);
          *(u32x4*)(O + row * 512 + h * 128 + sc8) = w; }
    }
    __syncthreads();
}

template <int W>
__device__ __forceinline__ void pool2d_wave(bf16_t* base, int lane) {
    float u[32], pv[33];
#pragma unroll
    for (int r = 0; r < 32; ++r) u[r] = bf2f(base[r * 64 + lane]);
    pv[0] = 0.f;
#pragma unroll
    for (int r = 0; r < 32; ++r) pv[r + 1] = pv[r] + u[r];
    const int cl = max(lane - W / 2, 0), chh = min(lane - W / 2 + W, 64);
#pragma unroll
    for (int r = 0; r < 32; ++r) {
        const int rl = (r - W / 2) < 0 ? 0 : (r - W / 2), rh = (r - W / 2 + W) > 32 ? 32 : (r - W / 2 + W);
        float x = pv[rh] - pv[rl];
#pragma unroll
        for (int d = 1; d < 64; d <<= 1) { const float y = __shfl_up(x, d); if (lane >= d) x += y; }
        const float hi = __shfl(x, chh - 1), lo = __shfl(x, cl > 0 ? cl - 1 : 0);
        const float s = hi - (cl > 0 ? lo : 0.f);
        const float cnt = (float)((rh - rl) * (chh - cl));
        base[r * 64 + lane] = f2bf(s / cnt - u[r]);
    }
}
__device__ __forceinline__ void pool1d_wave(bf16_t* base, int lane, int W) {
    float u[4], P[4];
#pragma unroll
    for (int j = 0; j < 4; ++j) u[j] = bf2f(base[j * 64 + lane]);
    float off = 0.f;
#pragma unroll
    for (int j = 0; j < 4; ++j) { float x = u[j];
#pragma unroll
        for (int d = 1; d < 64; d <<= 1) { const float y = __shfl_up(x, d); if (lane >= d) x += y; }
        P[j] = x + off; off += __shfl(x, 63); }
#pragma unroll
    for (int j = 0; j < 4; ++j) { const int t = j * 64 + lane; const int lo = max(t - W / 2, 0), hi = min(t - W / 2 + W, 256);
        const int ih = hi - 1, il = lo > 0 ? lo - 1 : 0;
        float vh = 0.f, vl = 0.f;
#pragma unroll
        for (int s = 0; s < 4; ++s) { const float a = __shfl(P[s], ih & 63), bq = __shfl(P[s], il & 63); if ((ih >> 6) == s) vh = a; if ((il >> 6) == s) vl = bq; }
        const float sum = vh - (lo > 0 ? vl : 0.f);
        u[j] = sum / (float)(hi - lo) - u[j]; }
#pragma unroll
    for (int j = 0; j < 4; ++j) base[j * 64 + lane] = f2bf(u[j]);
}

__global__ void __launch_bounds__(NTHREADS, 2) mega(Params p) {
    extern __shared__ __attribute__((aligned(16))) unsigned char lds_raw[];
    LAS unsigned char* lds = (LAS unsigned char*)lds_raw;
    LAS float* lf = (LAS float*)lds;
    cg::grid_group grid = cg::this_grid();
    const int G = gridDim.x, bid = blockIdx.x;
#define WSPTRS const int tid = tidx(), lane = tid & 63, wid = tid >> 6; (void)lane; (void)wid; unsigned char* ws = opq(p.ws); bf16_t* HX = (bf16_t*)(ws + WS_HX); bf16_t* T = (bf16_t*)(ws + WS_T); bf16_t* YG = (bf16_t*)(ws + WS_YG); bf16_t* PG = (bf16_t*)(ws + WS_PG); \
    float* CTXS = (float*)(ws + WS_CTX); const float* MOD = (const float*)(ws + WS_MOD); const float* BIAS = (const float*)(ws + WS_BIAS); (void)HX; (void)T; (void)YG; (void)PG; (void)CTXS; (void)MOD; (void)BIAS;

    for (int l = 0; l < 2; ++l) {
        unsigned char* ws = opq(p.ws);
        const float* win = p.in[I_WIN] + (size_t)l * D * N_IN;
        bf16_t* wt = (bf16_t*)(ws + WS_WT + l * SZ_WT);
        tconv(win, N_IN, 0, 1536, 1536, D, wt, lf);
        tconv(win, N_IN, POOL_OFF, 512, 512, D, wt + (size_t)1536 * D, lf);
        tconv(win, N_IN, GLA_OFF, NGV, NG, D, (bf16_t*)(ws + WS_WG + l * SZ_WG), lf);
        tconv(win, N_IN, GATE_OFF, 3072, 3072, D, (bf16_t*)(ws + WS_WGATE + l * SZ_WGATE), lf);
        tconv(p.in[I_WBH] + (size_t)l * 512 * 1024, 1024, 0, 1024, 1024, 512, (bf16_t*)(ws + WS_WBR + (size_t)(l * 3 + 0) * SZ_WBR), lf);
        tconv(p.in[I_WBG] + (size_t)l * 512 * 1024, 1024, 0, 1024, 1024, 512, (bf16_t*)(ws + WS_WBR + (size_t)(l * 3 + 1) * SZ_WBR), lf);
        tconv(p.in[I_WOUT] + (size_t)l * D * D, D, 0, D, D, D, (bf16_t*)(ws + WS_WOUT + l * SZ_WOUT), lf);
        tconv(p.in[I_WUP] + (size_t)l * D * DFF, DFF, 0, DFF, DFF, D, (bf16_t*)(ws + WS_WUP + l * SZ_WUP), lf);
        tconv(p.in[I_WDN] + (size_t)l * DFF * D, D, 0, D, D, DFF, (bf16_t*)(ws + WS_WDN + l * SZ_WDN), lf);
        job_poolcomb(p, l);
    }
    job_bias(p);
    job_mod(p, lf);
    job_filters(p, lds);
    grid.sync();

    { WSPTRS
    for (int row = bid * 8 + wid; row < TOK; row += G * 8) {
        const bool isl = row < TOKL; const float* x = isl ? p.in[I_X] + (size_t)row * D : p.in[I_CTX] + (size_t)(row - TOKL) * D;
        const float* mr = MOD + (size_t)(isl ? row >> 11 : 32) * 6144;
        ada_row(x, p.in[I_NMIX], mr, mr + 1024, HX + (size_t)row * D, nullptr, lane);
    } }
    grid.sync();

    for (int l_ = 0; l_ < 2; ++l_) {
        const int l = opqi(l_);
        { WSPTRS
            const int ntokt = l == 0 ? 288 : 256;
            const int nA = ntokt * 8, nB = 288 * 7;
            const bf16_t* wt = (const bf16_t*)(ws + WS_WT + l * SZ_WT); const bf16_t* wg = (const bf16_t*)(ws + WS_WG + l * SZ_WG);
            const float* biasT = BIAS + l * (NTR + NG); const float* biasG = biasT + NTR;
            for (int u = bid; u < nA + nB; u += G) {
                if (u < nA) { const int tt = u >> 3, ct = u & 7;
                    EpiStoreBf16 E{T + (size_t)(ct * 256) * TOK + (size_t)tt * 256, (size_t)TOK, biasT + ct * 256, true};
                    gemm_unit(lds, wt + (size_t)(ct * 256) * D, D, HX + (size_t)(tt * 256) * D, D, D, E); }
                else { const int v = u - nA, tt = v / 7, nt = v % 7;
                    EpiStoreBf16 E{PG + (size_t)(tt * 256) * NG + nt * 256, (size_t)NG, biasG + nt * 256, false};
                    gemm_unit(lds, HX + (size_t)(tt * 256) * D, D, wg + (size_t)(nt * 256) * D, D, D, E); }
            }
        }
        grid.sync();
        { WSPTRS
            for (int it = bid; it < 256; it += G) gla_item(p, l, it >> 3, (it >> 1) & 3, it & 1, lf);
            for (int it = bid; it < 512; it += G) hyena_mfma<2048, 8>(p, l, it, false, lds);
            if (l == 0) for (int it = bid; it < 512; it += G) hyena_mfma<256, 1>(p, l, it, true, lds);
            const int npl = l == 0 ? 32768 : 16384;
            for (int it = bid * 8 + wid; it < npl; it += G * 8) { const bool cx = it >= 16384; const int j = it & 16383, ch = j >> 5, b = j & 31, g = ch >> 7;
                bf16_t* base = T + (size_t)(1536 + ch) * TOK + (cx ? (size_t)TOKL + b * 256 : (size_t)b * 2048);
                if (cx) pool1d_wave(base, lane, 2 << g);
                else { if (g == 0) pool2d_wave<2>(base, lane); else if (g == 1) pool2d_wave<4>(base, lane); else if (g == 2) pool2d_wave<8>(base, lane); else pool2d_wave<16>(base, lane); } }
        }
        grid.sync();
        {
            WSPTRS
            const bf16_t* OF = (const bf16_t*)(ws + WS_OF); const bf16_t* OB = OF + (size_t)TOK * 512; const float* nw = p.in[I_GNW] + l * 128;
            const int ntok = l == 0 ? TOK : TOKL;
            for (int row = bid * 8 + wid; row < ntok; row += G * 8) {
                const u32x4 a = *(const u32x4*)(OF + (size_t)row * 512 + lane * 8), bq = *(const u32x4*)(OB + (size_t)row * 512 + lane * 8), rr = *(const u32x4*)(PG + (size_t)row * NG + 1024 + lane * 8);
                float o[8] = {lo16(a.x) + lo16(bq.x), hi16(a.x) + hi16(bq.x), lo16(a.y) + lo16(bq.y), hi16(a.y) + hi16(bq.y), lo16(a.z) + lo16(bq.z), hi16(a.z) + hi16(bq.z), lo16(a.w) + lo16(bq.w), hi16(a.w) + hi16(bq.w)};
                float r[8] = {lo16(rr.x), hi16(rr.x), lo16(rr.y), hi16(rr.y), lo16(rr.z), hi16(rr.z), lo16(rr.w), hi16(rr.w)};
                float ss = 0.f;
#pragma unroll
                for (int j = 0; j < 8; ++j) ss += o[j] * o[j];
                ss += __shfl_xor(ss, 1); ss += __shfl_xor(ss, 2); ss += __shfl_xor(ss, 4); ss += __shfl_xor(ss, 8);
                const float inv = rsqrtf(ss * (1.f / 128.f) + EPS);
                float y[8];
#pragma unroll
                for (int j = 0; j < 8; ++j) y[j] = o[j] * inv * nw[(lane & 15) * 8 + j] * (r[j] * sigmoidf_(r[j]));
                u32x4 w; w.x = cvt_pk_bf16(y[0], y[1]); w.y = cvt_pk_bf16(y[2], y[3]); w.z = cvt_pk_bf16(y[4], y[5]); w.w = cvt_pk_bf16(y[6], y[7]);
                *(u32x4*)(YG + (size_t)row * 512 + lane * 8) = w;
            }
        }
        grid.sync();
        {
            const int ntile = l == 0 ? 288 : 256;
            for (int tt_ = bid; tt_ < ntile; tt_ += G) {
            const int tt = opqi(tt_);
            WSPTRS
            const float* modl = MOD + (size_t)l * 33 * 6144;
            unsigned char* scr = ws + WS_SCR + (size_t)bid * SCR_PER;
            bf16_t* MERGED = (bf16_t*)(scr + SC_MERGED); bf16_t* TRY = (bf16_t*)(scr + SC_TRY); bf16_t* TRP = (bf16_t*)(scr + SC_TRP);
            f32x4* SG = (f32x4*)(scr + SC_SG); f32x4* ST = (f32x4*)(scr + SC_ST); bf16_t* HID = (bf16_t*)(scr + SC_HID);
            const bf16_t* wgate = (const bf16_t*)(ws + WS_WGATE + l * SZ_WGATE); const bf16_t* wbr = (const bf16_t*)(ws + WS_WBR + (size_t)l * 3 * SZ_WBR);
            const bf16_t* wout = (const bf16_t*)(ws + WS_WOUT + l * SZ_WOUT); const bf16_t* wup = (const bf16_t*)(ws + WS_WUP + l * SZ_WUP); const bf16_t* wdn = (const bf16_t*)(ws + WS_WDN + l * SZ_WDN);
            const float* bgate = p.in[I_BIN] + l * N_IN + GATE_OFF;
            {
                const size_t tok0 = (size_t)tt * 256; const bool isl = tt < 256;
                const float* mr = modl + (size_t)(isl ? tt >> 3 : 32) * 6144;
                const float* xsrc = isl ? (l == 0 ? p.in[I_X] + tok0 * D : p.out + tok0 * D) : p.in[I_CTX] + (tok0 - TOKL) * D;
                float* xdst = isl ? p.out + tok0 * D : CTXS + (tok0 - TOKL) * D;
                LAS bf16_t* tl = (LAS bf16_t*)lds;
                for (int which = 0; which < 2; ++which) { const bf16_t* src = T + (size_t)(which ? 1536 : 0) * TOK + tok0; bf16_t* dst = which ? TRP : TRY;
                    for (int ctile = 0; ctile < 8; ++ctile) {
                        __syncthreads();
#pragma unroll
                        for (int i = 0; i < 4; ++i) { const int idx = tid + i * NTHREADS, c = idx >> 5, t8 = (idx & 31) * 8;
                            *(LAS u32x4*)(tl + c * 264 + t8) = *(const u32x4*)(src + (size_t)(ctile * 64 + c) * TOK + t8); }
                        __syncthreads();
#pragma unroll
                        for (int i = 0; i < 4; ++i) { const int idx = tid + i * NTHREADS, tk = idx >> 3, c8 = (idx & 7) * 8; unsigned w[4];
#pragma unroll
                            for (int j = 0; j < 4; ++j) w[j] = (unsigned)tl[(c8 + 2 * j) * 264 + tk] | ((unsigned)tl[(c8 + 2 * j + 1) * 264 + tk] << 16);
                            *(u32x4*)(dst + (size_t)tk * 512 + ctile * 64 + c8) = (u32x4){w[0], w[1], w[2], w[3]}; }
                    } }
                __syncthreads();
                for (int nt = 0; nt < 4; ++nt)
                    for (int X = 0; X < 3; ++X) {
                        EpiGate Eg{SG, bgate + X * 1024 + nt * 256};
                        gemm_unit(lds, HX + tok0 * D, D, wgate + (size_t)(X * 1024 + nt * 256) * D, D, D, Eg);
                        const bf16_t* ya = X == 0 ? TRY : (X == 1 ? YG + tok0 * 512 : TRP);
                        EpiBranch Eb{SG, ST, MERGED + nt * 256, X == 0, X == 2};
                        gemm_unit(lds, ya, 512, wbr + (size_t)X * 1024 * 512 + (size_t)(nt * 256) * 512, 512, 512, Eb);
                    }
                for (int nt = 0; nt < 4; ++nt) { EpiResid Er{xsrc + nt * 256, xdst + nt * 256, mr + 2048 + nt * 256};
                    gemm_unit(lds, MERGED, 1024, wout + (size_t)(nt * 256) * D, D, D, Er); }
                for (int r = wid; r < 256; r += 8) ada_row(xdst + (size_t)r * D, p.in[I_NFFN] + l * D, mr + 3072, mr + 4096, MERGED + (size_t)r * D, nullptr, lane);
                __syncthreads();
                for (int hh = 0; hh < 2; ++hh) {
                    for (int nt = 0; nt < 8; ++nt) { EpiSqrelu Eu{HID + nt * 256, 2048};
                        gemm_unit(lds, MERGED, 1024, wup + (size_t)(hh * 2048 + nt * 256) * D, D, D, Eu); }
                    for (int nt = 0; nt < 4; ++nt) { EpiResid Ed{xdst + nt * 256, xdst + nt * 256, mr + 5120 + nt * 256};
                        gemm_unit(lds, HID, 2048, wdn + (size_t)(nt * 256) * DFF + hh * 2048, DFF, 2048, Ed); }
                }
                if (l == 0) { const float* mr1 = MOD + (size_t)33 * 6144 + (size_t)(isl ? tt >> 3 : 32) * 6144;
                    for (int r = wid; r < 256; r += 8) ada_row(xdst + (size_t)r * D, p.in[I_NMIX] + D, mr1, mr1 + 1024, HX + (tok0 + r) * D, nullptr, lane); }
                else { for (int r = wid; r < 256; r += 8) ada_row(xdst + (size_t)r * D, p.in[I_NFIN], nullptr, nullptr, nullptr, xdst + (size_t)r * D, lane); }
                __syncthreads();
            }
            }
        }
        if (l == 0) grid.sync();
    }
}

extern "C" void kernel_launch(void* const* d_in, const int* in_sizes, int n_in, void* d_out, int out_size,
                              void* d_ws, size_t ws_size, hipStream_t stream) {
    static int grid_blocks = 0;
    if (!grid_blocks) {
        int dev = 0, cus = 0, per_cu = 0;
        (void)hipGetDevice(&dev);
        (void)hipDeviceGetAttribute(&cus, hipDeviceAttributeMultiprocessorCount, dev);
        (void)hipFuncSetAttribute((const void*)mega, hipFuncAttributeMaxDynamicSharedMemorySize, LDS_BYTES);
        (void)hipOccupancyMaxActiveBlocksPerMultiprocessor(&per_cu, (const void*)mega, NTHREADS, LDS_BYTES);
        grid_blocks = cus > 256 ? 256 : cus;
        if (ws_size < WS_END || n_in != 33 || out_size != TOKL * D) { fprintf(stderr, "kernel_launch: unexpected sizes ws=%zu need=%zu n_in=%d out=%d\n", ws_size, (size_t)WS_END, n_in, out_size); grid_blocks = -1; }
    }
    if (grid_blocks < 0) return;
    Params p{};
    for (int i = 0; i < 33; ++i) p.in[i] = (const float*)d_in[i];
    p.out = (float*)d_out; p.ws = (unsigned char*)d_ws;
    void* args[] = {&p};
    hipError_t e = hipLaunchCooperativeKernel((const void*)mega, dim3(grid_blocks), dim3(NTHREADS), args, LDS_BYTES, stream);
    if (e != hipSuccess) fprintf(stderr, "cooperative launch failed: %s (grid %d)\n", hipGetErrorString(e), grid_blocks);
}
```

```cpp
#include <hip/hip_runtime.h>
#include <hip/hip_cooperative_groups.h>
#include <cstdio>
#include <cstdint>
namespace cg = cooperative_groups;

#define LAS __attribute__((address_space(3)))
typedef unsigned short bf16_t;
typedef short bf16x8 __attribute__((ext_vector_type(8)));
typedef float f32x4 __attribute__((ext_vector_type(4)));
typedef unsigned u32x2 __attribute__((ext_vector_type(2)));
typedef unsigned u32x4 __attribute__((ext_vector_type(4)));

constexpr int NTHREADS = 512;
constexpr int LDS_BYTES = 147456;
constexpr int D = 1024, NB = 32, SEQ = 2048, CTXL = 256;
constexpr int TOKL = NB * SEQ, TOKC = NB * CTXL, TOK = TOKL + TOKC;
constexpr int N_IN = 6688, GLA_OFF = 1536, POOL_OFF = 3104, GATE_OFF = 3616;
constexpr int NTR = 2048, NG = 1792, NGV = 1568, DFF = 4096;
constexpr float EPS = 1e-6f;

constexpr size_t SZ_WT = (size_t)NTR * D * 2, SZ_WG = (size_t)NG * D * 2, SZ_WGATE = (size_t)3072 * D * 2, SZ_WBR = (size_t)1024 * 512 * 2;
constexpr size_t SZ_WOUT = (size_t)D * D * 2, SZ_WUP = (size_t)DFF * D * 2, SZ_WDN = (size_t)D * DFF * 2;
constexpr size_t WS_WT = 0;
constexpr size_t WS_WG = WS_WT + 2 * SZ_WT;
constexpr size_t WS_WGATE = WS_WG + 2 * SZ_WG;
constexpr size_t WS_WBR = WS_WGATE + 2 * SZ_WGATE;
constexpr size_t WS_WOUT = WS_WBR + 6 * SZ_WBR;
constexpr size_t WS_WUP = WS_WOUT + 2 * SZ_WOUT;
constexpr size_t WS_WDN = WS_WUP + 2 * SZ_WUP;
constexpr size_t WS_BIAS = WS_WDN + 2 * SZ_WDN;
constexpr size_t WS_MOD = WS_BIAS + 32768;
constexpr size_t WS_HFL = WS_MOD + (size_t)2 * 33 * 6144 * 4;
constexpr size_t WS_HFC = WS_HFL + (size_t)2 * 4 * 512 * 2048 * 2;
constexpr size_t WS_CTX = WS_HFC + (size_t)4 * 512 * 256 * 2;
constexpr size_t WS_HX = WS_CTX + (size_t)TOKC * D * 4;
constexpr size_t WS_T = WS_HX + (size_t)TOK * D * 2;
constexpr size_t WS_YG = WS_T + (size_t)NTR * TOK * 2;
constexpr size_t WS_PG = WS_YG + (size_t)TOK * 512 * 2;
constexpr size_t WS_OF = WS_PG + (size_t)TOK * NG * 2;
constexpr size_t WS_END = WS_OF + (size_t)2 * TOK * 512 * 2;
constexpr size_t WS_YHY = WS_T + (size_t)512 * TOK * 2;
constexpr size_t WS_YPL = WS_T + (size_t)1024 * TOK * 2;
constexpr size_t WS_STASH = WS_PG;
constexpr size_t WS_MERGED = WS_OF;
constexpr size_t WS_HID = WS_T;
static_assert((size_t)TOK * DFF * 2 <= WS_OF - WS_T, "hidden");
constexpr size_t WS_SCR = WS_PG;
constexpr size_t SCR_PER = 1572864;
constexpr size_t SC_MERGED = 0, SC_TRY = 524288, SC_TRP = 786432, SC_SG = 1048576, SC_ST = 1310720, SC_HID = 524288;
static_assert(WS_END <= (size_t)1073741824, "ws");

struct Params { const float* in[33]; float* out; unsigned char* ws; };
enum { I_X = 0, I_C, I_CTX, I_CCTX, I_WMOD, I_BMOD, I_NMIX, I_NFFN, I_WIN, I_BIN, I_HSW, I_HSB, I_FW1, I_FB1, I_FFREQ, I_FW2, I_FB2, I_FW3, I_HSKIP,
       I_WAF, I_BAF, I_WAB, I_BAB, I_GNW, I_PW, I_PSC, I_WBH, I_WBG, I_WBP, I_WOUT, I_WUP, I_WDN, I_NFIN };

__device__ __forceinline__ float bf2f(bf16_t h) { return __uint_as_float((unsigned)h << 16); }
__device__ __forceinline__ unsigned cvt_pk_bf16(float lo, float hi) { unsigned r; asm volatile("v_cvt_pk_bf16_f32 %0, %1, %2" : "=v"(r) : "v"(lo), "v"(hi)); return r; }
__device__ __forceinline__ bf16_t f2bf(float f) { return (bf16_t)(cvt_pk_bf16(f, 0.f) & 0xffffu); }
__device__ __forceinline__ float lo16(unsigned u) { return __uint_as_float(u << 16); }
__device__ __forceinline__ float hi16(unsigned u) { return __uint_as_float(u & 0xffff0000u); }
__device__ __forceinline__ float sigmoidf_(float v) { return 1.f / (1.f + __expf(-v)); }
__device__ __forceinline__ unsigned char* opq(unsigned char* p) { asm volatile("" : "+s"(p)); return p; }
__device__ __forceinline__ int tidx() { int t = threadIdx.x; asm volatile("" : "+v"(t)); return t; }
__device__ __forceinline__ int opqi(int v) { asm volatile("" : "+s"(v)); return v; }
__device__ __forceinline__ float wave_sum(float v) {
#pragma unroll
    for (int o = 32; o >= 1; o >>= 1) v += __shfl_xor(v, o);
    return v;
}

constexpr int BK = 64, HALF = 128, HTB = HALF * BK * 2;
__device__ __forceinline__ int lds_byte(int r, int c) { const int st = (r >> 4) * 2 + (c >> 5), rr = r & 15, cc = c & 31, ob = rr * 64 + cc * 2; return st * 1024 + (ob ^ (((ob >> 9) & 1) << 5)); }
__device__ __forceinline__ void stage_rc(int b, int& R, int& C) { const int st = b / 1024, sb = b % 1024, swz = sb ^ (((sb >> 9) & 1) << 5); R = (st >> 1) * 16 + swz / 64; C = (st & 1) * 32 + (swz % 64) / 2; }

template <class Epi>
__device__ __forceinline__ void gemm_unit(LAS unsigned char* lds, const bf16_t* A, int lda, const bf16_t* Bt, int ldb, int K, const Epi& E) {
    const int tid = tidx(), wid = __builtin_amdgcn_readfirstlane(tid >> 6), lane = tid & 63, wr = wid >> 2, wc = wid & 3, fr = lane & 15, fq = lane >> 4;
    const int nt = K / BK;
    unsigned voffA[2], voffB[2];
#pragma unroll
    for (int i = 0; i < 2; ++i) { int R, C; stage_rc(tid * 16 + i * 8192, R, C); voffA[i] = (unsigned)(R * lda + C) * 2u; voffB[i] = (unsigned)(R * ldb + C) * 2u; }
    const size_t kstep = (size_t)(BK * 2);
    const size_t hstepA = (size_t)HALF * lda * 2, hstepB = (size_t)HALF * ldb * 2;
    const unsigned ldsw = (unsigned)wid * 1024u;
    const int aoff = lds_byte(wr * 64 + fr, fq * 8), boff = lds_byte(wc * 32 + fr, fq * 8);
#define G_SA(b, h) (((b) * 2 + (h)) * HTB)
#define G_SB(b, h) ((4 + (b) * 2 + (h)) * HTB)
#define G_STAGE(bufoff, gbase, voff) do { _Pragma("unroll") for (int _i = 0; _i < 2; ++_i) \
        __builtin_amdgcn_global_load_lds((const unsigned*)((const char*)(gbase) + (voff)[_i]), (LAS unsigned*)(lds + (bufoff) + ldsw + _i * 8192), 16, 0, 0); } while (0)
#define G_LDA(dst, b, h) do { _Pragma("unroll") for (int m = 0; m < 4; ++m) _Pragma("unroll") for (int k = 0; k < 2; ++k) dst[m][k] = *(const LAS bf16x8*)(lds + G_SA(b, h) + aoff + m * 2048 + k * 1024); } while (0)
#define G_LDB(dst, b, h) do { _Pragma("unroll") for (int n = 0; n < 2; ++n) _Pragma("unroll") for (int k = 0; k < 2; ++k) dst[n][k] = *(const LAS bf16x8*)(lds + G_SB(b, h) + boff + n * 2048 + k * 1024); } while (0)
#define G_MMA(ai, bj, At, Bt_) do { __builtin_amdgcn_s_setprio(1); _Pragma("unroll") for (int m = 0; m < 4; ++m) _Pragma("unroll") for (int n = 0; n < 2; ++n) _Pragma("unroll") for (int k = 0; k < 2; ++k) \
        acc[ai][bj][m][n] = __builtin_amdgcn_mfma_f32_16x16x32_bf16(Bt_[n][k], At[m][k], acc[ai][bj][m][n], 0, 0, 0); __builtin_amdgcn_s_setprio(0); } while (0)
#define G_WAIT_V(n) asm volatile("s_waitcnt vmcnt(" #n ")" ::: "memory")
#define G_WAIT_L(n) asm volatile("s_waitcnt lgkmcnt(" #n ")" ::: "memory")
#define G_BAR __builtin_amdgcn_s_barrier()
#define G_SCHED __builtin_amdgcn_sched_barrier(0)
    __syncthreads();
    f32x4 acc[2][2][4][2];
#pragma unroll
    for (int a = 0; a < 2; ++a)
#pragma unroll
        for (int b = 0; b < 2; ++b)
#pragma unroll
            for (int m = 0; m < 4; ++m)
#pragma unroll
                for (int n = 0; n < 2; ++n) acc[a][b][m][n] = (f32x4){0.f, 0.f, 0.f, 0.f};
    bf16x8 At[4][2], B0[2][2], B1[2][2];
    const char* cA = (const char*)A; const char* cB = (const char*)Bt;
    G_STAGE(G_SB(0, 0), cB, voffB); G_STAGE(G_SA(0, 0), cA, voffA); G_STAGE(G_SB(0, 1), cB + hstepB, voffB); G_STAGE(G_SA(0, 1), cA + hstepA, voffA);
    if (wr == 1) G_BAR;
    G_WAIT_V(4); G_BAR;
    G_STAGE(G_SB(1, 0), cB + kstep, voffB); G_STAGE(G_SA(1, 0), cA + kstep, voffA); G_STAGE(G_SB(1, 1), cB + hstepB + kstep, voffB);
    G_WAIT_V(6); G_BAR;
    for (int t = 0; t < nt; t += 2) {
        const bool last = (t == nt - 2);
        const char* a1 = cA + (size_t)(t + 1) * kstep;
        const char* a2 = last ? cA : cA + (size_t)(t + 2) * kstep; const char* b2 = last ? cB : cB + (size_t)(t + 2) * kstep;
        const char* a3 = a2 + kstep; const char* b3 = b2 + kstep;
        G_LDB(B0, 0, 0); G_SCHED; G_LDA(At, 0, 0); G_STAGE(G_SA(1, 1), a1 + hstepA, voffA);
        G_WAIT_L(8); G_BAR; G_WAIT_L(0); G_MMA(0, 0, At, B0); G_BAR; G_SCHED;
        G_LDB(B1, 0, 1); G_STAGE(G_SB(0, 0), b2, voffB);
        G_BAR; G_WAIT_L(0); G_MMA(0, 1, At, B1); G_BAR;
        G_LDA(At, 0, 1); G_STAGE(G_SA(0, 0), a2, voffA);
        G_BAR; G_WAIT_L(0); G_MMA(1, 0, At, B0); G_BAR; G_SCHED;
        G_STAGE(G_SB(0, 1), b2 + hstepB, voffB);
        G_WAIT_V(6); G_BAR; G_MMA(1, 1, At, B1); G_BAR;
        G_LDB(B0, 1, 0); G_SCHED; G_LDA(At, 1, 0); G_STAGE(G_SA(0, 1), a2 + hstepA, voffA);
        G_WAIT_L(8); G_BAR; G_WAIT_L(0); G_MMA(0, 0, At, B0); G_BAR; G_SCHED;
        G_LDB(B1, 1, 1); G_STAGE(G_SB(1, 0), b3, voffB);
        G_BAR; G_WAIT_L(0); G_MMA(0, 1, At, B1); G_BAR;
        G_LDA(At, 1, 1); G_STAGE(G_SA(1, 0), a3, voffA);
        G_BAR; G_WAIT_L(0); G_MMA(1, 0, At, B0); G_BAR; G_SCHED;
        G_STAGE(G_SB(1, 1), b3 + hstepB, voffB);
        G_WAIT_V(6); G_BAR; G_MMA(1, 1, At, B1); G_BAR;
    }
    E(acc, wr, wc, fr, fq);
    G_WAIT_V(0);
    if (wr == 0) G_BAR;
    G_BAR;
    __syncthreads();
}


typedef f32x4 AccT[2][2][4][2];
struct UDesc { const char* A; const char* B; int lda, ldb, K; };
template <class Prog>
__device__ __forceinline__ void gemm_stream(LAS unsigned char* lds, int nunits, const Prog& P) {
    if (nunits <= 0) return;
    const int tid = tidx(), wid = __builtin_amdgcn_readfirstlane(tid >> 6), lane = tid & 63, wr = wid >> 2, wc = wid & 3, fr = lane & 15, fq = lane >> 4;
    int sR, sC; { int R, C; stage_rc(tid * 16, R, C); sR = R * 2; sC = C * 2; }
    const unsigned kstep = (unsigned)(BK * 2);
    const unsigned ldsw = (unsigned)wid * 1024u;
    const int aoff = lds_byte(wr * 64 + fr, fq * 8), boff = lds_byte(wc * 32 + fr, fq * 8);
#define S_STAGE(bufoff, gbase, v, q) do { \
        __builtin_amdgcn_global_load_lds((const unsigned*)((const char*)(gbase) + (v)), (LAS unsigned*)(lds + (bufoff) + ldsw), 16, 0, 0); \
        __builtin_amdgcn_global_load_lds((const unsigned*)((const char*)(gbase) + (q) + (v)), (LAS unsigned*)(lds + (bufoff) + ldsw + 8192), 16, 0, 0); } while (0)
    UDesc cur, nxt; P.desc(0, cur);
    unsigned vA = (unsigned)(sR * cur.lda + sC), vB = (unsigned)(sR * cur.ldb + sC);
    __syncthreads();
    f32x4 acc[2][2][4][2];
#pragma unroll
    for (int a = 0; a < 2; ++a)
#pragma unroll
        for (int b = 0; b < 2; ++b)
#pragma unroll
            for (int m = 0; m < 4; ++m)
#pragma unroll
                for (int n = 0; n < 2; ++n) acc[a][b][m][n] = (f32x4){0.f, 0.f, 0.f, 0.f};
    bf16x8 At[4][2], B0[2][2], B1[2][2];
    { const char* cA = cur.A; const char* cB = cur.B; const unsigned hA = (unsigned)HALF * cur.lda * 2, hB = (unsigned)HALF * cur.ldb * 2, qA = hA >> 1, qB = hB >> 1;
      S_STAGE(G_SB(0, 0), cB, vB, qB); S_STAGE(G_SA(0, 0), cA, vA, qA); S_STAGE(G_SB(0, 1), cB + hB, vB, qB); S_STAGE(G_SA(0, 1), cA + hA, vA, qA);
      if (wr == 1) G_BAR;
      G_WAIT_V(4); G_BAR;
      S_STAGE(G_SB(1, 0), cB + kstep, vB, qB); S_STAGE(G_SA(1, 0), cA + kstep, vA, qA); S_STAGE(G_SB(1, 1), cB + hB + kstep, vB, qB);
      G_WAIT_V(6); G_BAR; }
    for (int ui = 0;; ++ui) {
        const bool has_next = ui + 1 < nunits;
        if (has_next) P.desc(ui + 1, nxt); else nxt = cur;
        const unsigned nA = (unsigned)(sR * nxt.lda + sC), nB = (unsigned)(sR * nxt.ldb + sC);
        const char* cA = cur.A; const char* cB = cur.B; const unsigned hA = (unsigned)HALF * cur.lda * 2, hB = (unsigned)HALF * cur.ldb * 2;
        const unsigned nhA = (unsigned)HALF * nxt.lda * 2, nhB = (unsigned)HALF * nxt.ldb * 2;
        const int nt = cur.K / BK;
        for (int t = 0; t < nt; t += 2) {
            const bool last = (t == nt - 2);
            const char* a1 = cA + (unsigned)(t + 1) * kstep;
            const char* a2 = last ? nxt.A : cA + (unsigned)(t + 2) * kstep; const char* b2 = last ? nxt.B : cB + (unsigned)(t + 2) * kstep;
            const char* a3 = a2 + kstep; const char* b3 = b2 + kstep;
            const unsigned hA2 = last ? nhA : hA, hB2 = last ? nhB : hB, qA = hA >> 1, qA2 = hA2 >> 1, qB2 = hB2 >> 1;
            const unsigned xA = last ? nA : vA, xB = last ? nB : vB;
            G_LDB(B0, 0, 0); G_SCHED; G_LDA(At, 0, 0); S_STAGE(G_SA(1, 1), a1 + hA, vA, qA);
            G_WAIT_L(8); G_BAR; G_WAIT_L(0); G_MMA(0, 0, At, B0); G_BAR; G_SCHED;
            G_LDB(B1, 0, 1); S_STAGE(G_SB(0, 0), b2, xB, qB2);
            G_BAR; G_WAIT_L(0); G_MMA(0, 1, At, B1); G_BAR;
            G_LDA(At, 0, 1); S_STAGE(G_SA(0, 0), a2, xA, qA2);
            G_BAR; G_WAIT_L(0); G_MMA(1, 0, At, B0); G_BAR; G_SCHED;
            S_STAGE(G_SB(0, 1), b2 + hB2, xB, qB2);
            G_WAIT_V(6); G_BAR; G_MMA(1, 1, At, B1); G_BAR;
            G_LDB(B0, 1, 0); G_SCHED; G_LDA(At, 1, 0); S_STAGE(G_SA(0, 1), a2 + hA2, xA, qA2);
            G_WAIT_L(8); G_BAR; G_WAIT_L(0); G_MMA(0, 0, At, B0); G_BAR; G_SCHED;
            G_LDB(B1, 1, 1); S_STAGE(G_SB(1, 0), b3, xB, qB2);
            G_BAR; G_WAIT_L(0); G_MMA(0, 1, At, B1); G_BAR;
            G_LDA(At, 1, 1); S_STAGE(G_SA(1, 0), a3, xA, qA2);
            G_BAR; G_WAIT_L(0); G_MMA(1, 0, At, B0); G_BAR; G_SCHED;
            S_STAGE(G_SB(1, 1), b3 + hB2, xB, qB2);
            G_WAIT_V(6); G_BAR; G_MMA(1, 1, At, B1); G_BAR;
        }
        P.epi(ui, acc, wr, wc, fr, fq);
        if (!has_next) break;
#pragma unroll
        for (int a = 0; a < 2; ++a)
#pragma unroll
            for (int b = 0; b < 2; ++b)
#pragma unroll
                for (int m = 0; m < 4; ++m)
#pragma unroll
                    for (int n = 0; n < 2; ++n) acc[a][b][m][n] = (f32x4){0.f, 0.f, 0.f, 0.f};
        cur = nxt; vA = nA; vB = nB;
    }
    G_WAIT_V(0);
    if (wr == 0) G_BAR;
    G_BAR;
    __syncthreads();
#undef S_STAGE
}

#define EPI_LOOP _Pragma("unroll") for (int ai = 0; ai < 2; ++ai) _Pragma("unroll") for (int m = 0; m < 4; ++m) _Pragma("unroll") for (int bj = 0; bj < 2; ++bj) _Pragma("unroll") for (int n = 0; n < 2; ++n)
#define EPI_ROW (ai * 128 + wr * 64 + m * 16 + fr)
#define EPI_COL (bj * 128 + wc * 32 + n * 16 + 4 * fq)

#define U4 _Pragma("unroll")
struct EpiStoreBf16 {
    bf16_t* O; size_t ldo; const float* bias; bool rowb;
    __device__ __forceinline__ void operator()(const AccT& acc, int wr, int wc, int fr, int fq) const {
        { const int tq_ = tidx(); wr = (tq_ >> 8) & 1; wc = (tq_ >> 6) & 3; fr = tq_ & 15; fq = (tq_ >> 4) & 3; }
        float br[2][4]; f32x4 bc[2][2];
        U4 for (int ai = 0; ai < 2; ++ai) U4 for (int m = 0; m < 4; ++m) br[ai][m] = rowb ? bias[ai * 128 + wr * 64 + m * 16 + fr] : 0.f;
        U4 for (int bj = 0; bj < 2; ++bj) U4 for (int n = 0; n < 2; ++n) bc[bj][n] = rowb ? (f32x4){0.f, 0.f, 0.f, 0.f} : *(const f32x4*)(bias + EPI_COL);
        EPI_LOOP { const int r = EPI_ROW, c = EPI_COL; const f32x4 v = acc[ai][bj][m][n] + bc[bj][n] + br[ai][m];
            u32x2 w; w.x = cvt_pk_bf16(v[0], v[1]); w.y = cvt_pk_bf16(v[2], v[3]); *(u32x2*)(O + (size_t)r * ldo + c) = w; }
    }
};
struct EpiGate {
    f32x4* SG; const float* bias;
    __device__ __forceinline__ void operator()(const AccT& acc, int wr, int wc, int fr, int fq) const {
        { const int tq_ = tidx(); wr = (tq_ >> 8) & 1; wc = (tq_ >> 6) & 3; fr = tq_ & 15; fq = (tq_ >> 4) & 3; }
        f32x4 bc[2][2];
        U4 for (int bj = 0; bj < 2; ++bj) U4 for (int n = 0; n < 2; ++n) bc[bj][n] = *(const f32x4*)(bias + EPI_COL);
        int i = 0; f32x4* SGt = SG + tidx();
        EPI_LOOP { f32x4 v = acc[ai][bj][m][n] + bc[bj][n];
            v[0] = sigmoidf_(v[0]); v[1] = sigmoidf_(v[1]); v[2] = sigmoidf_(v[2]); v[3] = sigmoidf_(v[3]);
            SGt[i * NTHREADS] = v; ++i; }
    }
};
struct EpiBranch {
    const f32x4* SG; f32x4* ST; bf16_t* MG; int first, last;
    __device__ __forceinline__ void operator()(const AccT& acc, int wr, int wc, int fr, int fq) const {
        { const int tq_ = tidx(); wr = (tq_ >> 8) & 1; wc = (tq_ >> 6) & 3; fr = tq_ & 15; fq = (tq_ >> 4) & 3; }
        const int tq = tidx(); const f32x4* SGt = SG + tq; f32x4* STt = ST + tq;
        U4 for (int ai = 0; ai < 2; ++ai) U4 for (int mh = 0; mh < 2; ++mh) {
            f32x4 g[8], t[8];
            U4 for (int q = 0; q < 8; ++q) { const int i = ai * 16 + mh * 8 + q; g[q] = SGt[i * NTHREADS]; t[q] = first ? (f32x4){0.f, 0.f, 0.f, 0.f} : STt[i * NTHREADS]; }
            U4 for (int q = 0; q < 8; ++q) { const int m = mh * 2 + (q >> 2), bj = (q >> 1) & 1, n = q & 1, i = ai * 16 + mh * 8 + q; const int r = EPI_ROW, c = EPI_COL;
                const f32x4 v = acc[ai][bj][m][n] * g[q] + t[q];
                if (last) { u32x2 w; w.x = cvt_pk_bf16(v[0], v[1]); w.y = cvt_pk_bf16(v[2], v[3]); *(u32x2*)(MG + (size_t)r * 1024 + c) = w; }
                else STt[i * NTHREADS] = v; }
        }
    }
};
struct EpiResid {
    const float* xsrc; float* xdst; const float* gate;
    __device__ __forceinline__ void operator()(const AccT& acc, int wr, int wc, int fr, int fq) const {
        { const int tq_ = tidx(); wr = (tq_ >> 8) & 1; wc = (tq_ >> 6) & 3; fr = tq_ & 15; fq = (tq_ >> 4) & 3; }
        f32x4 gc[2][2];
        U4 for (int bj = 0; bj < 2; ++bj) U4 for (int n = 0; n < 2; ++n) gc[bj][n] = *(const f32x4*)(gate + EPI_COL);
        U4 for (int ai = 0; ai < 2; ++ai) U4 for (int mh = 0; mh < 2; ++mh) {
            f32x4 xo[2][2][2];
            U4 for (int mm = 0; mm < 2; ++mm) U4 for (int bj = 0; bj < 2; ++bj) U4 for (int n = 0; n < 2; ++n) { const int m = mh * 2 + mm; xo[mm][bj][n] = *(const f32x4*)(xsrc + (size_t)EPI_ROW * 1024 + EPI_COL); }
            U4 for (int mm = 0; mm < 2; ++mm) U4 for (int bj = 0; bj < 2; ++bj) U4 for (int n = 0; n < 2; ++n) { const int m = mh * 2 + mm; *(f32x4*)(xdst + (size_t)EPI_ROW * 1024 + EPI_COL) = xo[mm][bj][n] + gc[bj][n] * acc[ai][bj][m][n]; }
        }
    }
};
struct EpiSqrelu {
    bf16_t* H; int ldh;
    __device__ __forceinline__ void operator()(const AccT& acc, int wr, int wc, int fr, int fq) const {
        { const int tq_ = tidx(); wr = (tq_ >> 8) & 1; wc = (tq_ >> 6) & 3; fr = tq_ & 15; fq = (tq_ >> 4) & 3; }
        EPI_LOOP { const int r = EPI_ROW, c = EPI_COL; f32x4 v = acc[ai][bj][m][n];
#pragma unroll
            for (int j = 0; j < 4; ++j) { const float t = fmaxf(v[j], 0.f); v[j] = t * t; }
            u32x2 w; w.x = cvt_pk_bf16(v[0], v[1]); w.y = cvt_pk_bf16(v[2], v[3]); *(u32x2*)(H + (size_t)r * ldh + c) = w; }
    }
};

struct ProgInproj {
    const bf16_t* wt; const bf16_t* wg; const bf16_t* HX; bf16_t* T; bf16_t* PG; const float* biasT; const float* biasG; int nA, bid, G;
    __device__ __forceinline__ void desc(int i, UDesc& d) const { const int u = bid + i * G;
        if (u < nA) { const int tt = u >> 3, ct = u & 7; d.A = (const char*)(wt + (size_t)(ct * 256) * D); d.B = (const char*)(HX + (size_t)(tt * 256) * D); }
        else { const int v = u - nA, tt = v / 7, nt = v % 7; d.A = (const char*)(HX + (size_t)(tt * 256) * D); d.B = (const char*)(wg + (size_t)(nt * 256) * D); }
        d.lda = D; d.ldb = D; d.K = D; }
    __device__ __forceinline__ void epi(int i, const AccT& acc, int wr, int wc, int fr, int fq) const { const int u = bid + i * G;
        if (u < nA) { const int tt = u >> 3, ct = u & 7; EpiStoreBf16 E{T + (size_t)(ct * 256) * TOK + (size_t)tt * 256, (size_t)TOK, biasT + ct * 256, true}; E(acc, wr, wc, fr, fq); }
        else { const int v = u - nA, tt = v / 7, nt = v % 7; EpiStoreBf16 E{PG + (size_t)(tt * 256) * NG + nt * 256, (size_t)NG, biasG + nt * 256, false}; E(acc, wr, wc, fr, fq); } }
};
struct ProgMix {
    unsigned char* ws; unsigned char* scr; const float* bgate; unsigned tok0; int l;
    __device__ __forceinline__ void desc(int i, UDesc& d) const { const int nt = i / 6, j = i % 6, X = j >> 1;
        if (!(j & 1)) { d.A = (const char*)(ws + WS_HX) + (size_t)tok0 * D * 2; d.B = (const char*)(ws + WS_WGATE + l * SZ_WGATE) + (size_t)(X * 1024 + nt * 256) * D * 2; d.lda = D; d.ldb = D; d.K = D; }
        else { d.A = X == 0 ? (const char*)(scr + SC_TRY) : (X == 1 ? (const char*)(ws + WS_YG) + (size_t)tok0 * 1024 : (const char*)(scr + SC_TRP));
               d.B = (const char*)(ws + WS_WBR + (size_t)l * 3 * SZ_WBR) + (size_t)X * SZ_WBR + (size_t)(nt * 256) * 1024; d.lda = 512; d.ldb = 512; d.K = 512; } }
    __device__ __forceinline__ void epi(int i, const AccT& acc, int wr, int wc, int fr, int fq) const { const int nt = i / 6, j = i % 6, X = j >> 1;
        if (!(j & 1)) { EpiGate E{(f32x4*)(scr + SC_SG), bgate + X * 1024 + nt * 256}; E(acc, wr, wc, fr, fq); }
        else { EpiBranch E{(const f32x4*)(scr + SC_SG), (f32x4*)(scr + SC_ST), (bf16_t*)(scr + SC_MERGED) + nt * 256, X == 0, X == 2}; E(acc, wr, wc, fr, fq); } }
};
struct ProgResid {
    const bf16_t* A; int lda; const bf16_t* W; int ldw, K; size_t wstep; const float* xsrc; float* xdst; const float* gate;
    __device__ __forceinline__ void desc(int i, UDesc& d) const { d.A = (const char*)A; d.B = (const char*)(W + (size_t)i * wstep); d.lda = lda; d.ldb = ldw; d.K = K; }
    __device__ __forceinline__ void epi(int i, const AccT& acc, int wr, int wc, int fr, int fq) const { EpiResid E{xsrc + i * 256, xdst + i * 256, gate + i * 256}; E(acc, wr, wc, fr, fq); }
};
struct ProgUp {
    const bf16_t* XN; const bf16_t* W; bf16_t* HID;
    __device__ __forceinline__ void desc(int i, UDesc& d) const { d.A = (const char*)XN; d.B = (const char*)(W + (size_t)(i * 256) * D); d.lda = D; d.ldb = D; d.K = D; }
    __device__ __forceinline__ void epi(int i, const AccT& acc, int wr, int wc, int fr, int fq) const { EpiSqrelu E{HID + i * 256, 2048}; E(acc, wr, wc, fr, fq); }
};


struct XMap { int NT, per_xcd, x, j;
    __device__ __forceinline__ void init(int bid, int ntt, int nt_) { NT = nt_; per_xcd = (ntt >> 3) * nt_; x = bid & 7; j = bid >> 3; }
    __device__ __forceinline__ int rounds() const { return j < per_xcd ? (per_xcd - j + 31) / 32 : 0; }
    __device__ __forceinline__ void get(int i, int& tt, int& nt) const { const int q = i * 32 + j; tt = x + 8 * (q / NT); nt = q % NT; }
};
struct TileIO { const float* xin; const float* ctxin; float* out; float* ctxs; const float* modl; int l;
    __device__ __forceinline__ const float* src(int tt) const { return tt < 256 ? (l == 0 ? xin : out) + (size_t)tt * 256 * D : ctxin + (size_t)(tt - 256) * 256 * D; }
    __device__ __forceinline__ float* dst(int tt) const { return tt < 256 ? out + (size_t)tt * 256 * D : ctxs + (size_t)(tt - 256) * 256 * D; }
    __device__ __forceinline__ const float* cur(int tt) const { return tt < 256 ? out + (size_t)tt * 256 * D : ctxs + (size_t)(tt - 256) * 256 * D; }
    __device__ __forceinline__ const float* mod(int tt) const { return modl + (size_t)(tt < 256 ? tt >> 3 : 32) * 6144; }
};
struct ProgMix2 {
    unsigned char* ws; unsigned char* stash; const float* bgate; XMap M; int l;
    __device__ __forceinline__ void desc(int ii, UDesc& d) const { int tt, nt; M.get(ii / 6, tt, nt); const int s6 = ii % 6, X = s6 >> 1;
        if (!(s6 & 1)) { d.A = (const char*)(ws + WS_HX) + (size_t)tt * 256 * D * 2; d.B = (const char*)(ws + WS_WGATE + l * SZ_WGATE) + (size_t)(X * 1024 + nt * 256) * D * 2; d.lda = D; d.ldb = D; d.K = D; }
        else { d.A = (const char*)(ws + (X == 0 ? WS_YHY : (X == 1 ? WS_YG : WS_YPL))) + (size_t)tt * 256 * 1024;
               d.B = (const char*)(ws + WS_WBR + (size_t)l * 3 * SZ_WBR) + (size_t)X * SZ_WBR + (size_t)(nt * 256) * 1024; d.lda = 512; d.ldb = 512; d.K = 512; } }
    __device__ __forceinline__ void epi(int ii, const AccT& acc, int wr, int wc, int fr, int fq) const { int tt, nt; M.get(ii / 6, tt, nt); const int s6 = ii % 6, X = s6 >> 1;
        if (!(s6 & 1)) { EpiGate E{(f32x4*)stash, bgate + X * 1024 + nt * 256}; E(acc, wr, wc, fr, fq); }
        else { EpiBranch E{(const f32x4*)stash, (f32x4*)(stash + 262144), (bf16_t*)(ws + WS_MERGED) + (size_t)tt * 256 * 1024 + nt * 256, X == 0, X == 2}; E(acc, wr, wc, fr, fq); } }
};
struct ProgOut2 {
    unsigned char* ws; TileIO io; XMap M; int l;
    __device__ __forceinline__ void desc(int i, UDesc& d) const { int tt, nt; M.get(i, tt, nt);
        d.A = (const char*)(ws + WS_MERGED) + (size_t)tt * 256 * 2048; d.B = (const char*)(ws + WS_WOUT + l * SZ_WOUT) + (size_t)(nt * 256) * D * 2; d.lda = D; d.ldb = D; d.K = D; }
    __device__ __forceinline__ void epi(int i, const AccT& acc, int wr, int wc, int fr, int fq) const { int tt, nt; M.get(i, tt, nt);
        EpiResid E{io.src(tt) + nt * 256, io.dst(tt) + nt * 256, io.mod(tt) + 2048 + nt * 256}; E(acc, wr, wc, fr, fq); }
};
struct ProgUp2 {
    unsigned char* ws; XMap M; int l;
    __device__ __forceinline__ void desc(int i, UDesc& d) const { int tt, nt; M.get(i, tt, nt);
        d.A = (const char*)(ws + WS_HX) + (size_t)tt * 256 * 2048; d.B = (const char*)(ws + WS_WUP + l * SZ_WUP) + (size_t)(nt * 256) * D * 2; d.lda = D; d.ldb = D; d.K = D; }
    __device__ __forceinline__ void epi(int i, const AccT& acc, int wr, int wc, int fr, int fq) const { int tt, nt; M.get(i, tt, nt);
        EpiSqrelu E{(bf16_t*)(ws + WS_HID) + (size_t)tt * 256 * DFF + nt * 256, DFF}; E(acc, wr, wc, fr, fq); }
};
struct ProgDown2 {
    unsigned char* ws; TileIO io; XMap M; int l;
    __device__ __forceinline__ void desc(int i, UDesc& d) const { int tt, nt; M.get(i, tt, nt);
        d.A = (const char*)(ws + WS_HID) + (size_t)tt * 256 * DFF * 2; d.B = (const char*)(ws + WS_WDN + l * SZ_WDN) + (size_t)(nt * 256) * DFF * 2; d.lda = DFF; d.ldb = DFF; d.K = DFF; }
    __device__ __forceinline__ void epi(int i, const AccT& acc, int wr, int wc, int fr, int fq) const { int tt, nt; M.get(i, tt, nt);
        EpiResid E{io.cur(tt) + nt * 256, io.dst(tt) + nt * 256, io.mod(tt) + 5120 + nt * 256}; E(acc, wr, wc, fr, fq); }
};

__device__ void tconv(const float* src, int ld, int c0, int nvalid, int ncols, int K, bf16_t* dst, LAS float* tile) {
    const int tid = tidx(), ntn = ncols / 64, ntile = ntn * (K / 64);
    for (int t = blockIdx.x; t < ntile; t += gridDim.x) {
        const int k0 = (t / ntn) * 64, n0 = (t % ntn) * 64;
        __syncthreads();
#pragma unroll
        for (int i = 0; i < 8; ++i) { const int k = i * 8 + (tid >> 6), n = tid & 63;
            tile[k * 65 + n] = (n0 + n < nvalid) ? src[(size_t)(k0 + k) * ld + c0 + n0 + n] : 0.f; }
        __syncthreads();
        const int n = tid >> 3, kc = (tid & 7) * 8;
        u32x4 w;
        w.x = cvt_pk_bf16(tile[(kc + 0) * 65 + n], tile[(kc + 1) * 65 + n]); w.y = cvt_pk_bf16(tile[(kc + 2) * 65 + n], tile[(kc + 3) * 65 + n]);
        w.z = cvt_pk_bf16(tile[(kc + 4) * 65 + n], tile[(kc + 5) * 65 + n]); w.w = cvt_pk_bf16(tile[(kc + 6) * 65 + n], tile[(kc + 7) * 65 + n]);
        *(u32x4*)(dst + (size_t)(n0 + n) * K + k0 + kc) = w;
    }
    __syncthreads();
}

__device__ __forceinline__ void job_poolcomb(const Params& p, int l) {
    const float* pw = p.in[I_PW] + (size_t)l * 4 * 128 * 128; const float* sc = p.in[I_PSC] + l * 512; const float* wb = p.in[I_WBP] + (size_t)l * 512 * 1024;
    bf16_t* dst = (bf16_t*)(p.ws + WS_WBR + (size_t)(l * 3 + 2) * SZ_WBR);
    for (int idx = blockIdx.x * NTHREADS + tidx(); idx < 512 * 1024; idx += gridDim.x * NTHREADS) {
        const int n = idx & 1023, k = idx >> 10, g = k >> 7, c = k & 127;
        float a = 0.f;
        for (int d = 0; d < 128; ++d) a += pw[(g * 128 + c) * 128 + d] * sc[g * 128 + d] * wb[(size_t)(g * 128 + d) * 1024 + n];
        dst[(size_t)n * 512 + k] = f2bf(a);
    }
}

__device__ __forceinline__ void job_bias(const Params& p) {
    float* bias = (float*)(p.ws + WS_BIAS);
    for (int idx = blockIdx.x * NTHREADS + tidx(); idx < 2 * (NTR + NG); idx += gridDim.x * NTHREADS) {
        const int l = idx / (NTR + NG), j = idx % (NTR + NG); const float* b = p.in[I_BIN] + l * N_IN;
        float v;
        if (j < 1536) v = b[j]; else if (j < NTR) v = b[POOL_OFF + (j - 1536)]; else { const int q = j - NTR; v = q < NGV ? b[GLA_OFF + q] : 0.f; }
        bias[idx] = v;
    }
}

__device__ __forceinline__ void job_mod(const Params& p, LAS float* sil) {
    if (blockIdx.x >= 192) return;
    const int tid = tidx();
    __syncthreads();
    for (int idx = tid; idx < 33 * 1024; idx += NTHREADS) { const int r = idx >> 10, k = idx & 1023; const float v = r < 32 ? p.in[I_C][r * 1024 + k] : p.in[I_CCTX][k]; sil[idx] = v / (1.f + expf(-v)); }
    __syncthreads();
    float* mod = (float*)(p.ws + WS_MOD);
    for (int it = blockIdx.x; it < 192; it += gridDim.x) {
        const int l = it / 96, n = (it % 96) * 64 + (tid & 63), rg = tid >> 6;
        const float* w = p.in[I_WMOD] + (size_t)l * 1024 * 6144 + n;
        float a0 = 0.f, a1 = 0.f, a2 = 0.f, a3 = 0.f, a4 = 0.f; const int r4 = (rg == 0) ? 32 : 0;
#pragma unroll 8
        for (int k = 0; k < 1024; ++k) { const float wv = w[(size_t)k * 6144];
            a0 += sil[rg * 1024 + k] * wv; a1 += sil[(rg + 8) * 1024 + k] * wv; a2 += sil[(rg + 16) * 1024 + k] * wv; a3 += sil[(rg + 24) * 1024 + k] * wv; a4 += sil[r4 * 1024 + k] * wv; }
        const float bm = p.in[I_BMOD][l * 6144 + n];
        float* o = mod + (size_t)l * 33 * 6144 + n;
        o[(size_t)rg * 6144] = a0 + bm; o[(size_t)(rg + 8) * 6144] = a1 + bm; o[(size_t)(rg + 16) * 6144] = a2 + bm; o[(size_t)(rg + 24) * 6144] = a3 + bm;
        if (rg == 0) o[(size_t)32 * 6144] = a4 + bm;
    }
    __syncthreads();
}

__device__ __forceinline__ void job_filters(const Params& p, LAS unsigned char* lds) {
    LAS float* a1 = (LAS float*)lds;
    LAS float* a2 = (LAS float*)(lds + 16384);
    LAS bf16_t* oT = (LAS bf16_t*)(lds + 16384 + 16640);
    const int tid = tidx();
    const int nitems = (32 + 4 + 32) * 4;
    for (int it = blockIdx.x; it < nitems; it += gridDim.x) {
        const int oc = it & 3; int rt = it >> 2; int l, L, t0; bf16_t* dst;
        if (rt < 32) { l = 0; L = 2048; t0 = rt * 64; dst = (bf16_t*)(p.ws + WS_HFL); }
        else if (rt < 36) { l = 0; L = 256; t0 = (rt - 32) * 64; dst = (bf16_t*)(p.ws + WS_HFC); }
        else { l = 1; L = 2048; t0 = (rt - 36) * 64; dst = (bf16_t*)(p.ws + WS_HFL) + (size_t)4 * 512 * 2048; }
        const float* w1 = p.in[I_FW1] + l * 17 * 64; const float* b1 = p.in[I_FB1] + l * 64; const float* fq = p.in[I_FFREQ] + l * 64;
        const float* w2 = p.in[I_FW2] + l * 64 * 64; const float* b2 = p.in[I_FB2] + l * 64; const float* w3 = p.in[I_FW3] + (size_t)l * 64 * 2048;
        __syncthreads();
        { const int row = tid >> 3, jg = (tid & 7) * 8; const float t = (float)(t0 + row); float z[17];
          z[0] = t / (float)L;
#pragma unroll
          for (int bnd = 1; bnd <= 8; ++bnd) { const float ang = (6.283185307179586f / (float)L) * t * (float)bnd; z[bnd] = cosf(ang); z[8 + bnd] = sinf(ang); }
#pragma unroll
          for (int j = 0; j < 8; ++j) { float s = b1[jg + j];
#pragma unroll
              for (int i = 0; i < 17; ++i) s += z[i] * w1[i * 64 + jg + j];
              a1[row * 64 + jg + j] = sinf(fq[jg + j] * s); } }
        __syncthreads();
        { const int row = tid >> 3, jg = (tid & 7) * 8;
#pragma unroll
          for (int j = 0; j < 8; ++j) { float s = b2[jg + j];
              for (int i = 0; i < 64; ++i) s += a1[row * 64 + i] * w2[i * 64 + jg + j];
              a2[row * 65 + jg + j] = sinf(fq[jg + j] * s); } }
        __syncthreads();
        { const int o = oc * 512 + tid, c = o & 511; float wreg[64];
#pragma unroll
          for (int j = 0; j < 64; ++j) wreg[j] = w3[(size_t)j * 2048 + o];
          const float delta = 3.0701134573253943f + (float)c * ((15.350567286626972f - 3.0701134573253943f) / 511.f);
          for (int row = 0; row < 64; ++row) { float s = 0.f;
#pragma unroll
              for (int j = 0; j < 64; ++j) s += a2[row * 65 + j] * wreg[j];
              const float win = expf(-((float)(t0 + row) / (float)L) * delta);
              oT[tid * 72 + row] = f2bf(s * win); } }
        __syncthreads();
        for (int q = tid; q < 4096; q += NTHREADS) { const int ol = q >> 3, ch = (q & 7) * 8; const int o = oc * 512 + ol, dir = o >> 10, ord = (o >> 9) & 1, c = o & 511;
            const u32x4 w = *(const LAS u32x4*)(oT + ol * 72 + ch);
            *(u32x4*)(dst + ((size_t)((ord * 2 + dir) * 512 + c)) * L + t0 + ch) = w; }
    }
    __syncthreads();
}

__device__ __forceinline__ void ada_row(const float* x, const float* g, const float* sh, const float* sc, bf16_t* dst, float* fdst, int lane) {
    f32x4 v[4]; float ss = 0.f;
#pragma unroll
    for (int i = 0; i < 4; ++i) { v[i] = *(const f32x4*)(x + i * 256 + lane * 4); ss += v[i][0] * v[i][0] + v[i][1] * v[i][1] + v[i][2] * v[i][2] + v[i][3] * v[i][3]; }
    ss = wave_sum(ss);
    const float inv = rsqrtf(ss * (1.f / 1024.f) + EPS);
#pragma unroll
    for (int i = 0; i < 4; ++i) { const int c = i * 256 + lane * 4; const f32x4 gg = *(const f32x4*)(g + c); f32x4 y = v[i] * inv * gg;
        if (sh) { const f32x4 s1 = *(const f32x4*)(sc + c), s0 = *(const f32x4*)(sh + c); y = y * (1.f + s1) + s0;
            u32x2 w; w.x = cvt_pk_bf16(y[0], y[1]); w.y = cvt_pk_bf16(y[2], y[3]); *(u32x2*)(dst + c) = w; }
        else *(f32x4*)(fdst + c) = y; }
}

typedef float f32x16 __attribute__((ext_vector_type(16)));
template <int L, int NT>
__device__ __forceinline__ void hyena_mfma(const Params& p, int l, int c, bool ctx, LAS unsigned char* lds) {
    LAS unsigned char* U = lds;
    LAS unsigned* F = (LAS unsigned*)(lds + L * 64);
    LAS bf16_t* F16 = (LAS bf16_t*)F;
    const int tid = tidx(), lane = tid & 63, w = __builtin_amdgcn_readfirstlane(tid >> 6), li = lane & 31, kg = lane >> 5;
    bf16_t* T = (bf16_t*)(p.ws + WS_T);
    const size_t tokb = ctx ? (size_t)TOKL : 0;
    const bf16_t* hf = ctx ? (const bf16_t*)(p.ws + WS_HFC) : (const bf16_t*)(p.ws + WS_HFL) + (size_t)l * 4 * 512 * 2048;
    const float* sw = p.in[I_HSW] + (size_t)l * 3 * 1536; const float* sb = p.in[I_HSB] + l * 1536;
    __syncthreads();
    {
        const int cc = 1024 + c; const bf16_t* row = T + (size_t)cc * TOK + tokb;
        const float w0 = sw[cc], w1 = sw[1536 + cc], w2 = sw[3072 + cc], bb = sb[cc];
        for (int idx = tid; idx < L * 4; idx += NTHREADS) { const int b = idx & 31, t8 = idx >> 5; const bf16_t* pr = row + (size_t)b * L + t8 * 8;
            const u32x4 r = *(const u32x4*)pr;
            float x[10]; x[0] = t8 > 0 ? bf2f(pr[-1]) : 0.f; x[9] = t8 < L / 8 - 1 ? bf2f(pr[8]) : 0.f;
            x[1] = lo16(r.x); x[2] = hi16(r.x); x[3] = lo16(r.y); x[4] = hi16(r.y); x[5] = lo16(r.z); x[6] = hi16(r.z); x[7] = lo16(r.w); x[8] = hi16(r.w);
            float y[8];
#pragma unroll
            for (int j = 0; j < 8; ++j) y[j] = w0 * x[j] + w1 * x[j + 1] + w2 * x[j + 2] + bb;
            u32x4 o; o.x = cvt_pk_bf16(y[0], y[1]); o.y = cvt_pk_bf16(y[2], y[3]); o.z = cvt_pk_bf16(y[4], y[5]); o.w = cvt_pk_bf16(y[6], y[7]);
            *(LAS u32x4*)(U + (size_t)idx * 16) = o; }
    }
    const int lane_dw = (li & 1) * L + ((8 * kg - li + L - (li & 1)) >> 1);
#define HY_LOADA(dst, f) do { const LAS unsigned* _q = F + (lane_dw - 8 * (f)); u32x4 _v; _v.x = _q[0]; _v.y = _q[1]; _v.z = _q[2]; _v.w = _q[3]; dst = __builtin_bit_cast(bf16x8, _v); } while (0)
#define HY_LOADB(dst, s0) dst = *(const LAS bf16x8*)(U + ((s0) >> 3) * 512 + lane * 16)
    for (int ord = 0; ord < 2; ++ord) {
        __syncthreads();
        for (int x = tid; x < 2 * L; x += NTHREADS) {
            bf16_t v = 0;
            if (x >= 1 && x <= L) v = hf[((size_t)((ord * 2 + 0) * 512 + c)) * L + (L - x)];
            else if (x > L) v = hf[((size_t)((ord * 2 + 1) * 512 + c)) * L + (x - L)];
            F16[x] = v; if (x >= 1) F16[2 * L + x - 1] = v; if (x == 2 * L - 1) F16[4 * L - 1] = 0; }
        __syncthreads();
        f32x16 acc[NT];
#pragma unroll
        for (int i = 0; i < NT; ++i)
#pragma unroll
            for (int r = 0; r < 16; ++r) acc[i][r] = 0.f;
        bf16x8 E[NT], O[NT];
#pragma unroll
        for (int i = 1; i < NT; ++i) { HY_LOADA(E[i], 2 * (NT * w + i)); HY_LOADA(O[i], 2 * (NT * w + i) - 1); }
        for (int n8 = 0; n8 < L / 32; n8 += 8) {
#pragma unroll
            for (int u = 0; u < 8; ++u) { const int n = n8 + u; const int fe = 2 * (NT * w - n); bf16x8 Bf;
                HY_LOADA(E[(8 - u) & (NT - 1)], fe); HY_LOADB(Bf, 32 * n);
#pragma unroll
                for (int i = 0; i < NT; ++i) acc[i] = __builtin_amdgcn_mfma_f32_32x32x16_bf16(E[(i - u) & (NT - 1)], Bf, acc[i], 0, 0, 0);
                HY_LOADA(O[(8 - u) & (NT - 1)], fe - 1); HY_LOADB(Bf, 32 * n + 16);
#pragma unroll
                for (int i = 0; i < NT; ++i) acc[i] = __builtin_amdgcn_mfma_f32_32x32x16_bf16(O[(i - u) & (NT - 1)], Bf, acc[i], 0, 0, 0);
            }
        }
        __syncthreads();
        const int xc = ord * 512 + c; const bf16_t* xrow = T + (size_t)xc * TOK + tokb + (size_t)li * L;
        bf16_t* orow = T + (size_t)c * TOK + tokb + (size_t)li * L;
        const float w0 = sw[xc], w1 = sw[1536 + xc], w2 = sw[3072 + xc], bb = sb[xc], sk = p.in[I_HSKIP][(l * 2 + ord) * 512 + c];
#pragma unroll
        for (int i = 0; i < NT; ++i)
#pragma unroll
            for (int rg = 0; rg < 4; ++rg) { const int tb = 32 * (NT * w + i) + 8 * rg + 4 * kg;
                const u32x2 xr = *(const u32x2*)(xrow + tb);
                float x[6]; x[0] = tb > 0 ? bf2f(xrow[tb - 1]) : 0.f; x[5] = tb + 4 < L ? bf2f(xrow[tb + 4]) : 0.f;
                x[1] = lo16(xr.x); x[2] = hi16(xr.x); x[3] = lo16(xr.y); x[4] = hi16(xr.y);
                LAS u32x2* up = (LAS u32x2*)(U + ((tb >> 3) * 32 + li) * 16 + (tb & 7) * 2);
                const u32x2 uv = *up; const float uu[4] = {lo16(uv.x), hi16(uv.x), lo16(uv.y), hi16(uv.y)};
                float z[4];
#pragma unroll
                for (int j = 0; j < 4; ++j) z[j] = (w0 * x[j] + w1 * x[j + 1] + w2 * x[j + 2] + bb) * (acc[i][rg * 4 + j] + sk * uu[j]);
                u32x2 o; o.x = cvt_pk_bf16(z[0], z[1]); o.y = cvt_pk_bf16(z[2], z[3]);
                if (ord == 0) *up = o; else *(u32x2*)(orow + tb) = o; }
    }
#undef HY_LOADA
#undef HY_LOADB
    __syncthreads();
}

__device__ __forceinline__ void gla_item(const Params& p, int l, int b, int h, int dir, LAS float* lf) {
    const int tid = tidx(), qd = tid & 3, dv = tid >> 2;
    LAS float* qL = lf; LAS float* kL = lf + 2048; LAS float* aL = lf + 4096; LAS float* vL = lf + 6144; LAS float* oL = lf + 10240; LAS float* waL = lf + 14336; LAS float* baL = lf + 15360;
    const bf16_t* PG = (const bf16_t*)(p.ws + WS_PG);
    bf16_t* O = (bf16_t*)(p.ws + WS_OF) + (size_t)dir * TOK * 512;
    const float* wa = (dir ? p.in[I_WAB] : p.in[I_WAF]) + l * 16 * 256; const float* ba = (dir ? p.in[I_BAB] : p.in[I_BAF]) + l * 256;
    __syncthreads();
    for (int i = tid; i < 1024; i += NTHREADS) waL[i] = wa[(i >> 6) * 256 + h * 64 + (i & 63)];
    if (tid < 64) baL[tid] = ba[h * 64 + tid];
    float S[16];
#pragma unroll
    for (int i = 0; i < 16; ++i) S[i] = 0.f;
    const int sp = tid >> 4, sc4 = (tid & 15) * 4, sc8 = (tid & 15) * 8;
    for (int ck = 0; ck < 72; ++ck) {
        const int P = ck * 32 + sp; size_t row;
        if (P < 256) row = (size_t)TOKL + b * 256 + (dir ? 255 - P : P); else { const int tl = P - 256; row = (size_t)b * 2048 + (dir ? 2047 - tl : tl); }
        const bf16_t* pr = PG + row * NG;
        __syncthreads();
        { const u32x2 wq = *(const u32x2*)(pr + h * 64 + sc4), wk = *(const u32x2*)(pr + 256 + h * 64 + sc4);
          *(LAS f32x4*)(qL + sp * 64 + sc4) = (f32x4){lo16(wq.x) * 0.125f, hi16(wq.x) * 0.125f, lo16(wq.y) * 0.125f, hi16(wq.y) * 0.125f};
          *(LAS f32x4*)(kL + sp * 64 + sc4) = (f32x4){lo16(wk.x), hi16(wk.x), lo16(wk.y), hi16(wk.y)};
          const u32x4 wv = *(const u32x4*)(pr + 512 + h * 128 + sc8);
          *(LAS f32x4*)(vL + sp * 128 + sc8) = (f32x4){lo16(wv.x), hi16(wv.x), lo16(wv.y), hi16(wv.y)};
          *(LAS f32x4*)(vL + sp * 128 + sc8 + 4) = (f32x4){lo16(wv.z), hi16(wv.z), lo16(wv.w), hi16(wv.w)};
          const u32x4 g0 = *(const u32x4*)(pr + 1536 + dir * 16), g1 = *(const u32x4*)(pr + 1536 + dir * 16 + 8);
          float gt[16] = {lo16(g0.x), hi16(g0.x), lo16(g0.y), hi16(g0.y), lo16(g0.z), hi16(g0.z), lo16(g0.w), hi16(g0.w),
                          lo16(g1.x), hi16(g1.x), lo16(g1.y), hi16(g1.y), lo16(g1.z), hi16(g1.z), lo16(g1.w), hi16(g1.w)};
#pragma unroll
          for (int j = 0; j < 4; ++j) { float z = baL[sc4 + j];
#pragma unroll
              for (int r = 0; r < 16; ++r) z += gt[r] * waL[r * 64 + sc4 + j];
              const float ls = -(fmaxf(-z, 0.f) + log1pf(expf(-fabsf(z))));
              aL[sp * 64 + sc4 + j] = expf(ls * (1.f / 16.f)); } }
        __syncthreads();
        for (int pos = 0; pos < 32; ++pos) {
            const float vv = vL[pos * 128 + dv]; float part = 0.f;
#pragma unroll
            for (int i4 = 0; i4 < 4; ++i4) { const f32x4 aa = *(const LAS f32x4*)(aL + pos * 64 + qd * 16 + i4 * 4), kk = *(const LAS f32x4*)(kL + pos * 64 + qd * 16 + i4 * 4), qq = *(const LAS f32x4*)(qL + pos * 64 + qd * 16 + i4 * 4);
#pragma unroll
                for (int j = 0; j < 4; ++j) { S[i4 * 4 + j] = aa[j] * S[i4 * 4 + j] + kk[j] * vv; part += qq[j] * S[i4 * 4 + j]; } }
            part += __shfl_xor(part, 1); part += __shfl_xor(part, 2);
            if (qd == 0) oL[pos * 128 + dv] = part;
        }
        __syncthreads();
        { const f32x4 o0 = *(const LAS f32x4*)(oL + sp * 128 + sc8), o1 = *(const LAS f32x4*)(oL + sp * 128 + sc8 + 4);
          u32x4 w; w.x = cvt_pk_bf16(o0[0], o0[1]); w.y = cvt_pk_bf16(o0[2], o0[3]); w.z = cvt_pk_bf16(o1[0], o1[1]); w.w = cvt_pk_bf16(o1[2], o1[3]);
          *(u32x4*)(O + row * 512 + h * 128 + sc8) = w; }
    }
    __syncthreads();
}

template <int W>
__device__ __forceinline__ void pool2d_wave(bf16_t* base, int lane) {
    float u[32], pv[33];
#pragma unroll
    for (int r = 0; r < 32; ++r) u[r] = bf2f(base[r * 64 + lane]);
    pv[0] = 0.f;
#pragma unroll
    for (int r = 0; r < 32; ++r) pv[r + 1] = pv[r] + u[r];
    const int cl = max(lane - W / 2, 0), chh = min(lane - W / 2 + W, 64);
#pragma unroll
    for (int r = 0; r < 32; ++r) {
        const int rl = (r - W / 2) < 0 ? 0 : (r - W / 2), rh = (r - W / 2 + W) > 32 ? 32 : (r - W / 2 + W);
        float x = pv[rh] - pv[rl];
#pragma unroll
        for (int d = 1; d < 64; d <<= 1) { const float y = __shfl_up(x, d); if (lane >= d) x += y; }
        const float hi = __shfl(x, chh - 1), lo = __shfl(x, cl > 0 ? cl - 1 : 0);
        const float s = hi - (cl > 0 ? lo : 0.f);
        const float cnt = (float)((rh - rl) * (chh - cl));
        base[r * 64 + lane] = f2bf(s / cnt - u[r]);
    }
}
__device__ __forceinline__ void pool1d_wave(bf16_t* base, int lane, int W) {
    float u[4], P[4];
#pragma unroll
    for (int j = 0; j < 4; ++j) u[j] = bf2f(base[j * 64 + lane]);
    float off = 0.f;
#pragma unroll
    for (int j = 0; j < 4; ++j) { float x = u[j];
#pragma unroll
        for (int d = 1; d < 64; d <<= 1) { const float y = __shfl_up(x, d); if (lane >= d) x += y; }
        P[j] = x + off; off += __shfl(x, 63); }
#pragma unroll
    for (int j = 0; j < 4; ++j) { const int t = j * 64 + lane; const int lo = max(t - W / 2, 0), hi = min(t - W / 2 + W, 256);
        const int ih = hi - 1, il = lo > 0 ? lo - 1 : 0;
        float vh = 0.f, vl = 0.f;
#pragma unroll
        for (int s = 0; s < 4; ++s) { const float a = __shfl(P[s], ih & 63), bq = __shfl(P[s], il & 63); if ((ih >> 6) == s) vh = a; if ((il >> 6) == s) vl = bq; }
        const float sum = vh - (lo > 0 ? vl : 0.f);
        u[j] = sum / (float)(hi - lo) - u[j]; }
#pragma unroll
    for (int j = 0; j < 4; ++j) base[j * 64 + lane] = f2bf(u[j]);
}

__global__ void __launch_bounds__(NTHREADS, 2) mega(Params p) {
    extern __shared__ __attribute__((aligned(16))) unsigned char lds_raw[];
    LAS unsigned char* lds = (LAS unsigned char*)lds_raw;
    LAS float* lf = (LAS float*)lds;
    cg::grid_group grid = cg::this_grid();
    const int G = gridDim.x, bid = blockIdx.x;
#define WSPTRS const int tid = tidx(), lane = tid & 63, wid = tid >> 6; (void)lane; (void)wid; unsigned char* ws = opq(p.ws); bf16_t* HX = (bf16_t*)(ws + WS_HX); bf16_t* T = (bf16_t*)(ws + WS_T); bf16_t* YG = (bf16_t*)(ws + WS_YG); bf16_t* PG = (bf16_t*)(ws + WS_PG); \
    float* CTXS = (float*)(ws + WS_CTX); const float* MOD = (const float*)(ws + WS_MOD); const float* BIAS = (const float*)(ws + WS_BIAS); (void)HX; (void)T; (void)YG; (void)PG; (void)CTXS; (void)MOD; (void)BIAS;

#ifdef TIMEX
    unsigned long long tx0 = 0, tx1 = 0; int txn = 0;
#define TX_MARK() do { if (txn == TIMEX) tx0 = __builtin_amdgcn_s_memrealtime(); if (txn == TIMEX + 1) tx1 = __builtin_amdgcn_s_memrealtime(); ++txn; } while (0)
    unsigned long long cx0 = 0, cxacc = 0;
#define CX_BEGIN(k) do { if (TIMEX == 100 + (k) && l == 1) { __syncthreads(); cx0 = __builtin_amdgcn_s_memrealtime(); } } while (0)
#define CX_END(k) do { if (TIMEX == 100 + (k) && l == 1) { __syncthreads(); cxacc += __builtin_amdgcn_s_memrealtime() - cx0; } } while (0)
#else
#define TX_MARK() do {} while (0)
#define CX_BEGIN(k) do {} while (0)
#define CX_END(k) do {} while (0)
#endif
    TX_MARK();
    for (int l = 0; l < 2; ++l) {
        unsigned char* ws = opq(p.ws);
        const float* win = p.in[I_WIN] + (size_t)l * D * N_IN;
        bf16_t* wt = (bf16_t*)(ws + WS_WT + l * SZ_WT);
        tconv(win, N_IN, 0, 1536, 1536, D, wt, lf);
        tconv(win, N_IN, POOL_OFF, 512, 512, D, wt + (size_t)1536 * D, lf);
        tconv(win, N_IN, GLA_OFF, NGV, NG, D, (bf16_t*)(ws + WS_WG + l * SZ_WG), lf);
        tconv(win, N_IN, GATE_OFF, 3072, 3072, D, (bf16_t*)(ws + WS_WGATE + l * SZ_WGATE), lf);
        tconv(p.in[I_WBH] + (size_t)l * 512 * 1024, 1024, 0, 1024, 1024, 512, (bf16_t*)(ws + WS_WBR + (size_t)(l * 3 + 0) * SZ_WBR), lf);
        tconv(p.in[I_WBG] + (size_t)l * 512 * 1024, 1024, 0, 1024, 1024, 512, (bf16_t*)(ws + WS_WBR + (size_t)(l * 3 + 1) * SZ_WBR), lf);
        tconv(p.in[I_WOUT] + (size_t)l * D * D, D, 0, D, D, D, (bf16_t*)(ws + WS_WOUT + l * SZ_WOUT), lf);
        tconv(p.in[I_WUP] + (size_t)l * D * DFF, DFF, 0, DFF, DFF, D, (bf16_t*)(ws + WS_WUP + l * SZ_WUP), lf);
        tconv(p.in[I_WDN] + (size_t)l * DFF * D, D, 0, D, D, DFF, (bf16_t*)(ws + WS_WDN + l * SZ_WDN), lf);
        job_poolcomb(p, l);
    }
    job_bias(p);
    job_mod(p, lf);
    job_filters(p, lds);
    grid.sync();

    { WSPTRS
    for (int row = bid * 8 + wid; row < TOK; row += G * 8) {
        const bool isl = row < TOKL; const float* x = isl ? p.in[I_X] + (size_t)row * D : p.in[I_CTX] + (size_t)(row - TOKL) * D;
        const float* mr = MOD + (size_t)(isl ? row >> 11 : 32) * 6144;
        ada_row(x, p.in[I_NMIX], mr, mr + 1024, HX + (size_t)row * D, nullptr, lane);
    } }
    grid.sync();
    TX_MARK();

    for (int l_ = 0; l_ < 2; ++l_) {
        const int l = opqi(l_);
        { WSPTRS
            const int ntokt = l == 0 ? 288 : 256;
            const int nA = ntokt * 8, nB = 288 * 7;
            const bf16_t* wt = (const bf16_t*)(ws + WS_WT + l * SZ_WT); const bf16_t* wg = (const bf16_t*)(ws + WS_WG + l * SZ_WG);
            const float* biasT = BIAS + l * (NTR + NG); const float* biasG = biasT + NTR;
            ProgInproj P{wt, wg, HX, T, PG, biasT, biasG, nA, bid, G};
            const int ntot = nA + nB; const int cnt = bid < ntot ? (ntot - bid + G - 1) / G : 0;
            gemm_stream(lds, cnt, P);
        }
        grid.sync();
        TX_MARK();
        { WSPTRS
            for (int it = bid; it < 256; it += G) gla_item(p, l, it >> 3, (it >> 1) & 3, it & 1, lf);
            for (int it = bid; it < 512; it += G) hyena_mfma<2048, 8>(p, l, it, false, lds);
            if (l == 0) for (int it = bid; it < 512; it += G) hyena_mfma<256, 1>(p, l, it, true, lds);
            const int npl = l == 0 ? 32768 : 16384;
            for (int it = bid * 8 + wid; it < npl; it += G * 8) { const bool cx = it >= 16384; const int j = it & 16383, ch = j >> 5, b = j & 31, g = ch >> 7;
                bf16_t* base = T + (size_t)(1536 + ch) * TOK + (cx ? (size_t)TOKL + b * 256 : (size_t)b * 2048);
                if (cx) pool1d_wave(base, lane, 2 << g);
                else { if (g == 0) pool2d_wave<2>(base, lane); else if (g == 1) pool2d_wave<4>(base, lane); else if (g == 2) pool2d_wave<8>(base, lane); else pool2d_wave<16>(base, lane); } }
        }
        grid.sync();
        TX_MARK();
        {
            WSPTRS
            const bf16_t* OF = (const bf16_t*)(ws + WS_OF); const bf16_t* OB = OF + (size_t)TOK * 512; const float* nw = p.in[I_GNW] + l * 128;
            const int ntok = l == 0 ? TOK : TOKL;
            for (int row = bid * 8 + wid; row < ntok; row += G * 8) {
                const u32x4 a = *(const u32x4*)(OF + (size_t)row * 512 + lane * 8), bq = *(const u32x4*)(OB + (size_t)row * 512 + lane * 8), rr = *(const u32x4*)(PG + (size_t)row * NG + 1024 + lane * 8);
                float o[8] = {lo16(a.x) + lo16(bq.x), hi16(a.x) + hi16(bq.x), lo16(a.y) + lo16(bq.y), hi16(a.y) + hi16(bq.y), lo16(a.z) + lo16(bq.z), hi16(a.z) + hi16(bq.z), lo16(a.w) + lo16(bq.w), hi16(a.w) + hi16(bq.w)};
                float r[8] = {lo16(rr.x), hi16(rr.x), lo16(rr.y), hi16(rr.y), lo16(rr.z), hi16(rr.z), lo16(rr.w), hi16(rr.w)};
                float ss = 0.f;
#pragma unroll
                for (int j = 0; j < 8; ++j) ss += o[j] * o[j];
                ss += __shfl_xor(ss, 1); ss += __shfl_xor(ss, 2); ss += __shfl_xor(ss, 4); ss += __shfl_xor(ss, 8);
                const float inv = rsqrtf(ss * (1.f / 128.f) + EPS);
                float y[8];
#pragma unroll
                for (int j = 0; j < 8; ++j) y[j] = o[j] * inv * nw[(lane & 15) * 8 + j] * (r[j] * sigmoidf_(r[j]));
                u32x4 w; w.x = cvt_pk_bf16(y[0], y[1]); w.y = cvt_pk_bf16(y[2], y[3]); w.z = cvt_pk_bf16(y[4], y[5]); w.w = cvt_pk_bf16(y[6], y[7]);
                *(u32x4*)(YG + (size_t)row * 512 + lane * 8) = w;
            }
            LAS bf16_t* tl = (LAS bf16_t*)lds;
            const int nit = 2 * (l == 0 ? 288 : 256) * 8;
            for (int it = bid; it < nit; it += G) { const int ctile = it & 7, tt = (it >> 3) % (l == 0 ? 288 : 256), which = (it >> 3) / (l == 0 ? 288 : 256);
                const bf16_t* src = T + (size_t)(which ? 1536 : 0) * TOK + (size_t)tt * 256; bf16_t* dst = (bf16_t*)(ws + (which ? WS_YPL : WS_YHY)) + (size_t)tt * 256 * 512;
                __syncthreads();
#pragma unroll
                for (int i = 0; i < 4; ++i) { const int idx = tid + i * NTHREADS, c = idx >> 5, t8 = (idx & 31) * 8;
                    *(LAS u32x4*)(tl + c * 264 + t8) = *(const u32x4*)(src + (size_t)(ctile * 64 + c) * TOK + t8); }
                __syncthreads();
#pragma unroll
                for (int i = 0; i < 4; ++i) { const int idx = tid + i * NTHREADS, tk = idx >> 3, c8 = (idx & 7) * 8; unsigned w[4];
#pragma unroll
                    for (int j = 0; j < 4; ++j) w[j] = (unsigned)tl[(c8 + 2 * j) * 264 + tk] | ((unsigned)tl[(c8 + 2 * j + 1) * 264 + tk] << 16);
                    *(u32x4*)(dst + (size_t)tk * 512 + ctile * 64 + c8) = (u32x4){w[0], w[1], w[2], w[3]}; }
            }
            __syncthreads();
        }
        grid.sync();
        TX_MARK();
        const int ntt = l == 0 ? 288 : 256;
        { WSPTRS
          XMap M; M.init(bid, ntt, 4);
          ProgMix2 P{ws, ws + WS_STASH + (size_t)bid * 524288, p.in[I_BIN] + l * N_IN + GATE_OFF, M, l};
          gemm_stream(lds, 6 * M.rounds(), P); }
        grid.sync();
        { WSPTRS
          XMap M; M.init(bid, ntt, 4);
          TileIO io{p.in[I_X], p.in[I_CTX], p.out, CTXS, MOD + (size_t)l * 33 * 6144, l};
          ProgOut2 P{ws, io, M, l};
          gemm_stream(lds, M.rounds(), P); }
        grid.sync();
        { WSPTRS
          const float* modl = MOD + (size_t)l * 33 * 6144; const int nrow = ntt * 256;
          for (int row = bid * 8 + wid; row < nrow; row += G * 8) { const bool isl = row < TOKL;
              const float* x = isl ? p.out + (size_t)row * D : CTXS + (size_t)(row - TOKL) * D; const float* mr = modl + (size_t)(isl ? row >> 11 : 32) * 6144;
              ada_row(x, p.in[I_NFFN] + l * D, mr + 3072, mr + 4096, HX + (size_t)row * D, nullptr, lane); } }
        grid.sync();
        { WSPTRS
          XMap M; M.init(bid, ntt, 16);
          ProgUp2 P{ws, M, l};
          gemm_stream(lds, M.rounds(), P); }
        grid.sync();
        { WSPTRS
          XMap M; M.init(bid, ntt, 4);
          TileIO io{p.in[I_X], p.in[I_CTX], p.out, CTXS, MOD + (size_t)l * 33 * 6144, l};
          ProgDown2 P{ws, io, M, l};
          gemm_stream(lds, M.rounds(), P); }
        grid.sync();
        { WSPTRS
          const int nrow = ntt * 256;
          for (int row = bid * 8 + wid; row < nrow; row += G * 8) { const bool isl = row < TOKL;
              float* x = isl ? p.out + (size_t)row * D : CTXS + (size_t)(row - TOKL) * D;
              if (l == 0) { const float* mr1 = MOD + (size_t)33 * 6144 + (size_t)(isl ? row >> 11 : 32) * 6144; ada_row(x, p.in[I_NMIX] + D, mr1, mr1 + 1024, HX + (size_t)row * D, nullptr, lane); }
              else ada_row(x, p.in[I_NFIN], nullptr, nullptr, nullptr, x, lane); } }
        if (l == 0) grid.sync();
        TX_MARK();
    }
#ifdef TIMEX
    if (blockIdx.x == 0 && threadIdx.x == 0) { const unsigned long long t = __builtin_amdgcn_s_memrealtime(); while (__builtin_amdgcn_s_memrealtime() - t < (unsigned long long)TIMEX_MULT * (TIMEX >= 100 ? cxacc : (tx1 - tx0))) __builtin_amdgcn_s_sleep(10); }
#endif
}

extern "C" void kernel_launch(void* const* d_in, const int* in_sizes, int n_in, void* d_out, int out_size,
                              void* d_ws, size_t ws_size, hipStream_t stream) {
    static int grid_blocks = 0;
    if (!grid_blocks) {
        int dev = 0, cus = 0, per_cu = 0;
        (void)hipGetDevice(&dev);
        (void)hipDeviceGetAttribute(&cus, hipDeviceAttributeMultiprocessorCount, dev);
        (void)hipFuncSetAttribute((const void*)mega, hipFuncAttributeMaxDynamicSharedMemorySize, LDS_BYTES);
        (void)hipOccupancyMaxActiveBlocksPerMultiprocessor(&per_cu, (const void*)mega, NTHREADS, LDS_BYTES);
        grid_blocks = cus > 256 ? 256 : cus;
        if (ws_size < WS_END || n_in != 33 || out_size != TOKL * D) { fprintf(stderr, "kernel_launch: unexpected sizes ws=%zu need=%zu n_in=%d out=%d\n", ws_size, (size_t)WS_END, n_in, out_size); grid_blocks = -1; }
    }
    if (grid_blocks < 0) return;
    Params p{};
    for (int i = 0; i < 33; ++i) p.in[i] = (const float*)d_in[i];
    p.out = (float*)d_out; p.ws = (unsigned char*)d_ws;
    void* args[] = {&p};
    hipError_t e = hipLaunchCooperativeKernel((const void*)mega, dim3(grid_blocks), dim3(NTHREADS), args, LDS_BYTES, stream);
    if (e != hipSuccess) fprintf(stderr, "cooperative launch failed: %s (grid %d)\n", hipGetErrorString(e), grid_blocks);
}
```

```cpp
#include <hip/hip_runtime.h>
#include <hip/hip_cooperative_groups.h>
#include <cstdio>
#include <cstdint>
namespace cg = cooperative_groups;

#define LAS __attribute__((address_space(3)))
typedef unsigned short bf16_t;
typedef short bf16x8 __attribute__((ext_vector_type(8)));
typedef float f32x4 __attribute__((ext_vector_type(4)));
typedef unsigned u32x2 __attribute__((ext_vector_type(2)));
typedef unsigned u32x4 __attribute__((ext_vector_type(4)));

constexpr int NTHREADS = 512;
constexpr int LDS_BYTES = 147456;
constexpr int D = 1024, NB = 32, SEQ = 2048, CTXL = 256;
constexpr int TOKL = NB * SEQ, TOKC = NB * CTXL, TOK = TOKL + TOKC;
constexpr int N_IN = 6688, GLA_OFF = 1536, POOL_OFF = 3104, GATE_OFF = 3616;
constexpr int NTR = 2048, NG = 1792, NGV = 1568, DFF = 4096;
constexpr float EPS = 1e-6f;

constexpr size_t SZ_WT = (size_t)NTR * D * 2, SZ_WG = (size_t)NG * D * 2, SZ_WGATE = (size_t)3072 * D * 2, SZ_WBR = (size_t)1024 * 512 * 2;
constexpr size_t SZ_WOUT = (size_t)D * D * 2, SZ_WUP = (size_t)DFF * D * 2, SZ_WDN = (size_t)D * DFF * 2;
constexpr size_t WS_WT = 0;
constexpr size_t WS_WG = WS_WT + 2 * SZ_WT;
constexpr size_t WS_WGATE = WS_WG + 2 * SZ_WG;
constexpr size_t WS_WBR = WS_WGATE + 2 * SZ_WGATE;
constexpr size_t WS_WOUT = WS_WBR + 6 * SZ_WBR;
constexpr size_t WS_WUP = WS_WOUT + 2 * SZ_WOUT;
constexpr size_t WS_WDN = WS_WUP + 2 * SZ_WUP;
constexpr size_t WS_BIAS = WS_WDN + 2 * SZ_WDN;
constexpr size_t WS_MOD = WS_BIAS + 32768;
constexpr size_t WS_HFL = WS_MOD + (size_t)2 * 33 * 6144 * 4;
constexpr size_t WS_HFC = WS_HFL + (size_t)2 * 4 * 512 * 2048 * 2;
constexpr size_t WS_CTX = WS_HFC + (size_t)4 * 512 * 256 * 2;
constexpr size_t WS_HX = WS_CTX + (size_t)TOKC * D * 4;
constexpr size_t WS_T = WS_HX + (size_t)TOK * D * 2;
constexpr size_t WS_YG = WS_T + (size_t)NTR * TOK * 2;
constexpr size_t WS_PG = WS_YG + (size_t)TOK * 512 * 2;
constexpr size_t WS_OF = WS_PG + (size_t)TOK * NG * 2;
constexpr size_t WS_BAR = WS_OF + (size_t)2 * TOK * 512 * 2;
constexpr size_t WS_END = WS_BAR + 256;
constexpr size_t WS_YHY = WS_T + (size_t)512 * TOK * 2;
constexpr size_t WS_YPL = WS_T + (size_t)1024 * TOK * 2;
constexpr size_t WS_STASH = WS_PG;
constexpr size_t WS_MERGED = WS_OF;
constexpr size_t WS_HID = WS_T;
static_assert((size_t)TOK * DFF * 2 <= WS_OF - WS_T, "hidden");
constexpr size_t WS_SCR = WS_PG;
constexpr size_t SCR_PER = 1572864;
constexpr size_t SC_MERGED = 0, SC_TRY = 524288, SC_TRP = 786432, SC_SG = 1048576, SC_ST = 1310720, SC_HID = 524288;
static_assert(WS_END <= (size_t)1073741824, "ws");

struct Params { const float* in[33]; float* out; unsigned char* ws; };
enum { I_X = 0, I_C, I_CTX, I_CCTX, I_WMOD, I_BMOD, I_NMIX, I_NFFN, I_WIN, I_BIN, I_HSW, I_HSB, I_FW1, I_FB1, I_FFREQ, I_FW2, I_FB2, I_FW3, I_HSKIP,
       I_WAF, I_BAF, I_WAB, I_BAB, I_GNW, I_PW, I_PSC, I_WBH, I_WBG, I_WBP, I_WOUT, I_WUP, I_WDN, I_NFIN };

__device__ __forceinline__ float bf2f(bf16_t h) { return __uint_as_float((unsigned)h << 16); }
__device__ __forceinline__ unsigned cvt_pk_bf16(float lo, float hi) { unsigned r; asm volatile("v_cvt_pk_bf16_f32 %0, %1, %2" : "=v"(r) : "v"(lo), "v"(hi)); return r; }
__device__ __forceinline__ bf16_t f2bf(float f) { return (bf16_t)(cvt_pk_bf16(f, 0.f) & 0xffffu); }
__device__ __forceinline__ float lo16(unsigned u) { return __uint_as_float(u << 16); }
__device__ __forceinline__ float hi16(unsigned u) { return __uint_as_float(u & 0xffff0000u); }
__device__ __forceinline__ float sigmoidf_(float v) { return 1.f / (1.f + __expf(-v)); }
__device__ __forceinline__ unsigned char* opq(unsigned char* p) { asm volatile("" : "+s"(p)); return p; }
__device__ __forceinline__ int tidx() { int t = threadIdx.x; asm volatile("" : "+v"(t)); return t; }
__device__ __forceinline__ int opqi(int v) { asm volatile("" : "+s"(v)); return v; }
__device__ __forceinline__ void gbar(unsigned* ctr, unsigned target) {
    asm volatile("s_waitcnt vmcnt(0) lgkmcnt(0)" ::: "memory");
    __syncthreads();
    if (threadIdx.x < 64) {
        if (threadIdx.x == 0) {
            __builtin_amdgcn_fence(__ATOMIC_RELEASE, "agent");
            asm volatile("s_waitcnt vmcnt(0)" ::: "memory");
            __hip_atomic_fetch_add(ctr, 1u, __ATOMIC_RELAXED, __HIP_MEMORY_SCOPE_AGENT);
            while (__hip_atomic_load(ctr, __ATOMIC_RELAXED, __HIP_MEMORY_SCOPE_AGENT) < target) __builtin_amdgcn_s_sleep(1);
        }
        __builtin_amdgcn_fence(__ATOMIC_ACQUIRE, "agent");
        asm volatile("s_waitcnt vmcnt(0)" ::: "memory");
    }
    __syncthreads();
}
__device__ __forceinline__ float wave_sum(float v) {
#pragma unroll
    for (int o = 32; o >= 1; o >>= 1) v += __shfl_xor(v, o);
    return v;
}

constexpr int BK = 64, HALF = 128, HTB = HALF * BK * 2;
__device__ __forceinline__ int lds_byte(int r, int c) { const int st = (r >> 4) * 2 + (c >> 5), rr = r & 15, cc = c & 31, ob = rr * 64 + cc * 2; return st * 1024 + (ob ^ (((ob >> 9) & 1) << 5)); }
__device__ __forceinline__ void stage_rc(int b, int& R, int& C) { const int st = b / 1024, sb = b % 1024, swz = sb ^ (((sb >> 9) & 1) << 5); R = (st >> 1) * 16 + swz / 64; C = (st & 1) * 32 + (swz % 64) / 2; }

template <class Epi>
__device__ __forceinline__ void gemm_unit(LAS unsigned char* lds, const bf16_t* A, int lda, const bf16_t* Bt, int ldb, int K, const Epi& E) {
    const int tid = tidx(), wid = __builtin_amdgcn_readfirstlane(tid >> 6), lane = tid & 63, wr = wid >> 2, wc = wid & 3, fr = lane & 15, fq = lane >> 4;
    const int nt = K / BK;
    unsigned voffA[2], voffB[2];
#pragma unroll
    for (int i = 0; i < 2; ++i) { int R, C; stage_rc(tid * 16 + i * 8192, R, C); voffA[i] = (unsigned)(R * lda + C) * 2u; voffB[i] = (unsigned)(R * ldb + C) * 2u; }
    const size_t kstep = (size_t)(BK * 2);
    const size_t hstepA = (size_t)HALF * lda * 2, hstepB = (size_t)HALF * ldb * 2;
    const unsigned ldsw = (unsigned)wid * 1024u;
    const int aoff = lds_byte(wr * 64 + fr, fq * 8), boff = lds_byte(wc * 32 + fr, fq * 8);
#define G_SA(b, h) (((b) * 2 + (h)) * HTB)
#define G_SB(b, h) ((4 + (b) * 2 + (h)) * HTB)
#define G_STAGE(bufoff, gbase, voff) do { _Pragma("unroll") for (int _i = 0; _i < 2; ++_i) \
        __builtin_amdgcn_global_load_lds((const unsigned*)((const char*)(gbase) + (voff)[_i]), (LAS unsigned*)(lds + (bufoff) + ldsw + _i * 8192), 16, 0, 0); } while (0)
#define G_LDA(dst, b, h) do { _Pragma("unroll") for (int m = 0; m < 4; ++m) _Pragma("unroll") for (int k = 0; k < 2; ++k) dst[m][k] = *(const LAS bf16x8*)(lds + G_SA(b, h) + aoff + m * 2048 + k * 1024); } while (0)
#define G_LDB(dst, b, h) do { _Pragma("unroll") for (int n = 0; n < 2; ++n) _Pragma("unroll") for (int k = 0; k < 2; ++k) dst[n][k] = *(const LAS bf16x8*)(lds + G_SB(b, h) + boff + n * 2048 + k * 1024); } while (0)
#define G_MMA(ai, bj, At, Bt_) do { __builtin_amdgcn_s_setprio(1); _Pragma("unroll") for (int m = 0; m < 4; ++m) _Pragma("unroll") for (int n = 0; n < 2; ++n) _Pragma("unroll") for (int k = 0; k < 2; ++k) \
        acc[ai][bj][m][n] = __builtin_amdgcn_mfma_f32_16x16x32_bf16(Bt_[n][k], At[m][k], acc[ai][bj][m][n], 0, 0, 0); __builtin_amdgcn_s_setprio(0); } while (0)
#define G_WAIT_V(n) asm volatile("s_waitcnt vmcnt(" #n ")" ::: "memory")
#define G_WAIT_L(n) asm volatile("s_waitcnt lgkmcnt(" #n ")" ::: "memory")
#define G_BAR __builtin_amdgcn_s_barrier()
#define G_SCHED __builtin_amdgcn_sched_barrier(0)
    __syncthreads();
    f32x4 acc[2][2][4][2];
#pragma unroll
    for (int a = 0; a < 2; ++a)
#pragma unroll
        for (int b = 0; b < 2; ++b)
#pragma unroll
            for (int m = 0; m < 4; ++m)
#pragma unroll
                for (int n = 0; n < 2; ++n) acc[a][b][m][n] = (f32x4){0.f, 0.f, 0.f, 0.f};
    bf16x8 At[4][2], B0[2][2], B1[2][2];
    const char* cA = (const char*)A; const char* cB = (const char*)Bt;
    G_STAGE(G_SB(0, 0), cB, voffB); G_STAGE(G_SA(0, 0), cA, voffA); G_STAGE(G_SB(0, 1), cB + hstepB, voffB); G_STAGE(G_SA(0, 1), cA + hstepA, voffA);
    if (wr == 1) G_BAR;
    G_WAIT_V(4); G_BAR;
    G_STAGE(G_SB(1, 0), cB + kstep, voffB); G_STAGE(G_SA(1, 0), cA + kstep, voffA); G_STAGE(G_SB(1, 1), cB + hstepB + kstep, voffB);
    G_WAIT_V(6); G_BAR;
    for (int t = 0; t < nt; t += 2) {
        const bool last = (t == nt - 2);
        const char* a1 = cA + (size_t)(t + 1) * kstep;
        const char* a2 = last ? cA : cA + (size_t)(t + 2) * kstep; const char* b2 = last ? cB : cB + (size_t)(t + 2) * kstep;
        const char* a3 = a2 + kstep; const char* b3 = b2 + kstep;
        G_LDB(B0, 0, 0); G_SCHED; G_LDA(At, 0, 0); G_STAGE(G_SA(1, 1), a1 + hstepA, voffA);
        G_WAIT_L(8); G_BAR; G_WAIT_L(0); G_MMA(0, 0, At, B0); G_BAR; G_SCHED;
        G_LDB(B1, 0, 1); G_STAGE(G_SB(0, 0), b2, voffB);
        G_BAR; G_WAIT_L(0); G_MMA(0, 1, At, B1); G_BAR;
        G_LDA(At, 0, 1); G_STAGE(G_SA(0, 0), a2, voffA);
        G_BAR; G_WAIT_L(0); G_MMA(1, 0, At, B0); G_BAR; G_SCHED;
        G_STAGE(G_SB(0, 1), b2 + hstepB, voffB);
        G_WAIT_V(6); G_BAR; G_MMA(1, 1, At, B1); G_BAR;
        G_LDB(B0, 1, 0); G_SCHED; G_LDA(At, 1, 0); G_STAGE(G_SA(0, 1), a2 + hstepA, voffA);
        G_WAIT_L(8); G_BAR; G_WAIT_L(0); G_MMA(0, 0, At, B0); G_BAR; G_SCHED;
        G_LDB(B1, 1, 1); G_STAGE(G_SB(1, 0), b3, voffB);
        G_BAR; G_WAIT_L(0); G_MMA(0, 1, At, B1); G_BAR;
        G_LDA(At, 1, 1); G_STAGE(G_SA(1, 0), a3, voffA);
        G_BAR; G_WAIT_L(0); G_MMA(1, 0, At, B0); G_BAR; G_SCHED;
        G_STAGE(G_SB(1, 1), b3 + hstepB, voffB);
        G_WAIT_V(6); G_BAR; G_MMA(1, 1, At, B1); G_BAR;
    }
    E(acc, wr, wc, fr, fq);
    G_WAIT_V(0);
    if (wr == 0) G_BAR;
    G_BAR;
    __syncthreads();
}


typedef f32x4 AccT[2][2][4][2];
struct UDesc { const char* A; const char* B; int lda, ldb, K; };
template <class Prog>
__device__ __forceinline__ void gemm_stream(LAS unsigned char* lds, int nunits, const Prog& P) {
    if (nunits <= 0) return;
    const int tid = tidx(), wid = __builtin_amdgcn_readfirstlane(tid >> 6), lane = tid & 63, wr = wid >> 2, wc = wid & 3, fr = lane & 15, fq = lane >> 4;
    int sR, sC; { int R, C; stage_rc(tid * 16, R, C); sR = R * 2; sC = C * 2; }
    const unsigned kstep = (unsigned)(BK * 2);
    const unsigned ldsw = (unsigned)wid * 1024u;
    const int aoff = lds_byte(wr * 64 + fr, fq * 8), boff = lds_byte(wc * 32 + fr, fq * 8);
#define S_STAGE(bufoff, gbase, v, q) do { \
        __builtin_amdgcn_global_load_lds((const unsigned*)((const char*)(gbase) + (v)), (LAS unsigned*)(lds + (bufoff) + ldsw), 16, 0, 0); \
        __builtin_amdgcn_global_load_lds((const unsigned*)((const char*)(gbase) + (q) + (v)), (LAS unsigned*)(lds + (bufoff) + ldsw + 8192), 16, 0, 0); } while (0)
    UDesc cur, nxt; P.desc(0, cur);
    unsigned vA = (unsigned)(sR * cur.lda + sC), vB = (unsigned)(sR * cur.ldb + sC);
    __syncthreads();
    f32x4 acc[2][2][4][2];
#pragma unroll
    for (int a = 0; a < 2; ++a)
#pragma unroll
        for (int b = 0; b < 2; ++b)
#pragma unroll
            for (int m = 0; m < 4; ++m)
#pragma unroll
                for (int n = 0; n < 2; ++n) acc[a][b][m][n] = (f32x4){0.f, 0.f, 0.f, 0.f};
    bf16x8 At[4][2], B0[2][2], B1[2][2];
    { const char* cA = cur.A; const char* cB = cur.B; const unsigned hA = (unsigned)HALF * cur.lda * 2, hB = (unsigned)HALF * cur.ldb * 2, qA = hA >> 1, qB = hB >> 1;
      S_STAGE(G_SB(0, 0), cB, vB, qB); S_STAGE(G_SA(0, 0), cA, vA, qA); S_STAGE(G_SB(0, 1), cB + hB, vB, qB); S_STAGE(G_SA(0, 1), cA + hA, vA, qA);
      if (wr == 1) G_BAR;
      G_WAIT_V(4); G_BAR;
      S_STAGE(G_SB(1, 0), cB + kstep, vB, qB); S_STAGE(G_SA(1, 0), cA + kstep, vA, qA); S_STAGE(G_SB(1, 1), cB + hB + kstep, vB, qB);
      G_WAIT_V(6); G_BAR; }
    for (int ui = 0;; ++ui) {
        const bool has_next = ui + 1 < nunits;
        if (has_next) P.desc(ui + 1, nxt); else nxt = cur;
        const unsigned nA = (unsigned)(sR * nxt.lda + sC), nB = (unsigned)(sR * nxt.ldb + sC);
        const char* cA = cur.A; const char* cB = cur.B; const unsigned hA = (unsigned)HALF * cur.lda * 2, hB = (unsigned)HALF * cur.ldb * 2;
        const unsigned nhA = (unsigned)HALF * nxt.lda * 2, nhB = (unsigned)HALF * nxt.ldb * 2;
        const int nt = cur.K / BK;
        for (int t = 0; t < nt; t += 2) {
            const bool last = (t == nt - 2);
            const char* a1 = cA + (unsigned)(t + 1) * kstep;
            const char* a2 = last ? nxt.A : cA + (unsigned)(t + 2) * kstep; const char* b2 = last ? nxt.B : cB + (unsigned)(t + 2) * kstep;
            const char* a3 = a2 + kstep; const char* b3 = b2 + kstep;
            const unsigned hA2 = last ? nhA : hA, hB2 = last ? nhB : hB, qA = hA >> 1, qA2 = hA2 >> 1, qB2 = hB2 >> 1;
            const unsigned xA = last ? nA : vA, xB = last ? nB : vB;
            G_LDB(B0, 0, 0); G_SCHED; G_LDA(At, 0, 0); S_STAGE(G_SA(1, 1), a1 + hA, vA, qA);
            G_WAIT_L(8); G_BAR; G_WAIT_L(0); G_MMA(0, 0, At, B0); G_BAR; G_SCHED;
            G_LDB(B1, 0, 1); S_STAGE(G_SB(0, 0), b2, xB, qB2);
            G_BAR; G_WAIT_L(0); G_MMA(0, 1, At, B1); G_BAR;
            G_LDA(At, 0, 1); S_STAGE(G_SA(0, 0), a2, xA, qA2);
            G_BAR; G_WAIT_L(0); G_MMA(1, 0, At, B0); G_BAR; G_SCHED;
            S_STAGE(G_SB(0, 1), b2 + hB2, xB, qB2);
            G_WAIT_V(6); G_BAR; G_MMA(1, 1, At, B1); G_BAR;
            G_LDB(B0, 1, 0); G_SCHED; G_LDA(At, 1, 0); S_STAGE(G_SA(0, 1), a2 + hA2, xA, qA2);
            G_WAIT_L(8); G_BAR; G_WAIT_L(0); G_MMA(0, 0, At, B0); G_BAR; G_SCHED;
            G_LDB(B1, 1, 1); S_STAGE(G_SB(1, 0), b3, xB, qB2);
            G_BAR; G_WAIT_L(0); G_MMA(0, 1, At, B1); G_BAR;
            G_LDA(At, 1, 1); S_STAGE(G_SA(1, 0), a3, xA, qA2);
            G_BAR; G_WAIT_L(0); G_MMA(1, 0, At, B0); G_BAR; G_SCHED;
            S_STAGE(G_SB(1, 1), b3 + hB2, xB, qB2);
            G_WAIT_V(6); G_BAR; G_MMA(1, 1, At, B1); G_BAR;
        }
        P.epi(ui, acc, wr, wc, fr, fq);
        if (!has_next) break;
#pragma unroll
        for (int a = 0; a < 2; ++a)
#pragma unroll
            for (int b = 0; b < 2; ++b)
#pragma unroll
                for (int m = 0; m < 4; ++m)
#pragma unroll
                    for (int n = 0; n < 2; ++n) acc[a][b][m][n] = (f32x4){0.f, 0.f, 0.f, 0.f};
        cur = nxt; vA = nA; vB = nB;
    }
    G_WAIT_V(0);
    if (wr == 0) G_BAR;
    G_BAR;
    __syncthreads();
#undef S_STAGE
}

#define EPI_LOOP _Pragma("unroll") for (int ai = 0; ai < 2; ++ai) _Pragma("unroll") for (int m = 0; m < 4; ++m) _Pragma("unroll") for (int bj = 0; bj < 2; ++bj) _Pragma("unroll") for (int n = 0; n < 2; ++n)
#define EPI_ROW (ai * 128 + wr * 64 + m * 16 + fr)
#define EPI_COL (bj * 128 + wc * 32 + n * 16 + 4 * fq)

#define U4 _Pragma("unroll")
struct EpiStoreBf16 {
    bf16_t* O; size_t ldo; const float* bias; bool rowb;
    __device__ __forceinline__ void operator()(const AccT& acc, int wr, int wc, int fr, int fq) const {
        { const int tq_ = tidx(); wr = (tq_ >> 8) & 1; wc = (tq_ >> 6) & 3; fr = tq_ & 15; fq = (tq_ >> 4) & 3; }
        float br[2][4]; f32x4 bc[2][2];
        U4 for (int ai = 0; ai < 2; ++ai) U4 for (int m = 0; m < 4; ++m) br[ai][m] = rowb ? bias[ai * 128 + wr * 64 + m * 16 + fr] : 0.f;
        U4 for (int bj = 0; bj < 2; ++bj) U4 for (int n = 0; n < 2; ++n) bc[bj][n] = rowb ? (f32x4){0.f, 0.f, 0.f, 0.f} : *(const f32x4*)(bias + EPI_COL);
        EPI_LOOP { const int r = EPI_ROW, c = EPI_COL; const f32x4 v = acc[ai][bj][m][n] + bc[bj][n] + br[ai][m];
            u32x2 w; w.x = cvt_pk_bf16(v[0], v[1]); w.y = cvt_pk_bf16(v[2], v[3]); *(u32x2*)(O + (size_t)r * ldo + c) = w; }
    }
};
struct EpiGate {
    f32x4* SG; const float* bias;
    __device__ __forceinline__ void operator()(const AccT& acc, int wr, int wc, int fr, int fq) const {
        { const int tq_ = tidx(); wr = (tq_ >> 8) & 1; wc = (tq_ >> 6) & 3; fr = tq_ & 15; fq = (tq_ >> 4) & 3; }
        f32x4 bc[2][2];
        U4 for (int bj = 0; bj < 2; ++bj) U4 for (int n = 0; n < 2; ++n) bc[bj][n] = *(const f32x4*)(bias + EPI_COL);
        int i = 0; f32x4* SGt = SG + tidx();
        EPI_LOOP { f32x4 v = acc[ai][bj][m][n] + bc[bj][n];
            v[0] = sigmoidf_(v[0]); v[1] = sigmoidf_(v[1]); v[2] = sigmoidf_(v[2]); v[3] = sigmoidf_(v[3]);
            SGt[i * NTHREADS] = v; ++i; }
    }
};
struct EpiBranch {
    const f32x4* SG; f32x4* ST; bf16_t* MG; int first, last;
    __device__ __forceinline__ void operator()(const AccT& acc, int wr, int wc, int fr, int fq) const {
        { const int tq_ = tidx(); wr = (tq_ >> 8) & 1; wc = (tq_ >> 6) & 3; fr = tq_ & 15; fq = (tq_ >> 4) & 3; }
        const int tq = tidx(); const f32x4* SGt = SG + tq; f32x4* STt = ST + tq;
        U4 for (int ai = 0; ai < 2; ++ai) U4 for (int mh = 0; mh < 2; ++mh) {
            f32x4 g[8], t[8];
            U4 for (int q = 0; q < 8; ++q) { const int i = ai * 16 + mh * 8 + q; g[q] = SGt[i * NTHREADS]; t[q] = first ? (f32x4){0.f, 0.f, 0.f, 0.f} : STt[i * NTHREADS]; }
            U4 for (int q = 0; q < 8; ++q) { const int m = mh * 2 + (q >> 2), bj = (q >> 1) & 1, n = q & 1, i = ai * 16 + mh * 8 + q; const int r = EPI_ROW, c = EPI_COL;
                const f32x4 v = acc[ai][bj][m][n] * g[q] + t[q];
                if (last) { u32x2 w; w.x = cvt_pk_bf16(v[0], v[1]); w.y = cvt_pk_bf16(v[2], v[3]); *(u32x2*)(MG + (size_t)r * 1024 + c) = w; }
                else STt[i * NTHREADS] = v; }
        }
    }
};
struct EpiResid {
    const float* xsrc; float* xdst; const float* gate;
    __device__ __forceinline__ void operator()(const AccT& acc, int wr, int wc, int fr, int fq) const {
        { const int tq_ = tidx(); wr = (tq_ >> 8) & 1; wc = (tq_ >> 6) & 3; fr = tq_ & 15; fq = (tq_ >> 4) & 3; }
        f32x4 gc[2][2];
        U4 for (int bj = 0; bj < 2; ++bj) U4 for (int n = 0; n < 2; ++n) gc[bj][n] = *(const f32x4*)(gate + EPI_COL);
        U4 for (int ai = 0; ai < 2; ++ai) U4 for (int mh = 0; mh < 2; ++mh) {
            f32x4 xo[2][2][2];
            U4 for (int mm = 0; mm < 2; ++mm) U4 for (int bj = 0; bj < 2; ++bj) U4 for (int n = 0; n < 2; ++n) { const int m = mh * 2 + mm; xo[mm][bj][n] = *(const f32x4*)(xsrc + (size_t)EPI_ROW * 1024 + EPI_COL); }
            U4 for (int mm = 0; mm < 2; ++mm) U4 for (int bj = 0; bj < 2; ++bj) U4 for (int n = 0; n < 2; ++n) { const int m = mh * 2 + mm; *(f32x4*)(xdst + (size_t)EPI_ROW * 1024 + EPI_COL) = xo[mm][bj][n] + gc[bj][n] * acc[ai][bj][m][n]; }
        }
    }
};
struct EpiSqrelu {
    bf16_t* H; int ldh;
    __device__ __forceinline__ void operator()(const AccT& acc, int wr, int wc, int fr, int fq) const {
        { const int tq_ = tidx(); wr = (tq_ >> 8) & 1; wc = (tq_ >> 6) & 3; fr = tq_ & 15; fq = (tq_ >> 4) & 3; }
        EPI_LOOP { const int r = EPI_ROW, c = EPI_COL; f32x4 v = acc[ai][bj][m][n];
#pragma unroll
            for (int j = 0; j < 4; ++j) { const float t = fmaxf(v[j], 0.f); v[j] = t * t; }
            u32x2 w; w.x = cvt_pk_bf16(v[0], v[1]); w.y = cvt_pk_bf16(v[2], v[3]); *(u32x2*)(H + (size_t)r * ldh + c) = w; }
    }
};

struct XMap { int NT, per_xcd, x, j;
    __device__ __forceinline__ void init(int bid, int ntt, int nt_) { NT = nt_; per_xcd = (ntt >> 3) * nt_; x = bid & 7; j = bid >> 3; }
    __device__ __forceinline__ int rounds() const { return j < per_xcd ? (per_xcd - j + 31) / 32 : 0; }
    __device__ __forceinline__ void get(int i, int& tt, int& nt) const { const int q = i * 32 + j; tt = x + 8 * (q / NT); nt = q % NT; }
};
struct ProgInproj {
    const bf16_t* wt; const bf16_t* wg; const bf16_t* HX; bf16_t* T; bf16_t* PG; const float* biasT; const float* biasG; XMap MA, MB; int rA;
    __device__ __forceinline__ void desc(int i, UDesc& d) const { int tt, nt;
        if (i < rA) { MA.get(i, tt, nt); d.A = (const char*)(wt + (size_t)(nt * 256) * D); d.B = (const char*)(HX + (size_t)(tt * 256) * D); }
        else { MB.get(i - rA, tt, nt); d.A = (const char*)(HX + (size_t)(tt * 256) * D); d.B = (const char*)(wg + (size_t)(nt * 256) * D); }
        d.lda = D; d.ldb = D; d.K = D; }
    __device__ __forceinline__ void epi(int i, const AccT& acc, int wr, int wc, int fr, int fq) const { int tt, nt;
        if (i < rA) { MA.get(i, tt, nt); EpiStoreBf16 E{T + (size_t)(nt * 256) * TOK + (size_t)tt * 256, (size_t)TOK, biasT + nt * 256, true}; E(acc, wr, wc, fr, fq); }
        else { MB.get(i - rA, tt, nt); EpiStoreBf16 E{PG + (size_t)(tt * 256) * NG + nt * 256, (size_t)NG, biasG + nt * 256, false}; E(acc, wr, wc, fr, fq); } }
};
struct ProgMix {
    unsigned char* ws; unsigned char* scr; const float* bgate; unsigned tok0; int l;
    __device__ __forceinline__ void desc(int i, UDesc& d) const { const int nt = i / 6, j = i % 6, X = j >> 1;
        if (!(j & 1)) { d.A = (const char*)(ws + WS_HX) + (size_t)tok0 * D * 2; d.B = (const char*)(ws + WS_WGATE + l * SZ_WGATE) + (size_t)(X * 1024 + nt * 256) * D * 2; d.lda = D; d.ldb = D; d.K = D; }
        else { d.A = X == 0 ? (const char*)(scr + SC_TRY) : (X == 1 ? (const char*)(ws + WS_YG) + (size_t)tok0 * 1024 : (const char*)(scr + SC_TRP));
               d.B = (const char*)(ws + WS_WBR + (size_t)l * 3 * SZ_WBR) + (size_t)X * SZ_WBR + (size_t)(nt * 256) * 1024; d.lda = 512; d.ldb = 512; d.K = 512; } }
    __device__ __forceinline__ void epi(int i, const AccT& acc, int wr, int wc, int fr, int fq) const { const int nt = i / 6, j = i % 6, X = j >> 1;
        if (!(j & 1)) { EpiGate E{(f32x4*)(scr + SC_SG), bgate + X * 1024 + nt * 256}; E(acc, wr, wc, fr, fq); }
        else { EpiBranch E{(const f32x4*)(scr + SC_SG), (f32x4*)(scr + SC_ST), (bf16_t*)(scr + SC_MERGED) + nt * 256, X == 0, X == 2}; E(acc, wr, wc, fr, fq); } }
};
struct ProgResid {
    const bf16_t* A; int lda; const bf16_t* W; int ldw, K; size_t wstep; const float* xsrc; float* xdst; const float* gate;
    __device__ __forceinline__ void desc(int i, UDesc& d) const { d.A = (const char*)A; d.B = (const char*)(W + (size_t)i * wstep); d.lda = lda; d.ldb = ldw; d.K = K; }
    __device__ __forceinline__ void epi(int i, const AccT& acc, int wr, int wc, int fr, int fq) const { EpiResid E{xsrc + i * 256, xdst + i * 256, gate + i * 256}; E(acc, wr, wc, fr, fq); }
};
struct ProgUp {
    const bf16_t* XN; const bf16_t* W; bf16_t* HID;
    __device__ __forceinline__ void desc(int i, UDesc& d) const { d.A = (const char*)XN; d.B = (const char*)(W + (size_t)(i * 256) * D); d.lda = D; d.ldb = D; d.K = D; }
    __device__ __forceinline__ void epi(int i, const AccT& acc, int wr, int wc, int fr, int fq) const { EpiSqrelu E{HID + i * 256, 2048}; E(acc, wr, wc, fr, fq); }
};


struct TileIO { const float* xin; const float* ctxin; float* out; float* ctxs; const float* modl; int l;
    __device__ __forceinline__ const float* src(int tt) const { return tt < 256 ? (l == 0 ? xin : out) + (size_t)tt * 256 * D : ctxin + (size_t)(tt - 256) * 256 * D; }
    __device__ __forceinline__ float* dst(int tt) const { return tt < 256 ? out + (size_t)tt * 256 * D : ctxs + (size_t)(tt - 256) * 256 * D; }
    __device__ __forceinline__ const float* cur(int tt) const { return tt < 256 ? out + (size_t)tt * 256 * D : ctxs + (size_t)(tt - 256) * 256 * D; }
    __device__ __forceinline__ const float* mod(int tt) const { return modl + (size_t)(tt < 256 ? tt >> 3 : 32) * 6144; }
};
struct ProgMix2 {
    unsigned char* ws; unsigned char* stash; const float* bgate; XMap M; int l;
    __device__ __forceinline__ void desc(int ii, UDesc& d) const { int tt, nt; M.get(ii / 6, tt, nt); const int s6 = ii % 6, X = s6 >> 1;
        if (!(s6 & 1)) { d.A = (const char*)(ws + WS_HX) + (size_t)tt * 256 * D * 2; d.B = (const char*)(ws + WS_WGATE + l * SZ_WGATE) + (size_t)(X * 1024 + nt * 256) * D * 2; d.lda = D; d.ldb = D; d.K = D; }
        else { d.A = (const char*)(ws + (X == 0 ? WS_YHY : (X == 1 ? WS_YG : WS_YPL))) + (size_t)tt * 256 * 1024;
               d.B = (const char*)(ws + WS_WBR + (size_t)l * 3 * SZ_WBR) + (size_t)X * SZ_WBR + (size_t)(nt * 256) * 1024; d.lda = 512; d.ldb = 512; d.K = 512; } }
    __device__ __forceinline__ void epi(int ii, const AccT& acc, int wr, int wc, int fr, int fq) const { int tt, nt; M.get(ii / 6, tt, nt); const int s6 = ii % 6, X = s6 >> 1;
        if (!(s6 & 1)) { EpiGate E{(f32x4*)stash, bgate + X * 1024 + nt * 256}; E(acc, wr, wc, fr, fq); }
        else { EpiBranch E{(const f32x4*)stash, (f32x4*)(stash + 262144), (bf16_t*)(ws + WS_MERGED) + (size_t)tt * 256 * 1024 + nt * 256, X == 0, X == 2}; E(acc, wr, wc, fr, fq); } }
};
struct ProgOut2 {
    unsigned char* ws; TileIO io; XMap M; int l;
    __device__ __forceinline__ void desc(int i, UDesc& d) const { int tt, nt; M.get(i, tt, nt);
        d.A = (const char*)(ws + WS_MERGED) + (size_t)tt * 256 * 2048; d.B = (const char*)(ws + WS_WOUT + l * SZ_WOUT) + (size_t)(nt * 256) * D * 2; d.lda = D; d.ldb = D; d.K = D; }
    __device__ __forceinline__ void epi(int i, const AccT& acc, int wr, int wc, int fr, int fq) const { int tt, nt; M.get(i, tt, nt);
        EpiResid E{io.src(tt) + nt * 256, io.dst(tt) + nt * 256, io.mod(tt) + 2048 + nt * 256}; E(acc, wr, wc, fr, fq); }
};
struct ProgUp2 {
    unsigned char* ws; XMap M; int l;
    __device__ __forceinline__ void desc(int i, UDesc& d) const { int tt, nt; M.get(i, tt, nt);
        d.A = (const char*)(ws + WS_HX) + (size_t)tt * 256 * 2048; d.B = (const char*)(ws + WS_WUP + l * SZ_WUP) + (size_t)(nt * 256) * D * 2; d.lda = D; d.ldb = D; d.K = D; }
    __device__ __forceinline__ void epi(int i, const AccT& acc, int wr, int wc, int fr, int fq) const { int tt, nt; M.get(i, tt, nt);
        EpiSqrelu E{(bf16_t*)(ws + WS_HID) + (size_t)tt * 256 * DFF + nt * 256, DFF}; E(acc, wr, wc, fr, fq); }
};
struct ProgDown2 {
    unsigned char* ws; TileIO io; XMap M; int l;
    __device__ __forceinline__ void desc(int i, UDesc& d) const { int tt, nt; M.get(i, tt, nt);
        d.A = (const char*)(ws + WS_HID) + (size_t)tt * 256 * DFF * 2; d.B = (const char*)(ws + WS_WDN + l * SZ_WDN) + (size_t)(nt * 256) * DFF * 2; d.lda = DFF; d.ldb = DFF; d.K = DFF; }
    __device__ __forceinline__ void epi(int i, const AccT& acc, int wr, int wc, int fr, int fq) const { int tt, nt; M.get(i, tt, nt);
        EpiResid E{io.cur(tt) + nt * 256, io.dst(tt) + nt * 256, io.mod(tt) + 5120 + nt * 256}; E(acc, wr, wc, fr, fq); }
};

__device__ void tconv(const float* src, int ld, int c0, int nvalid, int ncols, int K, bf16_t* dst, LAS float* tile) {
    const int tid = tidx(), ntn = ncols / 64, ntile = ntn * (K / 64);
    for (int t = blockIdx.x; t < ntile; t += gridDim.x) {
        const int k0 = (t / ntn) * 64, n0 = (t % ntn) * 64;
        __syncthreads();
#pragma unroll
        for (int i = 0; i < 8; ++i) { const int k = i * 8 + (tid >> 6), n = tid & 63;
            tile[k * 65 + n] = (n0 + n < nvalid) ? src[(size_t)(k0 + k) * ld + c0 + n0 + n] : 0.f; }
        __syncthreads();
        const int n = tid >> 3, kc = (tid & 7) * 8;
        u32x4 w;
        w.x = cvt_pk_bf16(tile[(kc + 0) * 65 + n], tile[(kc + 1) * 65 + n]); w.y = cvt_pk_bf16(tile[(kc + 2) * 65 + n], tile[(kc + 3) * 65 + n]);
        w.z = cvt_pk_bf16(tile[(kc + 4) * 65 + n], tile[(kc + 5) * 65 + n]); w.w = cvt_pk_bf16(tile[(kc + 6) * 65 + n], tile[(kc + 7) * 65 + n]);
        *(u32x4*)(dst + (size_t)(n0 + n) * K + k0 + kc) = w;
    }
    __syncthreads();
}

__device__ __forceinline__ void job_poolcomb(const Params& p, int l) {
    const float* pw = p.in[I_PW] + (size_t)l * 4 * 128 * 128; const float* sc = p.in[I_PSC] + l * 512; const float* wb = p.in[I_WBP] + (size_t)l * 512 * 1024;
    bf16_t* dst = (bf16_t*)(p.ws + WS_WBR + (size_t)(l * 3 + 2) * SZ_WBR);
    for (int idx = blockIdx.x * NTHREADS + tidx(); idx < 512 * 256; idx += gridDim.x * NTHREADS) {
        const int n = (idx & 255) * 4, k = idx >> 8, g = k >> 7, c = k & 127;
        f32x4 a = (f32x4){0.f, 0.f, 0.f, 0.f};
#pragma unroll 8
        for (int d = 0; d < 128; ++d) { const float ps = pw[(g * 128 + c) * 128 + d] * sc[g * 128 + d]; a += ps * *(const f32x4*)(wb + (size_t)(g * 128 + d) * 1024 + n); }
        dst[(size_t)n * 512 + k] = f2bf(a[0]); dst[(size_t)(n + 1) * 512 + k] = f2bf(a[1]); dst[(size_t)(n + 2) * 512 + k] = f2bf(a[2]); dst[(size_t)(n + 3) * 512 + k] = f2bf(a[3]);
    }
}

__device__ __forceinline__ void job_bias(const Params& p) {
    float* bias = (float*)(p.ws + WS_BIAS);
    for (int idx = blockIdx.x * NTHREADS + tidx(); idx < 2 * (NTR + NG); idx += gridDim.x * NTHREADS) {
        const int l = idx / (NTR + NG), j = idx % (NTR + NG); const float* b = p.in[I_BIN] + l * N_IN;
        float v;
        if (j < 1536) v = b[j]; else if (j < NTR) v = b[POOL_OFF + (j - 1536)]; else { const int q = j - NTR; v = q < NGV ? b[GLA_OFF + q] : 0.f; }
        bias[idx] = v;
    }
}

__device__ __forceinline__ void job_mod(const Params& p, LAS float* sil) {
    if (blockIdx.x >= 192) return;
    const int tid = tidx(), lane = tid & 63, kg = tid >> 6;
    float* mod = (float*)(p.ws + WS_MOD);
    for (int it = blockIdx.x; it < 192; it += gridDim.x) {
        __syncthreads();
        for (int idx = tid; idx < 33 * 1024; idx += NTHREADS) { const int r = idx >> 10, k = idx & 1023; const float v = r < 32 ? p.in[I_C][r * 1024 + k] : p.in[I_CCTX][k]; sil[idx] = v / (1.f + expf(-v)); }
        __syncthreads();
        const int l = it / 96, n0 = (it % 96) * 64;
        const float* w = p.in[I_WMOD] + (size_t)l * 1024 * 6144 + n0 + lane;
        float acc[33];
#pragma unroll
        for (int r = 0; r < 33; ++r) acc[r] = 0.f;
#pragma unroll 2
        for (int k4 = 0; k4 < 32; ++k4) { const int k = kg * 128 + k4 * 4;
            const float w0 = w[(size_t)k * 6144], w1 = w[(size_t)(k + 1) * 6144], w2 = w[(size_t)(k + 2) * 6144], w3 = w[(size_t)(k + 3) * 6144];
#pragma unroll
            for (int r = 0; r < 33; ++r) { const f32x4 sv = *(const LAS f32x4*)(sil + r * 1024 + k); acc[r] += sv[0] * w0 + sv[1] * w1 + sv[2] * w2 + sv[3] * w3; } }
        __syncthreads();
#pragma unroll
        for (int r = 0; r < 33; ++r) sil[(kg * 33 + r) * 64 + lane] = acc[r];
        __syncthreads();
        const float bm = p.in[I_BMOD][l * 6144 + n0 + lane];
        for (int r = kg; r < 33; r += 8) { float sum = 0.f;
#pragma unroll
            for (int q = 0; q < 8; ++q) sum += sil[(q * 33 + r) * 64 + lane];
            mod[(size_t)l * 33 * 6144 + (size_t)r * 6144 + n0 + lane] = sum + bm; }
    }
    __syncthreads();
}

__device__ __forceinline__ void job_filters(const Params& p, LAS unsigned char* lds) {
    LAS float* a1 = (LAS float*)lds;
    LAS float* a2 = (LAS float*)(lds + 16384);
    LAS bf16_t* oT = (LAS bf16_t*)(lds + 16384 + 16640);
    const int tid = tidx();
    const int nitems = (32 + 4 + 32) * 4;
    for (int it = blockIdx.x; it < nitems; it += gridDim.x) {
        const int oc = it & 3; int rt = it >> 2; int l, L, t0; bf16_t* dst;
        if (rt < 32) { l = 0; L = 2048; t0 = rt * 64; dst = (bf16_t*)(p.ws + WS_HFL); }
        else if (rt < 36) { l = 0; L = 256; t0 = (rt - 32) * 64; dst = (bf16_t*)(p.ws + WS_HFC); }
        else { l = 1; L = 2048; t0 = (rt - 36) * 64; dst = (bf16_t*)(p.ws + WS_HFL) + (size_t)4 * 512 * 2048; }
        const float* w1 = p.in[I_FW1] + l * 17 * 64; const float* b1 = p.in[I_FB1] + l * 64; const float* fq = p.in[I_FFREQ] + l * 64;
        const float* w2 = p.in[I_FW2] + l * 64 * 64; const float* b2 = p.in[I_FB2] + l * 64; const float* w3 = p.in[I_FW3] + (size_t)l * 64 * 2048;
        __syncthreads();
        { const int row = tid >> 3, jg = (tid & 7) * 8; const float t = (float)(t0 + row); float z[17];
          z[0] = t / (float)L;
#pragma unroll
          for (int bnd = 1; bnd <= 8; ++bnd) { const float ang = (6.283185307179586f / (float)L) * t * (float)bnd; z[bnd] = cosf(ang); z[8 + bnd] = sinf(ang); }
#pragma unroll
          for (int j = 0; j < 8; ++j) { float s = b1[jg + j];
#pragma unroll
              for (int i = 0; i < 17; ++i) s += z[i] * w1[i * 64 + jg + j];
              a1[row * 64 + jg + j] = sinf(fq[jg + j] * s); } }
        __syncthreads();
        { const int row = tid >> 3, jg = (tid & 7) * 8;
#pragma unroll
          for (int j = 0; j < 8; ++j) { float s = b2[jg + j];
              for (int i = 0; i < 64; ++i) s += a1[row * 64 + i] * w2[i * 64 + jg + j];
              a2[row * 65 + jg + j] = sinf(fq[jg + j] * s); } }
        __syncthreads();
        { const int o = oc * 512 + tid, c = o & 511; float wreg[64];
#pragma unroll
          for (int j = 0; j < 64; ++j) wreg[j] = w3[(size_t)j * 2048 + o];
          const float delta = 3.0701134573253943f + (float)c * ((15.350567286626972f - 3.0701134573253943f) / 511.f);
          for (int row = 0; row < 64; ++row) { float s = 0.f;
#pragma unroll
              for (int j = 0; j < 64; ++j) s += a2[row * 65 + j] * wreg[j];
              const float win = expf(-((float)(t0 + row) / (float)L) * delta);
              oT[tid * 72 + row] = f2bf(s * win); } }
        __syncthreads();
        for (int q = tid; q < 4096; q += NTHREADS) { const int ol = q >> 3, ch = (q & 7) * 8; const int o = oc * 512 + ol, dir = o >> 10, ord = (o >> 9) & 1, c = o & 511;
            const u32x4 w = *(const LAS u32x4*)(oT + ol * 72 + ch);
            *(u32x4*)(dst + ((size_t)((ord * 2 + dir) * 512 + c)) * L + t0 + ch) = w; }
    }
    __syncthreads();
}

__device__ __forceinline__ void ada_row(const float* x, const float* g, const float* sh, const float* sc, bf16_t* dst, float* fdst, int lane) {
    f32x4 v[4]; float ss = 0.f;
#pragma unroll
    for (int i = 0; i < 4; ++i) { v[i] = *(const f32x4*)(x + i * 256 + lane * 4); ss += v[i][0] * v[i][0] + v[i][1] * v[i][1] + v[i][2] * v[i][2] + v[i][3] * v[i][3]; }
    ss = wave_sum(ss);
    const float inv = rsqrtf(ss * (1.f / 1024.f) + EPS);
#pragma unroll
    for (int i = 0; i < 4; ++i) { const int c = i * 256 + lane * 4; const f32x4 gg = *(const f32x4*)(g + c); f32x4 y = v[i] * inv * gg;
        if (sh) { const f32x4 s1 = *(const f32x4*)(sc + c), s0 = *(const f32x4*)(sh + c); y = y * (1.f + s1) + s0;
            u32x2 w; w.x = cvt_pk_bf16(y[0], y[1]); w.y = cvt_pk_bf16(y[2], y[3]); *(u32x2*)(dst + c) = w; }
        else *(f32x4*)(fdst + c) = y; }
}

typedef float f32x16 __attribute__((ext_vector_type(16)));
template <int L, int NT>
__device__ __forceinline__ void hyena_mfma(const Params& p, int l, int c, bool ctx, LAS unsigned char* lds) {
    LAS unsigned char* U = lds;
    LAS unsigned* F = (LAS unsigned*)(lds + L * 64);
    LAS bf16_t* F16 = (LAS bf16_t*)F;
    const int tid = tidx(), lane = tid & 63, w = __builtin_amdgcn_readfirstlane(tid >> 6), li = lane & 31, kg = lane >> 5;
    bf16_t* T = (bf16_t*)(p.ws + WS_T);
    const size_t tokb = ctx ? (size_t)TOKL : 0;
    const bf16_t* hf = ctx ? (const bf16_t*)(p.ws + WS_HFC) : (const bf16_t*)(p.ws + WS_HFL) + (size_t)l * 4 * 512 * 2048;
    const float* sw = p.in[I_HSW] + (size_t)l * 3 * 1536; const float* sb = p.in[I_HSB] + l * 1536;
    __syncthreads();
    {
        const int cc = 1024 + c; const bf16_t* row = T + (size_t)cc * TOK + tokb;
        const float w0 = sw[cc], w1 = sw[1536 + cc], w2 = sw[3072 + cc], bb = sb[cc];
        for (int idx = tid; idx < L * 4; idx += NTHREADS) { const int b = idx & 31, t8 = idx >> 5; const bf16_t* pr = row + (size_t)b * L + t8 * 8;
            const u32x4 r = *(const u32x4*)pr;
            float x[10]; x[0] = t8 > 0 ? bf2f(pr[-1]) : 0.f; x[9] = t8 < L / 8 - 1 ? bf2f(pr[8]) : 0.f;
            x[1] = lo16(r.x); x[2] = hi16(r.x); x[3] = lo16(r.y); x[4] = hi16(r.y); x[5] = lo16(r.z); x[6] = hi16(r.z); x[7] = lo16(r.w); x[8] = hi16(r.w);
            float y[8];
#pragma unroll
            for (int j = 0; j < 8; ++j) y[j] = w0 * x[j] + w1 * x[j + 1] + w2 * x[j + 2] + bb;
            u32x4 o; o.x = cvt_pk_bf16(y[0], y[1]); o.y = cvt_pk_bf16(y[2], y[3]); o.z = cvt_pk_bf16(y[4], y[5]); o.w = cvt_pk_bf16(y[6], y[7]);
            *(LAS u32x4*)(U + (size_t)idx * 16) = o; }
    }
    const int lane_dw = (li & 1) * L + ((8 * kg - li + L - (li & 1)) >> 1);
#define HY_LOADA(dst, f) do { const LAS unsigned* _q = F + (lane_dw - 8 * (f)); u32x4 _v; _v.x = _q[0]; _v.y = _q[1]; _v.z = _q[2]; _v.w = _q[3]; dst = __builtin_bit_cast(bf16x8, _v); } while (0)
#define HY_LOADB(dst, s0) dst = *(const LAS bf16x8*)(U + ((s0) >> 3) * 512 + lane * 16)
    for (int ord = 0; ord < 2; ++ord) {
        __syncthreads();
        for (int x = tid; x < 2 * L; x += NTHREADS) {
            bf16_t v = 0;
            if (x >= 1 && x <= L) v = hf[((size_t)((ord * 2 + 0) * 512 + c)) * L + (L - x)];
            else if (x > L) v = hf[((size_t)((ord * 2 + 1) * 512 + c)) * L + (x - L)];
            F16[x] = v; if (x >= 1) F16[2 * L + x - 1] = v; if (x == 2 * L - 1) F16[4 * L - 1] = 0; }
        __syncthreads();
        f32x16 acc[NT];
#pragma unroll
        for (int i = 0; i < NT; ++i)
#pragma unroll
            for (int r = 0; r < 16; ++r) acc[i][r] = 0.f;
        bf16x8 E[NT], O[NT];
#pragma unroll
        for (int i = 1; i < NT; ++i) { HY_LOADA(E[i], 2 * (NT * w + i)); HY_LOADA(O[i], 2 * (NT * w + i) - 1); }
        for (int n8 = 0; n8 < L / 32; n8 += 8) {
#pragma unroll
            for (int u = 0; u < 8; ++u) { const int n = n8 + u; const int fe = 2 * (NT * w - n); bf16x8 Bf;
                HY_LOADA(E[(8 - u) & (NT - 1)], fe); HY_LOADB(Bf, 32 * n);
#pragma unroll
                for (int i = 0; i < NT; ++i) acc[i] = __builtin_amdgcn_mfma_f32_32x32x16_bf16(E[(i - u) & (NT - 1)], Bf, acc[i], 0, 0, 0);
                HY_LOADA(O[(8 - u) & (NT - 1)], fe - 1); HY_LOADB(Bf, 32 * n + 16);
#pragma unroll
                for (int i = 0; i < NT; ++i) acc[i] = __builtin_amdgcn_mfma_f32_32x32x16_bf16(O[(i - u) & (NT - 1)], Bf, acc[i], 0, 0, 0);
            }
        }
        __syncthreads();
        const int xc = ord * 512 + c; const bf16_t* xrow = T + (size_t)xc * TOK + tokb + (size_t)li * L;
        bf16_t* orow = T + (size_t)c * TOK + tokb + (size_t)li * L;
        const float w0 = sw[xc], w1 = sw[1536 + xc], w2 = sw[3072 + xc], bb = sb[xc], sk = p.in[I_HSKIP][(l * 2 + ord) * 512 + c];
#pragma unroll
        for (int i = 0; i < NT; ++i)
#pragma unroll
            for (int rg = 0; rg < 4; ++rg) { const int tb = 32 * (NT * w + i) + 8 * rg + 4 * kg;
                const u32x2 xr = *(const u32x2*)(xrow + tb);
                float x[6]; x[0] = tb > 0 ? bf2f(xrow[tb - 1]) : 0.f; x[5] = tb + 4 < L ? bf2f(xrow[tb + 4]) : 0.f;
                x[1] = lo16(xr.x); x[2] = hi16(xr.x); x[3] = lo16(xr.y); x[4] = hi16(xr.y);
                LAS u32x2* up = (LAS u32x2*)(U + ((tb >> 3) * 32 + li) * 16 + (tb & 7) * 2);
                const u32x2 uv = *up; const float uu[4] = {lo16(uv.x), hi16(uv.x), lo16(uv.y), hi16(uv.y)};
                float z[4];
#pragma unroll
                for (int j = 0; j < 4; ++j) z[j] = (w0 * x[j] + w1 * x[j + 1] + w2 * x[j + 2] + bb) * (acc[i][rg * 4 + j] + sk * uu[j]);
                u32x2 o; o.x = cvt_pk_bf16(z[0], z[1]); o.y = cvt_pk_bf16(z[2], z[3]);
                if (ord == 0) *up = o; else *(u32x2*)(orow + tb) = o; }
    }
#undef HY_LOADA
#undef HY_LOADB
    __syncthreads();
}

__device__ __forceinline__ void gla_item(const Params& p, int l, int b, int h, int dir, LAS float* lf) {
    const int tid = tidx(), qd = tid & 3, dv = tid >> 2;
    LAS float* qL = lf; LAS float* kL = lf + 2048; LAS float* aL = lf + 4096; LAS float* vL = lf + 6144; LAS float* oL = lf + 10240; LAS float* waL = lf + 14336; LAS float* baL = lf + 15360;
    const bf16_t* PG = (const bf16_t*)(p.ws + WS_PG);
    bf16_t* O = (bf16_t*)(p.ws + WS_OF) + (size_t)dir * TOK * 512;
    const float* wa = (dir ? p.in[I_WAB] : p.in[I_WAF]) + l * 16 * 256; const float* ba = (dir ? p.in[I_BAB] : p.in[I_BAF]) + l * 256;
    __syncthreads();
    for (int i = tid; i < 1024; i += NTHREADS) waL[i] = wa[(i >> 6) * 256 + h * 64 + (i & 63)];
    if (tid < 64) baL[tid] = ba[h * 64 + tid];
    float S[16];
#pragma unroll
    for (int i = 0; i < 16; ++i) S[i] = 0.f;
    const int sp = tid >> 4, sc4 = (tid & 15) * 4, sc8 = (tid & 15) * 8;
    for (int ck = 0; ck < 72; ++ck) {
        const int P = ck * 32 + sp; size_t row;
        if (P < 256) row = (size_t)TOKL + b * 256 + (dir ? 255 - P : P); else { const int tl = P - 256; row = (size_t)b * 2048 + (dir ? 2047 - tl : tl); }
        const bf16_t* pr = PG + row * NG;
        __syncthreads();
        { const u32x2 wq = *(const u32x2*)(pr + h * 64 + sc4), wk = *(const u32x2*)(pr + 256 + h * 64 + sc4);
          *(LAS f32x4*)(qL + sp * 64 + sc4) = (f32x4){lo16(wq.x) * 0.125f, hi16(wq.x) * 0.125f, lo16(wq.y) * 0.125f, hi16(wq.y) * 0.125f};
          *(LAS f32x4*)(kL + sp * 64 + sc4) = (f32x4){lo16(wk.x), hi16(wk.x), lo16(wk.y), hi16(wk.y)};
          const u32x4 wv = *(const u32x4*)(pr + 512 + h * 128 + sc8);
          *(LAS f32x4*)(vL + sp * 128 + sc8) = (f32x4){lo16(wv.x), hi16(wv.x), lo16(wv.y), hi16(wv.y)};
          *(LAS f32x4*)(vL + sp * 128 + sc8 + 4) = (f32x4){lo16(wv.z), hi16(wv.z), lo16(wv.w), hi16(wv.w)};
          const u32x4 g0 = *(const u32x4*)(pr + 1536 + dir * 16), g1 = *(const u32x4*)(pr + 1536 + dir * 16 + 8);
          float gt[16] = {lo16(g0.x), hi16(g0.x), lo16(g0.y), hi16(g0.y), lo16(g0.z), hi16(g0.z), lo16(g0.w), hi16(g0.w),
                          lo16(g1.x), hi16(g1.x), lo16(g1.y), hi16(g1.y), lo16(g1.z), hi16(g1.z), lo16(g1.w), hi16(g1.w)};
#pragma unroll
          for (int j = 0; j < 4; ++j) { float z = baL[sc4 + j];
#pragma unroll
              for (int r = 0; r < 16; ++r) z += gt[r] * waL[r * 64 + sc4 + j];
              const float ls = -(fmaxf(-z, 0.f) + log1pf(expf(-fabsf(z))));
              aL[sp * 64 + sc4 + j] = expf(ls * (1.f / 16.f)); } }
        __syncthreads();
        for (int pos = 0; pos < 32; ++pos) {
            const float vv = vL[pos * 128 + dv]; float part = 0.f;
#pragma unroll
            for (int i4 = 0; i4 < 4; ++i4) { const f32x4 aa = *(const LAS f32x4*)(aL + pos * 64 + qd * 16 + i4 * 4), kk = *(const LAS f32x4*)(kL + pos * 64 + qd * 16 + i4 * 4), qq = *(const LAS f32x4*)(qL + pos * 64 + qd * 16 + i4 * 4);
#pragma unroll
                for (int j = 0; j < 4; ++j) { S[i4 * 4 + j] = aa[j] * S[i4 * 4 + j] + kk[j] * vv; part += qq[j] * S[i4 * 4 + j]; } }
            part += __shfl_xor(part, 1); part += __shfl_xor(part, 2);
            if (qd == 0) oL[pos * 128 + dv] = part;
        }
        __syncthreads();
        { const f32x4 o0 = *(const LAS f32x4*)(oL + sp * 128 + sc8), o1 = *(const LAS f32x4*)(oL + sp * 128 + sc8 + 4);
          u32x4 w; w.x = cvt_pk_bf16(o0[0], o0[1]); w.y = cvt_pk_bf16(o0[2], o0[3]); w.z = cvt_pk_bf16(o1[0], o1[1]); w.w = cvt_pk_bf16(o1[2], o1[3]);
          *(u32x4*)(O + row * 512 + h * 128 + sc8) = w; }
    }
    __syncthreads();
}


__device__ __forceinline__ size_t gla_row(int P, int b, int dir) { return P < 256 ? (size_t)TOKL + b * 256 + (dir ? 255 - P : P) : (size_t)b * 2048 + (dir ? 2047 - (P - 256) : (P - 256)); }
__device__ __forceinline__ void gla_chunk_item(const Params& p, int l, int b, int h, int dir, LAS unsigned char* lds) {
    constexpr int RS = 72;
    LAS bf16_t* QD = (LAS bf16_t*)lds; LAS bf16_t* KI = QD + 64 * RS; LAS bf16_t* KET = KI + 64 * RS; LAS bf16_t* PP = KET + 64 * RS;
    LAS bf16_t* VT = PP + 64 * RS; LAS bf16_t* ST = VT + 128 * RS;
    LAS float* TOT = (LAS float*)(ST + 128 * RS); LAS float* DEC = TOT + 512; LAS float* WAL = DEC + 64; LAS float* BAL = WAL + 1024;
    const int tid = tidx(), lane = tid & 63, w = __builtin_amdgcn_readfirstlane(tid >> 6), i = tid >> 3, dg = tid & 7, d0 = dg * 8, l5 = lane & 31, hh = lane >> 5;
    const int ih = w >> 2, vq = w & 3;
    const bf16_t* PG = (const bf16_t*)(p.ws + WS_PG);
    bf16_t* O = (bf16_t*)(p.ws + WS_OF) + (size_t)dir * TOK * 512;
    const float* wa = (dir ? p.in[I_WAB] : p.in[I_WAF]) + l * 16 * 256; const float* ba = (dir ? p.in[I_BAB] : p.in[I_BAF]) + l * 256;
    __syncthreads();
    for (int q = tid; q < 1024; q += NTHREADS) WAL[q] = wa[(q >> 6) * 256 + h * 64 + (q & 63)];
    if (tid < 64) BAL[tid] = ba[h * 64 + tid];
    for (int q = tid; q < 73728 / 16; q += NTHREADS) *(LAS u32x4*)(lds + q * 16) = (u32x4){0u, 0u, 0u, 0u};
    f32x16 accS;
#pragma unroll
    for (int r = 0; r < 16; ++r) accS[r] = 0.f;
    u32x4 rq, rk, rg0, rg1, rv0, rv1;
    { const bf16_t* pr = PG + gla_row(i, b, dir) * NG;
      rq = *(const u32x4*)(pr + h * 64 + d0); rk = *(const u32x4*)(pr + 256 + h * 64 + d0); rg0 = *(const u32x4*)(pr + 1536 + dir * 16); rg1 = *(const u32x4*)(pr + 1536 + dir * 16 + 8);
      rv0 = *(const u32x4*)(pr + 512 + h * 128 + dg * 16); rv1 = *(const u32x4*)(pr + 512 + h * 128 + dg * 16 + 8); }
    __syncthreads();
    for (int ck = 0; ck < 36; ++ck) {
        float qf[8] = {lo16(rq.x), hi16(rq.x), lo16(rq.y), hi16(rq.y), lo16(rq.z), hi16(rq.z), lo16(rq.w), hi16(rq.w)};
        float kf[8] = {lo16(rk.x), hi16(rk.x), lo16(rk.y), hi16(rk.y), lo16(rk.z), hi16(rk.z), lo16(rk.w), hi16(rk.w)};
        float gt[16] = {lo16(rg0.x), hi16(rg0.x), lo16(rg0.y), hi16(rg0.y), lo16(rg0.z), hi16(rg0.z), lo16(rg0.w), hi16(rg0.w),
                        lo16(rg1.x), hi16(rg1.x), lo16(rg1.y), hi16(rg1.y), lo16(rg1.z), hi16(rg1.z), lo16(rg1.w), hi16(rg1.w)};
        float la[8];
#pragma unroll
        for (int j = 0; j < 8; ++j) { float z = BAL[d0 + j];
#pragma unroll
            for (int r = 0; r < 16; ++r) z += gt[r] * WAL[r * 64 + d0 + j];
            la[j] = -(fmaxf(-z, 0.f) + __logf(1.f + __expf(-fabsf(z)))) * (1.f / 16.f); }
#pragma unroll
        for (int st = 8; st < 64; st <<= 1) {
#pragma unroll
            for (int j = 0; j < 8; ++j) { const float y = __shfl_up(la[j], st); if (lane >= st) la[j] += y; } }
        if ((lane >> 3) == 7) { *(LAS f32x4*)(TOT + w * 64 + d0) = (f32x4){la[0], la[1], la[2], la[3]}; *(LAS f32x4*)(TOT + w * 64 + d0 + 4) = (f32x4){la[4], la[5], la[6], la[7]}; }
        __syncthreads();
        {
            float pre[8], bl[8];
#pragma unroll
            for (int j = 0; j < 8; ++j) { pre[j] = 0.f; bl[j] = 0.f; }
#pragma unroll
            for (int ww = 0; ww < 8; ++ww) { const f32x4 t0 = *(const LAS f32x4*)(TOT + ww * 64 + d0), t1 = *(const LAS f32x4*)(TOT + ww * 64 + d0 + 4);
                const float tv[8] = {t0[0], t0[1], t0[2], t0[3], t1[0], t1[1], t1[2], t1[3]};
#pragma unroll
                for (int j = 0; j < 8; ++j) { bl[j] += tv[j]; if (ww < w) pre[j] += tv[j]; } }
            float qd[8], ki[8], ke[8], eb[8];
#pragma unroll
            for (int j = 0; j < 8; ++j) { const float bc = la[j] + pre[j]; const float e1 = __expf(bc), e2 = __builtin_amdgcn_rcpf(e1); eb[j] = __expf(bl[j]);
                qd[j] = qf[j] * 0.125f * e1; ki[j] = kf[j] * e2; ke[j] = kf[j] * (eb[j] * e2); }
            u32x4 wq, wk;
            wq.x = cvt_pk_bf16(qd[0], qd[1]); wq.y = cvt_pk_bf16(qd[2], qd[3]); wq.z = cvt_pk_bf16(qd[4], qd[5]); wq.w = cvt_pk_bf16(qd[6], qd[7]);
            wk.x = cvt_pk_bf16(ki[0], ki[1]); wk.y = cvt_pk_bf16(ki[2], ki[3]); wk.z = cvt_pk_bf16(ki[4], ki[5]); wk.w = cvt_pk_bf16(ki[6], ki[7]);
            *(LAS u32x4*)(QD + i * RS + d0) = wq; *(LAS u32x4*)(KI + i * RS + d0) = wk;
#pragma unroll
            for (int j = 0; j < 8; j += 2) { const unsigned pk = cvt_pk_bf16(ke[j], ke[j + 1]); KET[(d0 + j) * RS + i] = (bf16_t)(pk & 0xffffu); KET[(d0 + j + 1) * RS + i] = (bf16_t)(pk >> 16); }
            const unsigned vv[8] = {rv0.x, rv0.y, rv0.z, rv0.w, rv1.x, rv1.y, rv1.z, rv1.w};
#pragma unroll
            for (int j = 0; j < 8; ++j) { VT[(dg * 16 + 2 * j) * RS + i] = (bf16_t)(vv[j] & 0xffffu); VT[(dg * 16 + 2 * j + 1) * RS + i] = (bf16_t)(vv[j] >> 16); }
            if (i == 0) { *(LAS f32x4*)(DEC + d0) = (f32x4){eb[0], eb[1], eb[2], eb[3]}; *(LAS f32x4*)(DEC + d0 + 4) = (f32x4){eb[4], eb[5], eb[6], eb[7]}; }
        }
        if (ck + 1 < 36) { const bf16_t* pr = PG + gla_row((ck + 1) * 64 + i, b, dir) * NG;
            rq = *(const u32x4*)(pr + h * 64 + d0); rk = *(const u32x4*)(pr + 256 + h * 64 + d0); rg0 = *(const u32x4*)(pr + 1536 + dir * 16); rg1 = *(const u32x4*)(pr + 1536 + dir * 16 + 8);
            rv0 = *(const u32x4*)(pr + 512 + h * 128 + dg * 16); rv1 = *(const u32x4*)(pr + 512 + h * 128 + dg * 16 + 8); }
        __syncthreads();
        f32x16 accO;
#pragma unroll
        for (int r = 0; r < 16; ++r) accO[r] = 0.f;
#pragma unroll
        for (int ks = 0; ks < 4; ++ks) { const bf16x8 A = *(const LAS bf16x8*)(QD + (ih * 32 + l5) * RS + ks * 16 + hh * 8), Bv = *(const LAS bf16x8*)(ST + (vq * 32 + l5) * RS + ks * 16 + hh * 8);
            accO = __builtin_amdgcn_mfma_f32_32x32x16_bf16(A, Bv, accO, 0, 0, 0); }
        if (w < 3) { const int si = w == 0 ? 0 : 1, sj = w == 2 ? 1 : 0; f32x16 accP;
#pragma unroll
            for (int r = 0; r < 16; ++r) accP[r] = 0.f;
#pragma unroll
            for (int ks = 0; ks < 4; ++ks) { const bf16x8 A = *(const LAS bf16x8*)(QD + (si * 32 + l5) * RS + ks * 16 + hh * 8), Bv = *(const LAS bf16x8*)(KI + (sj * 32 + l5) * RS + ks * 16 + hh * 8);
                accP = __builtin_amdgcn_mfma_f32_32x32x16_bf16(A, Bv, accP, 0, 0, 0); }
#pragma unroll
            for (int r = 0; r < 16; ++r) { const int ii = si * 32 + (r & 3) + 8 * (r >> 2) + 4 * hh, jj = sj * 32 + l5; PP[ii * RS + jj] = f2bf(jj <= ii ? accP[r] : 0.f); } }
        __syncthreads();
        { const int nk = ih == 0 ? 2 : 4;
          for (int ks = 0; ks < nk; ++ks) { const bf16x8 A = *(const LAS bf16x8*)(PP + (ih * 32 + l5) * RS + ks * 16 + hh * 8), Bv = *(const LAS bf16x8*)(VT + (vq * 32 + l5) * RS + ks * 16 + hh * 8);
              accO = __builtin_amdgcn_mfma_f32_32x32x16_bf16(A, Bv, accO, 0, 0, 0); } }
#pragma unroll
        for (int rg = 0; rg < 4; ++rg) { const f32x4 dv = *(const LAS f32x4*)(DEC + ih * 32 + 8 * rg + 4 * hh);
#pragma unroll
            for (int j = 0; j < 4; ++j) accS[rg * 4 + j] *= dv[j]; }
#pragma unroll
        for (int ks = 0; ks < 4; ++ks) { const bf16x8 A = *(const LAS bf16x8*)(KET + (ih * 32 + l5) * RS + ks * 16 + hh * 8), Bv = *(const LAS bf16x8*)(VT + (vq * 32 + l5) * RS + ks * 16 + hh * 8);
            accS = __builtin_amdgcn_mfma_f32_32x32x16_bf16(A, Bv, accS, 0, 0, 0); }
#pragma unroll
        for (int r = 0; r < 16; ++r) { const int ii = ih * 32 + (r & 3) + 8 * (r >> 2) + 4 * hh;
            O[gla_row(ck * 64 + ii, b, dir) * 512 + h * 128 + vq * 32 + l5] = f2bf(accO[r]); }
#pragma unroll
        for (int rg = 0; rg < 4; ++rg) { u32x2 o; o.x = cvt_pk_bf16(accS[rg * 4], accS[rg * 4 + 1]); o.y = cvt_pk_bf16(accS[rg * 4 + 2], accS[rg * 4 + 3]);
            *(LAS u32x2*)(ST + (vq * 32 + l5) * RS + ih * 32 + 8 * rg + 4 * hh) = o; }
        __syncthreads();
    }
    __syncthreads();
}

template <int W>
__device__ __forceinline__ void pool2d_wave(bf16_t* base, int lane) {
    float u[32], pv[33];
#pragma unroll
    for (int r = 0; r < 32; ++r) u[r] = bf2f(base[r * 64 + lane]);
    pv[0] = 0.f;
#pragma unroll
    for (int r = 0; r < 32; ++r) pv[r + 1] = pv[r] + u[r];
    const int cl = max(lane - W / 2, 0), chh = min(lane - W / 2 + W, 64);
#pragma unroll
    for (int r = 0; r < 32; ++r) {
        const int rl = (r - W / 2) < 0 ? 0 : (r - W / 2), rh = (r - W / 2 + W) > 32 ? 32 : (r - W / 2 + W);
        float x = pv[rh] - pv[rl];
#pragma unroll
        for (int d = 1; d < 64; d <<= 1) { const float y = __shfl_up(x, d); if (lane >= d) x += y; }
        const float hi = __shfl(x, chh - 1), lo = __shfl(x, cl > 0 ? cl - 1 : 0);
        const float s = hi - (cl > 0 ? lo : 0.f);
        const float cnt = (float)((rh - rl) * (chh - cl));
        base[r * 64 + lane] = f2bf(s / cnt - u[r]);
    }
}
__device__ __forceinline__ void pool1d_wave(bf16_t* base, int lane, int W) {
    float u[4], P[4];
#pragma unroll
    for (int j = 0; j < 4; ++j) u[j] = bf2f(base[j * 64 + lane]);
    float off = 0.f;
#pragma unroll
    for (int j = 0; j < 4; ++j) { float x = u[j];
#pragma unroll
        for (int d = 1; d < 64; d <<= 1) { const float y = __shfl_up(x, d); if (lane >= d) x += y; }
        P[j] = x + off; off += __shfl(x, 63); }
#pragma unroll
    for (int j = 0; j < 4; ++j) { const int t = j * 64 + lane; const int lo = max(t - W / 2, 0), hi = min(t - W / 2 + W, 256);
        const int ih = hi - 1, il = lo > 0 ? lo - 1 : 0;
        float vh = 0.f, vl = 0.f;
#pragma unroll
        for (int s = 0; s < 4; ++s) { const float a = __shfl(P[s], ih & 63), bq = __shfl(P[s], il & 63); if ((ih >> 6) == s) vh = a; if ((il >> 6) == s) vl = bq; }
        const float sum = vh - (lo > 0 ? vl : 0.f);
        u[j] = sum / (float)(hi - lo) - u[j]; }
#pragma unroll
    for (int j = 0; j < 4; ++j) base[j * 64 + lane] = f2bf(u[j]);
}

__global__ void __launch_bounds__(NTHREADS, 2) mega(Params p) {
    extern __shared__ __attribute__((aligned(16))) unsigned char lds_raw[];
    LAS unsigned char* lds = (LAS unsigned char*)lds_raw;
    LAS float* lf = (LAS float*)lds;
    cg::grid_group grid = cg::this_grid();
    unsigned bar_n = 0; unsigned* bar_ctr = (unsigned*)(p.ws + WS_BAR);
#define GBAR() do { bar_n += gridDim.x; gbar(bar_ctr, bar_n); } while (0)
    const int G = gridDim.x, bid = blockIdx.x;
#define WSPTRS const int tid = tidx(), lane = tid & 63, wid = tid >> 6; (void)lane; (void)wid; unsigned char* ws = opq(p.ws); bf16_t* HX = (bf16_t*)(ws + WS_HX); bf16_t* T = (bf16_t*)(ws + WS_T); bf16_t* YG = (bf16_t*)(ws + WS_YG); bf16_t* PG = (bf16_t*)(ws + WS_PG); \
    float* CTXS = (float*)(ws + WS_CTX); const float* MOD = (const float*)(ws + WS_MOD); const float* BIAS = (const float*)(ws + WS_BIAS); (void)HX; (void)T; (void)YG; (void)PG; (void)CTXS; (void)MOD; (void)BIAS;

#ifdef TIMEX
    unsigned long long tx0 = 0, tx1 = 0; int txn = 0;
#define TX_MARK() do { if (txn == TIMEX) tx0 = __builtin_amdgcn_s_memrealtime(); if (txn == TIMEX + 1) tx1 = __builtin_amdgcn_s_memrealtime(); ++txn; } while (0)
    unsigned long long cx0 = 0, cxacc = 0;
#define CX_BEGIN(k) do { if (TIMEX == 100 + (k) && l == 1) { __syncthreads(); cx0 = __builtin_amdgcn_s_memrealtime(); } } while (0)
#define CX_END(k) do { if (TIMEX == 100 + (k) && l == 1) { __syncthreads(); cxacc += __builtin_amdgcn_s_memrealtime() - cx0; } } while (0)
#else
#define TX_MARK() do {} while (0)
#define CX_BEGIN(k) do {} while (0)
#define CX_END(k) do {} while (0)
#endif
    TX_MARK();
    for (int l = 0; l < 2; ++l) {
        unsigned char* ws = opq(p.ws);
        const float* win = p.in[I_WIN] + (size_t)l * D * N_IN;
        bf16_t* wt = (bf16_t*)(ws + WS_WT + l * SZ_WT);
        tconv(win, N_IN, 0, 1536, 1536, D, wt, lf);
        tconv(win, N_IN, POOL_OFF, 512, 512, D, wt + (size_t)1536 * D, lf);
        tconv(win, N_IN, GLA_OFF, NGV, NG, D, (bf16_t*)(ws + WS_WG + l * SZ_WG), lf);
        tconv(win, N_IN, GATE_OFF, 3072, 3072, D, (bf16_t*)(ws + WS_WGATE + l * SZ_WGATE), lf);
        tconv(p.in[I_WBH] + (size_t)l * 512 * 1024, 1024, 0, 1024, 1024, 512, (bf16_t*)(ws + WS_WBR + (size_t)(l * 3 + 0) * SZ_WBR), lf);
        tconv(p.in[I_WBG] + (size_t)l * 512 * 1024, 1024, 0, 1024, 1024, 512, (bf16_t*)(ws + WS_WBR + (size_t)(l * 3 + 1) * SZ_WBR), lf);
        tconv(p.in[I_WOUT] + (size_t)l * D * D, D, 0, D, D, D, (bf16_t*)(ws + WS_WOUT + l * SZ_WOUT), lf);
        tconv(p.in[I_WUP] + (size_t)l * D * DFF, DFF, 0, DFF, DFF, D, (bf16_t*)(ws + WS_WUP + l * SZ_WUP), lf);
        tconv(p.in[I_WDN] + (size_t)l * DFF * D, D, 0, D, D, DFF, (bf16_t*)(ws + WS_WDN + l * SZ_WDN), lf);
        job_poolcomb(p, l);
    }
    job_bias(p);
    job_mod(p, lf);
    job_filters(p, lds);
    grid.sync();

    { WSPTRS
    for (int row = bid * 8 + wid; row < TOK; row += G * 8) {
        const bool isl = row < TOKL; const float* x = isl ? p.in[I_X] + (size_t)row * D : p.in[I_CTX] + (size_t)(row - TOKL) * D;
        const float* mr = MOD + (size_t)(isl ? row >> 11 : 32) * 6144;
        ada_row(x, p.in[I_NMIX], mr, mr + 1024, HX + (size_t)row * D, nullptr, lane);
    } }
    GBAR();
    TX_MARK();

    for (int l_ = 0; l_ < 2; ++l_) {
        const int l = opqi(l_);
        { WSPTRS
            const int ntokt = l == 0 ? 288 : 256;
            const int nA = ntokt * 8, nB = 288 * 7;
            const bf16_t* wt = (const bf16_t*)(ws + WS_WT + l * SZ_WT); const bf16_t* wg = (const bf16_t*)(ws + WS_WG + l * SZ_WG);
            const float* biasT = BIAS + l * (NTR + NG); const float* biasG = biasT + NTR;
            XMap MA, MB; MA.init(bid, ntokt, 8); MB.init(bid, 288, 7);
            ProgInproj P{wt, wg, HX, T, PG, biasT, biasG, MA, MB, MA.rounds()};
            gemm_stream(lds, MA.rounds() + MB.rounds(), P);
        }
        GBAR();
        TX_MARK();
        { WSPTRS
            for (int it = bid; it < 256; it += G) gla_chunk_item(p, l, it >> 3, (it >> 1) & 3, it & 1, lds);
            for (int it = bid; it < 512; it += G) hyena_mfma<2048, 8>(p, l, it, false, lds);
            if (l == 0) for (int it = bid; it < 512; it += G) hyena_mfma<256, 1>(p, l, it, true, lds);
            const int npl = l == 0 ? 32768 : 16384;
            for (int it = bid * 8 + wid; it < npl; it += G * 8) { const bool cx = it >= 16384; const int j = it & 16383, ch = j >> 5, b = j & 31, g = ch >> 7;
                bf16_t* base = T + (size_t)(1536 + ch) * TOK + (cx ? (size_t)TOKL + b * 256 : (size_t)b * 2048);
                if (cx) pool1d_wave(base, lane, 2 << g);
                else { if (g == 0) pool2d_wave<2>(base, lane); else if (g == 1) pool2d_wave<4>(base, lane); else if (g == 2) pool2d_wave<8>(base, lane); else pool2d_wave<16>(base, lane); } }
        }
        GBAR();
        TX_MARK();
        {
            WSPTRS
            const bf16_t* OF = (const bf16_t*)(ws + WS_OF); const bf16_t* OB = OF + (size_t)TOK * 512; const float* nw = p.in[I_GNW] + l * 128;
            const int ntok = l == 0 ? TOK : TOKL;
            for (int row = bid * 8 + wid; row < ntok; row += G * 8) {
                const u32x4 a = *(const u32x4*)(OF + (size_t)row * 512 + lane * 8), bq = *(const u32x4*)(OB + (size_t)row * 512 + lane * 8), rr = *(const u32x4*)(PG + (size_t)row * NG + 1024 + lane * 8);
                float o[8] = {lo16(a.x) + lo16(bq.x), hi16(a.x) + hi16(bq.x), lo16(a.y) + lo16(bq.y), hi16(a.y) + hi16(bq.y), lo16(a.z) + lo16(bq.z), hi16(a.z) + hi16(bq.z), lo16(a.w) + lo16(bq.w), hi16(a.w) + hi16(bq.w)};
                float r[8] = {lo16(rr.x), hi16(rr.x), lo16(rr.y), hi16(rr.y), lo16(rr.z), hi16(rr.z), lo16(rr.w), hi16(rr.w)};
                float ss = 0.f;
#pragma unroll
                for (int j = 0; j < 8; ++j) ss += o[j] * o[j];
                ss += __shfl_xor(ss, 1); ss += __shfl_xor(ss, 2); ss += __shfl_xor(ss, 4); ss += __shfl_xor(ss, 8);
                const float inv = rsqrtf(ss * (1.f / 128.f) + EPS);
                float y[8];
#pragma unroll
                for (int j = 0; j < 8; ++j) y[j] = o[j] * inv * nw[(lane & 15) * 8 + j] * (r[j] * sigmoidf_(r[j]));
                u32x4 w; w.x = cvt_pk_bf16(y[0], y[1]); w.y = cvt_pk_bf16(y[2], y[3]); w.z = cvt_pk_bf16(y[4], y[5]); w.w = cvt_pk_bf16(y[6], y[7]);
                *(u32x4*)(YG + (size_t)row * 512 + lane * 8) = w;
            }
            LAS bf16_t* tl = (LAS bf16_t*)lds;
            const int nit = 2 * (l == 0 ? 288 : 256) * 8;
            for (int it = bid; it < nit; it += G) { const int ctile = it & 7, tt = (it >> 3) % (l == 0 ? 288 : 256), which = (it >> 3) / (l == 0 ? 288 : 256);
                const bf16_t* src = T + (size_t)(which ? 1536 : 0) * TOK + (size_t)tt * 256; bf16_t* dst = (bf16_t*)(ws + (which ? WS_YPL : WS_YHY)) + (size_t)tt * 256 * 512;
                __syncthreads();
#pragma unroll
                for (int i = 0; i < 4; ++i) { const int idx = tid + i * NTHREADS, c = idx >> 5, t8 = (idx & 31) * 8;
                    *(LAS u32x4*)(tl + c * 264 + t8) = *(const u32x4*)(src + (size_t)(ctile * 64 + c) * TOK + t8); }
                __syncthreads();
#pragma unroll
                for (int i = 0; i < 4; ++i) { const int idx = tid + i * NTHREADS, tk = idx >> 3, c8 = (idx & 7) * 8; unsigned w[4];
#pragma unroll
                    for (int j = 0; j < 4; ++j) w[j] = (unsigned)tl[(c8 + 2 * j) * 264 + tk] | ((unsigned)tl[(c8 + 2 * j + 1) * 264 + tk] << 16);
                    *(u32x4*)(dst + (size_t)tk * 512 + ctile * 64 + c8) = (u32x4){w[0], w[1], w[2], w[3]}; }
            }
            __syncthreads();
        }
        GBAR();
        TX_MARK();
        const int ntt = l == 0 ? 288 : 256;
        { WSPTRS
          XMap M; M.init(bid, ntt, 4);
          ProgMix2 P{ws, ws + WS_STASH + (size_t)bid * 524288, p.in[I_BIN] + l * N_IN + GATE_OFF, M, l};
          gemm_stream(lds, 6 * M.rounds(), P); }
        GBAR();
        { WSPTRS
          XMap M; M.init(bid, ntt, 4);
          TileIO io{p.in[I_X], p.in[I_CTX], p.out, CTXS, MOD + (size_t)l * 33 * 6144, l};
          ProgOut2 P{ws, io, M, l};
          gemm_stream(lds, M.rounds(), P); }
        GBAR();
        { WSPTRS
          const float* modl = MOD + (size_t)l * 33 * 6144; const int nrow = ntt * 256;
          for (int row = bid * 8 + wid; row < nrow; row += G * 8) { const bool isl = row < TOKL;
              const float* x = isl ? p.out + (size_t)row * D : CTXS + (size_t)(row - TOKL) * D; const float* mr = modl + (size_t)(isl ? row >> 11 : 32) * 6144;
              ada_row(x, p.in[I_NFFN] + l * D, mr + 3072, mr + 4096, HX + (size_t)row * D, nullptr, lane); } }
        GBAR();
        { WSPTRS
          XMap M; M.init(bid, ntt, 16);
          ProgUp2 P{ws, M, l};
          gemm_stream(lds, M.rounds(), P); }
        GBAR();
        { WSPTRS
          XMap M; M.init(bid, ntt, 4);
          TileIO io{p.in[I_X], p.in[I_CTX], p.out, CTXS, MOD + (size_t)l * 33 * 6144, l};
          ProgDown2 P{ws, io, M, l};
          gemm_stream(lds, M.rounds(), P); }
        GBAR();
        { WSPTRS
          const int nrow = ntt * 256;
          for (int row = bid * 8 + wid; row < nrow; row += G * 8) { const bool isl = row < TOKL;
              float* x = isl ? p.out + (size_t)row * D : CTXS + (size_t)(row - TOKL) * D;
              if (l == 0) { const float* mr1 = MOD + (size_t)33 * 6144 + (size_t)(isl ? row >> 11 : 32) * 6144; ada_row(x, p.in[I_NMIX] + D, mr1, mr1 + 1024, HX + (size_t)row * D, nullptr, lane); }
              else ada_row(x, p.in[I_NFIN], nullptr, nullptr, nullptr, x, lane); } }
        if (l == 0) GBAR();
        TX_MARK();
    }
#ifdef TIMEX
    if (blockIdx.x == 0 && threadIdx.x == 0) { const unsigned long long t = __builtin_amdgcn_s_memrealtime(); while (__builtin_amdgcn_s_memrealtime() - t < (unsigned long long)TIMEX_MULT * (TIMEX >= 100 ? cxacc : (tx1 - tx0))) __builtin_amdgcn_s_sleep(10); }
#endif
}

extern "C" void kernel_launch(void* const* d_in, const int* in_sizes, int n_in, void* d_out, int out_size,
                              void* d_ws, size_t ws_size, hipStream_t stream) {
    static int grid_blocks = 0;
    if (!grid_blocks) {
        int dev = 0, cus = 0, per_cu = 0;
        (void)hipGetDevice(&dev);
        (void)hipDeviceGetAttribute(&cus, hipDeviceAttributeMultiprocessorCount, dev);
        (void)hipFuncSetAttribute((const void*)mega, hipFuncAttributeMaxDynamicSharedMemorySize, LDS_BYTES);
        (void)hipOccupancyMaxActiveBlocksPerMultiprocessor(&per_cu, (const void*)mega, NTHREADS, LDS_BYTES);
        grid_blocks = cus > 256 ? 256 : cus;
        if (ws_size < WS_END || n_in != 33 || out_size != TOKL * D) { fprintf(stderr, "kernel_launch: unexpected sizes ws=%zu need=%zu n_in=%d out=%d\n", ws_size, (size_t)WS_END, n_in, out_size); grid_blocks = -1; }
    }
    if (grid_blocks < 0) return;
    Params p{};
    for (int i = 0; i < 33; ++i) p.in[i] = (const float*)d_in[i];
    p.out = (float*)d_out; p.ws = (unsigned char*)d_ws;
    (void)hipMemsetAsync((unsigned char*)d_ws + WS_BAR, 0, 256, stream);
    void* args[] = {&p};
    hipError_t e = hipLaunchCooperativeKernel((const void*)mega, dim3(grid_blocks), dim3(NTHREADS), args, LDS_BYTES, stream);
    if (e != hipSuccess) fprintf(stderr, "cooperative launch failed: %s (grid %d)\n", hipGetErrorString(e), grid_blocks);
}
```

```cpp
#include <hip/hip_runtime.h>
#include <hip/hip_cooperative_groups.h>
#include <cstdio>
#include <cstdint>
namespace cg = cooperative_groups;

#define LAS __attribute__((address_space(3)))
typedef unsigned short bf16_t;
typedef short bf16x8 __attribute__((ext_vector_type(8)));
typedef float f32x4 __attribute__((ext_vector_type(4)));
typedef unsigned u32x2 __attribute__((ext_vector_type(2)));
typedef unsigned u32x4 __attribute__((ext_vector_type(4)));

constexpr int NTHREADS = 512;
constexpr int LDS_BYTES = 147456;
constexpr int D = 1024, NB = 32, SEQ = 2048, CTXL = 256;
constexpr int TOKL = NB * SEQ, TOKC = NB * CTXL, TOK = TOKL + TOKC;
constexpr int N_IN = 6688, GLA_OFF = 1536, POOL_OFF = 3104, GATE_OFF = 3616;
constexpr int NTR = 2048, NG = 1792, NGV = 1568, DFF = 4096;
constexpr float EPS = 1e-6f;

constexpr size_t SZ_WT = (size_t)NTR * D * 2, SZ_WG = (size_t)NG * D * 2, SZ_WGATE = (size_t)3072 * D * 2, SZ_WBR = (size_t)1024 * 512 * 2;
constexpr size_t SZ_WOUT = (size_t)D * D * 2, SZ_WUP = (size_t)DFF * D * 2, SZ_WDN = (size_t)D * DFF * 2;
constexpr size_t WS_WT = 0;
constexpr size_t WS_WG = WS_WT + 2 * SZ_WT;
constexpr size_t WS_WGATE = WS_WG + 2 * SZ_WG;
constexpr size_t WS_WBR = WS_WGATE + 2 * SZ_WGATE;
constexpr size_t WS_WOUT = WS_WBR + 6 * SZ_WBR;
constexpr size_t WS_WUP = WS_WOUT + 2 * SZ_WOUT;
constexpr size_t WS_WDN = WS_WUP + 2 * SZ_WUP;
constexpr size_t WS_BIAS = WS_WDN + 2 * SZ_WDN;
constexpr size_t WS_MOD = WS_BIAS + 32768;
constexpr size_t WS_HFL = WS_MOD + (size_t)2 * 33 * 6144 * 4;
constexpr size_t WS_HFC = WS_HFL + (size_t)2 * 4 * 512 * 2048 * 2;
constexpr size_t WS_CTX = WS_HFC + (size_t)4 * 512 * 256 * 2;
constexpr size_t WS_HX = WS_CTX + (size_t)TOKC * D * 4;
constexpr size_t WS_T = WS_HX + (size_t)TOK * D * 2;
constexpr size_t WS_YG = WS_T + (size_t)NTR * TOK * 2;
constexpr size_t WS_PG = WS_YG + (size_t)TOK * 512 * 2;
constexpr size_t WS_OF = WS_PG + (size_t)TOK * NG * 2;
constexpr size_t WS_BAR = WS_OF + (size_t)2 * TOK * 512 * 2;
constexpr size_t WS_END = WS_BAR + 256;
constexpr size_t WS_YHY = WS_T + (size_t)512 * TOK * 2;
constexpr size_t WS_YPL = WS_T + (size_t)1024 * TOK * 2;
constexpr size_t WS_STASH = WS_PG;
constexpr size_t WS_MERGED = WS_OF;
constexpr size_t WS_HID = WS_T;
static_assert((size_t)TOK * DFF * 2 <= WS_OF - WS_T, "hidden");
constexpr size_t WS_SCR = WS_PG;
constexpr size_t SCR_PER = 1572864;
constexpr size_t SC_MERGED = 0, SC_TRY = 524288, SC_TRP = 786432, SC_SG = 1048576, SC_ST = 1310720, SC_HID = 524288;
static_assert(WS_END <= (size_t)1073741824, "ws");

struct Params { const float* in[33]; float* out; unsigned char* ws; };
enum { I_X = 0, I_C, I_CTX, I_CCTX, I_WMOD, I_BMOD, I_NMIX, I_NFFN, I_WIN, I_BIN, I_HSW, I_HSB, I_FW1, I_FB1, I_FFREQ, I_FW2, I_FB2, I_FW3, I_HSKIP,
       I_WAF, I_BAF, I_WAB, I_BAB, I_GNW, I_PW, I_PSC, I_WBH, I_WBG, I_WBP, I_WOUT, I_WUP, I_WDN, I_NFIN };

__device__ __forceinline__ float bf2f(bf16_t h) { return __uint_as_float((unsigned)h << 16); }
__device__ __forceinline__ unsigned cvt_pk_bf16(float lo, float hi) { unsigned r; asm volatile("v_cvt_pk_bf16_f32 %0, %1, %2" : "=v"(r) : "v"(lo), "v"(hi)); return r; }
__device__ __forceinline__ bf16_t f2bf(float f) { return (bf16_t)(cvt_pk_bf16(f, 0.f) & 0xffffu); }
__device__ __forceinline__ float lo16(unsigned u) { return __uint_as_float(u << 16); }
__device__ __forceinline__ float hi16(unsigned u) { return __uint_as_float(u & 0xffff0000u); }
__device__ __forceinline__ float sigmoidf_(float v) { return 1.f / (1.f + __expf(-v)); }
__device__ __forceinline__ unsigned char* opq(unsigned char* p) { asm volatile("" : "+s"(p)); return p; }
__device__ __forceinline__ int tidx() { int t = threadIdx.x; asm volatile("" : "+v"(t)); return t; }
__device__ __forceinline__ int opqi(int v) { asm volatile("" : "+s"(v)); return v; }
__device__ __forceinline__ void gbar(unsigned* ctr, unsigned target) {
    asm volatile("s_waitcnt vmcnt(0) lgkmcnt(0)" ::: "memory");
    __syncthreads();
    if (threadIdx.x < 64) {
        if (threadIdx.x == 0) {
            __builtin_amdgcn_fence(__ATOMIC_RELEASE, "agent");
            asm volatile("s_waitcnt vmcnt(0)" ::: "memory");
            __hip_atomic_fetch_add(ctr, 1u, __ATOMIC_RELAXED, __HIP_MEMORY_SCOPE_AGENT);
            while (__hip_atomic_load(ctr, __ATOMIC_RELAXED, __HIP_MEMORY_SCOPE_AGENT) < target) __builtin_amdgcn_s_sleep(1);
        }
        __builtin_amdgcn_fence(__ATOMIC_ACQUIRE, "agent");
        asm volatile("s_waitcnt vmcnt(0)" ::: "memory");
    }
    __syncthreads();
}
__device__ __forceinline__ float wave_sum(float v) {
#pragma unroll
    for (int o = 32; o >= 1; o >>= 1) v += __shfl_xor(v, o);
    return v;
}

constexpr int BK = 64, HALF = 128, HTB = HALF * BK * 2;
__device__ __forceinline__ int lds_byte(int r, int c) { const int st = (r >> 4) * 2 + (c >> 5), rr = r & 15, cc = c & 31, ob = rr * 64 + cc * 2; return st * 1024 + (ob ^ (((ob >> 9) & 1) << 5)); }
__device__ __forceinline__ void stage_rc(int b, int& R, int& C) { const int st = b / 1024, sb = b % 1024, swz = sb ^ (((sb >> 9) & 1) << 5); R = (st >> 1) * 16 + swz / 64; C = (st & 1) * 32 + (swz % 64) / 2; }

template <class Epi>
__device__ __forceinline__ void gemm_unit(LAS unsigned char* lds, const bf16_t* A, int lda, const bf16_t* Bt, int ldb, int K, const Epi& E) {
    const int tid = tidx(), wid = __builtin_amdgcn_readfirstlane(tid >> 6), lane = tid & 63, wr = wid >> 2, wc = wid & 3, fr = lane & 15, fq = lane >> 4;
    const int nt = K / BK;
    unsigned voffA[2], voffB[2];
#pragma unroll
    for (int i = 0; i < 2; ++i) { int R, C; stage_rc(tid * 16 + i * 8192, R, C); voffA[i] = (unsigned)(R * lda + C) * 2u; voffB[i] = (unsigned)(R * ldb + C) * 2u; }
    const size_t kstep = (size_t)(BK * 2);
    const size_t hstepA = (size_t)HALF * lda * 2, hstepB = (size_t)HALF * ldb * 2;
    const unsigned ldsw = (unsigned)wid * 1024u;
    const int aoff = lds_byte(wr * 64 + fr, fq * 8), boff = lds_byte(wc * 32 + fr, fq * 8);
#define G_SA(b, h) (((b) * 2 + (h)) * HTB)
#define G_SB(b, h) ((4 + (b) * 2 + (h)) * HTB)
#define G_STAGE(bufoff, gbase, voff) do { _Pragma("unroll") for (int _i = 0; _i < 2; ++_i) \
        __builtin_amdgcn_global_load_lds((const unsigned*)((const char*)(gbase) + (voff)[_i]), (LAS unsigned*)(lds + (bufoff) + ldsw + _i * 8192), 16, 0, 0); } while (0)
#define G_LDA(dst, b, h) do { _Pragma("unroll") for (int m = 0; m < 4; ++m) _Pragma("unroll") for (int k = 0; k < 2; ++k) dst[m][k] = *(const LAS bf16x8*)(lds + G_SA(b, h) + aoff + m * 2048 + k * 1024); } while (0)
#define G_LDB(dst, b, h) do { _Pragma("unroll") for (int n = 0; n < 2; ++n) _Pragma("unroll") for (int k = 0; k < 2; ++k) dst[n][k] = *(const LAS bf16x8*)(lds + G_SB(b, h) + boff + n * 2048 + k * 1024); } while (0)
#define G_MMA(ai, bj, At, Bt_) do { __builtin_amdgcn_s_setprio(1); _Pragma("unroll") for (int m = 0; m < 4; ++m) _Pragma("unroll") for (int n = 0; n < 2; ++n) _Pragma("unroll") for (int k = 0; k < 2; ++k) \
        acc[ai][bj][m][n] = __builtin_amdgcn_mfma_f32_16x16x32_bf16(Bt_[n][k], At[m][k], acc[ai][bj][m][n], 0, 0, 0); __builtin_amdgcn_s_setprio(0); } while (0)
#define G_WAIT_V(n) asm volatile("s_waitcnt vmcnt(" #n ")" ::: "memory")
#define G_WAIT_L(n) asm volatile("s_waitcnt lgkmcnt(" #n ")" ::: "memory")
#define G_BAR __builtin_amdgcn_s_barrier()
#define G_SCHED __builtin_amdgcn_sched_barrier(0)
    __syncthreads();
    f32x4 acc[2][2][4][2];
#pragma unroll
    for (int a = 0; a < 2; ++a)
#pragma unroll
        for (int b = 0; b < 2; ++b)
#pragma unroll
            for (int m = 0; m < 4; ++m)
#pragma unroll
                for (int n = 0; n < 2; ++n) acc[a][b][m][n] = (f32x4){0.f, 0.f, 0.f, 0.f};
    bf16x8 At[4][2], B0[2][2], B1[2][2];
    const char* cA = (const char*)A; const char* cB = (const char*)Bt;
    G_STAGE(G_SB(0, 0), cB, voffB); G_STAGE(G_SA(0, 0), cA, voffA); G_STAGE(G_SB(0, 1), cB + hstepB, voffB); G_STAGE(G_SA(0, 1), cA + hstepA, voffA);
    if (wr == 1) G_BAR;
    G_WAIT_V(4); G_BAR;
    G_STAGE(G_SB(1, 0), cB + kstep, voffB); G_STAGE(G_SA(1, 0), cA + kstep, voffA); G_STAGE(G_SB(1, 1), cB + hstepB + kstep, voffB);
    G_WAIT_V(6); G_BAR;
    for (int t = 0; t < nt; t += 2) {
        const bool last = (t == nt - 2);
        const char* a1 = cA + (size_t)(t + 1) * kstep;
        const char* a2 = last ? cA : cA + (size_t)(t + 2) * kstep; const char* b2 = last ? cB : cB + (size_t)(t + 2) * kstep;
        const char* a3 = a2 + kstep; const char* b3 = b2 + kstep;
        G_LDB(B0, 0, 0); G_SCHED; G_LDA(At, 0, 0); G_STAGE(G_SA(1, 1), a1 + hstepA, voffA);
        G_WAIT_L(8); G_BAR; G_WAIT_L(0); G_MMA(0, 0, At, B0); G_BAR; G_SCHED;
        G_LDB(B1, 0, 1); G_STAGE(G_SB(0, 0), b2, voffB);
        G_BAR; G_WAIT_L(0); G_MMA(0, 1, At, B1); G_BAR;
        G_LDA(At, 0, 1); G_STAGE(G_SA(0, 0), a2, voffA);
        G_BAR; G_WAIT_L(0); G_MMA(1, 0, At, B0); G_BAR; G_SCHED;
        G_STAGE(G_SB(0, 1), b2 + hstepB, voffB);
        G_WAIT_V(6); G_BAR; G_MMA(1, 1, At, B1); G_BAR;
        G_LDB(B0, 1, 0); G_SCHED; G_LDA(At, 1, 0); G_STAGE(G_SA(0, 1), a2 + hstepA, voffA);
        G_WAIT_L(8); G_BAR; G_WAIT_L(0); G_MMA(0, 0, At, B0); G_BAR; G_SCHED;
        G_LDB(B1, 1, 1); G_STAGE(G_SB(1, 0), b3, voffB);
        G_BAR; G_WAIT_L(0); G_MMA(0, 1, At, B1); G_BAR;
        G_LDA(At, 1, 1); G_STAGE(G_SA(1, 0), a3, voffA);
        G_BAR; G_WAIT_L(0); G_MMA(1, 0, At, B0); G_BAR; G_SCHED;
        G_STAGE(G_SB(1, 1), b3 + hstepB, voffB);
        G_WAIT_V(6); G_BAR; G_MMA(1, 1, At, B1); G_BAR;
    }
    E(acc, wr, wc, fr, fq);
    G_WAIT_V(0);
    if (wr == 0) G_BAR;
    G_BAR;
    __syncthreads();
}


__device__ __forceinline__ int perm32(int rho) { const int n = rho >> 4, i = rho & 15; return 8 * (i >> 2) + 4 * n + (i & 3); }
typedef f32x4 AccT[2][2][4][2];
struct UDesc { const char* A; const char* B; int lda, ldb, K; };
template <class Prog>
__device__ __forceinline__ void gemm_stream(LAS unsigned char* lds, int nunits, const Prog& P) {
    if (nunits <= 0) return;
    const int tid = tidx(), wid = __builtin_amdgcn_readfirstlane(tid >> 6), lane = tid & 63, wr = wid >> 2, wc = wid & 3, fr = lane & 15, fq = lane >> 4;
    int sR, sRb, sC; { int R, C; stage_rc(tid * 16, R, C); sR = R * 2; sRb = ((R & ~31) + perm32(R & 31)) * 2; sC = C * 2; }
    const unsigned kstep = (unsigned)(BK * 2);
    const unsigned ldsw = (unsigned)wid * 1024u;
    const int aoff = lds_byte(wr * 64 + fr, fq * 8), boff = lds_byte(wc * 32 + fr, fq * 8);
#define S_STAGE(bufoff, gbase, v, q) do { \
        __builtin_amdgcn_global_load_lds((const unsigned*)((const char*)(gbase) + (v)), (LAS unsigned*)(lds + (bufoff) + ldsw), 16, 0, 0); \
        __builtin_amdgcn_global_load_lds((const unsigned*)((const char*)(gbase) + (q) + (v)), (LAS unsigned*)(lds + (bufoff) + ldsw + 8192), 16, 0, 0); } while (0)
    UDesc cur, nxt; P.desc(0, cur);
    unsigned vA = (unsigned)(sR * cur.lda + sC), vB = (unsigned)(sRb * cur.ldb + sC);
    __syncthreads();
    f32x4 acc[2][2][4][2];
#pragma unroll
    for (int a = 0; a < 2; ++a)
#pragma unroll
        for (int b = 0; b < 2; ++b)
#pragma unroll
            for (int m = 0; m < 4; ++m)
#pragma unroll
                for (int n = 0; n < 2; ++n) acc[a][b][m][n] = (f32x4){0.f, 0.f, 0.f, 0.f};
    bf16x8 At[4][2], B0[2][2], B1[2][2];
    { const char* cA = cur.A; const char* cB = cur.B; const unsigned hA = (unsigned)HALF * cur.lda * 2, hB = (unsigned)HALF * cur.ldb * 2, qA = hA >> 1, qB = hB >> 1;
      S_STAGE(G_SB(0, 0), cB, vB, qB); S_STAGE(G_SA(0, 0), cA, vA, qA); S_STAGE(G_SB(0, 1), cB + hB, vB, qB); S_STAGE(G_SA(0, 1), cA + hA, vA, qA);
      if (wr == 1) G_BAR;
      G_WAIT_V(4); G_BAR;
      S_STAGE(G_SB(1, 0), cB + kstep, vB, qB); S_STAGE(G_SA(1, 0), cA + kstep, vA, qA); S_STAGE(G_SB(1, 1), cB + hB + kstep, vB, qB);
      G_WAIT_V(6); G_BAR; }
    for (int ui = 0;; ++ui) {
        const bool has_next = ui + 1 < nunits;
        if (has_next) P.desc(ui + 1, nxt); else nxt = cur;
        const unsigned nA = (unsigned)(sR * nxt.lda + sC), nB = (unsigned)(sRb * nxt.ldb + sC);
        const char* cA = cur.A; const char* cB = cur.B; const unsigned hA = (unsigned)HALF * cur.lda * 2, hB = (unsigned)HALF * cur.ldb * 2;
        const unsigned nhA = (unsigned)HALF * nxt.lda * 2, nhB = (unsigned)HALF * nxt.ldb * 2;
        const int nt = cur.K / BK;
        for (int t = 0; t < nt; t += 2) {
            const bool last = (t == nt - 2);
            const char* a1 = cA + (unsigned)(t + 1) * kstep;
            const char* a2 = last ? nxt.A : cA + (unsigned)(t + 2) * kstep; const char* b2 = last ? nxt.B : cB + (unsigned)(t + 2) * kstep;
            const char* a3 = a2 + kstep; const char* b3 = b2 + kstep;
            const unsigned hA2 = last ? nhA : hA, hB2 = last ? nhB : hB, qA = hA >> 1, qA2 = hA2 >> 1, qB2 = hB2 >> 1;
            const unsigned xA = last ? nA : vA, xB = last ? nB : vB;
            G_LDB(B0, 0, 0); G_SCHED; G_LDA(At, 0, 0); S_STAGE(G_SA(1, 1), a1 + hA, vA, qA);
            G_WAIT_L(8); G_BAR; G_WAIT_L(0); G_MMA(0, 0, At, B0); G_BAR; G_SCHED;
            G_LDB(B1, 0, 1); S_STAGE(G_SB(0, 0), b2, xB, qB2);
            G_BAR; G_WAIT_L(0); G_MMA(0, 1, At, B1); G_BAR;
            G_LDA(At, 0, 1); S_STAGE(G_SA(0, 0), a2, xA, qA2);
            G_BAR; G_WAIT_L(0); G_MMA(1, 0, At, B0); G_BAR; G_SCHED;
            S_STAGE(G_SB(0, 1), b2 + hB2, xB, qB2);
            G_WAIT_V(6); G_BAR; G_MMA(1, 1, At, B1); G_BAR;
            G_LDB(B0, 1, 0); G_SCHED; G_LDA(At, 1, 0); S_STAGE(G_SA(0, 1), a2 + hA2, xA, qA2);
            G_WAIT_L(8); G_BAR; G_WAIT_L(0); G_MMA(0, 0, At, B0); G_BAR; G_SCHED;
            G_LDB(B1, 1, 1); S_STAGE(G_SB(1, 0), b3, xB, qB2);
            G_BAR; G_WAIT_L(0); G_MMA(0, 1, At, B1); G_BAR;
            G_LDA(At, 1, 1); S_STAGE(G_SA(1, 0), a3, xA, qA2);
            G_BAR; G_WAIT_L(0); G_MMA(1, 0, At, B0); G_BAR; G_SCHED;
            S_STAGE(G_SB(1, 1), b3 + hB2, xB, qB2);
            G_WAIT_V(6); G_BAR; G_MMA(1, 1, At, B1); G_BAR;
        }
        P.epi(ui, acc, wr, wc, fr, fq);
        if (!has_next) break;
#pragma unroll
        for (int a = 0; a < 2; ++a)
#pragma unroll
            for (int b = 0; b < 2; ++b)
#pragma unroll
                for (int m = 0; m < 4; ++m)
#pragma unroll
                    for (int n = 0; n < 2; ++n) acc[a][b][m][n] = (f32x4){0.f, 0.f, 0.f, 0.f};
        cur = nxt; vA = nA; vB = nB;
    }
    G_WAIT_V(0);
    if (wr == 0) G_BAR;
    G_BAR;
    __syncthreads();
#undef S_STAGE
}

#define EPI_LOOP _Pragma("unroll") for (int ai = 0; ai < 2; ++ai) _Pragma("unroll") for (int m = 0; m < 4; ++m) _Pragma("unroll") for (int bj = 0; bj < 2; ++bj) _Pragma("unroll") for (int n = 0; n < 2; ++n)
#define EPI_ROW (ai * 128 + wr * 64 + m * 16 + fr)
#define EPI_COL (bj * 128 + wc * 32 + 8 * fq + 4 * n)

#define U4 _Pragma("unroll")
struct EpiStoreBf16 {
    bf16_t* O; size_t ldo; const float* bias; bool rowb;
    __device__ __forceinline__ void operator()(const AccT& acc, int wr, int wc, int fr, int fq) const {
        { const int tq_ = tidx(); wr = (tq_ >> 8) & 1; wc = (tq_ >> 6) & 3; fr = tq_ & 15; fq = (tq_ >> 4) & 3; }
        float br[2][4]; f32x4 bc[2][2];
        U4 for (int ai = 0; ai < 2; ++ai) U4 for (int m = 0; m < 4; ++m) br[ai][m] = rowb ? bias[ai * 128 + wr * 64 + m * 16 + fr] : 0.f;
        U4 for (int bj = 0; bj < 2; ++bj) U4 for (int n = 0; n < 2; ++n) bc[bj][n] = rowb ? (f32x4){0.f, 0.f, 0.f, 0.f} : *(const f32x4*)(bias + EPI_COL);
        U4 for (int ai = 0; ai < 2; ++ai) U4 for (int m = 0; m < 4; ++m) U4 for (int bj = 0; bj < 2; ++bj) { const int n = 0; const int r = EPI_ROW, c = EPI_COL;
            const f32x4 v0 = acc[ai][bj][m][0] + bc[bj][0] + br[ai][m], v1 = acc[ai][bj][m][1] + bc[bj][1] + br[ai][m];
            u32x4 w; w.x = cvt_pk_bf16(v0[0], v0[1]); w.y = cvt_pk_bf16(v0[2], v0[3]); w.z = cvt_pk_bf16(v1[0], v1[1]); w.w = cvt_pk_bf16(v1[2], v1[3]); *(u32x4*)(O + (size_t)r * ldo + c) = w; }
    }
};
struct EpiGate {
    f32x4* SG; const float* bias;
    __device__ __forceinline__ void operator()(const AccT& acc, int wr, int wc, int fr, int fq) const {
        { const int tq_ = tidx(); wr = (tq_ >> 8) & 1; wc = (tq_ >> 6) & 3; fr = tq_ & 15; fq = (tq_ >> 4) & 3; }
        f32x4 bc[2][2];
        U4 for (int bj = 0; bj < 2; ++bj) U4 for (int n = 0; n < 2; ++n) bc[bj][n] = *(const f32x4*)(bias + EPI_COL);
        int i = 0; f32x4* SGt = SG + tidx();
        EPI_LOOP { f32x4 v = acc[ai][bj][m][n] + bc[bj][n];
            v[0] = sigmoidf_(v[0]); v[1] = sigmoidf_(v[1]); v[2] = sigmoidf_(v[2]); v[3] = sigmoidf_(v[3]);
            SGt[i * NTHREADS] = v; ++i; }
    }
};
struct EpiBranch {
    const f32x4* SG; f32x4* ST; bf16_t* MG; int first, last;
    __device__ __forceinline__ void operator()(const AccT& acc, int wr, int wc, int fr, int fq) const {
        { const int tq_ = tidx(); wr = (tq_ >> 8) & 1; wc = (tq_ >> 6) & 3; fr = tq_ & 15; fq = (tq_ >> 4) & 3; }
        const int tq = tidx(); const f32x4* SGt = SG + tq; f32x4* STt = ST + tq;
        U4 for (int ai = 0; ai < 2; ++ai) U4 for (int mh = 0; mh < 2; ++mh) {
            f32x4 g[8], t[8];
            U4 for (int q = 0; q < 8; ++q) { const int i = ai * 16 + mh * 8 + q; g[q] = SGt[i * NTHREADS]; t[q] = first ? (f32x4){0.f, 0.f, 0.f, 0.f} : STt[i * NTHREADS]; }
            if (last) { U4 for (int q = 0; q < 8; q += 2) { const int m = mh * 2 + (q >> 2), bj = (q >> 1) & 1, n = 0; const int r = EPI_ROW, c = EPI_COL;
                    const f32x4 v0 = acc[ai][bj][m][0] * g[q] + t[q], v1 = acc[ai][bj][m][1] * g[q + 1] + t[q + 1];
                    u32x4 w; w.x = cvt_pk_bf16(v0[0], v0[1]); w.y = cvt_pk_bf16(v0[2], v0[3]); w.z = cvt_pk_bf16(v1[0], v1[1]); w.w = cvt_pk_bf16(v1[2], v1[3]); *(u32x4*)(MG + (size_t)r * 1024 + c) = w; } }
            else { U4 for (int q = 0; q < 8; ++q) { const int m = mh * 2 + (q >> 2), bj = (q >> 1) & 1, n = q & 1, i = ai * 16 + mh * 8 + q;
                    STt[i * NTHREADS] = acc[ai][bj][m][n] * g[q] + t[q]; } }
        }
    }
};
struct EpiResid {
    const float* xsrc; float* xdst; const float* gate;
    __device__ __forceinline__ void operator()(const AccT& acc, int wr, int wc, int fr, int fq) const {
        { const int tq_ = tidx(); wr = (tq_ >> 8) & 1; wc = (tq_ >> 6) & 3; fr = tq_ & 15; fq = (tq_ >> 4) & 3; }
        f32x4 gc[2][2];
        U4 for (int bj = 0; bj < 2; ++bj) U4 for (int n = 0; n < 2; ++n) gc[bj][n] = *(const f32x4*)(gate + EPI_COL);
        U4 for (int ai = 0; ai < 2; ++ai) U4 for (int mh = 0; mh < 2; ++mh) {
            f32x4 xo[2][2][2];
            U4 for (int mm = 0; mm < 2; ++mm) U4 for (int bj = 0; bj < 2; ++bj) U4 for (int n = 0; n < 2; ++n) { const int m = mh * 2 + mm; xo[mm][bj][n] = *(const f32x4*)(xsrc + (size_t)EPI_ROW * 1024 + EPI_COL); }
            U4 for (int mm = 0; mm < 2; ++mm) U4 for (int bj = 0; bj < 2; ++bj) U4 for (int n = 0; n < 2; ++n) { const int m = mh * 2 + mm; *(f32x4*)(xdst + (size_t)EPI_ROW * 1024 + EPI_COL) = xo[mm][bj][n] + gc[bj][n] * acc[ai][bj][m][n]; }
        }
    }
};
struct EpiSqrelu {
    bf16_t* H; int ldh;
    __device__ __forceinline__ void operator()(const AccT& acc, int wr, int wc, int fr, int fq) const {
        { const int tq_ = tidx(); wr = (tq_ >> 8) & 1; wc = (tq_ >> 6) & 3; fr = tq_ & 15; fq = (tq_ >> 4) & 3; }
        U4 for (int ai = 0; ai < 2; ++ai) U4 for (int m = 0; m < 4; ++m) U4 for (int bj = 0; bj < 2; ++bj) { const int n = 0; const int r = EPI_ROW, c = EPI_COL; f32x4 v0 = acc[ai][bj][m][0], v1 = acc[ai][bj][m][1];
#pragma unroll
            for (int j = 0; j < 4; ++j) { const float t0 = fmaxf(v0[j], 0.f), t1 = fmaxf(v1[j], 0.f); v0[j] = t0 * t0; v1[j] = t1 * t1; }
            u32x4 w; w.x = cvt_pk_bf16(v0[0], v0[1]); w.y = cvt_pk_bf16(v0[2], v0[3]); w.z = cvt_pk_bf16(v1[0], v1[1]); w.w = cvt_pk_bf16(v1[2], v1[3]); *(u32x4*)(H + (size_t)r * ldh + c) = w; }
    }
};

struct XMap { int NT, per_xcd, x, j;
    __device__ __forceinline__ void init(int bid, int ntt, int nt_) { NT = nt_; per_xcd = (ntt >> 3) * nt_; x = bid & 7; j = bid >> 3; }
    __device__ __forceinline__ int rounds() const { return j < per_xcd ? (per_xcd - j + 31) / 32 : 0; }
    __device__ __forceinline__ void get(int i, int& tt, int& nt) const { const int q = i * 32 + j; tt = x + 8 * (q / NT); nt = q % NT; }
};
struct ProgInproj {
    const bf16_t* wt; const bf16_t* wg; const bf16_t* HX; bf16_t* T; bf16_t* PG; const float* biasT; const float* biasG; XMap MA, MB; int rA;
    __device__ __forceinline__ void desc(int i, UDesc& d) const { int tt, nt;
        if (i < rA) { MA.get(i, tt, nt); d.A = (const char*)(wt + (size_t)(nt * 256) * D); d.B = (const char*)(HX + (size_t)(tt * 256) * D); }
        else { MB.get(i - rA, tt, nt); d.A = (const char*)(HX + (size_t)(tt * 256) * D); d.B = (const char*)(wg + (size_t)(nt * 256) * D); }
        d.lda = D; d.ldb = D; d.K = D; }
    __device__ __forceinline__ void epi(int i, const AccT& acc, int wr, int wc, int fr, int fq) const { int tt, nt;
        if (i < rA) { MA.get(i, tt, nt); EpiStoreBf16 E{T + (size_t)(nt * 256) * TOK + (size_t)tt * 256, (size_t)TOK, biasT + nt * 256, true}; E(acc, wr, wc, fr, fq); }
        else { MB.get(i - rA, tt, nt); EpiStoreBf16 E{PG + (size_t)(tt * 256) * NG + nt * 256, (size_t)NG, biasG + nt * 256, false}; E(acc, wr, wc, fr, fq); } }
};
struct ProgMix {
    unsigned char* ws; unsigned char* scr; const float* bgate; unsigned tok0; int l;
    __device__ __forceinline__ void desc(int i, UDesc& d) const { const int nt = i / 6, j = i % 6, X = j >> 1;
        if (!(j & 1)) { d.A = (const char*)(ws + WS_HX) + (size_t)tok0 * D * 2; d.B = (const char*)(ws + WS_WGATE + l * SZ_WGATE) + (size_t)(X * 1024 + nt * 256) * D * 2; d.lda = D; d.ldb = D; d.K = D; }
        else { d.A = X == 0 ? (const char*)(scr + SC_TRY) : (X == 1 ? (const char*)(ws + WS_YG) + (size_t)tok0 * 1024 : (const char*)(scr + SC_TRP));
               d.B = (const char*)(ws + WS_WBR + (size_t)l * 3 * SZ_WBR) + (size_t)X * SZ_WBR + (size_t)(nt * 256) * 1024; d.lda = 512; d.ldb = 512; d.K = 512; } }
    __device__ __forceinline__ void epi(int i, const AccT& acc, int wr, int wc, int fr, int fq) const { const int nt = i / 6, j = i % 6, X = j >> 1;
        if (!(j & 1)) { EpiGate E{(f32x4*)(scr + SC_SG), bgate + X * 1024 + nt * 256}; E(acc, wr, wc, fr, fq); }
        else { EpiBranch E{(const f32x4*)(scr + SC_SG), (f32x4*)(scr + SC_ST), (bf16_t*)(scr + SC_MERGED) + nt * 256, X == 0, X == 2}; E(acc, wr, wc, fr, fq); } }
};
struct ProgResid {
    const bf16_t* A; int lda; const bf16_t* W; int ldw, K; size_t wstep; const float* xsrc; float* xdst; const float* gate;
    __device__ __forceinline__ void desc(int i, UDesc& d) const { d.A = (const char*)A; d.B = (const char*)(W + (size_t)i * wstep); d.lda = lda; d.ldb = ldw; d.K = K; }
    __device__ __forceinline__ void epi(int i, const AccT& acc, int wr, int wc, int fr, int fq) const { EpiResid E{xsrc + i * 256, xdst + i * 256, gate + i * 256}; E(acc, wr, wc, fr, fq); }
};
struct ProgUp {
    const bf16_t* XN; const bf16_t* W; bf16_t* HID;
    __device__ __forceinline__ void desc(int i, UDesc& d) const { d.A = (const char*)XN; d.B = (const char*)(W + (size_t)(i * 256) * D); d.lda = D; d.ldb = D; d.K = D; }
    __device__ __forceinline__ void epi(int i, const AccT& acc, int wr, int wc, int fr, int fq) const { EpiSqrelu E{HID + i * 256, 2048}; E(acc, wr, wc, fr, fq); }
};


struct TileIO { const float* xin; const float* ctxin; float* out; float* ctxs; const float* modl; int l;
    __device__ __forceinline__ const float* src(int tt) const { return tt < 256 ? (l == 0 ? xin : out) + (size_t)tt * 256 * D : ctxin + (size_t)(tt - 256) * 256 * D; }
    __device__ __forceinline__ float* dst(int tt) const { return tt < 256 ? out + (size_t)tt * 256 * D : ctxs + (size_t)(tt - 256) * 256 * D; }
    __device__ __forceinline__ const float* cur(int tt) const { return tt < 256 ? out + (size_t)tt * 256 * D : ctxs + (size_t)(tt - 256) * 256 * D; }
    __device__ __forceinline__ const float* mod(int tt) const { return modl + (size_t)(tt < 256 ? tt >> 3 : 32) * 6144; }
};
struct ProgMix2 {
    unsigned char* ws; unsigned char* stash; const float* bgate; XMap M; int l;
    __device__ __forceinline__ void desc(int ii, UDesc& d) const { int tt, nt; M.get(ii / 6, tt, nt); const int s6 = ii % 6, X = s6 >> 1;
        if (!(s6 & 1)) { d.A = (const char*)(ws + WS_HX) + (size_t)tt * 256 * D * 2; d.B = (const char*)(ws + WS_WGATE + l * SZ_WGATE) + (size_t)(X * 1024 + nt * 256) * D * 2; d.lda = D; d.ldb = D; d.K = D; }
        else { d.A = (const char*)(ws + (X == 0 ? WS_YHY : (X == 1 ? WS_YG : WS_YPL))) + (size_t)tt * 256 * 1024;
               d.B = (const char*)(ws + WS_WBR + (size_t)l * 3 * SZ_WBR) + (size_t)X * SZ_WBR + (size_t)(nt * 256) * 1024; d.lda = 512; d.ldb = 512; d.K = 512; } }
    __device__ __forceinline__ void epi(int ii, const AccT& acc, int wr, int wc, int fr, int fq) const { int tt, nt; M.get(ii / 6, tt, nt); const int s6 = ii % 6, X = s6 >> 1;
        if (!(s6 & 1)) { EpiGate E{(f32x4*)stash, bgate + X * 1024 + nt * 256}; E(acc, wr, wc, fr, fq); }
        else { EpiBranch E{(const f32x4*)stash, (f32x4*)(stash + 262144), (bf16_t*)(ws + WS_MERGED) + (size_t)tt * 256 * 1024 + nt * 256, X == 0, X == 2}; E(acc, wr, wc, fr, fq); } }
};
struct ProgOut2 {
    unsigned char* ws; TileIO io; XMap M; int l;
    __device__ __forceinline__ void desc(int i, UDesc& d) const { int tt, nt; M.get(i, tt, nt);
        d.A = (const char*)(ws + WS_MERGED) + (size_t)tt * 256 * 2048; d.B = (const char*)(ws + WS_WOUT + l * SZ_WOUT) + (size_t)(nt * 256) * D * 2; d.lda = D; d.ldb = D; d.K = D; }
    __device__ __forceinline__ void epi(int i, const AccT& acc, int wr, int wc, int fr, int fq) const { int tt, nt; M.get(i, tt, nt);
        EpiResid E{io.src(tt) + nt * 256, io.dst(tt) + nt * 256, io.mod(tt) + 2048 + nt * 256}; E(acc, wr, wc, fr, fq); }
};
struct ProgUp2 {
    unsigned char* ws; XMap M; int l;
    __device__ __forceinline__ void desc(int i, UDesc& d) const { int tt, nt; M.get(i, tt, nt);
        d.A = (const char*)(ws + WS_HX) + (size_t)tt * 256 * 2048; d.B = (const char*)(ws + WS_WUP + l * SZ_WUP) + (size_t)(nt * 256) * D * 2; d.lda = D; d.ldb = D; d.K = D; }
    __device__ __forceinline__ void epi(int i, const AccT& acc, int wr, int wc, int fr, int fq) const { int tt, nt; M.get(i, tt, nt);
        EpiSqrelu E{(bf16_t*)(ws + WS_HID) + (size_t)tt * 256 * DFF + nt * 256, DFF}; E(acc, wr, wc, fr, fq); }
};
struct ProgDown2 {
    unsigned char* ws; TileIO io; XMap M; int l;
    __device__ __forceinline__ void desc(int i, UDesc& d) const { int tt, nt; M.get(i, tt, nt);
        d.A = (const char*)(ws + WS_HID) + (size_t)tt * 256 * DFF * 2; d.B = (const char*)(ws + WS_WDN + l * SZ_WDN) + (size_t)(nt * 256) * DFF * 2; d.lda = DFF; d.ldb = DFF; d.K = DFF; }
    __device__ __forceinline__ void epi(int i, const AccT& acc, int wr, int wc, int fr, int fq) const { int tt, nt; M.get(i, tt, nt);
        EpiResid E{io.cur(tt) + nt * 256, io.dst(tt) + nt * 256, io.mod(tt) + 5120 + nt * 256}; E(acc, wr, wc, fr, fq); }
};

__device__ __forceinline__ void tconv(const float* src, int ld, int c0, int nvalid, int ncols, int K, bf16_t* dst, LAS float* tile) {
    const int tid = tidx(), ntn = ncols / 64, ntile = ntn * (K / 64);
    for (int t = blockIdx.x; t < ntile; t += gridDim.x) {
        const int k0 = (t / ntn) * 64, n0 = (t % ntn) * 64;
        __syncthreads();
#pragma unroll
        for (int i = 0; i < 8; ++i) { const int k = i * 8 + (tid >> 6), n = tid & 63;
            tile[k * 65 + n] = (n0 + n < nvalid) ? src[(size_t)(k0 + k) * ld + c0 + n0 + n] : 0.f; }
        __syncthreads();
        const int n = tid >> 3, kc = (tid & 7) * 8;
        u32x4 w;
        w.x = cvt_pk_bf16(tile[(kc + 0) * 65 + n], tile[(kc + 1) * 65 + n]); w.y = cvt_pk_bf16(tile[(kc + 2) * 65 + n], tile[(kc + 3) * 65 + n]);
        w.z = cvt_pk_bf16(tile[(kc + 4) * 65 + n], tile[(kc + 5) * 65 + n]); w.w = cvt_pk_bf16(tile[(kc + 6) * 65 + n], tile[(kc + 7) * 65 + n]);
        *(u32x4*)(dst + (size_t)(n0 + n) * K + k0 + kc) = w;
    }
    __syncthreads();
}

__device__ __forceinline__ void job_poolcomb(const Params& p, int l) {
    const float* pw = p.in[I_PW] + (size_t)l * 4 * 128 * 128; const float* sc = p.in[I_PSC] + l * 512; const float* wb = p.in[I_WBP] + (size_t)l * 512 * 1024;
    bf16_t* dst = (bf16_t*)(p.ws + WS_WBR + (size_t)(l * 3 + 2) * SZ_WBR);
    for (int idx = blockIdx.x * NTHREADS + tidx(); idx < 512 * 256; idx += gridDim.x * NTHREADS) {
        const int n = (idx & 255) * 4, k = idx >> 8, g = k >> 7, c = k & 127;
        f32x4 a = (f32x4){0.f, 0.f, 0.f, 0.f};
#pragma unroll 8
        for (int d = 0; d < 128; ++d) { const float ps = pw[(g * 128 + c) * 128 + d] * sc[g * 128 + d]; a += ps * *(const f32x4*)(wb + (size_t)(g * 128 + d) * 1024 + n); }
        dst[(size_t)n * 512 + k] = f2bf(a[0]); dst[(size_t)(n + 1) * 512 + k] = f2bf(a[1]); dst[(size_t)(n + 2) * 512 + k] = f2bf(a[2]); dst[(size_t)(n + 3) * 512 + k] = f2bf(a[3]);
    }
}

__device__ __forceinline__ void job_bias(const Params& p) {
    float* bias = (float*)(p.ws + WS_BIAS);
    for (int idx = blockIdx.x * NTHREADS + tidx(); idx < 2 * (NTR + NG); idx += gridDim.x * NTHREADS) {
        const int l = idx / (NTR + NG), j = idx % (NTR + NG); const float* b = p.in[I_BIN] + l * N_IN;
        float v;
        if (j < 1536) v = b[j]; else if (j < NTR) v = b[POOL_OFF + (j - 1536)]; else { const int q = j - NTR; v = q < NGV ? b[GLA_OFF + q] : 0.f; }
        bias[idx] = v;
    }
}

__device__ __forceinline__ void job_mod(const Params& p, LAS float* sil) {
    if (blockIdx.x >= 192) return;
    const int tid = tidx(), lane = tid & 63, kg = tid >> 6;
    float* mod = (float*)(p.ws + WS_MOD);
    for (int it = blockIdx.x; it < 192; it += gridDim.x) {
        __syncthreads();
        for (int idx = tid; idx < 33 * 1024; idx += NTHREADS) { const int r = idx >> 10, k = idx & 1023; const float v = r < 32 ? p.in[I_C][r * 1024 + k] : p.in[I_CCTX][k]; sil[idx] = v / (1.f + expf(-v)); }
        __syncthreads();
        const int l = it / 96, n0 = (it % 96) * 64;
        const float* w = p.in[I_WMOD] + (size_t)l * 1024 * 6144 + n0 + lane;
        float acc[33];
#pragma unroll
        for (int r = 0; r < 33; ++r) acc[r] = 0.f;
#pragma unroll 2
        for (int k4 = 0; k4 < 32; ++k4) { const int k = kg * 128 + k4 * 4;
            const float w0 = w[(size_t)k * 6144], w1 = w[(size_t)(k + 1) * 6144], w2 = w[(size_t)(k + 2) * 6144], w3 = w[(size_t)(k + 3) * 6144];
#pragma unroll
            for (int r = 0; r < 33; ++r) { const f32x4 sv = *(const LAS f32x4*)(sil + r * 1024 + k); acc[r] += sv[0] * w0 + sv[1] * w1 + sv[2] * w2 + sv[3] * w3; } }
        __syncthreads();
#pragma unroll
        for (int r = 0; r < 33; ++r) sil[(kg * 33 + r) * 64 + lane] = acc[r];
        __syncthreads();
        const float bm = p.in[I_BMOD][l * 6144 + n0 + lane];
        for (int r = kg; r < 33; r += 8) { float sum = 0.f;
#pragma unroll
            for (int q = 0; q < 8; ++q) sum += sil[(q * 33 + r) * 64 + lane];
            mod[(size_t)l * 33 * 6144 + (size_t)r * 6144 + n0 + lane] = sum + bm; }
    }
    __syncthreads();
}

__device__ __forceinline__ void job_filters(const Params& p, LAS unsigned char* lds) {
    LAS float* a1 = (LAS float*)lds;
    LAS float* a2 = (LAS float*)(lds + 16384);
    LAS bf16_t* oT = (LAS bf16_t*)(lds + 16384 + 16640);
    const int tid = tidx();
    const int nitems = (32 + 4 + 32) * 4;
    for (int it = blockIdx.x; it < nitems; it += gridDim.x) {
        const int oc = it & 3; int rt = it >> 2; int l, L, t0; bf16_t* dst;
        if (rt < 32) { l = 0; L = 2048; t0 = rt * 64; dst = (bf16_t*)(p.ws + WS_HFL); }
        else if (rt < 36) { l = 0; L = 256; t0 = (rt - 32) * 64; dst = (bf16_t*)(p.ws + WS_HFC); }
        else { l = 1; L = 2048; t0 = (rt - 36) * 64; dst = (bf16_t*)(p.ws + WS_HFL) + (size_t)4 * 512 * 2048; }
        const float* w1 = p.in[I_FW1] + l * 17 * 64; const float* b1 = p.in[I_FB1] + l * 64; const float* fq = p.in[I_FFREQ] + l * 64;
        const float* w2 = p.in[I_FW2] + l * 64 * 64; const float* b2 = p.in[I_FB2] + l * 64; const float* w3 = p.in[I_FW3] + (size_t)l * 64 * 2048;
        __syncthreads();
        { const int row = tid >> 3, jg = (tid & 7) * 8; const float t = (float)(t0 + row); float z[17];
          z[0] = t / (float)L;
#pragma unroll
          for (int bnd = 1; bnd <= 8; ++bnd) { const float ang = (6.283185307179586f / (float)L) * t * (float)bnd; z[bnd] = cosf(ang); z[8 + bnd] = sinf(ang); }
#pragma unroll
          for (int j = 0; j < 8; ++j) { float s = b1[jg + j];
#pragma unroll
              for (int i = 0; i < 17; ++i) s += z[i] * w1[i * 64 + jg + j];
              a1[row * 64 + jg + j] = sinf(fq[jg + j] * s); } }
        __syncthreads();
        { const int row = tid >> 3, jg = (tid & 7) * 8;
#pragma unroll
          for (int j = 0; j < 8; ++j) { float s = b2[jg + j];
              for (int i = 0; i < 64; ++i) s += a1[row * 64 + i] * w2[i * 64 + jg + j];
              a2[row * 65 + jg + j] = sinf(fq[jg + j] * s); } }
        __syncthreads();
        { const int o = oc * 512 + tid, c = o & 511; float wreg[64];
#pragma unroll
          for (int j = 0; j < 64; ++j) wreg[j] = w3[(size_t)j * 2048 + o];
          const float delta = 3.0701134573253943f + (float)c * ((15.350567286626972f - 3.0701134573253943f) / 511.f);
          for (int row = 0; row < 64; ++row) { float s = 0.f;
#pragma unroll
              for (int j = 0; j < 64; ++j) s += a2[row * 65 + j] * wreg[j];
              const float win = expf(-((float)(t0 + row) / (float)L) * delta);
              oT[tid * 72 + row] = f2bf(s * win); } }
        __syncthreads();
        for (int q = tid; q < 4096; q += NTHREADS) { const int ol = q >> 3, ch = (q & 7) * 8; const int o = oc * 512 + ol, dir = o >> 10, ord = (o >> 9) & 1, c = o & 511;
            const u32x4 w = *(const LAS u32x4*)(oT + ol * 72 + ch);
            *(u32x4*)(dst + ((size_t)((ord * 2 + dir) * 512 + c)) * L + t0 + ch) = w; }
    }
    __syncthreads();
}

__device__ __forceinline__ void ada_write(const f32x4 (&v)[4], float inv, const float* g, const float* sh, const float* sc, bf16_t* dst, float* fdst, int lane) {
#pragma unroll
    for (int i = 0; i < 4; ++i) { const int c = i * 256 + lane * 4; const f32x4 gg = *(const f32x4*)(g + c); f32x4 y = v[i] * inv * gg;
        if (sh) { const f32x4 s1 = *(const f32x4*)(sc + c), s0 = *(const f32x4*)(sh + c); y = y * (1.f + s1) + s0;
            u32x2 w; w.x = cvt_pk_bf16(y[0], y[1]); w.y = cvt_pk_bf16(y[2], y[3]); *(u32x2*)(dst + c) = w; }
        else *(f32x4*)(fdst + c) = y; }
}
__device__ __forceinline__ void ada_row2(const float* xa, const float* xb, bool hb, const float* g, const float* sha, const float* sca, const float* shb, const float* scb,
                                         bf16_t* da, bf16_t* db, float* fa, float* fb, int lane) {
    f32x4 va[4], vb[4]; float sa = 0.f, sb = 0.f;
#pragma unroll
    for (int i = 0; i < 4; ++i) va[i] = *(const f32x4*)(xa + i * 256 + lane * 4);
#pragma unroll
    for (int i = 0; i < 4; ++i) vb[i] = hb ? *(const f32x4*)(xb + i * 256 + lane * 4) : (f32x4){0.f, 0.f, 0.f, 0.f};
#pragma unroll
    for (int i = 0; i < 4; ++i) { sa += va[i][0] * va[i][0] + va[i][1] * va[i][1] + va[i][2] * va[i][2] + va[i][3] * va[i][3]; sb += vb[i][0] * vb[i][0] + vb[i][1] * vb[i][1] + vb[i][2] * vb[i][2] + vb[i][3] * vb[i][3]; }
#pragma unroll
    for (int o = 32; o >= 1; o >>= 1) { sa += __shfl_xor(sa, o); sb += __shfl_xor(sb, o); }
    ada_write(va, rsqrtf(sa * (1.f / 1024.f) + EPS), g, sha, sca, da, fa, lane);
    if (hb) ada_write(vb, rsqrtf(sb * (1.f / 1024.f) + EPS), g, shb, scb, db, fb, lane);
}
__device__ __forceinline__ void ada_row(const float* x, const float* g, const float* sh, const float* sc, bf16_t* dst, float* fdst, int lane) {
    f32x4 v[4]; float ss = 0.f;
#pragma unroll
    for (int i = 0; i < 4; ++i) { v[i] = *(const f32x4*)(x + i * 256 + lane * 4); ss += v[i][0] * v[i][0] + v[i][1] * v[i][1] + v[i][2] * v[i][2] + v[i][3] * v[i][3]; }
    ss = wave_sum(ss);
    const float inv = rsqrtf(ss * (1.f / 1024.f) + EPS);
#pragma unroll
    for (int i = 0; i < 4; ++i) { const int c = i * 256 + lane * 4; const f32x4 gg = *(const f32x4*)(g + c); f32x4 y = v[i] * inv * gg;
        if (sh) { const f32x4 s1 = *(const f32x4*)(sc + c), s0 = *(const f32x4*)(sh + c); y = y * (1.f + s1) + s0;
            u32x2 w; w.x = cvt_pk_bf16(y[0], y[1]); w.y = cvt_pk_bf16(y[2], y[3]); *(u32x2*)(dst + c) = w; }
        else *(f32x4*)(fdst + c) = y; }
}

typedef float f32x16 __attribute__((ext_vector_type(16)));
template <int L, int NT>
__device__ __forceinline__ void hyena_mfma(const Params& p, int l, int c, bool ctx, LAS unsigned char* lds) {
    LAS unsigned char* U = lds;
    LAS unsigned* F = (LAS unsigned*)(lds + L * 64);
    LAS bf16_t* F16 = (LAS bf16_t*)F;
    const int tid = tidx(), lane = tid & 63, w = __builtin_amdgcn_readfirstlane(tid >> 6), li = lane & 31, kg = lane >> 5;
    bf16_t* T = (bf16_t*)(p.ws + WS_T);
    const size_t tokb = ctx ? (size_t)TOKL : 0;
    const bf16_t* hf = ctx ? (const bf16_t*)(p.ws + WS_HFC) : (const bf16_t*)(p.ws + WS_HFL) + (size_t)l * 4 * 512 * 2048;
    const float* sw = p.in[I_HSW] + (size_t)l * 3 * 1536; const float* sb = p.in[I_HSB] + l * 1536;
    __syncthreads();
    {
        const int cc = 1024 + c; const bf16_t* row = T + (size_t)cc * TOK + tokb;
        const float w0 = sw[cc], w1 = sw[1536 + cc], w2 = sw[3072 + cc], bb = sb[cc];
        constexpr int ITER = L / 128, BATCH = ITER >= 4 ? 4 : ITER;
        for (int it0 = 0; it0 < ITER; it0 += BATCH) {
            u32x4 rr[BATCH]; bf16_t hm[BATCH], hp[BATCH];
#pragma unroll
            for (int q = 0; q < BATCH; ++q) { const int idx = tid + (it0 + q) * NTHREADS, bq = idx & 31, t8 = idx >> 5; const bf16_t* pr = row + (size_t)bq * L + t8 * 8;
                rr[q] = *(const u32x4*)pr; hm[q] = t8 > 0 ? pr[-1] : (bf16_t)0; hp[q] = t8 < L / 8 - 1 ? pr[8] : (bf16_t)0; }
#pragma unroll
            for (int q = 0; q < BATCH; ++q) { const int idx = tid + (it0 + q) * NTHREADS; const u32x4 r = rr[q];
                float x[10]; x[0] = bf2f(hm[q]); x[9] = bf2f(hp[q]);
                x[1] = lo16(r.x); x[2] = hi16(r.x); x[3] = lo16(r.y); x[4] = hi16(r.y); x[5] = lo16(r.z); x[6] = hi16(r.z); x[7] = lo16(r.w); x[8] = hi16(r.w);
                float y[8];
#pragma unroll
                for (int j = 0; j < 8; ++j) y[j] = w0 * x[j] + w1 * x[j + 1] + w2 * x[j + 2] + bb;
                u32x4 o; o.x = cvt_pk_bf16(y[0], y[1]); o.y = cvt_pk_bf16(y[2], y[3]); o.z = cvt_pk_bf16(y[4], y[5]); o.w = cvt_pk_bf16(y[6], y[7]);
                *(LAS u32x4*)(U + (size_t)idx * 16) = o; }
        }
    }
    const int lane_dw = (li & 1) * L + ((8 * kg - li + L - (li & 1)) >> 1);
#define HY_LOADA(dst, f) do { const LAS unsigned* _q = F + (lane_dw - 8 * (f)); u32x4 _v; _v.x = _q[0]; _v.y = _q[1]; _v.z = _q[2]; _v.w = _q[3]; dst = __builtin_bit_cast(bf16x8, _v); } while (0)
#define HY_LOADB(dst, s0) dst = *(const LAS bf16x8*)(U + ((s0) >> 3) * 512 + lane * 16)
    for (int ord = 0; ord < 2; ++ord) {
        __syncthreads();
        for (int x0 = tid; x0 < 2 * L; x0 += 4 * NTHREADS) {
            bf16_t fv[4];
#pragma unroll
            for (int q = 0; q < 4; ++q) { const int x = x0 + q * NTHREADS; bf16_t v = 0;
                if (x >= 1 && x <= L) v = hf[((size_t)((ord * 2 + 0) * 512 + c)) * L + (L - x)];
                else if (x > L && x < 2 * L) v = hf[((size_t)((ord * 2 + 1) * 512 + c)) * L + (x - L)];
                fv[q] = v; }
#pragma unroll
            for (int q = 0; q < 4; ++q) { const int x = x0 + q * NTHREADS; const bf16_t v = fv[q];
                if (x < 2 * L) { F16[x] = v; if (x >= 1) F16[2 * L + x - 1] = v; if (x == 2 * L - 1) F16[4 * L - 1] = 0; } } }
        if (false) for (int x = tid; x < 0; ++x) {
            bf16_t v = 0;
            if (x >= 1 && x <= L) v = hf[((size_t)((ord * 2 + 0) * 512 + c)) * L + (L - x)];
            else if (x > L) v = hf[((size_t)((ord * 2 + 1) * 512 + c)) * L + (x - L)];
            F16[x] = v; if (x >= 1) F16[2 * L + x - 1] = v; if (x == 2 * L - 1) F16[4 * L - 1] = 0; }
        __syncthreads();
        f32x16 acc[NT];
#pragma unroll
        for (int i = 0; i < NT; ++i)
#pragma unroll
            for (int r = 0; r < 16; ++r) acc[i][r] = 0.f;
        bf16x8 E[NT], O[NT];
#pragma unroll
        for (int i = 1; i < NT; ++i) { HY_LOADA(E[i], 2 * (NT * w + i)); HY_LOADA(O[i], 2 * (NT * w + i) - 1); }
        for (int n8 = 0; n8 < L / 32; n8 += 8) {
#pragma unroll
            for (int u = 0; u < 8; ++u) { const int n = n8 + u; const int fe = 2 * (NT * w - n); bf16x8 Bf;
                HY_LOADA(E[(8 - u) & (NT - 1)], fe); HY_LOADB(Bf, 32 * n);
#pragma unroll
                for (int i = 0; i < NT; ++i) acc[i] = __builtin_amdgcn_mfma_f32_32x32x16_bf16(E[(i - u) & (NT - 1)], Bf, acc[i], 0, 0, 0);
                HY_LOADA(O[(8 - u) & (NT - 1)], fe - 1); HY_LOADB(Bf, 32 * n + 16);
#pragma unroll
                for (int i = 0; i < NT; ++i) acc[i] = __builtin_amdgcn_mfma_f32_32x32x16_bf16(O[(i - u) & (NT - 1)], Bf, acc[i], 0, 0, 0);
            }
        }
        __syncthreads();
        const int lane2 = tidx() & 63, li = lane2 & 31, kg = lane2 >> 5;
        const int xc = ord * 512 + c; const bf16_t* xrow = T + (size_t)xc * TOK + tokb + (size_t)li * L;
        bf16_t* orow = T + (size_t)c * TOK + tokb + (size_t)li * L;
        const float w0 = sw[xc], w1 = sw[1536 + xc], w2 = sw[3072 + xc], bb = sb[xc], sk = p.in[I_HSKIP][(l * 2 + ord) * 512 + c];
#pragma unroll
        for (int i = 0; i < NT; ++i) {
#pragma unroll
            for (int rh = 0; rh < 4; rh += 2) {
            u32x2 xr4[2]; bf16_t hm[2], hp[2];
#pragma unroll
            for (int r2 = 0; r2 < 2; ++r2) { const int rg = rh + r2; const int tb = 32 * (NT * w + i) + 8 * rg + 4 * kg;
                xr4[r2] = *(const u32x2*)(xrow + tb); hm[r2] = tb > 0 ? xrow[tb - 1] : (bf16_t)0; hp[r2] = tb + 4 < L ? xrow[tb + 4] : (bf16_t)0; }
#pragma unroll
            for (int r2 = 0; r2 < 2; ++r2) { const int rg = rh + r2; const int tb = 32 * (NT * w + i) + 8 * rg + 4 * kg; const u32x2 xr = xr4[r2];
                float x[6]; x[0] = bf2f(hm[r2]); x[5] = bf2f(hp[r2]);
                x[1] = lo16(xr.x); x[2] = hi16(xr.x); x[3] = lo16(xr.y); x[4] = hi16(xr.y);
                LAS u32x2* up = (LAS u32x2*)(U + ((tb >> 3) * 32 + li) * 16 + (tb & 7) * 2);
                const u32x2 uv = *up; const float uu[4] = {lo16(uv.x), hi16(uv.x), lo16(uv.y), hi16(uv.y)};
                float z[4];
#pragma unroll
                for (int j = 0; j < 4; ++j) z[j] = (w0 * x[j] + w1 * x[j + 1] + w2 * x[j + 2] + bb) * (acc[i][rg * 4 + j] + sk * uu[j]);
                u32x2 o; o.x = cvt_pk_bf16(z[0], z[1]); o.y = cvt_pk_bf16(z[2], z[3]);
                if (ord == 0) *up = o; else *(u32x2*)(orow + tb) = o; }
            }
        }
    }
#undef HY_LOADA
#undef HY_LOADB
    __syncthreads();
}

__device__ __forceinline__ void gla_item(const Params& p, int l, int b, int h, int dir, LAS float* lf) {
    const int tid = tidx(), qd = tid & 3, dv = tid >> 2;
    LAS float* qL = lf; LAS float* kL = lf + 2048; LAS float* aL = lf + 4096; LAS float* vL = lf + 6144; LAS float* oL = lf + 10240; LAS float* waL = lf + 14336; LAS float* baL = lf + 15360;
    const bf16_t* PG = (const bf16_t*)(p.ws + WS_PG);
    bf16_t* O = (bf16_t*)(p.ws + WS_OF) + (size_t)dir * TOK * 512;
    const float* wa = (dir ? p.in[I_WAB] : p.in[I_WAF]) + l * 16 * 256; const float* ba = (dir ? p.in[I_BAB] : p.in[I_BAF]) + l * 256;
    __syncthreads();
    for (int i = tid; i < 1024; i += NTHREADS) waL[i] = wa[(i >> 6) * 256 + h * 64 + (i & 63)];
    if (tid < 64) baL[tid] = ba[h * 64 + tid];
    float S[16];
#pragma unroll
    for (int i = 0; i < 16; ++i) S[i] = 0.f;
    const int sp = tid >> 4, sc4 = (tid & 15) * 4, sc8 = (tid & 15) * 8;
    for (int ck = 0; ck < 72; ++ck) {
        const int P = ck * 32 + sp; size_t row;
        if (P < 256) row = (size_t)TOKL + b * 256 + (dir ? 255 - P : P); else { const int tl = P - 256; row = (size_t)b * 2048 + (dir ? 2047 - tl : tl); }
        const bf16_t* pr = PG + row * NG;
        __syncthreads();
        { const u32x2 wq = *(const u32x2*)(pr + h * 64 + sc4), wk = *(const u32x2*)(pr + 256 + h * 64 + sc4);
          *(LAS f32x4*)(qL + sp * 64 + sc4) = (f32x4){lo16(wq.x) * 0.125f, hi16(wq.x) * 0.125f, lo16(wq.y) * 0.125f, hi16(wq.y) * 0.125f};
          *(LAS f32x4*)(kL + sp * 64 + sc4) = (f32x4){lo16(wk.x), hi16(wk.x), lo16(wk.y), hi16(wk.y)};
          const u32x4 wv = *(const u32x4*)(pr + 512 + h * 128 + sc8);
          *(LAS f32x4*)(vL + sp * 128 + sc8) = (f32x4){lo16(wv.x), hi16(wv.x), lo16(wv.y), hi16(wv.y)};
          *(LAS f32x4*)(vL + sp * 128 + sc8 + 4) = (f32x4){lo16(wv.z), hi16(wv.z), lo16(wv.w), hi16(wv.w)};
          const u32x4 g0 = *(const u32x4*)(pr + 1536 + dir * 16), g1 = *(const u32x4*)(pr + 1536 + dir * 16 + 8);
          float gt[16] = {lo16(g0.x), hi16(g0.x), lo16(g0.y), hi16(g0.y), lo16(g0.z), hi16(g0.z), lo16(g0.w), hi16(g0.w),
                          lo16(g1.x), hi16(g1.x), lo16(g1.y), hi16(g1.y), lo16(g1.z), hi16(g1.z), lo16(g1.w), hi16(g1.w)};
#pragma unroll
          for (int j = 0; j < 4; ++j) { float z = baL[sc4 + j];
#pragma unroll
              for (int r = 0; r < 16; ++r) z += gt[r] * waL[r * 64 + sc4 + j];
              const float ls = -(fmaxf(-z, 0.f) + log1pf(expf(-fabsf(z))));
              aL[sp * 64 + sc4 + j] = expf(ls * (1.f / 16.f)); } }
        __syncthreads();
        for (int pos = 0; pos < 32; ++pos) {
            const float vv = vL[pos * 128 + dv]; float part = 0.f;
#pragma unroll
            for (int i4 = 0; i4 < 4; ++i4) { const f32x4 aa = *(const LAS f32x4*)(aL + pos * 64 + qd * 16 + i4 * 4), kk = *(const LAS f32x4*)(kL + pos * 64 + qd * 16 + i4 * 4), qq = *(const LAS f32x4*)(qL + pos * 64 + qd * 16 + i4 * 4);
#pragma unroll
                for (int j = 0; j < 4; ++j) { S[i4 * 4 + j] = aa[j] * S[i4 * 4 + j] + kk[j] * vv; part += qq[j] * S[i4 * 4 + j]; } }
            part += __shfl_xor(part, 1); part += __shfl_xor(part, 2);
            if (qd == 0) oL[pos * 128 + dv] = part;
        }
        __syncthreads();
        { const f32x4 o0 = *(const LAS f32x4*)(oL + sp * 128 + sc8), o1 = *(const LAS f32x4*)(oL + sp * 128 + sc8 + 4);
          u32x4 w; w.x = cvt_pk_bf16(o0[0], o0[1]); w.y = cvt_pk_bf16(o0[2], o0[3]); w.z = cvt_pk_bf16(o1[0], o1[1]); w.w = cvt_pk_bf16(o1[2], o1[3]);
          *(u32x4*)(O + row * 512 + h * 128 + sc8) = w; }
    }
    __syncthreads();
}


__device__ __forceinline__ size_t gla_row(int P, int b, int dir) { return P < 256 ? (size_t)TOKL + b * 256 + (dir ? 255 - P : P) : (size_t)b * 2048 + (dir ? 2047 - (P - 256) : (P - 256)); }
__device__ __forceinline__ void gla_chunk_item(const Params& p, int l, int b, int h, int dir, LAS unsigned char* lds) {
    constexpr int RS = 72;
    LAS bf16_t* QD = (LAS bf16_t*)lds; LAS bf16_t* KI = QD + 64 * RS; LAS bf16_t* KET = KI + 64 * RS; LAS bf16_t* PP = KET + 64 * RS;
    LAS bf16_t* VT = PP + 64 * RS; LAS bf16_t* ST = VT + 128 * RS;
    LAS float* TOT = (LAS float*)(ST + 128 * RS); LAS float* DEC = TOT + 512; LAS float* WAL = DEC + 64; LAS float* BAL = WAL + 1024;
    const int tid = tidx(), lane = tid & 63, w = __builtin_amdgcn_readfirstlane(tid >> 6), i = tid >> 3, dg = tid & 7, d0 = dg * 8, l5 = lane & 31, hh = lane >> 5;
    const int ih = w >> 2, vq = w & 3;
    const bf16_t* PG = (const bf16_t*)(p.ws + WS_PG);
    bf16_t* O = (bf16_t*)(p.ws + WS_OF) + (size_t)dir * TOK * 512;
    const float* wa = (dir ? p.in[I_WAB] : p.in[I_WAF]) + l * 16 * 256; const float* ba = (dir ? p.in[I_BAB] : p.in[I_BAF]) + l * 256;
    __syncthreads();
    for (int q = tid; q < 1024; q += NTHREADS) WAL[q] = wa[(q >> 6) * 256 + h * 64 + (q & 63)];
    if (tid < 64) BAL[tid] = ba[h * 64 + tid];
    for (int q = tid; q < 73728 / 16; q += NTHREADS) *(LAS u32x4*)(lds + q * 16) = (u32x4){0u, 0u, 0u, 0u};
    f32x16 accS;
#pragma unroll
    for (int r = 0; r < 16; ++r) accS[r] = 0.f;
    u32x4 rq, rk, rg0, rg1, rv0, rv1;
    { const bf16_t* pr = PG + gla_row(i, b, dir) * NG;
      rq = *(const u32x4*)(pr + h * 64 + d0); rk = *(const u32x4*)(pr + 256 + h * 64 + d0); rg0 = *(const u32x4*)(pr + 1536 + dir * 16); rg1 = *(const u32x4*)(pr + 1536 + dir * 16 + 8);
      rv0 = *(const u32x4*)(pr + 512 + h * 128 + dg * 16); rv1 = *(const u32x4*)(pr + 512 + h * 128 + dg * 16 + 8); }
    __syncthreads();
    for (int ck = 0; ck < 36; ++ck) {
        float qf[8] = {lo16(rq.x), hi16(rq.x), lo16(rq.y), hi16(rq.y), lo16(rq.z), hi16(rq.z), lo16(rq.w), hi16(rq.w)};
        float kf[8] = {lo16(rk.x), hi16(rk.x), lo16(rk.y), hi16(rk.y), lo16(rk.z), hi16(rk.z), lo16(rk.w), hi16(rk.w)};
        float gt[16] = {lo16(rg0.x), hi16(rg0.x), lo16(rg0.y), hi16(rg0.y), lo16(rg0.z), hi16(rg0.z), lo16(rg0.w), hi16(rg0.w),
                        lo16(rg1.x), hi16(rg1.x), lo16(rg1.y), hi16(rg1.y), lo16(rg1.z), hi16(rg1.z), lo16(rg1.w), hi16(rg1.w)};
        float la[8];
#pragma unroll
        for (int j = 0; j < 8; ++j) { float z = BAL[d0 + j];
#pragma unroll
            for (int r = 0; r < 16; ++r) z += gt[r] * WAL[r * 64 + d0 + j];
            la[j] = -(fmaxf(-z, 0.f) + __logf(1.f + __expf(-fabsf(z)))) * (1.f / 16.f); }
#pragma unroll
        for (int st = 8; st < 64; st <<= 1) {
#pragma unroll
            for (int j = 0; j < 8; ++j) { const float y = __shfl_up(la[j], st); if (lane >= st) la[j] += y; } }
        if ((lane >> 3) == 7) { *(LAS f32x4*)(TOT + w * 64 + d0) = (f32x4){la[0], la[1], la[2], la[3]}; *(LAS f32x4*)(TOT + w * 64 + d0 + 4) = (f32x4){la[4], la[5], la[6], la[7]}; }
        __syncthreads();
        {
            float pre[8], bl[8];
#pragma unroll
            for (int j = 0; j < 8; ++j) { pre[j] = 0.f; bl[j] = 0.f; }
#pragma unroll
            for (int ww = 0; ww < 8; ++ww) { const f32x4 t0 = *(const LAS f32x4*)(TOT + ww * 64 + d0), t1 = *(const LAS f32x4*)(TOT + ww * 64 + d0 + 4);
                const float tv[8] = {t0[0], t0[1], t0[2], t0[3], t1[0], t1[1], t1[2], t1[3]};
#pragma unroll
                for (int j = 0; j < 8; ++j) { bl[j] += tv[j]; if (ww < w) pre[j] += tv[j]; } }
            float qd[8], ki[8], ke[8], eb[8];
#pragma unroll
            for (int j = 0; j < 8; ++j) { const float bc = la[j] + pre[j]; const float e1 = __expf(bc), e2 = __builtin_amdgcn_rcpf(e1); eb[j] = __expf(bl[j]);
                qd[j] = qf[j] * 0.125f * e1; ki[j] = kf[j] * e2; ke[j] = kf[j] * (eb[j] * e2); }
            u32x4 wq, wk;
            wq.x = cvt_pk_bf16(qd[0], qd[1]); wq.y = cvt_pk_bf16(qd[2], qd[3]); wq.z = cvt_pk_bf16(qd[4], qd[5]); wq.w = cvt_pk_bf16(qd[6], qd[7]);
            wk.x = cvt_pk_bf16(ki[0], ki[1]); wk.y = cvt_pk_bf16(ki[2], ki[3]); wk.z = cvt_pk_bf16(ki[4], ki[5]); wk.w = cvt_pk_bf16(ki[6], ki[7]);
            *(LAS u32x4*)(QD + i * RS + d0) = wq; *(LAS u32x4*)(KI + i * RS + d0) = wk;
#pragma unroll
            for (int j = 0; j < 8; j += 2) { const unsigned pk = cvt_pk_bf16(ke[j], ke[j + 1]); KET[(d0 + j) * RS + i] = (bf16_t)(pk & 0xffffu); KET[(d0 + j + 1) * RS + i] = (bf16_t)(pk >> 16); }
            const unsigned vv[8] = {rv0.x, rv0.y, rv0.z, rv0.w, rv1.x, rv1.y, rv1.z, rv1.w};
#pragma unroll
            for (int j = 0; j < 8; ++j) { VT[(dg * 16 + 2 * j) * RS + i] = (bf16_t)(vv[j] & 0xffffu); VT[(dg * 16 + 2 * j + 1) * RS + i] = (bf16_t)(vv[j] >> 16); }
            if (i == 0) { *(LAS f32x4*)(DEC + d0) = (f32x4){eb[0], eb[1], eb[2], eb[3]}; *(LAS f32x4*)(DEC + d0 + 4) = (f32x4){eb[4], eb[5], eb[6], eb[7]}; }
        }
        if (ck + 1 < 36) { const bf16_t* pr = PG + gla_row((ck + 1) * 64 + i, b, dir) * NG;
            rq = *(const u32x4*)(pr + h * 64 + d0); rk = *(const u32x4*)(pr + 256 + h * 64 + d0); rg0 = *(const u32x4*)(pr + 1536 + dir * 16); rg1 = *(const u32x4*)(pr + 1536 + dir * 16 + 8);
            rv0 = *(const u32x4*)(pr + 512 + h * 128 + dg * 16); rv1 = *(const u32x4*)(pr + 512 + h * 128 + dg * 16 + 8); }
        __syncthreads();
        f32x16 accO;
#pragma unroll
        for (int r = 0; r < 16; ++r) accO[r] = 0.f;
#pragma unroll
        for (int ks = 0; ks < 4; ++ks) { const bf16x8 A = *(const LAS bf16x8*)(QD + (ih * 32 + l5) * RS + ks * 16 + hh * 8), Bv = *(const LAS bf16x8*)(ST + (vq * 32 + l5) * RS + ks * 16 + hh * 8);
            accO = __builtin_amdgcn_mfma_f32_32x32x16_bf16(A, Bv, accO, 0, 0, 0); }
        if (w < 3) { const int si = w == 0 ? 0 : 1, sj = w == 2 ? 1 : 0; f32x16 accP;
#pragma unroll
            for (int r = 0; r < 16; ++r) accP[r] = 0.f;
#pragma unroll
            for (int ks = 0; ks < 4; ++ks) { const bf16x8 A = *(const LAS bf16x8*)(QD + (si * 32 + l5) * RS + ks * 16 + hh * 8), Bv = *(const LAS bf16x8*)(KI + (sj * 32 + l5) * RS + ks * 16 + hh * 8);
                accP = __builtin_amdgcn_mfma_f32_32x32x16_bf16(A, Bv, accP, 0, 0, 0); }
#pragma unroll
            for (int r = 0; r < 16; ++r) { const int ii = si * 32 + (r & 3) + 8 * (r >> 2) + 4 * hh, jj = sj * 32 + l5; PP[ii * RS + jj] = f2bf(jj <= ii ? accP[r] : 0.f); } }
        __syncthreads();
        { const int nk = ih == 0 ? 2 : 4;
          for (int ks = 0; ks < nk; ++ks) { const bf16x8 A = *(const LAS bf16x8*)(PP + (ih * 32 + l5) * RS + ks * 16 + hh * 8), Bv = *(const LAS bf16x8*)(VT + (vq * 32 + l5) * RS + ks * 16 + hh * 8);
              accO = __builtin_amdgcn_mfma_f32_32x32x16_bf16(A, Bv, accO, 0, 0, 0); } }
#pragma unroll
        for (int rg = 0; rg < 4; ++rg) { const f32x4 dv = *(const LAS f32x4*)(DEC + ih * 32 + 8 * rg + 4 * hh);
#pragma unroll
            for (int j = 0; j < 4; ++j) accS[rg * 4 + j] *= dv[j]; }
#pragma unroll
        for (int ks = 0; ks < 4; ++ks) { const bf16x8 A = *(const LAS bf16x8*)(KET + (ih * 32 + l5) * RS + ks * 16 + hh * 8), Bv = *(const LAS bf16x8*)(VT + (vq * 32 + l5) * RS + ks * 16 + hh * 8);
            accS = __builtin_amdgcn_mfma_f32_32x32x16_bf16(A, Bv, accS, 0, 0, 0); }
#pragma unroll
        for (int r = 0; r < 16; ++r) { const int ii = ih * 32 + (r & 3) + 8 * (r >> 2) + 4 * hh;
            O[gla_row(ck * 64 + ii, b, dir) * 512 + h * 128 + vq * 32 + l5] = f2bf(accO[r]); }
#pragma unroll
        for (int rg = 0; rg < 4; ++rg) { u32x2 o; o.x = cvt_pk_bf16(accS[rg * 4], accS[rg * 4 + 1]); o.y = cvt_pk_bf16(accS[rg * 4 + 2], accS[rg * 4 + 3]);
            *(LAS u32x2*)(ST + (vq * 32 + l5) * RS + ih * 32 + 8 * rg + 4 * hh) = o; }
        __syncthreads();
    }
    __syncthreads();
}

template <int W>
__device__ __forceinline__ void pool2d_wave(bf16_t* base, int lane) {
    float u[32], pv[33];
#pragma unroll
    for (int r = 0; r < 32; ++r) u[r] = bf2f(base[r * 64 + lane]);
    pv[0] = 0.f;
#pragma unroll
    for (int r = 0; r < 32; ++r) pv[r + 1] = pv[r] + u[r];
    const int cl = max(lane - W / 2, 0), chh = min(lane - W / 2 + W, 64);
#pragma unroll
    for (int r = 0; r < 32; ++r) {
        const int rl = (r - W / 2) < 0 ? 0 : (r - W / 2), rh = (r - W / 2 + W) > 32 ? 32 : (r - W / 2 + W);
        float x = pv[rh] - pv[rl];
#pragma unroll
        for (int d = 1; d < 64; d <<= 1) { const float y = __shfl_up(x, d); if (lane >= d) x += y; }
        const float hi = __shfl(x, chh - 1), lo = __shfl(x, cl > 0 ? cl - 1 : 0);
        const float s = hi - (cl > 0 ? lo : 0.f);
        const float cnt = (float)((rh - rl) * (chh - cl));
        base[r * 64 + lane] = f2bf(s / cnt - u[r]);
    }
}
__device__ __forceinline__ void pool1d_wave(bf16_t* base, int lane, int W) {
    float u[4], P[4];
#pragma unroll
    for (int j = 0; j < 4; ++j) u[j] = bf2f(base[j * 64 + lane]);
    float off = 0.f;
#pragma unroll
    for (int j = 0; j < 4; ++j) { float x = u[j];
#pragma unroll
        for (int d = 1; d < 64; d <<= 1) { const float y = __shfl_up(x, d); if (lane >= d) x += y; }
        P[j] = x + off; off += __shfl(x, 63); }
#pragma unroll
    for (int j = 0; j < 4; ++j) { const int t = j * 64 + lane; const int lo = max(t - W / 2, 0), hi = min(t - W / 2 + W, 256);
        const int ih = hi - 1, il = lo > 0 ? lo - 1 : 0;
        float vh = 0.f, vl = 0.f;
#pragma unroll
        for (int s = 0; s < 4; ++s) { const float a = __shfl(P[s], ih & 63), bq = __shfl(P[s], il & 63); if ((ih >> 6) == s) vh = a; if ((il >> 6) == s) vl = bq; }
        const float sum = vh - (lo > 0 ? vl : 0.f);
        u[j] = sum / (float)(hi - lo) - u[j]; }
#pragma unroll
    for (int j = 0; j < 4; ++j) base[j * 64 + lane] = f2bf(u[j]);
}

__global__ void __launch_bounds__(NTHREADS, 2) mega(Params p) {
    extern __shared__ __attribute__((aligned(16))) unsigned char lds_raw[];
    LAS unsigned char* lds = (LAS unsigned char*)lds_raw;
    LAS float* lf = (LAS float*)lds;
    cg::grid_group grid = cg::this_grid();
    unsigned bar_n = 0; unsigned* bar_ctr = (unsigned*)(p.ws + WS_BAR);
#define GBAR() do { bar_n += gridDim.x; gbar(bar_ctr, bar_n); } while (0)
    const int G = gridDim.x, bid = blockIdx.x;
#define WSPTRS const int tid = tidx(), lane = tid & 63, wid = tid >> 6; (void)lane; (void)wid; unsigned char* ws = opq(p.ws); bf16_t* HX = (bf16_t*)(ws + WS_HX); bf16_t* T = (bf16_t*)(ws + WS_T); bf16_t* YG = (bf16_t*)(ws + WS_YG); bf16_t* PG = (bf16_t*)(ws + WS_PG); \
    float* CTXS = (float*)(ws + WS_CTX); const float* MOD = (const float*)(ws + WS_MOD); const float* BIAS = (const float*)(ws + WS_BIAS); (void)HX; (void)T; (void)YG; (void)PG; (void)CTXS; (void)MOD; (void)BIAS;

#ifdef TIMEX
    unsigned long long tx0 = 0, tx1 = 0; int txn = 0;
#define TX_MARK() do { if (txn == TIMEX) tx0 = __builtin_amdgcn_s_memrealtime(); if (txn == TIMEX + 1) tx1 = __builtin_amdgcn_s_memrealtime(); ++txn; } while (0)
    unsigned long long cx0 = 0, cxacc = 0;
#define CX_BEGIN(k) do { if (TIMEX == 100 + (k) && l == 1) { __syncthreads(); cx0 = __builtin_amdgcn_s_memrealtime(); } } while (0)
#define CX_END(k) do { if (TIMEX == 100 + (k) && l == 1) { __syncthreads(); cxacc += __builtin_amdgcn_s_memrealtime() - cx0; } } while (0)
#else
#define TX_MARK() do {} while (0)
#define CX_BEGIN(k) do {} while (0)
#define CX_END(k) do {} while (0)
#endif
    TX_MARK();
    for (int l = 0; l < 2; ++l) {
        unsigned char* ws = opq(p.ws);
        const float* win = p.in[I_WIN] + (size_t)l * D * N_IN;
        bf16_t* wt = (bf16_t*)(ws + WS_WT + l * SZ_WT);
        tconv(win, N_IN, 0, 1536, 1536, D, wt, lf);
        tconv(win, N_IN, POOL_OFF, 512, 512, D, wt + (size_t)1536 * D, lf);
        tconv(win, N_IN, GLA_OFF, NGV, NG, D, (bf16_t*)(ws + WS_WG + l * SZ_WG), lf);
        tconv(win, N_IN, GATE_OFF, 3072, 3072, D, (bf16_t*)(ws + WS_WGATE + l * SZ_WGATE), lf);
        tconv(p.in[I_WBH] + (size_t)l * 512 * 1024, 1024, 0, 1024, 1024, 512, (bf16_t*)(ws + WS_WBR + (size_t)(l * 3 + 0) * SZ_WBR), lf);
        tconv(p.in[I_WBG] + (size_t)l * 512 * 1024, 1024, 0, 1024, 1024, 512, (bf16_t*)(ws + WS_WBR + (size_t)(l * 3 + 1) * SZ_WBR), lf);
        tconv(p.in[I_WOUT] + (size_t)l * D * D, D, 0, D, D, D, (bf16_t*)(ws + WS_WOUT + l * SZ_WOUT), lf);
        tconv(p.in[I_WUP] + (size_t)l * D * DFF, DFF, 0, DFF, DFF, D, (bf16_t*)(ws + WS_WUP + l * SZ_WUP), lf);
        tconv(p.in[I_WDN] + (size_t)l * DFF * D, D, 0, D, D, DFF, (bf16_t*)(ws + WS_WDN + l * SZ_WDN), lf);
        job_poolcomb(p, l);
    }
    job_bias(p);
    job_mod(p, lf);
    job_filters(p, lds);
    grid.sync();

    { WSPTRS
    for (int row = bid * 8 + wid; row < TOK; row += 2 * G * 8) {
        const int rb = row + G * 8; const bool hb = rb < TOK; const int rb2 = hb ? rb : row;
        const bool la = row < TOKL, lb = rb2 < TOKL;
        const float* xa = la ? p.in[I_X] + (size_t)row * D : p.in[I_CTX] + (size_t)(row - TOKL) * D; const float* xb = lb ? p.in[I_X] + (size_t)rb2 * D : p.in[I_CTX] + (size_t)(rb2 - TOKL) * D;
        const float* ma = MOD + (size_t)(la ? row >> 11 : 32) * 6144; const float* mb = MOD + (size_t)(lb ? rb2 >> 11 : 32) * 6144;
        ada_row2(xa, xb, hb, p.in[I_NMIX], ma, ma + 1024, mb, mb + 1024, HX + (size_t)row * D, HX + (size_t)rb2 * D, nullptr, nullptr, lane);
    } }
    GBAR();
    TX_MARK();

    for (int l_ = 0; l_ < 2; ++l_) {
        const int l = opqi(l_);
        { WSPTRS
            const int ntokt = l == 0 ? 288 : 256;
            const int nA = ntokt * 8, nB = 288 * 7;
            const bf16_t* wt = (const bf16_t*)(ws + WS_WT + l * SZ_WT); const bf16_t* wg = (const bf16_t*)(ws + WS_WG + l * SZ_WG);
            const float* biasT = BIAS + l * (NTR + NG); const float* biasG = biasT + NTR;
            XMap MA, MB; MA.init(bid, ntokt, 8); MB.init(bid, 288, 7);
            ProgInproj P{wt, wg, HX, T, PG, biasT, biasG, MA, MB, MA.rounds()};
            gemm_stream(lds, MA.rounds() + MB.rounds(), P);
        }
        GBAR();
        TX_MARK();
        { WSPTRS
            for (int it = bid; it < 256; it += G) gla_chunk_item(p, l, it >> 3, (it >> 1) & 3, it & 1, lds);
            for (int it = bid; it < 512; it += G) hyena_mfma<2048, 8>(p, l, it, false, lds);
            if (l == 0) for (int it = bid; it < 512; it += G) hyena_mfma<256, 1>(p, l, it, true, lds);
            const int npl = l == 0 ? 32768 : 16384;
            for (int it = bid * 8 + wid; it < npl; it += G * 8) { const bool cx = it >= 16384; const int j = it & 16383, ch = j >> 5, b = j & 31, g = ch >> 7;
                bf16_t* base = T + (size_t)(1536 + ch) * TOK + (cx ? (size_t)TOKL + b * 256 : (size_t)b * 2048);
                if (cx) pool1d_wave(base, lane, 2 << g);
                else { if (g == 0) pool2d_wave<2>(base, lane); else if (g == 1) pool2d_wave<4>(base, lane); else if (g == 2) pool2d_wave<8>(base, lane); else pool2d_wave<16>(base, lane); } }
        }
        GBAR();
        TX_MARK();
        {
            WSPTRS
            const bf16_t* OF = (const bf16_t*)(ws + WS_OF); const bf16_t* OB = OF + (size_t)TOK * 512; const float* nw = p.in[I_GNW] + l * 128;
            const int ntok = l == 0 ? TOK : TOKL;
            for (int row = bid * 8 + wid; row < ntok; row += 2 * G * 8) {
                const int rowb = row + G * 8; const bool hb = rowb < ntok; const int rows[2] = {row, hb ? rowb : row};
                u32x4 av[2], bv[2], rv[2];
#pragma unroll
                for (int q = 0; q < 2; ++q) { av[q] = *(const u32x4*)(OF + (size_t)rows[q] * 512 + lane * 8); bv[q] = *(const u32x4*)(OB + (size_t)rows[q] * 512 + lane * 8); rv[q] = *(const u32x4*)(PG + (size_t)rows[q] * NG + 1024 + lane * 8); }
#pragma unroll
                for (int q = 0; q < 2; ++q) { if (q == 1 && !hb) break;
                    const u32x4 a = av[q], bq = bv[q], rr = rv[q];
                    float o[8] = {lo16(a.x) + lo16(bq.x), hi16(a.x) + hi16(bq.x), lo16(a.y) + lo16(bq.y), hi16(a.y) + hi16(bq.y), lo16(a.z) + lo16(bq.z), hi16(a.z) + hi16(bq.z), lo16(a.w) + lo16(bq.w), hi16(a.w) + hi16(bq.w)};
                    float r[8] = {lo16(rr.x), hi16(rr.x), lo16(rr.y), hi16(rr.y), lo16(rr.z), hi16(rr.z), lo16(rr.w), hi16(rr.w)};
                    float ss = 0.f;
#pragma unroll
                    for (int j = 0; j < 8; ++j) ss += o[j] * o[j];
                    ss += __shfl_xor(ss, 1); ss += __shfl_xor(ss, 2); ss += __shfl_xor(ss, 4); ss += __shfl_xor(ss, 8);
                    const float inv = rsqrtf(ss * (1.f / 128.f) + EPS);
                    float y[8];
#pragma unroll
                    for (int j = 0; j < 8; ++j) y[j] = o[j] * inv * nw[(lane & 15) * 8 + j] * (r[j] * sigmoidf_(r[j]));
                    u32x4 w; w.x = cvt_pk_bf16(y[0], y[1]); w.y = cvt_pk_bf16(y[2], y[3]); w.z = cvt_pk_bf16(y[4], y[5]); w.w = cvt_pk_bf16(y[6], y[7]);
                    *(u32x4*)(YG + (size_t)rows[q] * 512 + lane * 8) = w; }
            }
            LAS bf16_t* tl = (LAS bf16_t*)lds;
            const int nit = 2 * (l == 0 ? 288 : 256) * 8;
            for (int it = bid; it < nit; it += G) { const int ctile = it & 7, tt = (it >> 3) % (l == 0 ? 288 : 256), which = (it >> 3) / (l == 0 ? 288 : 256);
                const bf16_t* src = T + (size_t)(which ? 1536 : 0) * TOK + (size_t)tt * 256; bf16_t* dst = (bf16_t*)(ws + (which ? WS_YPL : WS_YHY)) + (size_t)tt * 256 * 512;
                __syncthreads();
#pragma unroll
                for (int i = 0; i < 4; ++i) { const int idx = tid + i * NTHREADS, c = idx >> 5, t8 = (idx & 31) * 8;
                    *(LAS u32x4*)(tl + c * 264 + t8) = *(const u32x4*)(src + (size_t)(ctile * 64 + c) * TOK + t8); }
                __syncthreads();
#pragma unroll
                for (int i = 0; i < 4; ++i) { const int idx = tid + i * NTHREADS, tk = idx >> 3, c8 = (idx & 7) * 8; unsigned w[4];
#pragma unroll
                    for (int j = 0; j < 4; ++j) w[j] = (unsigned)tl[(c8 + 2 * j) * 264 + tk] | ((unsigned)tl[(c8 + 2 * j + 1) * 264 + tk] << 16);
                    *(u32x4*)(dst + (size_t)tk * 512 + ctile * 64 + c8) = (u32x4){w[0], w[1], w[2], w[3]}; }
            }
            __syncthreads();
        }
        GBAR();
        TX_MARK();
        const int ntt = l == 0 ? 288 : 256;
        { WSPTRS
          XMap M; M.init(bid, ntt, 4);
          ProgMix2 P{ws, ws + WS_STASH + (size_t)bid * 524288, p.in[I_BIN] + l * N_IN + GATE_OFF, M, l};
          gemm_stream(lds, 6 * M.rounds(), P); }
        GBAR();
        { WSPTRS
          XMap M; M.init(bid, ntt, 4);
          TileIO io{p.in[I_X], p.in[I_CTX], p.out, CTXS, MOD + (size_t)l * 33 * 6144, l};
          ProgOut2 P{ws, io, M, l};
          gemm_stream(lds, M.rounds(), P); }
        GBAR();
        { WSPTRS
          const float* modl = MOD + (size_t)l * 33 * 6144; const int nrow = ntt * 256;
          for (int row = bid * 8 + wid; row < nrow; row += 2 * G * 8) { const int rb = row + G * 8; const bool hb = rb < nrow; const int rb2 = hb ? rb : row; const bool la = row < TOKL, lb = rb2 < TOKL;
              const float* xa = la ? p.out + (size_t)row * D : CTXS + (size_t)(row - TOKL) * D; const float* xb = lb ? p.out + (size_t)rb2 * D : CTXS + (size_t)(rb2 - TOKL) * D;
              const float* ma = modl + (size_t)(la ? row >> 11 : 32) * 6144; const float* mb = modl + (size_t)(lb ? rb2 >> 11 : 32) * 6144;
              ada_row2(xa, xb, hb, p.in[I_NFFN] + l * D, ma + 3072, ma + 4096, mb + 3072, mb + 4096, HX + (size_t)row * D, HX + (size_t)rb2 * D, nullptr, nullptr, lane); } }
        GBAR();
        { WSPTRS
          XMap M; M.init(bid, ntt, 16);
          ProgUp2 P{ws, M, l};
          gemm_stream(lds, M.rounds(), P); }
        GBAR();
        { WSPTRS
          XMap M; M.init(bid, ntt, 4);
          TileIO io{p.in[I_X], p.in[I_CTX], p.out, CTXS, MOD + (size_t)l * 33 * 6144, l};
          ProgDown2 P{ws, io, M, l};
          gemm_stream(lds, M.rounds(), P); }
        GBAR();
        { WSPTRS
          const int nrow = ntt * 256;
          for (int row = bid * 8 + wid; row < nrow; row += 2 * G * 8) { const int rb = row + G * 8; const bool hb = rb < nrow; const int rb2 = hb ? rb : row; const bool la = row < TOKL, lb = rb2 < TOKL;
              float* xa = la ? p.out + (size_t)row * D : CTXS + (size_t)(row - TOKL) * D; float* xb = lb ? p.out + (size_t)rb2 * D : CTXS + (size_t)(rb2 - TOKL) * D;
              if (l == 0) { const float* ma = MOD + (size_t)33 * 6144 + (size_t)(la ? row >> 11 : 32) * 6144; const float* mb = MOD + (size_t)33 * 6144 + (size_t)(lb ? rb2 >> 11 : 32) * 6144;
                  ada_row2(xa, xb, hb, p.in[I_NMIX] + D, ma, ma + 1024, mb, mb + 1024, HX + (size_t)row * D, HX + (size_t)rb2 * D, nullptr, nullptr, lane); }
              else ada_row2(xa, xb, hb, p.in[I_NFIN], nullptr, nullptr, nullptr, nullptr, nullptr, nullptr, xa, xb, lane); } }
        if (l == 0) GBAR();
        TX_MARK();
    }
#ifdef TIMEX
    if (blockIdx.x == 0 && threadIdx.x == 0) { const unsigned long long t = __builtin_amdgcn_s_memrealtime(); while (__builtin_amdgcn_s_memrealtime() - t < (unsigned long long)TIMEX_MULT * (TIMEX >= 100 ? cxacc : (tx1 - tx0))) __builtin_amdgcn_s_sleep(10); }
#endif
}

extern "C" void kernel_launch(void* const* d_in, const int* in_sizes, int n_in, void* d_out, int out_size,
                              void* d_ws, size_t ws_size, hipStream_t stream) {
    static int grid_blocks = 0;
    if (!grid_blocks) {
        int dev = 0, cus = 0, per_cu = 0;
        (void)hipGetDevice(&dev);
        (void)hipDeviceGetAttribute(&cus, hipDeviceAttributeMultiprocessorCount, dev);
        (void)hipFuncSetAttribute((const void*)mega, hipFuncAttributeMaxDynamicSharedMemorySize, LDS_BYTES);
        (void)hipOccupancyMaxActiveBlocksPerMultiprocessor(&per_cu, (const void*)mega, NTHREADS, LDS_BYTES);
        grid_blocks = cus > 256 ? 256 : cus;
        if (ws_size < WS_END || n_in != 33 || out_size != TOKL * D) { fprintf(stderr, "kernel_launch: unexpected sizes ws=%zu need=%zu n_in=%d out=%d\n", ws_size, (size_t)WS_END, n_in, out_size); grid_blocks = -1; }
    }
    if (grid_blocks < 0) return;
    Params p{};
    for (int i = 0; i < 33; ++i) p.in[i] = (const float*)d_in[i];
    p.out = (float*)d_out; p.ws = (unsigned char*)d_ws;
    (void)hipMemsetAsync((unsigned char*)d_ws + WS_BAR, 0, 256, stream);
    void* args[] = {&p};
    hipError_t e = hipLaunchCooperativeKernel((const void*)mega, dim3(grid_blocks), dim3(NTHREADS), args, LDS_BYTES, stream);
    if (e != hipSuccess) fprintf(stderr, "cooperative launch failed: %s (grid %d)\n", hipGetErrorString(e), grid_blocks);
}
```

```cpp
#include <hip/hip_runtime.h>
#include <hip/hip_cooperative_groups.h>
#include <cstdio>
#include <cstdint>
namespace cg = cooperative_groups;

#define LAS __attribute__((address_space(3)))
typedef unsigned short bf16_t;
typedef short bf16x8 __attribute__((ext_vector_type(8)));
typedef float f32x4 __attribute__((ext_vector_type(4)));
typedef unsigned u32x2 __attribute__((ext_vector_type(2)));
typedef unsigned u32x4 __attribute__((ext_vector_type(4)));

constexpr int NTHREADS = 512;
constexpr int LDS_BYTES = 147456;
constexpr int D = 1024, NB = 32, SEQ = 2048, CTXL = 256;
constexpr int TOKL = NB * SEQ, TOKC = NB * CTXL, TOK = TOKL + TOKC;
constexpr int N_IN = 6688, GLA_OFF = 1536, POOL_OFF = 3104, GATE_OFF = 3616;
constexpr int NTR = 2048, NG = 1792, NGV = 1568, DFF = 4096;
constexpr float EPS = 1e-6f;

constexpr size_t SZ_WT = (size_t)NTR * D * 2, SZ_WG = (size_t)NG * D * 2, SZ_WGATE = (size_t)3072 * D * 2, SZ_WBR = (size_t)1024 * 512 * 2;
constexpr size_t SZ_WOUT = (size_t)D * D * 2, SZ_WUP = (size_t)DFF * D * 2, SZ_WDN = (size_t)D * DFF * 2;
constexpr size_t WS_WT = 0;
constexpr size_t WS_WG = WS_WT + 2 * SZ_WT;
constexpr size_t WS_WGATE = WS_WG + 2 * SZ_WG;
constexpr size_t WS_WBR = WS_WGATE + 2 * SZ_WGATE;
constexpr size_t WS_WOUT = WS_WBR + 6 * SZ_WBR;
constexpr size_t WS_WUP = WS_WOUT + 2 * SZ_WOUT;
constexpr size_t WS_WDN = WS_WUP + 2 * SZ_WUP;
constexpr size_t WS_BIAS = WS_WDN + 2 * SZ_WDN;
constexpr size_t WS_MOD = WS_BIAS + 32768;
constexpr size_t WS_HFL = WS_MOD + (size_t)2 * 33 * 6144 * 4;
constexpr size_t WS_HFC = WS_HFL + (size_t)2 * 4 * 512 * 2048 * 2;
constexpr size_t WS_CTX = WS_HFC + (size_t)4 * 512 * 256 * 2;
constexpr size_t WS_HX = WS_CTX + (size_t)TOKC * D * 4;
constexpr size_t WS_T = WS_HX + (size_t)TOK * D * 2;
constexpr size_t WS_YG = WS_T + (size_t)NTR * TOK * 2;
constexpr size_t WS_PG = WS_YG + (size_t)TOK * 512 * 2;
constexpr size_t WS_OF = WS_PG + (size_t)TOK * NG * 2;
constexpr size_t WS_BAR = WS_OF + (size_t)2 * TOK * 512 * 2;
constexpr size_t WS_END = WS_BAR + 256;
constexpr size_t WS_YHY = WS_T + (size_t)512 * TOK * 2;
constexpr size_t WS_YPL = WS_T + (size_t)1024 * TOK * 2;
constexpr size_t WS_STASH = WS_PG;
constexpr size_t WS_MERGED = WS_OF;
constexpr size_t WS_HID = WS_T;
static_assert((size_t)TOK * DFF * 2 <= WS_OF - WS_T, "hidden");
constexpr size_t WS_SCR = WS_PG;
constexpr size_t SCR_PER = 1572864;
constexpr size_t SC_MERGED = 0, SC_TRY = 524288, SC_TRP = 786432, SC_SG = 1048576, SC_ST = 1310720, SC_HID = 524288;
static_assert(WS_END <= (size_t)1073741824, "ws");

struct Params { const float* in[33]; float* out; unsigned char* ws; };
enum { I_X = 0, I_C, I_CTX, I_CCTX, I_WMOD, I_BMOD, I_NMIX, I_NFFN, I_WIN, I_BIN, I_HSW, I_HSB, I_FW1, I_FB1, I_FFREQ, I_FW2, I_FB2, I_FW3, I_HSKIP,
       I_WAF, I_BAF, I_WAB, I_BAB, I_GNW, I_PW, I_PSC, I_WBH, I_WBG, I_WBP, I_WOUT, I_WUP, I_WDN, I_NFIN };

__device__ __forceinline__ float bf2f(bf16_t h) { return __uint_as_float((unsigned)h << 16); }
__device__ __forceinline__ unsigned cvt_pk_bf16(float lo, float hi) { unsigned r; asm volatile("v_cvt_pk_bf16_f32 %0, %1, %2" : "=v"(r) : "v"(lo), "v"(hi)); return r; }
__device__ __forceinline__ bf16_t f2bf(float f) { return (bf16_t)(cvt_pk_bf16(f, 0.f) & 0xffffu); }
__device__ __forceinline__ float lo16(unsigned u) { return __uint_as_float(u << 16); }
__device__ __forceinline__ float hi16(unsigned u) { return __uint_as_float(u & 0xffff0000u); }
__device__ __forceinline__ float sigmoidf_(float v) { return 1.f / (1.f + __expf(-v)); }
__device__ __forceinline__ unsigned char* opq(unsigned char* p) { asm volatile("" : "+s"(p)); return p; }
__device__ __forceinline__ int tidx() { int t = threadIdx.x; asm volatile("" : "+v"(t)); return t; }
__device__ __forceinline__ int opqi(int v) { asm volatile("" : "+s"(v)); return v; }
__device__ __forceinline__ void gbar(unsigned* ctr, unsigned target) {
    asm volatile("s_waitcnt vmcnt(0) lgkmcnt(0)" ::: "memory");
    __syncthreads();
    if (threadIdx.x < 64) {
        if (threadIdx.x == 0) {
            __builtin_amdgcn_fence(__ATOMIC_RELEASE, "agent");
            asm volatile("s_waitcnt vmcnt(0)" ::: "memory");
            __hip_atomic_fetch_add(ctr, 1u, __ATOMIC_RELAXED, __HIP_MEMORY_SCOPE_AGENT);
            while (__hip_atomic_load(ctr, __ATOMIC_RELAXED, __HIP_MEMORY_SCOPE_AGENT) < target) __builtin_amdgcn_s_sleep(1);
        }
        __builtin_amdgcn_fence(__ATOMIC_ACQUIRE, "agent");
        asm volatile("s_waitcnt vmcnt(0)" ::: "memory");
    }
    __syncthreads();
}
__device__ __forceinline__ float wave_sum(float v) {
#pragma unroll
    for (int o = 32; o >= 1; o >>= 1) v += __shfl_xor(v, o);
    return v;
}

constexpr int BK = 64, HALF = 128, HTB = HALF * BK * 2;
__device__ __forceinline__ int lds_byte(int r, int c) { const int st = (r >> 4) * 2 + (c >> 5), rr = r & 15, cc = c & 31, ob = rr * 64 + cc * 2; return st * 1024 + (ob ^ (((ob >> 9) & 1) << 5)); }
__device__ __forceinline__ void stage_rc(int b, int& R, int& C) { const int st = b / 1024, sb = b % 1024, swz = sb ^ (((sb >> 9) & 1) << 5); R = (st >> 1) * 16 + swz / 64; C = (st & 1) * 32 + (swz % 64) / 2; }

template <class Epi>
__device__ __forceinline__ void gemm_unit(LAS unsigned char* lds, const bf16_t* A, int lda, const bf16_t* Bt, int ldb, int K, const Epi& E) {
    const int tid = tidx(), wid = __builtin_amdgcn_readfirstlane(tid >> 6), lane = tid & 63, wr = wid >> 2, wc = wid & 3, fr = lane & 15, fq = lane >> 4;
    const int nt = K / BK;
    unsigned voffA[2], voffB[2];
#pragma unroll
    for (int i = 0; i < 2; ++i) { int R, C; stage_rc(tid * 16 + i * 8192, R, C); voffA[i] = (unsigned)(R * lda + C) * 2u; voffB[i] = (unsigned)(R * ldb + C) * 2u; }
    const size_t kstep = (size_t)(BK * 2);
    const size_t hstepA = (size_t)HALF * lda * 2, hstepB = (size_t)HALF * ldb * 2;
    const unsigned ldsw = (unsigned)wid * 1024u;
    const int aoff = lds_byte(wr * 64 + fr, fq * 8), boff = lds_byte(wc * 32 + fr, fq * 8);
#define G_SA(b, h) (((b) * 2 + (h)) * HTB)
#define G_SB(b, h) ((4 + (b) * 2 + (h)) * HTB)
#define G_STAGE(bufoff, gbase, voff) do { _Pragma("unroll") for (int _i = 0; _i < 2; ++_i) \
        __builtin_amdgcn_global_load_lds((const unsigned*)((const char*)(gbase) + (voff)[_i]), (LAS unsigned*)(lds + (bufoff) + ldsw + _i * 8192), 16, 0, 0); } while (0)
#define G_LDA(dst, b, h) do { _Pragma("unroll") for (int m = 0; m < 4; ++m) _Pragma("unroll") for (int k = 0; k < 2; ++k) dst[m][k] = *(const LAS bf16x8*)(lds + G_SA(b, h) + aoff + m * 2048 + k * 1024); } while (0)
#define G_LDB(dst, b, h) do { _Pragma("unroll") for (int n = 0; n < 2; ++n) _Pragma("unroll") for (int k = 0; k < 2; ++k) dst[n][k] = *(const LAS bf16x8*)(lds + G_SB(b, h) + boff + n * 2048 + k * 1024); } while (0)
#define G_MMA(ai, bj, At, Bt_) do { __builtin_amdgcn_s_setprio(1); _Pragma("unroll") for (int m = 0; m < 4; ++m) _Pragma("unroll") for (int n = 0; n < 2; ++n) _Pragma("unroll") for (int k = 0; k < 2; ++k) \
        acc[ai][bj][m][n] = __builtin_amdgcn_mfma_f32_16x16x32_bf16(Bt_[n][k], At[m][k], acc[ai][bj][m][n], 0, 0, 0); __builtin_amdgcn_s_setprio(0); } while (0)
#define G_WAIT_V(n) asm volatile("s_waitcnt vmcnt(" #n ")" ::: "memory")
#define G_WAIT_L(n) asm volatile("s_waitcnt lgkmcnt(" #n ")" ::: "memory")
#define G_BAR __builtin_amdgcn_s_barrier()
#define G_SCHED __builtin_amdgcn_sched_barrier(0)
    __syncthreads();
    f32x4 acc[2][2][4][2];
#pragma unroll
    for (int a = 0; a < 2; ++a)
#pragma unroll
        for (int b = 0; b < 2; ++b)
#pragma unroll
            for (int m = 0; m < 4; ++m)
#pragma unroll
                for (int n = 0; n < 2; ++n) acc[a][b][m][n] = (f32x4){0.f, 0.f, 0.f, 0.f};
    bf16x8 At[4][2], B0[2][2], B1[2][2];
    const char* cA = (const char*)A; const char* cB = (const char*)Bt;
    G_STAGE(G_SB(0, 0), cB, voffB); G_STAGE(G_SA(0, 0), cA, voffA); G_STAGE(G_SB(0, 1), cB + hstepB, voffB); G_STAGE(G_SA(0, 1), cA + hstepA, voffA);
    if (wr == 1) G_BAR;
    G_WAIT_V(4); G_BAR;
    G_STAGE(G_SB(1, 0), cB + kstep, voffB); G_STAGE(G_SA(1, 0), cA + kstep, voffA); G_STAGE(G_SB(1, 1), cB + hstepB + kstep, voffB);
    G_WAIT_V(6); G_BAR;
    for (int t = 0; t < nt; t += 2) {
        const bool last = (t == nt - 2);
        const char* a1 = cA + (size_t)(t + 1) * kstep;
        const char* a2 = last ? cA : cA + (size_t)(t + 2) * kstep; const char* b2 = last ? cB : cB + (size_t)(t + 2) * kstep;
        const char* a3 = a2 + kstep; const char* b3 = b2 + kstep;
        G_LDB(B0, 0, 0); G_SCHED; G_LDA(At, 0, 0); G_STAGE(G_SA(1, 1), a1 + hstepA, voffA);
        G_WAIT_L(8); G_BAR; G_WAIT_L(0); G_MMA(0, 0, At, B0); G_BAR; G_SCHED;
        G_LDB(B1, 0, 1); G_STAGE(G_SB(0, 0), b2, voffB);
        G_BAR; G_WAIT_L(0); G_MMA(0, 1, At, B1); G_BAR;
        G_LDA(At, 0, 1); G_STAGE(G_SA(0, 0), a2, voffA);
        G_BAR; G_WAIT_L(0); G_MMA(1, 0, At, B0); G_BAR; G_SCHED;
        G_STAGE(G_SB(0, 1), b2 + hstepB, voffB);
        G_WAIT_V(6); G_BAR; G_MMA(1, 1, At, B1); G_BAR;
        G_LDB(B0, 1, 0); G_SCHED; G_LDA(At, 1, 0); G_STAGE(G_SA(0, 1), a2 + hstepA, voffA);
        G_WAIT_L(8); G_BAR; G_WAIT_L(0); G_MMA(0, 0, At, B0); G_BAR; G_SCHED;
        G_LDB(B1, 1, 1); G_STAGE(G_SB(1, 0), b3, voffB);
        G_BAR; G_WAIT_L(0); G_MMA(0, 1, At, B1); G_BAR;
        G_LDA(At, 1, 1); G_STAGE(G_SA(1, 0), a3, voffA);
        G_BAR; G_WAIT_L(0); G_MMA(1, 0, At, B0); G_BAR; G_SCHED;
        G_STAGE(G_SB(1, 1), b3 + hstepB, voffB);
        G_WAIT_V(6); G_BAR; G_MMA(1, 1, At, B1); G_BAR;
    }
    E(acc, wr, wc, fr, fq);
    G_WAIT_V(0);
    if (wr == 0) G_BAR;
    G_BAR;
    __syncthreads();
}


__device__ __forceinline__ int perm32(int rho) { const int n = rho >> 4, i = rho & 15; return 8 * (i >> 2) + 4 * n + (i & 3); }
typedef f32x4 AccT[2][2][4][2];
struct UDesc { const char* A; const char* B; int lda, ldb, K; };
template <class Prog>
__device__ __forceinline__ void gemm_stream(LAS unsigned char* lds, int nunits, const Prog& P) {
    if (nunits <= 0) return;
    const int tid = tidx(), wid = __builtin_amdgcn_readfirstlane(tid >> 6), lane = tid & 63, wr = wid >> 2, wc = wid & 3, fr = lane & 15, fq = lane >> 4;
    int sR, sRb, sC; { int R, C; stage_rc(tid * 16, R, C); sR = R * 2; sRb = ((R & ~31) + perm32(R & 31)) * 2; sC = C * 2; }
    const unsigned kstep = (unsigned)(BK * 2);
    const unsigned ldsw = (unsigned)wid * 1024u;
    const int aoff = lds_byte(wr * 64 + fr, fq * 8), boff = lds_byte(wc * 32 + fr, fq * 8);
#define S_STAGE(bufoff, gbase, v, q) do { \
        __builtin_amdgcn_global_load_lds((const unsigned*)((const char*)(gbase) + (v)), (LAS unsigned*)(lds + (bufoff) + ldsw), 16, 0, 0); \
        __builtin_amdgcn_global_load_lds((const unsigned*)((const char*)(gbase) + (q) + (v)), (LAS unsigned*)(lds + (bufoff) + ldsw + 8192), 16, 0, 0); } while (0)
    UDesc cur, nxt; P.desc(0, cur);
    unsigned vA = (unsigned)(sR * cur.lda + sC), vB = (unsigned)(sRb * cur.ldb + sC);
    __syncthreads();
    f32x4 acc[2][2][4][2];
#pragma unroll
    for (int a = 0; a < 2; ++a)
#pragma unroll
        for (int b = 0; b < 2; ++b)
#pragma unroll
            for (int m = 0; m < 4; ++m)
#pragma unroll
                for (int n = 0; n < 2; ++n) acc[a][b][m][n] = (f32x4){0.f, 0.f, 0.f, 0.f};
    bf16x8 At[4][2], B0[2][2], B1[2][2];
    { const char* cA = cur.A; const char* cB = cur.B; const unsigned hA = (unsigned)HALF * cur.lda * 2, hB = (unsigned)HALF * cur.ldb * 2, qA = hA >> 1, qB = hB >> 1;
      S_STAGE(G_SB(0, 0), cB, vB, qB); S_STAGE(G_SA(0, 0), cA, vA, qA); S_STAGE(G_SB(0, 1), cB + hB, vB, qB); S_STAGE(G_SA(0, 1), cA + hA, vA, qA);
      if (wr == 1) G_BAR;
      G_WAIT_V(4); G_BAR;
      S_STAGE(G_SB(1, 0), cB + kstep, vB, qB); S_STAGE(G_SA(1, 0), cA + kstep, vA, qA); S_STAGE(G_SB(1, 1), cB + hB + kstep, vB, qB);
      G_WAIT_V(6); G_BAR; }
    for (int ui = 0;; ++ui) {
        const bool has_next = ui + 1 < nunits;
        if (has_next) P.desc(ui + 1, nxt); else nxt = cur;
        const unsigned nA = (unsigned)(sR * nxt.lda + sC), nB = (unsigned)(sRb * nxt.ldb + sC);
        const char* cA = cur.A; const char* cB = cur.B; const unsigned hA = (unsigned)HALF * cur.lda * 2, hB = (unsigned)HALF * cur.ldb * 2;
        const unsigned nhA = (unsigned)HALF * nxt.lda * 2, nhB = (unsigned)HALF * nxt.ldb * 2;
        const int nt = cur.K / BK;
        for (int t = 0; t < nt; t += 2) {
            const bool last = (t == nt - 2);
            const char* a1 = cA + (unsigned)(t + 1) * kstep;
            const char* a2 = last ? nxt.A : cA + (unsigned)(t + 2) * kstep; const char* b2 = last ? nxt.B : cB + (unsigned)(t + 2) * kstep;
            const char* a3 = a2 + kstep; const char* b3 = b2 + kstep;
            const unsigned hA2 = last ? nhA : hA, hB2 = last ? nhB : hB, qA = hA >> 1, qA2 = hA2 >> 1, qB2 = hB2 >> 1;
            const unsigned xA = last ? nA : vA, xB = last ? nB : vB;
            G_LDB(B0, 0, 0); G_SCHED; G_LDA(At, 0, 0); S_STAGE(G_SA(1, 1), a1 + hA, vA, qA);
            G_WAIT_L(8); G_BAR; G_WAIT_L(0); G_MMA(0, 0, At, B0); G_BAR; G_SCHED;
            G_LDB(B1, 0, 1); S_STAGE(G_SB(0, 0), b2, xB, qB2);
            G_BAR; G_WAIT_L(0); G_MMA(0, 1, At, B1); G_BAR;
            G_LDA(At, 0, 1); S_STAGE(G_SA(0, 0), a2, xA, qA2);
            G_BAR; G_WAIT_L(0); G_MMA(1, 0, At, B0); G_BAR; G_SCHED;
            S_STAGE(G_SB(0, 1), b2 + hB2, xB, qB2);
            G_WAIT_V(6); G_BAR; G_MMA(1, 1, At, B1); G_BAR;
            G_LDB(B0, 1, 0); G_SCHED; G_LDA(At, 1, 0); S_STAGE(G_SA(0, 1), a2 + hA2, xA, qA2);
            G_WAIT_L(8); G_BAR; G_WAIT_L(0); G_MMA(0, 0, At, B0); G_BAR; G_SCHED;
            G_LDB(B1, 1, 1); S_STAGE(G_SB(1, 0), b3, xB, qB2);
            G_BAR; G_WAIT_L(0); G_MMA(0, 1, At, B1); G_BAR;
            G_LDA(At, 1, 1); S_STAGE(G_SA(1, 0), a3, xA, qA2);
            G_BAR; G_WAIT_L(0); G_MMA(1, 0, At, B0); G_BAR; G_SCHED;
            S_STAGE(G_SB(1, 1), b3 + hB2, xB, qB2);
            G_WAIT_V(6); G_BAR; G_MMA(1, 1, At, B1); G_BAR;
        }
        P.epi(ui, acc, wr, wc, fr, fq);
        if (!has_next) break;
#pragma unroll
        for (int a = 0; a < 2; ++a)
#pragma unroll
            for (int b = 0; b < 2; ++b)
#pragma unroll
                for (int m = 0; m < 4; ++m)
#pragma unroll
                    for (int n = 0; n < 2; ++n) acc[a][b][m][n] = (f32x4){0.f, 0.f, 0.f, 0.f};
        cur = nxt; vA = nA; vB = nB;
    }
    G_WAIT_V(0);
    if (wr == 0) G_BAR;
    G_BAR;
    __syncthreads();
#undef S_STAGE
}

#define EPI_LOOP _Pragma("unroll") for (int ai = 0; ai < 2; ++ai) _Pragma("unroll") for (int m = 0; m < 4; ++m) _Pragma("unroll") for (int bj = 0; bj < 2; ++bj) _Pragma("unroll") for (int n = 0; n < 2; ++n)
#define EPI_ROW (ai * 128 + wr * 64 + m * 16 + fr)
#define EPI_COL (bj * 128 + wc * 32 + 8 * fq + 4 * n)

#define U4 _Pragma("unroll")
struct EpiStoreBf16 {
    bf16_t* O; size_t ldo; const float* bias; bool rowb;
    __device__ __forceinline__ void operator()(const AccT& acc, int wr, int wc, int fr, int fq) const {
        { const int tq_ = tidx(); wr = (tq_ >> 8) & 1; wc = (tq_ >> 6) & 3; fr = tq_ & 15; fq = (tq_ >> 4) & 3; }
        float br[2][4]; f32x4 bc[2][2];
        U4 for (int ai = 0; ai < 2; ++ai) U4 for (int m = 0; m < 4; ++m) br[ai][m] = rowb ? bias[ai * 128 + wr * 64 + m * 16 + fr] : 0.f;
        U4 for (int bj = 0; bj < 2; ++bj) U4 for (int n = 0; n < 2; ++n) bc[bj][n] = rowb ? (f32x4){0.f, 0.f, 0.f, 0.f} : *(const f32x4*)(bias + EPI_COL);
        U4 for (int ai = 0; ai < 2; ++ai) U4 for (int m = 0; m < 4; ++m) U4 for (int bj = 0; bj < 2; ++bj) { const int n = 0; const int r = EPI_ROW, c = EPI_COL;
            const f32x4 v0 = acc[ai][bj][m][0] + bc[bj][0] + br[ai][m], v1 = acc[ai][bj][m][1] + bc[bj][1] + br[ai][m];
            u32x4 w; w.x = cvt_pk_bf16(v0[0], v0[1]); w.y = cvt_pk_bf16(v0[2], v0[3]); w.z = cvt_pk_bf16(v1[0], v1[1]); w.w = cvt_pk_bf16(v1[2], v1[3]); *(u32x4*)(O + (size_t)r * ldo + c) = w; }
    }
};
struct EpiGate {
    f32x4* SG; const float* bias;
    __device__ __forceinline__ void operator()(const AccT& acc, int wr, int wc, int fr, int fq) const {
        { const int tq_ = tidx(); wr = (tq_ >> 8) & 1; wc = (tq_ >> 6) & 3; fr = tq_ & 15; fq = (tq_ >> 4) & 3; }
        f32x4 bc[2][2];
        U4 for (int bj = 0; bj < 2; ++bj) U4 for (int n = 0; n < 2; ++n) bc[bj][n] = *(const f32x4*)(bias + EPI_COL);
        int i = 0; f32x4* SGt = SG + tidx();
        EPI_LOOP { f32x4 v = acc[ai][bj][m][n] + bc[bj][n];
            v[0] = sigmoidf_(v[0]); v[1] = sigmoidf_(v[1]); v[2] = sigmoidf_(v[2]); v[3] = sigmoidf_(v[3]);
            SGt[i * NTHREADS] = v; ++i; }
    }
};
struct EpiBranch {
    const f32x4* SG; f32x4* ST; bf16_t* MG; int first, last;
    __device__ __forceinline__ void operator()(const AccT& acc, int wr, int wc, int fr, int fq) const {
        { const int tq_ = tidx(); wr = (tq_ >> 8) & 1; wc = (tq_ >> 6) & 3; fr = tq_ & 15; fq = (tq_ >> 4) & 3; }
        const int tq = tidx(); const f32x4* SGt = SG + tq; f32x4* STt = ST + tq;
        U4 for (int ai = 0; ai < 2; ++ai) U4 for (int mh = 0; mh < 2; ++mh) {
            f32x4 g[8], t[8];
            U4 for (int q = 0; q < 8; ++q) { const int i = ai * 16 + mh * 8 + q; g[q] = SGt[i * NTHREADS]; t[q] = first ? (f32x4){0.f, 0.f, 0.f, 0.f} : STt[i * NTHREADS]; }
            if (last) { U4 for (int q = 0; q < 8; q += 2) { const int m = mh * 2 + (q >> 2), bj = (q >> 1) & 1, n = 0; const int r = EPI_ROW, c = EPI_COL;
                    const f32x4 v0 = acc[ai][bj][m][0] * g[q] + t[q], v1 = acc[ai][bj][m][1] * g[q + 1] + t[q + 1];
                    u32x4 w; w.x = cvt_pk_bf16(v0[0], v0[1]); w.y = cvt_pk_bf16(v0[2], v0[3]); w.z = cvt_pk_bf16(v1[0], v1[1]); w.w = cvt_pk_bf16(v1[2], v1[3]); *(u32x4*)(MG + (size_t)r * 1024 + c) = w; } }
            else { U4 for (int q = 0; q < 8; ++q) { const int m = mh * 2 + (q >> 2), bj = (q >> 1) & 1, n = q & 1, i = ai * 16 + mh * 8 + q;
                    STt[i * NTHREADS] = acc[ai][bj][m][n] * g[q] + t[q]; } }
        }
    }
};
struct EpiResid {
    const float* xsrc; float* xdst; const float* gate;
    __device__ __forceinline__ void operator()(const AccT& acc, int wr, int wc, int fr, int fq) const {
        { const int tq_ = tidx(); wr = (tq_ >> 8) & 1; wc = (tq_ >> 6) & 3; fr = tq_ & 15; fq = (tq_ >> 4) & 3; }
        f32x4 gc[2][2];
        U4 for (int bj = 0; bj < 2; ++bj) U4 for (int n = 0; n < 2; ++n) gc[bj][n] = *(const f32x4*)(gate + EPI_COL);
        U4 for (int ai = 0; ai < 2; ++ai) U4 for (int mh = 0; mh < 2; ++mh) {
            f32x4 xo[2][2][2];
            U4 for (int mm = 0; mm < 2; ++mm) U4 for (int bj = 0; bj < 2; ++bj) U4 for (int n = 0; n < 2; ++n) { const int m = mh * 2 + mm; xo[mm][bj][n] = *(const f32x4*)(xsrc + (size_t)EPI_ROW * 1024 + EPI_COL); }
            U4 for (int mm = 0; mm < 2; ++mm) U4 for (int bj = 0; bj < 2; ++bj) U4 for (int n = 0; n < 2; ++n) { const int m = mh * 2 + mm; *(f32x4*)(xdst + (size_t)EPI_ROW * 1024 + EPI_COL) = xo[mm][bj][n] + gc[bj][n] * acc[ai][bj][m][n]; }
        }
    }
};
struct EpiSqrelu {
    bf16_t* H; int ldh;
    __device__ __forceinline__ void operator()(const AccT& acc, int wr, int wc, int fr, int fq) const {
        { const int tq_ = tidx(); wr = (tq_ >> 8) & 1; wc = (tq_ >> 6) & 3; fr = tq_ & 15; fq = (tq_ >> 4) & 3; }
        U4 for (int ai = 0; ai < 2; ++ai) U4 for (int m = 0; m < 4; ++m) U4 for (int bj = 0; bj < 2; ++bj) { const int n = 0; const int r = EPI_ROW, c = EPI_COL; f32x4 v0 = acc[ai][bj][m][0], v1 = acc[ai][bj][m][1];
#pragma unroll
            for (int j = 0; j < 4; ++j) { const float t0 = fmaxf(v0[j], 0.f), t1 = fmaxf(v1[j], 0.f); v0[j] = t0 * t0; v1[j] = t1 * t1; }
            u32x4 w; w.x = cvt_pk_bf16(v0[0], v0[1]); w.y = cvt_pk_bf16(v0[2], v0[3]); w.z = cvt_pk_bf16(v1[0], v1[1]); w.w = cvt_pk_bf16(v1[2], v1[3]); *(u32x4*)(H + (size_t)r * ldh + c) = w; }
    }
};

struct XMap { int NT, per_xcd, x, j, bpx;
    __device__ __forceinline__ void init(int bid, int ntt, int nt_) { NT = nt_; per_xcd = (ntt >> 3) * nt_; x = bid & 7; j = bid >> 3; bpx = (int)(gridDim.x >> 3); }
    __device__ __forceinline__ int rounds() const { return j < per_xcd ? (per_xcd - j + bpx - 1) / bpx : 0; }
    __device__ __forceinline__ void get(int i, int& tt, int& nt) const { const int q = i * bpx + j; tt = x + 8 * (q / NT); nt = q % NT; }
};
struct ProgInproj {
    const bf16_t* wt; const bf16_t* wg; const bf16_t* HX; bf16_t* T; bf16_t* PG; const float* biasT; const float* biasG; XMap MA, MB; int rA;
    __device__ __forceinline__ void desc(int i, UDesc& d) const { int tt, nt;
        if (i < rA) { MA.get(i, tt, nt); d.A = (const char*)(wt + (size_t)(nt * 256) * D); d.B = (const char*)(HX + (size_t)(tt * 256) * D); }
        else { MB.get(i - rA, tt, nt); d.A = (const char*)(HX + (size_t)(tt * 256) * D); d.B = (const char*)(wg + (size_t)(nt * 256) * D); }
        d.lda = D; d.ldb = D; d.K = D; }
    __device__ __forceinline__ void epi(int i, const AccT& acc, int wr, int wc, int fr, int fq) const { int tt, nt;
        if (i < rA) { MA.get(i, tt, nt); EpiStoreBf16 E{T + (size_t)(nt * 256) * TOK + (size_t)tt * 256, (size_t)TOK, biasT + nt * 256, true}; E(acc, wr, wc, fr, fq); }
        else { MB.get(i - rA, tt, nt); EpiStoreBf16 E{PG + (size_t)(tt * 256) * NG + nt * 256, (size_t)NG, biasG + nt * 256, false}; E(acc, wr, wc, fr, fq); } }
};
struct ProgMix {
    unsigned char* ws; unsigned char* scr; const float* bgate; unsigned tok0; int l;
    __device__ __forceinline__ void desc(int i, UDesc& d) const { const int nt = i / 6, j = i % 6, X = j >> 1;
        if (!(j & 1)) { d.A = (const char*)(ws + WS_HX) + (size_t)tok0 * D * 2; d.B = (const char*)(ws + WS_WGATE + l * SZ_WGATE) + (size_t)(X * 1024 + nt * 256) * D * 2; d.lda = D; d.ldb = D; d.K = D; }
        else { d.A = X == 0 ? (const char*)(scr + SC_TRY) : (X == 1 ? (const char*)(ws + WS_YG) + (size_t)tok0 * 1024 : (const char*)(scr + SC_TRP));
               d.B = (const char*)(ws + WS_WBR + (size_t)l * 3 * SZ_WBR) + (size_t)X * SZ_WBR + (size_t)(nt * 256) * 1024; d.lda = 512; d.ldb = 512; d.K = 512; } }
    __device__ __forceinline__ void epi(int i, const AccT& acc, int wr, int wc, int fr, int fq) const { const int nt = i / 6, j = i % 6, X = j >> 1;
        if (!(j & 1)) { EpiGate E{(f32x4*)(scr + SC_SG), bgate + X * 1024 + nt * 256}; E(acc, wr, wc, fr, fq); }
        else { EpiBranch E{(const f32x4*)(scr + SC_SG), (f32x4*)(scr + SC_ST), (bf16_t*)(scr + SC_MERGED) + nt * 256, X == 0, X == 2}; E(acc, wr, wc, fr, fq); } }
};
struct ProgResid {
    const bf16_t* A; int lda; const bf16_t* W; int ldw, K; size_t wstep; const float* xsrc; float* xdst; const float* gate;
    __device__ __forceinline__ void desc(int i, UDesc& d) const { d.A = (const char*)A; d.B = (const char*)(W + (size_t)i * wstep); d.lda = lda; d.ldb = ldw; d.K = K; }
    __device__ __forceinline__ void epi(int i, const AccT& acc, int wr, int wc, int fr, int fq) const { EpiResid E{xsrc + i * 256, xdst + i * 256, gate + i * 256}; E(acc, wr, wc, fr, fq); }
};
struct ProgUp {
    const bf16_t* XN; const bf16_t* W; bf16_t* HID;
    __device__ __forceinline__ void desc(int i, UDesc& d) const { d.A = (const char*)XN; d.B = (const char*)(W + (size_t)(i * 256) * D); d.lda = D; d.ldb = D; d.K = D; }
    __device__ __forceinline__ void epi(int i, const AccT& acc, int wr, int wc, int fr, int fq) const { EpiSqrelu E{HID + i * 256, 2048}; E(acc, wr, wc, fr, fq); }
};


struct TileIO { const float* xin; const float* ctxin; float* out; float* ctxs; const float* modl; int l;
    __device__ __forceinline__ const float* src(int tt) const { return tt < 256 ? (l == 0 ? xin : out) + (size_t)tt * 256 * D : ctxin + (size_t)(tt - 256) * 256 * D; }
    __device__ __forceinline__ float* dst(int tt) const { return tt < 256 ? out + (size_t)tt * 256 * D : ctxs + (size_t)(tt - 256) * 256 * D; }
    __device__ __forceinline__ const float* cur(int tt) const { return tt < 256 ? out + (size_t)tt * 256 * D : ctxs + (size_t)(tt - 256) * 256 * D; }
    __device__ __forceinline__ const float* mod(int tt) const { return modl + (size_t)(tt < 256 ? tt >> 3 : 32) * 6144; }
};
struct ProgMix2 {
    unsigned char* ws; unsigned char* stash; const float* bgate; XMap M; int l;
    __device__ __forceinline__ void desc(int ii, UDesc& d) const { int tt, nt; M.get(ii / 6, tt, nt); const int s6 = ii % 6, X = s6 >> 1;
        if (!(s6 & 1)) { d.A = (const char*)(ws + WS_HX) + (size_t)tt * 256 * D * 2; d.B = (const char*)(ws + WS_WGATE + l * SZ_WGATE) + (size_t)(X * 1024 + nt * 256) * D * 2; d.lda = D; d.ldb = D; d.K = D; }
        else { d.A = (const char*)(ws + (X == 0 ? WS_YHY : (X == 1 ? WS_YG : WS_YPL))) + (size_t)tt * 256 * 1024;
               d.B = (const char*)(ws + WS_WBR + (size_t)l * 3 * SZ_WBR) + (size_t)X * SZ_WBR + (size_t)(nt * 256) * 1024; d.lda = 512; d.ldb = 512; d.K = 512; } }
    __device__ __forceinline__ void epi(int ii, const AccT& acc, int wr, int wc, int fr, int fq) const { int tt, nt; M.get(ii / 6, tt, nt); const int s6 = ii % 6, X = s6 >> 1;
        if (!(s6 & 1)) { EpiGate E{(f32x4*)stash, bgate + X * 1024 + nt * 256}; E(acc, wr, wc, fr, fq); }
        else { EpiBranch E{(const f32x4*)stash, (f32x4*)(stash + 262144), (bf16_t*)(ws + WS_MERGED) + (size_t)tt * 256 * 1024 + nt * 256, X == 0, X == 2}; E(acc, wr, wc, fr, fq); } }
};
struct ProgOut2 {
    unsigned char* ws; TileIO io; XMap M; int l;
    __device__ __forceinline__ void desc(int i, UDesc& d) const { int tt, nt; M.get(i, tt, nt);
        d.A = (const char*)(ws + WS_MERGED) + (size_t)tt * 256 * 2048; d.B = (const char*)(ws + WS_WOUT + l * SZ_WOUT) + (size_t)(nt * 256) * D * 2; d.lda = D; d.ldb = D; d.K = D; }
    __device__ __forceinline__ void epi(int i, const AccT& acc, int wr, int wc, int fr, int fq) const { int tt, nt; M.get(i, tt, nt);
        EpiResid E{io.src(tt) + nt * 256, io.dst(tt) + nt * 256, io.mod(tt) + 2048 + nt * 256}; E(acc, wr, wc, fr, fq); }
};
struct ProgUp2 {
    unsigned char* ws; XMap M; int l;
    __device__ __forceinline__ void desc(int i, UDesc& d) const { int tt, nt; M.get(i, tt, nt);
        d.A = (const char*)(ws + WS_HX) + (size_t)tt * 256 * 2048; d.B = (const char*)(ws + WS_WUP + l * SZ_WUP) + (size_t)(nt * 256) * D * 2; d.lda = D; d.ldb = D; d.K = D; }
    __device__ __forceinline__ void epi(int i, const AccT& acc, int wr, int wc, int fr, int fq) const { int tt, nt; M.get(i, tt, nt);
        EpiSqrelu E{(bf16_t*)(ws + WS_HID) + (size_t)tt * 256 * DFF + nt * 256, DFF}; E(acc, wr, wc, fr, fq); }
};
struct ProgDown2 {
    unsigned char* ws; TileIO io; XMap M; int l;
    __device__ __forceinline__ void desc(int i, UDesc& d) const { int tt, nt; M.get(i, tt, nt);
        d.A = (const char*)(ws + WS_HID) + (size_t)tt * 256 * DFF * 2; d.B = (const char*)(ws + WS_WDN + l * SZ_WDN) + (size_t)(nt * 256) * DFF * 2; d.lda = DFF; d.ldb = DFF; d.K = DFF; }
    __device__ __forceinline__ void epi(int i, const AccT& acc, int wr, int wc, int fr, int fq) const { int tt, nt; M.get(i, tt, nt);
        EpiResid E{io.cur(tt) + nt * 256, io.dst(tt) + nt * 256, io.mod(tt) + 5120 + nt * 256}; E(acc, wr, wc, fr, fq); }
};

__device__ __forceinline__ void tconv(const float* src, int ld, int c0, int nvalid, int ncols, int K, bf16_t* dst, LAS float* tile) {
    const int tid = tidx(), ntn = ncols / 64, ntile = ntn * (K / 64);
    float v[8];
    { const int t = blockIdx.x; if (t < ntile) { const int k0 = (t / ntn) * 64, n0 = (t % ntn) * 64;
#pragma unroll
        for (int i = 0; i < 8; ++i) { const int k = i * 8 + (tid >> 6), n = tid & 63; v[i] = (n0 + n < nvalid) ? src[(size_t)(k0 + k) * ld + c0 + n0 + n] : 0.f; } } }
    for (int t = blockIdx.x; t < ntile; t += gridDim.x) {
        const int k0 = (t / ntn) * 64, n0 = (t % ntn) * 64;
        __syncthreads();
#pragma unroll
        for (int i = 0; i < 8; ++i) { const int k = i * 8 + (tid >> 6), n = tid & 63; tile[k * 65 + n] = v[i]; }
        { const int t2 = t + gridDim.x; if (t2 < ntile) { const int k2 = (t2 / ntn) * 64, n2 = (t2 % ntn) * 64;
#pragma unroll
            for (int i = 0; i < 8; ++i) { const int k = i * 8 + (tid >> 6), n = tid & 63; v[i] = (n2 + n < nvalid) ? src[(size_t)(k2 + k) * ld + c0 + n2 + n] : 0.f; } } }
        __syncthreads();
        const int n = tid >> 3, kc = (tid & 7) * 8;
        u32x4 w;
        w.x = cvt_pk_bf16(tile[(kc + 0) * 65 + n], tile[(kc + 1) * 65 + n]); w.y = cvt_pk_bf16(tile[(kc + 2) * 65 + n], tile[(kc + 3) * 65 + n]);
        w.z = cvt_pk_bf16(tile[(kc + 4) * 65 + n], tile[(kc + 5) * 65 + n]); w.w = cvt_pk_bf16(tile[(kc + 6) * 65 + n], tile[(kc + 7) * 65 + n]);
        *(u32x4*)(dst + (size_t)(n0 + n) * K + k0 + kc) = w;
    }
    __syncthreads();
}

__device__ __forceinline__ void job_poolcomb(const Params& p, int l) {
    const float* pw = p.in[I_PW] + (size_t)l * 4 * 128 * 128; const float* sc = p.in[I_PSC] + l * 512; const float* wb = p.in[I_WBP] + (size_t)l * 512 * 1024;
    bf16_t* dst = (bf16_t*)(p.ws + WS_WBR + (size_t)(l * 3 + 2) * SZ_WBR);
    for (int idx = blockIdx.x * NTHREADS + tidx(); idx < 512 * 256; idx += gridDim.x * NTHREADS) {
        const int n = (idx & 255) * 4, k = idx >> 8, g = k >> 7, c = k & 127;
        f32x4 a = (f32x4){0.f, 0.f, 0.f, 0.f};
#pragma unroll 8
        for (int d = 0; d < 128; ++d) { const float ps = pw[(g * 128 + c) * 128 + d] * sc[g * 128 + d]; a += ps * *(const f32x4*)(wb + (size_t)(g * 128 + d) * 1024 + n); }
        dst[(size_t)n * 512 + k] = f2bf(a[0]); dst[(size_t)(n + 1) * 512 + k] = f2bf(a[1]); dst[(size_t)(n + 2) * 512 + k] = f2bf(a[2]); dst[(size_t)(n + 3) * 512 + k] = f2bf(a[3]);
    }
}

__device__ __forceinline__ void job_bias(const Params& p) {
    float* bias = (float*)(p.ws + WS_BIAS);
    for (int idx = blockIdx.x * NTHREADS + tidx(); idx < 2 * (NTR + NG); idx += gridDim.x * NTHREADS) {
        const int l = idx / (NTR + NG), j = idx % (NTR + NG); const float* b = p.in[I_BIN] + l * N_IN;
        float v;
        if (j < 1536) v = b[j]; else if (j < NTR) v = b[POOL_OFF + (j - 1536)]; else { const int q = j - NTR; v = q < NGV ? b[GLA_OFF + q] : 0.f; }
        bias[idx] = v;
    }
}

__device__ __forceinline__ void job_mod(const Params& p, LAS float* sil) {
    if (blockIdx.x >= 192) return;
    const int tid = tidx(), lane = tid & 63, kg = tid >> 6;
    float* mod = (float*)(p.ws + WS_MOD);
    for (int it = blockIdx.x; it < 192; it += gridDim.x) {
        __syncthreads();
        for (int idx = tid; idx < 33 * 1024; idx += NTHREADS) { const int r = idx >> 10, k = idx & 1023; const float v = r < 32 ? p.in[I_C][r * 1024 + k] : p.in[I_CCTX][k]; sil[idx] = v / (1.f + expf(-v)); }
        __syncthreads();
        const int l = it / 96, n0 = (it % 96) * 64;
        const float* w = p.in[I_WMOD] + (size_t)l * 1024 * 6144 + n0 + lane;
        float acc[33];
#pragma unroll
        for (int r = 0; r < 33; ++r) acc[r] = 0.f;
#pragma unroll 2
        for (int k4 = 0; k4 < 32; ++k4) { const int k = kg * 128 + k4 * 4;
            const float w0 = w[(size_t)k * 6144], w1 = w[(size_t)(k + 1) * 6144], w2 = w[(size_t)(k + 2) * 6144], w3 = w[(size_t)(k + 3) * 6144];
#pragma unroll
            for (int r = 0; r < 33; ++r) { const f32x4 sv = *(const LAS f32x4*)(sil + r * 1024 + k); acc[r] += sv[0] * w0 + sv[1] * w1 + sv[2] * w2 + sv[3] * w3; } }
        __syncthreads();
#pragma unroll
        for (int r = 0; r < 33; ++r) sil[(kg * 33 + r) * 64 + lane] = acc[r];
        __syncthreads();
        const float bm = p.in[I_BMOD][l * 6144 + n0 + lane];
        for (int r = kg; r < 33; r += 8) { float sum = 0.f;
#pragma unroll
            for (int q = 0; q < 8; ++q) sum += sil[(q * 33 + r) * 64 + lane];
            mod[(size_t)l * 33 * 6144 + (size_t)r * 6144 + n0 + lane] = sum + bm; }
    }
    __syncthreads();
}

__device__ __forceinline__ void job_filters(const Params& p, LAS unsigned char* lds) {
    LAS float* a1 = (LAS float*)lds;
    LAS float* a2 = (LAS float*)(lds + 16384);
    LAS bf16_t* oT = (LAS bf16_t*)(lds + 16384 + 16640);
    LAS float* w2L = (LAS float*)(lds + 16384 + 16640 + 73728);
    const int tid = tidx();
    const int nitems = (32 + 4 + 32) * 4;
    const int nrep = gridDim.x == 256 ? 2 : (nitems + (int)gridDim.x - 1) / (int)gridDim.x;
    for (int rep = 0; rep < nrep; ++rep) {
        int it;
        if (gridDim.x == 256) it = rep == 0 ? (int)blockIdx.x : ((blockIdx.x >= 192 && blockIdx.x < 208) ? 256 + (int)blockIdx.x - 192 : -1);
        else it = (int)blockIdx.x + rep * (int)gridDim.x;
        if (it < 0 || it >= nitems) continue;
        const int oc = it & 3; int rt = it >> 2; int l, L, t0; bf16_t* dst;
        if (rt < 32) { l = 0; L = 2048; t0 = rt * 64; dst = (bf16_t*)(p.ws + WS_HFL); }
        else if (rt < 36) { l = 0; L = 256; t0 = (rt - 32) * 64; dst = (bf16_t*)(p.ws + WS_HFC); }
        else { l = 1; L = 2048; t0 = (rt - 36) * 64; dst = (bf16_t*)(p.ws + WS_HFL) + (size_t)4 * 512 * 2048; }
        const float* w1 = p.in[I_FW1] + l * 17 * 64; const float* b1 = p.in[I_FB1] + l * 64; const float* fq = p.in[I_FFREQ] + l * 64;
        const float* w2 = p.in[I_FW2] + l * 64 * 64; const float* b2 = p.in[I_FB2] + l * 64; const float* w3 = p.in[I_FW3] + (size_t)l * 64 * 2048;
        __syncthreads();
#pragma unroll
        for (int q = 0; q < 2; ++q) *(LAS f32x4*)(w2L + (tid + q * NTHREADS) * 4) = *(const f32x4*)(w2 + (tid + q * NTHREADS) * 4);
        { const int row = tid >> 3, jg = (tid & 7) * 8; const float t = (float)(t0 + row); float z[17];
          z[0] = t / (float)L;
#pragma unroll
          for (int bnd = 1; bnd <= 8; ++bnd) { const float ang = (6.283185307179586f / (float)L) * t * (float)bnd; z[bnd] = cosf(ang); z[8 + bnd] = sinf(ang); }
#pragma unroll
          for (int j = 0; j < 8; ++j) { float s_ = b1[jg + j];
#pragma unroll
              for (int i = 0; i < 17; ++i) s_ += z[i] * w1[i * 64 + jg + j];
              a1[row * 64 + jg + j] = sinf(fq[jg + j] * s_); } }
        __syncthreads();
        { const int row = tid >> 3, jg = (tid & 7) * 8; float acc8[8];
#pragma unroll
          for (int j = 0; j < 8; ++j) acc8[j] = b2[jg + j];
#pragma unroll 4
          for (int i4 = 0; i4 < 64; i4 += 4) { const f32x4 av = *(const LAS f32x4*)(a1 + row * 64 + i4);
#pragma unroll
              for (int ii = 0; ii < 4; ++ii) { const f32x4 wa = *(const LAS f32x4*)(w2L + (i4 + ii) * 64 + jg), wb = *(const LAS f32x4*)(w2L + (i4 + ii) * 64 + jg + 4);
                  acc8[0] += av[ii] * wa[0]; acc8[1] += av[ii] * wa[1]; acc8[2] += av[ii] * wa[2]; acc8[3] += av[ii] * wa[3];
                  acc8[4] += av[ii] * wb[0]; acc8[5] += av[ii] * wb[1]; acc8[6] += av[ii] * wb[2]; acc8[7] += av[ii] * wb[3]; } }
#pragma unroll
          for (int j = 0; j < 8; ++j) a2[row * 65 + jg + j] = sinf(fq[jg + j] * acc8[j]); }
        __syncthreads();
        { const int o = oc * 512 + tid, c = o & 511; float wreg[64];
#pragma unroll
          for (int j = 0; j < 64; ++j) wreg[j] = w3[(size_t)j * 2048 + o];
          const float delta = 3.0701134573253943f + (float)c * ((15.350567286626972f - 3.0701134573253943f) / 511.f);
          for (int row = 0; row < 64; ++row) { float s = 0.f;
#pragma unroll
              for (int j = 0; j < 64; ++j) s += a2[row * 65 + j] * wreg[j];
              const float win = expf(-((float)(t0 + row) / (float)L) * delta);
              oT[tid * 72 + row] = f2bf(s * win); } }
        __syncthreads();
        for (int q = tid; q < 4096; q += NTHREADS) { const int ol = q >> 3, ch = (q & 7) * 8; const int o = oc * 512 + ol, dir = o >> 10, ord = (o >> 9) & 1, c = o & 511;
            const u32x4 w = *(const LAS u32x4*)(oT + ol * 72 + ch);
            *(u32x4*)(dst + ((size_t)((ord * 2 + dir) * 512 + c)) * L + t0 + ch) = w; }
    }
    __syncthreads();
}

__device__ __forceinline__ void ada_write(const f32x4 (&v)[4], float inv, const float* g, const float* sh, const float* sc, bf16_t* dst, float* fdst, int lane) {
#pragma unroll
    for (int i = 0; i < 4; ++i) { const int c = i * 256 + lane * 4; const f32x4 gg = *(const f32x4*)(g + c); f32x4 y = v[i] * inv * gg;
        if (sh) { const f32x4 s1 = *(const f32x4*)(sc + c), s0 = *(const f32x4*)(sh + c); y = y * (1.f + s1) + s0;
            u32x2 w; w.x = cvt_pk_bf16(y[0], y[1]); w.y = cvt_pk_bf16(y[2], y[3]); *(u32x2*)(dst + c) = w; }
        else *(f32x4*)(fdst + c) = y; }
}
__device__ __forceinline__ void ada_row2(const float* xa, const float* xb, bool hb, const float* g, const float* sha, const float* sca, const float* shb, const float* scb,
                                         bf16_t* da, bf16_t* db, float* fa, float* fb, int lane) {
    f32x4 va[4], vb[4]; float sa = 0.f, sb = 0.f;
#pragma unroll
    for (int i = 0; i < 4; ++i) va[i] = *(const f32x4*)(xa + i * 256 + lane * 4);
#pragma unroll
    for (int i = 0; i < 4; ++i) vb[i] = hb ? *(const f32x4*)(xb + i * 256 + lane * 4) : (f32x4){0.f, 0.f, 0.f, 0.f};
#pragma unroll
    for (int i = 0; i < 4; ++i) { sa += va[i][0] * va[i][0] + va[i][1] * va[i][1] + va[i][2] * va[i][2] + va[i][3] * va[i][3]; sb += vb[i][0] * vb[i][0] + vb[i][1] * vb[i][1] + vb[i][2] * vb[i][2] + vb[i][3] * vb[i][3]; }
#pragma unroll
    for (int o = 32; o >= 1; o >>= 1) { sa += __shfl_xor(sa, o); sb += __shfl_xor(sb, o); }
    ada_write(va, rsqrtf(sa * (1.f / 1024.f) + EPS), g, sha, sca, da, fa, lane);
    if (hb) ada_write(vb, rsqrtf(sb * (1.f / 1024.f) + EPS), g, shb, scb, db, fb, lane);
}
__device__ __forceinline__ void ada_row(const float* x, const float* g, const float* sh, const float* sc, bf16_t* dst, float* fdst, int lane) {
    f32x4 v[4]; float ss = 0.f;
#pragma unroll
    for (int i = 0; i < 4; ++i) { v[i] = *(const f32x4*)(x + i * 256 + lane * 4); ss += v[i][0] * v[i][0] + v[i][1] * v[i][1] + v[i][2] * v[i][2] + v[i][3] * v[i][3]; }
    ss = wave_sum(ss);
    const float inv = rsqrtf(ss * (1.f / 1024.f) + EPS);
#pragma unroll
    for (int i = 0; i < 4; ++i) { const int c = i * 256 + lane * 4; const f32x4 gg = *(const f32x4*)(g + c); f32x4 y = v[i] * inv * gg;
        if (sh) { const f32x4 s1 = *(const f32x4*)(sc + c), s0 = *(const f32x4*)(sh + c); y = y * (1.f + s1) + s0;
            u32x2 w; w.x = cvt_pk_bf16(y[0], y[1]); w.y = cvt_pk_bf16(y[2], y[3]); *(u32x2*)(dst + c) = w; }
        else *(f32x4*)(fdst + c) = y; }
}

typedef float f32x16 __attribute__((ext_vector_type(16)));
template <int L, int NT>
__device__ __forceinline__ void hyena_mfma(const Params& p, int l, int c, bool ctx, LAS unsigned char* lds) {
    LAS unsigned char* U = lds;
    LAS unsigned* F = (LAS unsigned*)(lds + L * 64);
    LAS bf16_t* F16 = (LAS bf16_t*)F;
    const int tid = tidx(), lane = tid & 63, w = __builtin_amdgcn_readfirstlane(tid >> 6), li = lane & 31, kg = lane >> 5;
    bf16_t* T = (bf16_t*)(p.ws + WS_T);
    const size_t tokb = ctx ? (size_t)TOKL : 0;
    const bf16_t* hf = ctx ? (const bf16_t*)(p.ws + WS_HFC) : (const bf16_t*)(p.ws + WS_HFL) + (size_t)l * 4 * 512 * 2048;
    const float* sw = p.in[I_HSW] + (size_t)l * 3 * 1536; const float* sb = p.in[I_HSB] + l * 1536;
    __syncthreads();
    {
        const int cc = 1024 + c; const bf16_t* row = T + (size_t)cc * TOK + tokb;
        const float w0 = sw[cc], w1 = sw[1536 + cc], w2 = sw[3072 + cc], bb = sb[cc];
        constexpr int ITER = L / 128, BATCH = ITER >= 4 ? 4 : ITER;
        for (int it0 = 0; it0 < ITER; it0 += BATCH) {
            u32x4 rr[BATCH]; bf16_t hm[BATCH], hp[BATCH];
#pragma unroll
            for (int q = 0; q < BATCH; ++q) { const int idx = tid + (it0 + q) * NTHREADS, bq = idx & 31, t8 = idx >> 5; const bf16_t* pr = row + (size_t)bq * L + t8 * 8;
                rr[q] = *(const u32x4*)pr; hm[q] = t8 > 0 ? pr[-1] : (bf16_t)0; hp[q] = t8 < L / 8 - 1 ? pr[8] : (bf16_t)0; }
#pragma unroll
            for (int q = 0; q < BATCH; ++q) { const int idx = tid + (it0 + q) * NTHREADS; const u32x4 r = rr[q];
                float x[10]; x[0] = bf2f(hm[q]); x[9] = bf2f(hp[q]);
                x[1] = lo16(r.x); x[2] = hi16(r.x); x[3] = lo16(r.y); x[4] = hi16(r.y); x[5] = lo16(r.z); x[6] = hi16(r.z); x[7] = lo16(r.w); x[8] = hi16(r.w);
                float y[8];
#pragma unroll
                for (int j = 0; j < 8; ++j) y[j] = w0 * x[j] + w1 * x[j + 1] + w2 * x[j + 2] + bb;
                u32x4 o; o.x = cvt_pk_bf16(y[0], y[1]); o.y = cvt_pk_bf16(y[2], y[3]); o.z = cvt_pk_bf16(y[4], y[5]); o.w = cvt_pk_bf16(y[6], y[7]);
                *(LAS u32x4*)(U + (size_t)idx * 16) = o; }
        }
    }
    const int lane_dw = (li & 1) * L + ((8 * kg - li + L - (li & 1)) >> 1);
#define HY_LOADA(dst, f) do { const LAS unsigned* _q = F + (lane_dw - 8 * (f)); u32x4 _v; _v.x = _q[0]; _v.y = _q[1]; _v.z = _q[2]; _v.w = _q[3]; dst = __builtin_bit_cast(bf16x8, _v); } while (0)
#define HY_LOADB(dst, s0) dst = *(const LAS bf16x8*)(U + ((s0) >> 3) * 512 + lane * 16)
    for (int ord = 0; ord < 2; ++ord) {
        __syncthreads();
        for (int x0 = tid; x0 < 2 * L; x0 += 4 * NTHREADS) {
            bf16_t fv[4];
#pragma unroll
            for (int q = 0; q < 4; ++q) { const int x = x0 + q * NTHREADS; bf16_t v = 0;
                if (x >= 1 && x <= L) v = hf[((size_t)((ord * 2 + 0) * 512 + c)) * L + (L - x)];
                else if (x > L && x < 2 * L) v = hf[((size_t)((ord * 2 + 1) * 512 + c)) * L + (x - L)];
                fv[q] = v; }
#pragma unroll
            for (int q = 0; q < 4; ++q) { const int x = x0 + q * NTHREADS; const bf16_t v = fv[q];
                if (x < 2 * L) { F16[x] = v; if (x >= 1) F16[2 * L + x - 1] = v; if (x == 2 * L - 1) F16[4 * L - 1] = 0; } } }
        if (false) for (int x = tid; x < 0; ++x) {
            bf16_t v = 0;
            if (x >= 1 && x <= L) v = hf[((size_t)((ord * 2 + 0) * 512 + c)) * L + (L - x)];
            else if (x > L) v = hf[((size_t)((ord * 2 + 1) * 512 + c)) * L + (x - L)];
            F16[x] = v; if (x >= 1) F16[2 * L + x - 1] = v; if (x == 2 * L - 1) F16[4 * L - 1] = 0; }
        __syncthreads();
        f32x16 acc[NT];
#pragma unroll
        for (int i = 0; i < NT; ++i)
#pragma unroll
            for (int r = 0; r < 16; ++r) acc[i][r] = 0.f;
        bf16x8 E[NT], O[NT];
#pragma unroll
        for (int i = 1; i < NT; ++i) { HY_LOADA(E[i], 2 * (NT * w + i)); HY_LOADA(O[i], 2 * (NT * w + i) - 1); }
        for (int n8 = 0; n8 < L / 32; n8 += 8) {
#pragma unroll
            for (int u = 0; u < 8; ++u) { const int n = n8 + u; const int fe = 2 * (NT * w - n); bf16x8 Bf;
                HY_LOADA(E[(8 - u) & (NT - 1)], fe); HY_LOADB(Bf, 32 * n);
#pragma unroll
                for (int i = 0; i < NT; ++i) acc[i] = __builtin_amdgcn_mfma_f32_32x32x16_bf16(E[(i - u) & (NT - 1)], Bf, acc[i], 0, 0, 0);
                HY_LOADA(O[(8 - u) & (NT - 1)], fe - 1); HY_LOADB(Bf, 32 * n + 16);
#pragma unroll
                for (int i = 0; i < NT; ++i) acc[i] = __builtin_amdgcn_mfma_f32_32x32x16_bf16(O[(i - u) & (NT - 1)], Bf, acc[i], 0, 0, 0);
            }
        }
        __syncthreads();
        const int lane2 = tidx() & 63, li = lane2 & 31, kg = lane2 >> 5;
        const int xc = ord * 512 + c; const bf16_t* xrow = T + (size_t)xc * TOK + tokb + (size_t)li * L;
        bf16_t* orow = T + (size_t)c * TOK + tokb + (size_t)li * L;
        const float w0 = sw[xc], w1 = sw[1536 + xc], w2 = sw[3072 + xc], bb = sb[xc], sk = p.in[I_HSKIP][(l * 2 + ord) * 512 + c];
#pragma unroll
        for (int i = 0; i < NT; ++i) {
#pragma unroll
            for (int rh = 0; rh < 4; rh += 2) {
            u32x2 xr4[2]; bf16_t hm[2], hp[2];
#pragma unroll
            for (int r2 = 0; r2 < 2; ++r2) { const int rg = rh + r2; const int tb = 32 * (NT * w + i) + 8 * rg + 4 * kg;
                xr4[r2] = *(const u32x2*)(xrow + tb); hm[r2] = tb > 0 ? xrow[tb - 1] : (bf16_t)0; hp[r2] = tb + 4 < L ? xrow[tb + 4] : (bf16_t)0; }
#pragma unroll
            for (int r2 = 0; r2 < 2; ++r2) { const int rg = rh + r2; const int tb = 32 * (NT * w + i) + 8 * rg + 4 * kg; const u32x2 xr = xr4[r2];
                float x[6]; x[0] = bf2f(hm[r2]); x[5] = bf2f(hp[r2]);
                x[1] = lo16(xr.x); x[2] = hi16(xr.x); x[3] = lo16(xr.y); x[4] = hi16(xr.y);
                LAS u32x2* up = (LAS u32x2*)(U + ((tb >> 3) * 32 + li) * 16 + (tb & 7) * 2);
                const u32x2 uv = *up; const float uu[4] = {lo16(uv.x), hi16(uv.x), lo16(uv.y), hi16(uv.y)};
                float z[4];
#pragma unroll
                for (int j = 0; j < 4; ++j) z[j] = (w0 * x[j] + w1 * x[j + 1] + w2 * x[j + 2] + bb) * (acc[i][rg * 4 + j] + sk * uu[j]);
                u32x2 o; o.x = cvt_pk_bf16(z[0], z[1]); o.y = cvt_pk_bf16(z[2], z[3]);
                if (ord == 0) *up = o; else *(u32x2*)(orow + tb) = o; }
            }
        }
    }
#undef HY_LOADA
#undef HY_LOADB
    __syncthreads();
}

__device__ __forceinline__ void gla_item(const Params& p, int l, int b, int h, int dir, LAS float* lf) {
    const int tid = tidx(), qd = tid & 3, dv = tid >> 2;
    LAS float* qL = lf; LAS float* kL = lf + 2048; LAS float* aL = lf + 4096; LAS float* vL = lf + 6144; LAS float* oL = lf + 10240; LAS float* waL = lf + 14336; LAS float* baL = lf + 15360;
    const bf16_t* PG = (const bf16_t*)(p.ws + WS_PG);
    bf16_t* O = (bf16_t*)(p.ws + WS_OF) + (size_t)dir * TOK * 512;
    const float* wa = (dir ? p.in[I_WAB] : p.in[I_WAF]) + l * 16 * 256; const float* ba = (dir ? p.in[I_BAB] : p.in[I_BAF]) + l * 256;
    __syncthreads();
    for (int i = tid; i < 1024; i += NTHREADS) waL[i] = wa[(i >> 6) * 256 + h * 64 + (i & 63)];
    if (tid < 64) baL[tid] = ba[h * 64 + tid];
    float S[16];
#pragma unroll
    for (int i = 0; i < 16; ++i) S[i] = 0.f;
    const int sp = tid >> 4, sc4 = (tid & 15) * 4, sc8 = (tid & 15) * 8;
    for (int ck = 0; ck < 72; ++ck) {
        const int P = ck * 32 + sp; size_t row;
        if (P < 256) row = (size_t)TOKL + b * 256 + (dir ? 255 - P : P); else { const int tl = P - 256; row = (size_t)b * 2048 + (dir ? 2047 - tl : tl); }
        const bf16_t* pr = PG + row * NG;
        __syncthreads();
        { const u32x2 wq = *(const u32x2*)(pr + h * 64 + sc4), wk = *(const u32x2*)(pr + 256 + h * 64 + sc4);
          *(LAS f32x4*)(qL + sp * 64 + sc4) = (f32x4){lo16(wq.x) * 0.125f, hi16(wq.x) * 0.125f, lo16(wq.y) * 0.125f, hi16(wq.y) * 0.125f};
          *(LAS f32x4*)(kL + sp * 64 + sc4) = (f32x4){lo16(wk.x), hi16(wk.x), lo16(wk.y), hi16(wk.y)};
          const u32x4 wv = *(const u32x4*)(pr + 512 + h * 128 + sc8);
          *(LAS f32x4*)(vL + sp * 128 + sc8) = (f32x4){lo16(wv.x), hi16(wv.x), lo16(wv.y), hi16(wv.y)};
          *(LAS f32x4*)(vL + sp * 128 + sc8 + 4) = (f32x4){lo16(wv.z), hi16(wv.z), lo16(wv.w), hi16(wv.w)};
          const u32x4 g0 = *(const u32x4*)(pr + 1536 + dir * 16), g1 = *(const u32x4*)(pr + 1536 + dir * 16 + 8);
          float gt[16] = {lo16(g0.x), hi16(g0.x), lo16(g0.y), hi16(g0.y), lo16(g0.z), hi16(g0.z), lo16(g0.w), hi16(g0.w),
                          lo16(g1.x), hi16(g1.x), lo16(g1.y), hi16(g1.y), lo16(g1.z), hi16(g1.z), lo16(g1.w), hi16(g1.w)};
#pragma unroll
          for (int j = 0; j < 4; ++j) { float z = baL[sc4 + j];
#pragma unroll
              for (int r = 0; r < 16; ++r) z += gt[r] * waL[r * 64 + sc4 + j];
              const float ls = -(fmaxf(-z, 0.f) + log1pf(expf(-fabsf(z))));
              aL[sp * 64 + sc4 + j] = expf(ls * (1.f / 16.f)); } }
        __syncthreads();
        for (int pos = 0; pos < 32; ++pos) {
            const float vv = vL[pos * 128 + dv]; float part = 0.f;
#pragma unroll
            for (int i4 = 0; i4 < 4; ++i4) { const f32x4 aa = *(const LAS f32x4*)(aL + pos * 64 + qd * 16 + i4 * 4), kk = *(const LAS f32x4*)(kL + pos * 64 + qd * 16 + i4 * 4), qq = *(const LAS f32x4*)(qL + pos * 64 + qd * 16 + i4 * 4);
#pragma unroll
                for (int j = 0; j < 4; ++j) { S[i4 * 4 + j] = aa[j] * S[i4 * 4 + j] + kk[j] * vv; part += qq[j] * S[i4 * 4 + j]; } }
            part += __shfl_xor(part, 1); part += __shfl_xor(part, 2);
            if (qd == 0) oL[pos * 128 + dv] = part;
        }
        __syncthreads();
        { const f32x4 o0 = *(const LAS f32x4*)(oL + sp * 128 + sc8), o1 = *(const LAS f32x4*)(oL + sp * 128 + sc8 + 4);
          u32x4 w; w.x = cvt_pk_bf16(o0[0], o0[1]); w.y = cvt_pk_bf16(o0[2], o0[3]); w.z = cvt_pk_bf16(o1[0], o1[1]); w.w = cvt_pk_bf16(o1[2], o1[3]);
          *(u32x4*)(O + row * 512 + h * 128 + sc8) = w; }
    }
    __syncthreads();
}


__device__ __forceinline__ size_t gla_row(int P, int b, int dir) { return P < 256 ? (size_t)TOKL + b * 256 + (dir ? 255 - P : P) : (size_t)b * 2048 + (dir ? 2047 - (P - 256) : (P - 256)); }
__device__ __forceinline__ void gla_chunk_item(const Params& p, int l, int b, int h, int dir, LAS unsigned char* lds) {
    constexpr int RS = 72;
    LAS bf16_t* QD = (LAS bf16_t*)lds; LAS bf16_t* KI = QD + 64 * RS; LAS bf16_t* KET = KI + 64 * RS; LAS bf16_t* PP = KET + 64 * RS;
    LAS bf16_t* VT = PP + 64 * RS; LAS bf16_t* ST = VT + 128 * RS;
    LAS float* TOT = (LAS float*)(ST + 128 * RS); LAS float* DEC = TOT + 512; LAS float* WAL = DEC + 64; LAS float* BAL = WAL + 1024;
    const int tid = tidx(), lane = tid & 63, w = __builtin_amdgcn_readfirstlane(tid >> 6), i = tid >> 3, dg = tid & 7, d0 = dg * 8, l5 = lane & 31, hh = lane >> 5;
    const int ih = w >> 2, vq = w & 3;
    const bf16_t* PG = (const bf16_t*)(p.ws + WS_PG);
    bf16_t* O = (bf16_t*)(p.ws + WS_OF) + (size_t)dir * TOK * 512;
    const float* wa = (dir ? p.in[I_WAB] : p.in[I_WAF]) + l * 16 * 256; const float* ba = (dir ? p.in[I_BAB] : p.in[I_BAF]) + l * 256;
    __syncthreads();
    for (int q = tid; q < 1024; q += NTHREADS) WAL[q] = wa[(q >> 6) * 256 + h * 64 + (q & 63)];
    if (tid < 64) BAL[tid] = ba[h * 64 + tid];
    for (int q = tid; q < 73728 / 16; q += NTHREADS) *(LAS u32x4*)(lds + q * 16) = (u32x4){0u, 0u, 0u, 0u};
    f32x16 accS;
#pragma unroll
    for (int r = 0; r < 16; ++r) accS[r] = 0.f;
    u32x4 rq, rk, rg0, rg1, rv0, rv1;
    { const bf16_t* pr = PG + gla_row(i, b, dir) * NG;
      rq = *(const u32x4*)(pr + h * 64 + d0); rk = *(const u32x4*)(pr + 256 + h * 64 + d0); rg0 = *(const u32x4*)(pr + 1536 + dir * 16); rg1 = *(const u32x4*)(pr + 1536 + dir * 16 + 8);
      rv0 = *(const u32x4*)(pr + 512 + h * 128 + dg * 16); rv1 = *(const u32x4*)(pr + 512 + h * 128 + dg * 16 + 8); }
    __syncthreads();
    for (int ck = 0; ck < 36; ++ck) {
        float qf[8] = {lo16(rq.x), hi16(rq.x), lo16(rq.y), hi16(rq.y), lo16(rq.z), hi16(rq.z), lo16(rq.w), hi16(rq.w)};
        float kf[8] = {lo16(rk.x), hi16(rk.x), lo16(rk.y), hi16(rk.y), lo16(rk.z), hi16(rk.z), lo16(rk.w), hi16(rk.w)};
        float gt[16] = {lo16(rg0.x), hi16(rg0.x), lo16(rg0.y), hi16(rg0.y), lo16(rg0.z), hi16(rg0.z), lo16(rg0.w), hi16(rg0.w),
                        lo16(rg1.x), hi16(rg1.x), lo16(rg1.y), hi16(rg1.y), lo16(rg1.z), hi16(rg1.z), lo16(rg1.w), hi16(rg1.w)};
        float la[8];
#pragma unroll
        for (int j = 0; j < 8; ++j) { float z = BAL[d0 + j];
#pragma unroll
            for (int r = 0; r < 16; ++r) z += gt[r] * WAL[r * 64 + d0 + j];
            la[j] = -(fmaxf(-z, 0.f) + __logf(1.f + __expf(-fabsf(z)))) * (1.f / 16.f); }
#pragma unroll
        for (int st = 8; st < 64; st <<= 1) {
#pragma unroll
            for (int j = 0; j < 8; ++j) { const float y = __shfl_up(la[j], st); if (lane >= st) la[j] += y; } }
        if ((lane >> 3) == 7) { *(LAS f32x4*)(TOT + w * 64 + d0) = (f32x4){la[0], la[1], la[2], la[3]}; *(LAS f32x4*)(TOT + w * 64 + d0 + 4) = (f32x4){la[4], la[5], la[6], la[7]}; }
        __syncthreads();
        {
            float pre[8], bl[8];
#pragma unroll
            for (int j = 0; j < 8; ++j) { pre[j] = 0.f; bl[j] = 0.f; }
#pragma unroll
            for (int ww = 0; ww < 8; ++ww) { const f32x4 t0 = *(const LAS f32x4*)(TOT + ww * 64 + d0), t1 = *(const LAS f32x4*)(TOT + ww * 64 + d0 + 4);
                const float tv[8] = {t0[0], t0[1], t0[2], t0[3], t1[0], t1[1], t1[2], t1[3]};
#pragma unroll
                for (int j = 0; j < 8; ++j) { bl[j] += tv[j]; if (ww < w) pre[j] += tv[j]; } }
            float qd[8], ki[8], ke[8], eb[8];
#pragma unroll
            for (int j = 0; j < 8; ++j) { const float bc = la[j] + pre[j]; const float e1 = __expf(bc), e2 = __builtin_amdgcn_rcpf(e1); eb[j] = __expf(bl[j]);
                qd[j] = qf[j] * 0.125f * e1; ki[j] = kf[j] * e2; ke[j] = kf[j] * (eb[j] * e2); }
            u32x4 wq, wk;
            wq.x = cvt_pk_bf16(qd[0], qd[1]); wq.y = cvt_pk_bf16(qd[2], qd[3]); wq.z = cvt_pk_bf16(qd[4], qd[5]); wq.w = cvt_pk_bf16(qd[6], qd[7]);
            wk.x = cvt_pk_bf16(ki[0], ki[1]); wk.y = cvt_pk_bf16(ki[2], ki[3]); wk.z = cvt_pk_bf16(ki[4], ki[5]); wk.w = cvt_pk_bf16(ki[6], ki[7]);
            *(LAS u32x4*)(QD + i * RS + d0) = wq; *(LAS u32x4*)(KI + i * RS + d0) = wk;
#pragma unroll
            for (int j = 0; j < 8; j += 2) { const unsigned pk = cvt_pk_bf16(ke[j], ke[j + 1]); KET[(d0 + j) * RS + i] = (bf16_t)(pk & 0xffffu); KET[(d0 + j + 1) * RS + i] = (bf16_t)(pk >> 16); }
            const unsigned vv[8] = {rv0.x, rv0.y, rv0.z, rv0.w, rv1.x, rv1.y, rv1.z, rv1.w};
#pragma unroll
            for (int j = 0; j < 8; ++j) { VT[(dg * 16 + 2 * j) * RS + i] = (bf16_t)(vv[j] & 0xffffu); VT[(dg * 16 + 2 * j + 1) * RS + i] = (bf16_t)(vv[j] >> 16); }
            if (i == 0) { *(LAS f32x4*)(DEC + d0) = (f32x4){eb[0], eb[1], eb[2], eb[3]}; *(LAS f32x4*)(DEC + d0 + 4) = (f32x4){eb[4], eb[5], eb[6], eb[7]}; }
        }
        if (ck + 1 < 36) { const bf16_t* pr = PG + gla_row((ck + 1) * 64 + i, b, dir) * NG;
            rq = *(const u32x4*)(pr + h * 64 + d0); rk = *(const u32x4*)(pr + 256 + h * 64 + d0); rg0 = *(const u32x4*)(pr + 1536 + dir * 16); rg1 = *(const u32x4*)(pr + 1536 + dir * 16 + 8);
            rv0 = *(const u32x4*)(pr + 512 + h * 128 + dg * 16); rv1 = *(const u32x4*)(pr + 512 + h * 128 + dg * 16 + 8); }
        __syncthreads();
        f32x16 accO;
#pragma unroll
        for (int r = 0; r < 16; ++r) accO[r] = 0.f;
#pragma unroll
        for (int ks = 0; ks < 4; ++ks) { const bf16x8 A = *(const LAS bf16x8*)(QD + (ih * 32 + l5) * RS + ks * 16 + hh * 8), Bv = *(const LAS bf16x8*)(ST + (vq * 32 + l5) * RS + ks * 16 + hh * 8);
            accO = __builtin_amdgcn_mfma_f32_32x32x16_bf16(A, Bv, accO, 0, 0, 0); }
        if (w < 3) { const int si = w == 0 ? 0 : 1, sj = w == 2 ? 1 : 0; f32x16 accP;
#pragma unroll
            for (int r = 0; r < 16; ++r) accP[r] = 0.f;
#pragma unroll
            for (int ks = 0; ks < 4; ++ks) { const bf16x8 A = *(const LAS bf16x8*)(QD + (si * 32 + l5) * RS + ks * 16 + hh * 8), Bv = *(const LAS bf16x8*)(KI + (sj * 32 + l5) * RS + ks * 16 + hh * 8);
                accP = __builtin_amdgcn_mfma_f32_32x32x16_bf16(A, Bv, accP, 0, 0, 0); }
#pragma unroll
            for (int r = 0; r < 16; ++r) { const int ii = si * 32 + (r & 3) + 8 * (r >> 2) + 4 * hh, jj = sj * 32 + l5; PP[ii * RS + jj] = f2bf(jj <= ii ? accP[r] : 0.f); } }
        __syncthreads();
        { const int nk = ih == 0 ? 2 : 4;
          for (int ks = 0; ks < nk; ++ks) { const bf16x8 A = *(const LAS bf16x8*)(PP + (ih * 32 + l5) * RS + ks * 16 + hh * 8), Bv = *(const LAS bf16x8*)(VT + (vq * 32 + l5) * RS + ks * 16 + hh * 8);
              accO = __builtin_amdgcn_mfma_f32_32x32x16_bf16(A, Bv, accO, 0, 0, 0); } }
#pragma unroll
        for (int rg = 0; rg < 4; ++rg) { const f32x4 dv = *(const LAS f32x4*)(DEC + ih * 32 + 8 * rg + 4 * hh);
#pragma unroll
            for (int j = 0; j < 4; ++j) accS[rg * 4 + j] *= dv[j]; }
#pragma unroll
        for (int ks = 0; ks < 4; ++ks) { const bf16x8 A = *(const LAS bf16x8*)(KET + (ih * 32 + l5) * RS + ks * 16 + hh * 8), Bv = *(const LAS bf16x8*)(VT + (vq * 32 + l5) * RS + ks * 16 + hh * 8);
            accS = __builtin_amdgcn_mfma_f32_32x32x16_bf16(A, Bv, accS, 0, 0, 0); }
#pragma unroll
        for (int r = 0; r < 16; ++r) { const int ii = ih * 32 + (r & 3) + 8 * (r >> 2) + 4 * hh;
            O[gla_row(ck * 64 + ii, b, dir) * 512 + h * 128 + vq * 32 + l5] = f2bf(accO[r]); }
#pragma unroll
        for (int rg = 0; rg < 4; ++rg) { u32x2 o; o.x = cvt_pk_bf16(accS[rg * 4], accS[rg * 4 + 1]); o.y = cvt_pk_bf16(accS[rg * 4 + 2], accS[rg * 4 + 3]);
            *(LAS u32x2*)(ST + (vq * 32 + l5) * RS + ih * 32 + 8 * rg + 4 * hh) = o; }
        __syncthreads();
    }
    __syncthreads();
}

template <int W>
__device__ __forceinline__ void pool2d_wave(bf16_t* base, int lane) {
    float u[32], pv[33];
#pragma unroll
    for (int r = 0; r < 32; ++r) u[r] = bf2f(base[r * 64 + lane]);
    pv[0] = 0.f;
#pragma unroll
    for (int r = 0; r < 32; ++r) pv[r + 1] = pv[r] + u[r];
    const int cl = max(lane - W / 2, 0), chh = min(lane - W / 2 + W, 64);
#pragma unroll
    for (int r = 0; r < 32; ++r) {
        const int rl = (r - W / 2) < 0 ? 0 : (r - W / 2), rh = (r - W / 2 + W) > 32 ? 32 : (r - W / 2 + W);
        float x = pv[rh] - pv[rl];
#pragma unroll
        for (int d = 1; d < 64; d <<= 1) { const float y = __shfl_up(x, d); if (lane >= d) x += y; }
        const float hi = __shfl(x, chh - 1), lo = __shfl(x, cl > 0 ? cl - 1 : 0);
        const float s = hi - (cl > 0 ? lo : 0.f);
        const float cnt = (float)((rh - rl) * (chh - cl));
        base[r * 64 + lane] = f2bf(s / cnt - u[r]);
    }
}
__device__ __forceinline__ void pool1d_wave(bf16_t* base, int lane, int W) {
    float u[4], P[4];
#pragma unroll
    for (int j = 0; j < 4; ++j) u[j] = bf2f(base[j * 64 + lane]);
    float off = 0.f;
#pragma unroll
    for (int j = 0; j < 4; ++j) { float x = u[j];
#pragma unroll
        for (int d = 1; d < 64; d <<= 1) { const float y = __shfl_up(x, d); if (lane >= d) x += y; }
        P[j] = x + off; off += __shfl(x, 63); }
#pragma unroll
    for (int j = 0; j < 4; ++j) { const int t = j * 64 + lane; const int lo = max(t - W / 2, 0), hi = min(t - W / 2 + W, 256);
        const int ih = hi - 1, il = lo > 0 ? lo - 1 : 0;
        float vh = 0.f, vl = 0.f;
#pragma unroll
        for (int s = 0; s < 4; ++s) { const float a = __shfl(P[s], ih & 63), bq = __shfl(P[s], il & 63); if ((ih >> 6) == s) vh = a; if ((il >> 6) == s) vl = bq; }
        const float sum = vh - (lo > 0 ? vl : 0.f);
        u[j] = sum / (float)(hi - lo) - u[j]; }
#pragma unroll
    for (int j = 0; j < 4; ++j) base[j * 64 + lane] = f2bf(u[j]);
}

__global__ void __launch_bounds__(NTHREADS, 2) mega(Params p) {
    extern __shared__ __attribute__((aligned(16))) unsigned char lds_raw[];
    LAS unsigned char* lds = (LAS unsigned char*)lds_raw;
    LAS float* lf = (LAS float*)lds;
    cg::grid_group grid = cg::this_grid();
    unsigned bar_n = 0; unsigned* bar_ctr = (unsigned*)(p.ws + WS_BAR);
#define GBAR() do { bar_n += gridDim.x; gbar(bar_ctr, bar_n); } while (0)
    const int G = gridDim.x, bid = blockIdx.x;
#define WSPTRS const int tid = tidx(), lane = tid & 63, wid = tid >> 6; (void)lane; (void)wid; unsigned char* ws = opq(p.ws); bf16_t* HX = (bf16_t*)(ws + WS_HX); bf16_t* T = (bf16_t*)(ws + WS_T); bf16_t* YG = (bf16_t*)(ws + WS_YG); bf16_t* PG = (bf16_t*)(ws + WS_PG); \
    float* CTXS = (float*)(ws + WS_CTX); const float* MOD = (const float*)(ws + WS_MOD); const float* BIAS = (const float*)(ws + WS_BIAS); (void)HX; (void)T; (void)YG; (void)PG; (void)CTXS; (void)MOD; (void)BIAS;

#ifdef TIMEX
    unsigned long long tx0 = 0, tx1 = 0; int txn = 0;
#define TX_MARK() do { if (txn == TIMEX) tx0 = __builtin_amdgcn_s_memrealtime(); if (txn == TIMEX + 1) tx1 = __builtin_amdgcn_s_memrealtime(); ++txn; } while (0)
    unsigned long long cx0 = 0, cxacc = 0;
#define CX_BEGIN(k) do { if (TIMEX == 100 + (k) && l == 1) { __syncthreads(); cx0 = __builtin_amdgcn_s_memrealtime(); } } while (0)
#define CX_END(k) do { if (TIMEX == 100 + (k) && l == 1) { __syncthreads(); cxacc += __builtin_amdgcn_s_memrealtime() - cx0; } } while (0)
#else
#define TX_MARK() do {} while (0)
#define CX_BEGIN(k) do {} while (0)
#define CX_END(k) do {} while (0)
#endif
    TX_MARK();
    for (int l = 0; l < 2; ++l) {
        unsigned char* ws = opq(p.ws);
        const float* win = p.in[I_WIN] + (size_t)l * D * N_IN;
        bf16_t* wt = (bf16_t*)(ws + WS_WT + l * SZ_WT);
        tconv(win, N_IN, 0, 1536, 1536, D, wt, lf);
        tconv(win, N_IN, POOL_OFF, 512, 512, D, wt + (size_t)1536 * D, lf);
        tconv(win, N_IN, GLA_OFF, NGV, NG, D, (bf16_t*)(ws + WS_WG + l * SZ_WG), lf);
        tconv(win, N_IN, GATE_OFF, 3072, 3072, D, (bf16_t*)(ws + WS_WGATE + l * SZ_WGATE), lf);
        tconv(p.in[I_WBH] + (size_t)l * 512 * 1024, 1024, 0, 1024, 1024, 512, (bf16_t*)(ws + WS_WBR + (size_t)(l * 3 + 0) * SZ_WBR), lf);
        tconv(p.in[I_WBG] + (size_t)l * 512 * 1024, 1024, 0, 1024, 1024, 512, (bf16_t*)(ws + WS_WBR + (size_t)(l * 3 + 1) * SZ_WBR), lf);
        tconv(p.in[I_WOUT] + (size_t)l * D * D, D, 0, D, D, D, (bf16_t*)(ws + WS_WOUT + l * SZ_WOUT), lf);
        tconv(p.in[I_WUP] + (size_t)l * D * DFF, DFF, 0, DFF, DFF, D, (bf16_t*)(ws + WS_WUP + l * SZ_WUP), lf);
        tconv(p.in[I_WDN] + (size_t)l * DFF * D, D, 0, D, D, DFF, (bf16_t*)(ws + WS_WDN + l * SZ_WDN), lf);
        job_poolcomb(p, l);
    }
    job_bias(p);
    job_mod(p, lf);
    job_filters(p, lds);
    if (p.ws == nullptr) grid.sync();
    GBAR();

    { WSPTRS
    for (int row = bid * 8 + wid; row < TOK; row += 2 * G * 8) {
        const int rb = row + G * 8; const bool hb = rb < TOK; const int rb2 = hb ? rb : row;
        const bool la = row < TOKL, lb = rb2 < TOKL;
        const float* xa = la ? p.in[I_X] + (size_t)row * D : p.in[I_CTX] + (size_t)(row - TOKL) * D; const float* xb = lb ? p.in[I_X] + (size_t)rb2 * D : p.in[I_CTX] + (size_t)(rb2 - TOKL) * D;
        const float* ma = MOD + (size_t)(la ? row >> 11 : 32) * 6144; const float* mb = MOD + (size_t)(lb ? rb2 >> 11 : 32) * 6144;
        ada_row2(xa, xb, hb, p.in[I_NMIX], ma, ma + 1024, mb, mb + 1024, HX + (size_t)row * D, HX + (size_t)rb2 * D, nullptr, nullptr, lane);
    } }
    GBAR();
    TX_MARK();

    for (int l_ = 0; l_ < 2; ++l_) {
        const int l = opqi(l_);
        { WSPTRS
            const int ntokt = l == 0 ? 288 : 256;
            const int nA = ntokt * 8, nB = 288 * 7;
            const bf16_t* wt = (const bf16_t*)(ws + WS_WT + l * SZ_WT); const bf16_t* wg = (const bf16_t*)(ws + WS_WG + l * SZ_WG);
            const float* biasT = BIAS + l * (NTR + NG); const float* biasG = biasT + NTR;
            XMap MA, MB; MA.init(bid, ntokt, 8); MB.init(bid, 288, 7);
            ProgInproj P{wt, wg, HX, T, PG, biasT, biasG, MA, MB, MA.rounds()};
            gemm_stream(lds, MA.rounds() + MB.rounds(), P);
        }
        GBAR();
        TX_MARK();
        { WSPTRS
            for (int it = bid; it < 256; it += G) gla_chunk_item(p, l, it >> 3, (it >> 1) & 3, it & 1, lds);
            for (int it = bid; it < 512; it += G) hyena_mfma<2048, 8>(p, l, it, false, lds);
            if (l == 0) for (int it = bid; it < 512; it += G) hyena_mfma<256, 1>(p, l, it, true, lds);
            const int npl = l == 0 ? 32768 : 16384;
            for (int it = bid * 8 + wid; it < npl; it += G * 8) { const bool cx = it >= 16384; const int j = it & 16383, ch = j >> 5, b = j & 31, g = ch >> 7;
                bf16_t* base = T + (size_t)(1536 + ch) * TOK + (cx ? (size_t)TOKL + b * 256 : (size_t)b * 2048);
                if (cx) pool1d_wave(base, lane, 2 << g);
                else { if (g == 0) pool2d_wave<2>(base, lane); else if (g == 1) pool2d_wave<4>(base, lane); else if (g == 2) pool2d_wave<8>(base, lane); else pool2d_wave<16>(base, lane); } }
        }
        GBAR();
        TX_MARK();
        {
            WSPTRS
            const bf16_t* OF = (const bf16_t*)(ws + WS_OF); const bf16_t* OB = OF + (size_t)TOK * 512; const float* nw = p.in[I_GNW] + l * 128;
            const int ntok = l == 0 ? TOK : TOKL;
            for (int row = bid * 8 + wid; row < ntok; row += 2 * G * 8) {
                const int rowb = row + G * 8; const bool hb = rowb < ntok; const int rows[2] = {row, hb ? rowb : row};
                u32x4 av[2], bv[2], rv[2];
#pragma unroll
                for (int q = 0; q < 2; ++q) { av[q] = *(const u32x4*)(OF + (size_t)rows[q] * 512 + lane * 8); bv[q] = *(const u32x4*)(OB + (size_t)rows[q] * 512 + lane * 8); rv[q] = *(const u32x4*)(PG + (size_t)rows[q] * NG + 1024 + lane * 8); }
#pragma unroll
                for (int q = 0; q < 2; ++q) { if (q == 1 && !hb) break;
                    const u32x4 a = av[q], bq = bv[q], rr = rv[q];
                    float o[8] = {lo16(a.x) + lo16(bq.x), hi16(a.x) + hi16(bq.x), lo16(a.y) + lo16(bq.y), hi16(a.y) + hi16(bq.y), lo16(a.z) + lo16(bq.z), hi16(a.z) + hi16(bq.z), lo16(a.w) + lo16(bq.w), hi16(a.w) + hi16(bq.w)};
                    float r[8] = {lo16(rr.x), hi16(rr.x), lo16(rr.y), hi16(rr.y), lo16(rr.z), hi16(rr.z), lo16(rr.w), hi16(rr.w)};
                    float ss = 0.f;
#pragma unroll
                    for (int j = 0; j < 8; ++j) ss += o[j] * o[j];
                    ss += __shfl_xor(ss, 1); ss += __shfl_xor(ss, 2); ss += __shfl_xor(ss, 4); ss += __shfl_xor(ss, 8);
                    const float inv = rsqrtf(ss * (1.f / 128.f) + EPS);
                    float y[8];
#pragma unroll
                    for (int j = 0; j < 8; ++j) y[j] = o[j] * inv * nw[(lane & 15) * 8 + j] * (r[j] * sigmoidf_(r[j]));
                    u32x4 w; w.x = cvt_pk_bf16(y[0], y[1]); w.y = cvt_pk_bf16(y[2], y[3]); w.z = cvt_pk_bf16(y[4], y[5]); w.w = cvt_pk_bf16(y[6], y[7]);
                    *(u32x4*)(YG + (size_t)rows[q] * 512 + lane * 8) = w; }
            }
            LAS bf16_t* tl = (LAS bf16_t*)lds;
            const int nit = 2 * (l == 0 ? 288 : 256) * 8;
            for (int it = bid; it < nit; it += G) { const int ctile = it & 7, tt = (it >> 3) % (l == 0 ? 288 : 256), which = (it >> 3) / (l == 0 ? 288 : 256);
                const bf16_t* src = T + (size_t)(which ? 1536 : 0) * TOK + (size_t)tt * 256; bf16_t* dst = (bf16_t*)(ws + (which ? WS_YPL : WS_YHY)) + (size_t)tt * 256 * 512;
                __syncthreads();
#pragma unroll
                for (int i = 0; i < 4; ++i) { const int idx = tid + i * NTHREADS, c = idx >> 5, t8 = (idx & 31) * 8;
                    *(LAS u32x4*)(tl + c * 264 + t8) = *(const u32x4*)(src + (size_t)(ctile * 64 + c) * TOK + t8); }
                __syncthreads();
#pragma unroll
                for (int i = 0; i < 4; ++i) { const int idx = tid + i * NTHREADS, tk = idx >> 3, c8 = (idx & 7) * 8; unsigned w[4];
#pragma unroll
                    for (int j = 0; j < 4; ++j) w[j] = (unsigned)tl[(c8 + 2 * j) * 264 + tk] | ((unsigned)tl[(c8 + 2 * j + 1) * 264 + tk] << 16);
                    *(u32x4*)(dst + (size_t)tk * 512 + ctile * 64 + c8) = (u32x4){w[0], w[1], w[2], w[3]}; }
            }
            __syncthreads();
        }
        GBAR();
        TX_MARK();
        const int ntt = l == 0 ? 288 : 256;
        { WSPTRS
          XMap M; M.init(bid, ntt, 4);
          ProgMix2 P{ws, ws + WS_STASH + (size_t)bid * 524288, p.in[I_BIN] + l * N_IN + GATE_OFF, M, l};
          gemm_stream(lds, 6 * M.rounds(), P); }
        GBAR();
        { WSPTRS
          XMap M; M.init(bid, ntt, 4);
          TileIO io{p.in[I_X], p.in[I_CTX], p.out, CTXS, MOD + (size_t)l * 33 * 6144, l};
          ProgOut2 P{ws, io, M, l};
          gemm_stream(lds, M.rounds(), P); }
        GBAR();
        { WSPTRS
          const float* modl = MOD + (size_t)l * 33 * 6144; const int nrow = ntt * 256;
          for (int row = bid * 8 + wid; row < nrow; row += 2 * G * 8) { const int rb = row + G * 8; const bool hb = rb < nrow; const int rb2 = hb ? rb : row; const bool la = row < TOKL, lb = rb2 < TOKL;
              const float* xa = la ? p.out + (size_t)row * D : CTXS + (size_t)(row - TOKL) * D; const float* xb = lb ? p.out + (size_t)rb2 * D : CTXS + (size_t)(rb2 - TOKL) * D;
              const float* ma = modl + (size_t)(la ? row >> 11 : 32) * 6144; const float* mb = modl + (size_t)(lb ? rb2 >> 11 : 32) * 6144;
              ada_row2(xa, xb, hb, p.in[I_NFFN] + l * D, ma + 3072, ma + 4096, mb + 3072, mb + 4096, HX + (size_t)row * D, HX + (size_t)rb2 * D, nullptr, nullptr, lane); } }
        GBAR();
        { WSPTRS
          XMap M; M.init(bid, ntt, 16);
          ProgUp2 P{ws, M, l};
          gemm_stream(lds, M.rounds(), P); }
        GBAR();
        { WSPTRS
          XMap M; M.init(bid, ntt, 4);
          TileIO io{p.in[I_X], p.in[I_CTX], p.out, CTXS, MOD + (size_t)l * 33 * 6144, l};
          ProgDown2 P{ws, io, M, l};
          gemm_stream(lds, M.rounds(), P); }
        GBAR();
        { WSPTRS
          const int nrow = ntt * 256;
          for (int row = bid * 8 + wid; row < nrow; row += 2 * G * 8) { const int rb = row + G * 8; const bool hb = rb < nrow; const int rb2 = hb ? rb : row; const bool la = row < TOKL, lb = rb2 < TOKL;
              float* xa = la ? p.out + (size_t)row * D : CTXS + (size_t)(row - TOKL) * D; float* xb = lb ? p.out + (size_t)rb2 * D : CTXS + (size_t)(rb2 - TOKL) * D;
              if (l == 0) { const float* ma = MOD + (size_t)33 * 6144 + (size_t)(la ? row >> 11 : 32) * 6144; const float* mb = MOD + (size_t)33 * 6144 + (size_t)(lb ? rb2 >> 11 : 32) * 6144;
                  ada_row2(xa, xb, hb, p.in[I_NMIX] + D, ma, ma + 1024, mb, mb + 1024, HX + (size_t)row * D, HX + (size_t)rb2 * D, nullptr, nullptr, lane); }
              else ada_row2(xa, xb, hb, p.in[I_NFIN], nullptr, nullptr, nullptr, nullptr, nullptr, nullptr, xa, xb, lane); } }
        if (l == 0) GBAR();
        TX_MARK();
    }
#ifdef TIMEX
    if (blockIdx.x == 0 && threadIdx.x == 0) { const unsigned long long t = __builtin_amdgcn_s_memrealtime(); while (__builtin_amdgcn_s_memrealtime() - t < (unsigned long long)TIMEX_MULT * (TIMEX >= 100 ? cxacc : (tx1 - tx0))) __builtin_amdgcn_s_sleep(10); }
#endif
}

extern "C" void kernel_launch(void* const* d_in, const int* in_sizes, int n_in, void* d_out, int out_size,
                              void* d_ws, size_t ws_size, hipStream_t stream) {
    static int grid_blocks = 0;
    if (!grid_blocks) {
        int dev = 0, cus = 0, per_cu = 0;
        (void)hipGetDevice(&dev);
        (void)hipDeviceGetAttribute(&cus, hipDeviceAttributeMultiprocessorCount, dev);
        (void)hipFuncSetAttribute((const void*)mega, hipFuncAttributeMaxDynamicSharedMemorySize, LDS_BYTES);
        (void)hipOccupancyMaxActiveBlocksPerMultiprocessor(&per_cu, (const void*)mega, NTHREADS, LDS_BYTES);
        grid_blocks = cus > 256 ? 256 : cus;
        if (ws_size < WS_END || n_in != 33 || out_size != TOKL * D) { fprintf(stderr, "kernel_launch: unexpected sizes ws=%zu need=%zu n_in=%d out=%d\n", ws_size, (size_t)WS_END, n_in, out_size); grid_blocks = -1; }
    }
    if (grid_blocks < 0) return;
    Params p{};
    for (int i = 0; i < 33; ++i) p.in[i] = (const float*)d_in[i];
    p.out = (float*)d_out; p.ws = (unsigned char*)d_ws;
    (void)hipMemsetAsync((unsigned char*)d_ws + WS_BAR, 0, 256, stream);
    void* args[] = {&p};
    hipError_t e = hipLaunchCooperativeKernel((const void*)mega, dim3(grid_blocks), dim3(NTHREADS), args, LDS_BYTES, stream);
    if (e != hipSuccess) fprintf(stderr, "cooperative launch failed: %s (grid %d)\n", hipGetErrorString(e), grid_blocks);
}
```

```cpp
#include <hip/hip_runtime.h>
#include <hip/hip_cooperative_groups.h>
#include <cstdio>
#include <cstdint>
namespace cg = cooperative_groups;

#define LAS __attribute__((address_space(3)))
typedef unsigned short bf16_t;
typedef short bf16x8 __attribute__((ext_vector_type(8)));
typedef float f32x4 __attribute__((ext_vector_type(4)));
typedef unsigned u32x2 __attribute__((ext_vector_type(2)));
typedef unsigned u32x4 __attribute__((ext_vector_type(4)));

constexpr int NTHREADS = 512;
constexpr int LDS_BYTES = 147456;
constexpr int D = 1024, NB = 32, SEQ = 2048, CTXL = 256;
constexpr int TOKL = NB * SEQ, TOKC = NB * CTXL, TOK = TOKL + TOKC;
constexpr int N_IN = 6688, GLA_OFF = 1536, POOL_OFF = 3104, GATE_OFF = 3616;
constexpr int NTR = 2048, NG = 1792, NGV = 1568, DFF = 4096;
constexpr float EPS = 1e-6f;

constexpr size_t SZ_WT = (size_t)NTR * D * 2, SZ_WG = (size_t)NG * D * 2, SZ_WGATE = (size_t)3072 * D * 2, SZ_WBR = (size_t)1024 * 512 * 2;
constexpr size_t SZ_WOUT = (size_t)D * D * 2, SZ_WUP = (size_t)DFF * D * 2, SZ_WDN = (size_t)D * DFF * 2;
constexpr size_t WS_WT = 0;
constexpr size_t WS_WG = WS_WT + 2 * SZ_WT;
constexpr size_t WS_WGATE = WS_WG + 2 * SZ_WG;
constexpr size_t WS_WBR = WS_WGATE + 2 * SZ_WGATE;
constexpr size_t WS_WOUT = WS_WBR + 6 * SZ_WBR;
constexpr size_t WS_WUP = WS_WOUT + 2 * SZ_WOUT;
constexpr size_t WS_WDN = WS_WUP + 2 * SZ_WUP;
constexpr size_t WS_BIAS = WS_WDN + 2 * SZ_WDN;
constexpr size_t WS_MOD = WS_BIAS + 32768;
constexpr size_t WS_HFL = WS_MOD + (size_t)2 * 33 * 6144 * 4;
constexpr size_t WS_HFC = WS_HFL + (size_t)2 * 4 * 512 * 2048 * 2;
constexpr size_t WS_CTX = WS_HFC + (size_t)4 * 512 * 256 * 2;
constexpr size_t WS_HX = WS_CTX + (size_t)TOKC * D * 4;
constexpr size_t WS_T = WS_HX + (size_t)TOK * D * 2;
constexpr size_t WS_YG = WS_T + (size_t)NTR * TOK * 2;
constexpr size_t WS_PG = WS_YG + (size_t)TOK * 512 * 2;
constexpr size_t WS_OF = WS_PG + (size_t)TOK * NG * 2;
constexpr size_t WS_BAR = WS_OF + (size_t)2 * TOK * 512 * 2;
constexpr size_t WS_END = WS_BAR + 256;
constexpr size_t WS_YHY = WS_T + (size_t)512 * TOK * 2;
constexpr size_t WS_YPL = WS_T + (size_t)1024 * TOK * 2;
constexpr size_t WS_STASH = WS_PG;
constexpr size_t WS_MERGED = WS_OF;
constexpr size_t WS_HID = WS_T;
static_assert((size_t)TOK * DFF * 2 <= WS_OF - WS_T, "hidden");
constexpr size_t WS_SCR = WS_PG;
constexpr size_t SCR_PER = 1572864;
constexpr size_t SC_MERGED = 0, SC_TRY = 524288, SC_TRP = 786432, SC_SG = 1048576, SC_ST = 1310720, SC_HID = 524288;
static_assert(WS_END <= (size_t)1073741824, "ws");

struct Params { const float* in[33]; float* out; unsigned char* ws; };
enum { I_X = 0, I_C, I_CTX, I_CCTX, I_WMOD, I_BMOD, I_NMIX, I_NFFN, I_WIN, I_BIN, I_HSW, I_HSB, I_FW1, I_FB1, I_FFREQ, I_FW2, I_FB2, I_FW3, I_HSKIP,
       I_WAF, I_BAF, I_WAB, I_BAB, I_GNW, I_PW, I_PSC, I_WBH, I_WBG, I_WBP, I_WOUT, I_WUP, I_WDN, I_NFIN };

__device__ __forceinline__ float bf2f(bf16_t h) { return __uint_as_float((unsigned)h << 16); }
__device__ __forceinline__ unsigned cvt_pk_bf16(float lo, float hi) { unsigned r; asm volatile("v_cvt_pk_bf16_f32 %0, %1, %2" : "=v"(r) : "v"(lo), "v"(hi)); return r; }
__device__ __forceinline__ bf16_t f2bf(float f) { return (bf16_t)(cvt_pk_bf16(f, 0.f) & 0xffffu); }
__device__ __forceinline__ float lo16(unsigned u) { return __uint_as_float(u << 16); }
__device__ __forceinline__ float hi16(unsigned u) { return __uint_as_float(u & 0xffff0000u); }
__device__ __forceinline__ float sigmoidf_(float v) { return 1.f / (1.f + __expf(-v)); }
__device__ __forceinline__ unsigned char* opq(unsigned char* p) { asm volatile("" : "+s"(p)); return p; }
__device__ __forceinline__ int tidx() { int t = threadIdx.x; asm volatile("" : "+v"(t)); return t; }
__device__ __forceinline__ int opqi(int v) { asm volatile("" : "+s"(v)); return v; }
__device__ __forceinline__ void gbar(unsigned* ctr, unsigned target) {
    asm volatile("s_waitcnt vmcnt(0) lgkmcnt(0)" ::: "memory");
    __syncthreads();
    if (threadIdx.x < 64) {
        if (threadIdx.x == 0) {
            __builtin_amdgcn_fence(__ATOMIC_RELEASE, "agent");
            asm volatile("s_waitcnt vmcnt(0)" ::: "memory");
            __hip_atomic_fetch_add(ctr, 1u, __ATOMIC_RELAXED, __HIP_MEMORY_SCOPE_AGENT);
            while (__hip_atomic_load(ctr, __ATOMIC_RELAXED, __HIP_MEMORY_SCOPE_AGENT) < target) __builtin_amdgcn_s_sleep(1);
        }
        __builtin_amdgcn_fence(__ATOMIC_ACQUIRE, "agent");
        asm volatile("s_waitcnt vmcnt(0)" ::: "memory");
    }
    __syncthreads();
}
__device__ __forceinline__ float wave_sum(float v) {
#pragma unroll
    for (int o = 32; o >= 1; o >>= 1) v += __shfl_xor(v, o);
    return v;
}

constexpr int BK = 64, HALF = 128, HTB = HALF * BK * 2;
__device__ __forceinline__ int lds_byte(int r, int c) { const int st = (r >> 4) * 2 + (c >> 5), rr = r & 15, cc = c & 31, ob = rr * 64 + cc * 2; return st * 1024 + (ob ^ (((ob >> 9) & 1) << 5)); }
__device__ __forceinline__ void stage_rc(int b, int& R, int& C) { const int st = b / 1024, sb = b % 1024, swz = sb ^ (((sb >> 9) & 1) << 5); R = (st >> 1) * 16 + swz / 64; C = (st & 1) * 32 + (swz % 64) / 2; }

template <class Epi>
__device__ __forceinline__ void gemm_unit(LAS unsigned char* lds, const bf16_t* A, int lda, const bf16_t* Bt, int ldb, int K, const Epi& E) {
    const int tid = tidx(), wid = __builtin_amdgcn_readfirstlane(tid >> 6), lane = tid & 63, wr = wid >> 2, wc = wid & 3, fr = lane & 15, fq = lane >> 4;
    const int nt = K / BK;
    unsigned voffA[2], voffB[2];
#pragma unroll
    for (int i = 0; i < 2; ++i) { int R, C; stage_rc(tid * 16 + i * 8192, R, C); voffA[i] = (unsigned)(R * lda + C) * 2u; voffB[i] = (unsigned)(R * ldb + C) * 2u; }
    const size_t kstep = (size_t)(BK * 2);
    const size_t hstepA = (size_t)HALF * lda * 2, hstepB = (size_t)HALF * ldb * 2;
    const unsigned ldsw = (unsigned)wid * 1024u;
    const int aoff = lds_byte(wr * 64 + fr, fq * 8), boff = lds_byte(wc * 32 + fr, fq * 8);
#define G_SA(b, h) (((b) * 2 + (h)) * HTB)
#define G_SB(b, h) ((4 + (b) * 2 + (h)) * HTB)
#define G_STAGE(bufoff, gbase, voff) do { _Pragma("unroll") for (int _i = 0; _i < 2; ++_i) \
        __builtin_amdgcn_global_load_lds((const unsigned*)((const char*)(gbase) + (voff)[_i]), (LAS unsigned*)(lds + (bufoff) + ldsw + _i * 8192), 16, 0, 0); } while (0)
#define G_LDA(dst, b, h) do { _Pragma("unroll") for (int m = 0; m < 4; ++m) _Pragma("unroll") for (int k = 0; k < 2; ++k) dst[m][k] = *(const LAS bf16x8*)(lds + G_SA(b, h) + aoff + m * 2048 + k * 1024); } while (0)
#define G_LDB(dst, b, h) do { _Pragma("unroll") for (int n = 0; n < 2; ++n) _Pragma("unroll") for (int k = 0; k < 2; ++k) dst[n][k] = *(const LAS bf16x8*)(lds + G_SB(b, h) + boff + n * 2048 + k * 1024); } while (0)
#define G_MMA(ai, bj, At, Bt_) do { __builtin_amdgcn_s_setprio(1); _Pragma("unroll") for (int m = 0; m < 4; ++m) _Pragma("unroll") for (int n = 0; n < 2; ++n) _Pragma("unroll") for (int k = 0; k < 2; ++k) \
        acc[ai][bj][m][n] = __builtin_amdgcn_mfma_f32_16x16x32_bf16(Bt_[n][k], At[m][k], acc[ai][bj][m][n], 0, 0, 0); __builtin_amdgcn_s_setprio(0); } while (0)
#define G_WAIT_V(n) asm volatile("s_waitcnt vmcnt(" #n ")" ::: "memory")
#define G_WAIT_L(n) asm volatile("s_waitcnt lgkmcnt(" #n ")" ::: "memory")
#define G_BAR __builtin_amdgcn_s_barrier()
#define G_SCHED __builtin_amdgcn_sched_barrier(0)
    __syncthreads();
    f32x4 acc[2][2][4][2];
#pragma unroll
    for (int a = 0; a < 2; ++a)
#pragma unroll
        for (int b = 0; b < 2; ++b)
#pragma unroll
            for (int m = 0; m < 4; ++m)
#pragma unroll
                for (int n = 0; n < 2; ++n) acc[a][b][m][n] = (f32x4){0.f, 0.f, 0.f, 0.f};
    bf16x8 At[4][2], B0[2][2], B1[2][2];
    const char* cA = (const char*)A; const char* cB = (const char*)Bt;
    G_STAGE(G_SB(0, 0), cB, voffB); G_STAGE(G_SA(0, 0), cA, voffA); G_STAGE(G_SB(0, 1), cB + hstepB, voffB); G_STAGE(G_SA(0, 1), cA + hstepA, voffA);
    if (wr == 1) G_BAR;
    G_WAIT_V(4); G_BAR;
    G_STAGE(G_SB(1, 0), cB + kstep, voffB); G_STAGE(G_SA(1, 0), cA + kstep, voffA); G_STAGE(G_SB(1, 1), cB + hstepB + kstep, voffB);
    G_WAIT_V(6); G_BAR;
    for (int t = 0; t < nt; t += 2) {
        const bool last = (t == nt - 2);
        const char* a1 = cA + (size_t)(t + 1) * kstep;
        const char* a2 = last ? cA : cA + (size_t)(t + 2) * kstep; const char* b2 = last ? cB : cB + (size_t)(t + 2) * kstep;
        const char* a3 = a2 + kstep; const char* b3 = b2 + kstep;
        G_LDB(B0, 0, 0); G_SCHED; G_LDA(At, 0, 0); G_STAGE(G_SA(1, 1), a1 + hstepA, voffA);
        G_WAIT_L(8); G_BAR; G_WAIT_L(0); G_MMA(0, 0, At, B0); G_BAR; G_SCHED;
        G_LDB(B1, 0, 1); G_STAGE(G_SB(0, 0), b2, voffB);
        G_BAR; G_WAIT_L(0); G_MMA(0, 1, At, B1); G_BAR;
        G_LDA(At, 0, 1); G_STAGE(G_SA(0, 0), a2, voffA);
        G_BAR; G_WAIT_L(0); G_MMA(1, 0, At, B0); G_BAR; G_SCHED;
        G_STAGE(G_SB(0, 1), b2 + hstepB, voffB);
        G_WAIT_V(6); G_BAR; G_MMA(1, 1, At, B1); G_BAR;
        G_LDB(B0, 1, 0); G_SCHED; G_LDA(At, 1, 0); G_STAGE(G_SA(0, 1), a2 + hstepA, voffA);
        G_WAIT_L(8); G_BAR; G_WAIT_L(0); G_MMA(0, 0, At, B0); G_BAR; G_SCHED;
        G_LDB(B1, 1, 1); G_STAGE(G_SB(1, 0), b3, voffB);
        G_BAR; G_WAIT_L(0); G_MMA(0, 1, At, B1); G_BAR;
        G_LDA(At, 1, 1); G_STAGE(G_SA(1, 0), a3, voffA);
        G_BAR; G_WAIT_L(0); G_MMA(1, 0, At, B0); G_BAR; G_SCHED;
        G_STAGE(G_SB(1, 1), b3 + hstepB, voffB);
        G_WAIT_V(6); G_BAR; G_MMA(1, 1, At, B1); G_BAR;
    }
    E(acc, wr, wc, fr, fq);
    G_WAIT_V(0);
    if (wr == 0) G_BAR;
    G_BAR;
    __syncthreads();
}


__device__ __forceinline__ int perm32(int rho) { const int n = rho >> 4, i = rho & 15; return 8 * (i >> 2) + 4 * n + (i & 3); }
typedef f32x4 AccT[2][2][4][2];
struct UDesc { const char* A; const char* B; int lda, ldb, K; };
template <class Prog>
__device__ __forceinline__ void gemm_stream(LAS unsigned char* lds, int nunits, const Prog& P) {
    if (nunits <= 0) return;
    const int tid = tidx(), wid = __builtin_amdgcn_readfirstlane(tid >> 6), lane = tid & 63, wr = wid >> 2, wc = wid & 3, fr = lane & 15, fq = lane >> 4;
    int sR, sRb, sC; { int R, C; stage_rc(tid * 16, R, C); sR = R * 2; sRb = ((R & ~31) + perm32(R & 31)) * 2; sC = C * 2; }
    const unsigned kstep = (unsigned)(BK * 2);
    const unsigned ldsw = (unsigned)wid * 1024u;
    const int aoff = lds_byte(wr * 64 + fr, fq * 8), boff = lds_byte(wc * 32 + fr, fq * 8);
#define S_STAGE(bufoff, gbase, v, q) do { \
        __builtin_amdgcn_global_load_lds((const unsigned*)((const char*)(gbase) + (v)), (LAS unsigned*)(lds + (bufoff) + ldsw), 16, 0, 0); \
        __builtin_amdgcn_global_load_lds((const unsigned*)((const char*)(gbase) + (q) + (v)), (LAS unsigned*)(lds + (bufoff) + ldsw + 8192), 16, 0, 0); } while (0)
    UDesc cur, nxt; P.desc(0, cur);
    unsigned vA = (unsigned)(sR * cur.lda + sC), vB = (unsigned)(sRb * cur.ldb + sC);
    __syncthreads();
    f32x4 acc[2][2][4][2];
#pragma unroll
    for (int a = 0; a < 2; ++a)
#pragma unroll
        for (int b = 0; b < 2; ++b)
#pragma unroll
            for (int m = 0; m < 4; ++m)
#pragma unroll
                for (int n = 0; n < 2; ++n) acc[a][b][m][n] = (f32x4){0.f, 0.f, 0.f, 0.f};
    bf16x8 At[4][2], B0[2][2], B1[2][2];
    { const char* cA = cur.A; const char* cB = cur.B; const unsigned hA = (unsigned)HALF * cur.lda * 2, hB = (unsigned)HALF * cur.ldb * 2, qA = hA >> 1, qB = hB >> 1;
      S_STAGE(G_SB(0, 0), cB, vB, qB); S_STAGE(G_SA(0, 0), cA, vA, qA); S_STAGE(G_SB(0, 1), cB + hB, vB, qB); S_STAGE(G_SA(0, 1), cA + hA, vA, qA);
      if (wr == 1) G_BAR;
      G_WAIT_V(4); G_BAR;
      S_STAGE(G_SB(1, 0), cB + kstep, vB, qB); S_STAGE(G_SA(1, 0), cA + kstep, vA, qA); S_STAGE(G_SB(1, 1), cB + hB + kstep, vB, qB);
      G_WAIT_V(6); G_BAR; }
    for (int ui = 0;; ++ui) {
        const bool has_next = ui + 1 < nunits;
        if (has_next) P.desc(ui + 1, nxt); else nxt = cur;
        const unsigned nA = (unsigned)(sR * nxt.lda + sC), nB = (unsigned)(sRb * nxt.ldb + sC);
        const char* cA = cur.A; const char* cB = cur.B; const unsigned hA = (unsigned)HALF * cur.lda * 2, hB = (unsigned)HALF * cur.ldb * 2;
        const unsigned nhA = (unsigned)HALF * nxt.lda * 2, nhB = (unsigned)HALF * nxt.ldb * 2;
        const int nt = cur.K / BK;
        for (int t = 0; t < nt; t += 2) {
            const bool last = (t == nt - 2);
            const char* a1 = cA + (unsigned)(t + 1) * kstep;
            const char* a2 = last ? nxt.A : cA + (unsigned)(t + 2) * kstep; const char* b2 = last ? nxt.B : cB + (unsigned)(t + 2) * kstep;
            const char* a3 = a2 + kstep; const char* b3 = b2 + kstep;
            const unsigned hA2 = last ? nhA : hA, hB2 = last ? nhB : hB, qA = hA >> 1, qA2 = hA2 >> 1, qB2 = hB2 >> 1;
            const unsigned xA = last ? nA : vA, xB = last ? nB : vB;
            G_LDB(B0, 0, 0); G_SCHED; G_LDA(At, 0, 0); S_STAGE(G_SA(1, 1), a1 + hA, vA, qA);
            G_WAIT_L(8); G_BAR; G_WAIT_L(0); G_MMA(0, 0, At, B0); G_BAR; G_SCHED;
            G_LDB(B1, 0, 1); S_STAGE(G_SB(0, 0), b2, xB, qB2);
            G_BAR; G_WAIT_L(0); G_MMA(0, 1, At, B1); G_BAR;
            G_LDA(At, 0, 1); S_STAGE(G_SA(0, 0), a2, xA, qA2);
            G_BAR; G_WAIT_L(0); G_MMA(1, 0, At, B0); G_BAR; G_SCHED;
            S_STAGE(G_SB(0, 1), b2 + hB2, xB, qB2);
            G_WAIT_V(6); G_BAR; G_MMA(1, 1, At, B1); G_BAR;
            G_LDB(B0, 1, 0); G_SCHED; G_LDA(At, 1, 0); S_STAGE(G_SA(0, 1), a2 + hA2, xA, qA2);
            G_WAIT_L(8); G_BAR; G_WAIT_L(0); G_MMA(0, 0, At, B0); G_BAR; G_SCHED;
            G_LDB(B1, 1, 1); S_STAGE(G_SB(1, 0), b3, xB, qB2);
            G_BAR; G_WAIT_L(0); G_MMA(0, 1, At, B1); G_BAR;
            G_LDA(At, 1, 1); S_STAGE(G_SA(1, 0), a3, xA, qA2);
            G_BAR; G_WAIT_L(0); G_MMA(1, 0, At, B0); G_BAR; G_SCHED;
            S_STAGE(G_SB(1, 1), b3 + hB2, xB, qB2);
            G_WAIT_V(6); G_BAR; G_MMA(1, 1, At, B1); G_BAR;
        }
        P.epi(ui, acc, wr, wc, fr, fq);
        if (!has_next) break;
#pragma unroll
        for (int a = 0; a < 2; ++a)
#pragma unroll
            for (int b = 0; b < 2; ++b)
#pragma unroll
                for (int m = 0; m < 4; ++m)
#pragma unroll
                    for (int n = 0; n < 2; ++n) acc[a][b][m][n] = (f32x4){0.f, 0.f, 0.f, 0.f};
        cur = nxt; vA = nA; vB = nB;
    }
    G_WAIT_V(0);
    if (wr == 0) G_BAR;
    G_BAR;
    __syncthreads();
#undef S_STAGE
}

#define EPI_LOOP _Pragma("unroll") for (int ai = 0; ai < 2; ++ai) _Pragma("unroll") for (int m = 0; m < 4; ++m) _Pragma("unroll") for (int bj = 0; bj < 2; ++bj) _Pragma("unroll") for (int n = 0; n < 2; ++n)
#define EPI_ROW (ai * 128 + wr * 64 + m * 16 + fr)
#define EPI_COL (bj * 128 + wc * 32 + 8 * fq + 4 * n)

#define U4 _Pragma("unroll")
struct EpiStoreBf16 {
    bf16_t* O; size_t ldo; const float* bias; bool rowb;
    __device__ __forceinline__ void operator()(const AccT& acc, int wr, int wc, int fr, int fq) const {
        { const int tq_ = tidx(); wr = (tq_ >> 8) & 1; wc = (tq_ >> 6) & 3; fr = tq_ & 15; fq = (tq_ >> 4) & 3; }
        float br[2][4]; f32x4 bc[2][2];
        U4 for (int ai = 0; ai < 2; ++ai) U4 for (int m = 0; m < 4; ++m) br[ai][m] = rowb ? bias[ai * 128 + wr * 64 + m * 16 + fr] : 0.f;
        U4 for (int bj = 0; bj < 2; ++bj) U4 for (int n = 0; n < 2; ++n) bc[bj][n] = rowb ? (f32x4){0.f, 0.f, 0.f, 0.f} : *(const f32x4*)(bias + EPI_COL);
        U4 for (int ai = 0; ai < 2; ++ai) U4 for (int m = 0; m < 4; ++m) U4 for (int bj = 0; bj < 2; ++bj) { const int n = 0; const int r = EPI_ROW, c = EPI_COL;
            const f32x4 v0 = acc[ai][bj][m][0] + bc[bj][0] + br[ai][m], v1 = acc[ai][bj][m][1] + bc[bj][1] + br[ai][m];
            u32x4 w; w.x = cvt_pk_bf16(v0[0], v0[1]); w.y = cvt_pk_bf16(v0[2], v0[3]); w.z = cvt_pk_bf16(v1[0], v1[1]); w.w = cvt_pk_bf16(v1[2], v1[3]); *(u32x4*)(O + (size_t)r * ldo + c) = w; }
    }
};
struct EpiGate {
    f32x4* SG; const float* bias;
    __device__ __forceinline__ void operator()(const AccT& acc, int wr, int wc, int fr, int fq) const {
        { const int tq_ = tidx(); wr = (tq_ >> 8) & 1; wc = (tq_ >> 6) & 3; fr = tq_ & 15; fq = (tq_ >> 4) & 3; }
        f32x4 bc[2][2];
        U4 for (int bj = 0; bj < 2; ++bj) U4 for (int n = 0; n < 2; ++n) bc[bj][n] = *(const f32x4*)(bias + EPI_COL);
        int i = 0; f32x4* SGt = SG + tidx();
        EPI_LOOP { f32x4 v = acc[ai][bj][m][n] + bc[bj][n];
            v[0] = sigmoidf_(v[0]); v[1] = sigmoidf_(v[1]); v[2] = sigmoidf_(v[2]); v[3] = sigmoidf_(v[3]);
            SGt[i * NTHREADS] = v; ++i; }
    }
};
struct EpiBranch {
    const f32x4* SG; f32x4* ST; bf16_t* MG; int first, last;
    __device__ __forceinline__ void operator()(const AccT& acc, int wr, int wc, int fr, int fq) const {
        { const int tq_ = tidx(); wr = (tq_ >> 8) & 1; wc = (tq_ >> 6) & 3; fr = tq_ & 15; fq = (tq_ >> 4) & 3; }
        const int tq = tidx(); const f32x4* SGt = SG + tq; f32x4* STt = ST + tq;
        f32x4 g[2][4], t[2][4];
        U4 for (int q = 0; q < 4; ++q) { g[0][q] = SGt[q * NTHREADS]; t[0][q] = first ? (f32x4){0.f, 0.f, 0.f, 0.f} : STt[q * NTHREADS]; }
        U4 for (int bt = 0; bt < 8; ++bt) { const int cb = bt & 1, nb = cb ^ 1, ai = bt >> 2, m = bt & 3;
            if (bt + 1 < 8) { U4 for (int q = 0; q < 4; ++q) { const int i = (bt + 1) * 4 + q; g[nb][q] = SGt[i * NTHREADS]; t[nb][q] = first ? (f32x4){0.f, 0.f, 0.f, 0.f} : STt[i * NTHREADS]; } }
            if (last) { U4 for (int bj = 0; bj < 2; ++bj) { const int n = 0; const int r = EPI_ROW, c = EPI_COL;
                    const f32x4 v0 = acc[ai][bj][m][0] * g[cb][bj * 2] + t[cb][bj * 2], v1 = acc[ai][bj][m][1] * g[cb][bj * 2 + 1] + t[cb][bj * 2 + 1];
                    u32x4 w; w.x = cvt_pk_bf16(v0[0], v0[1]); w.y = cvt_pk_bf16(v0[2], v0[3]); w.z = cvt_pk_bf16(v1[0], v1[1]); w.w = cvt_pk_bf16(v1[2], v1[3]); *(u32x4*)(MG + (size_t)r * 1024 + c) = w; } }
            else { U4 for (int q = 0; q < 4; ++q) { const int bj = q >> 1, n = q & 1, i = bt * 4 + q; STt[i * NTHREADS] = acc[ai][bj][m][n] * g[cb][q] + t[cb][q]; } }
        }
    }
};
struct EpiResid {
    const float* xsrc; float* xdst; const float* gate;
    __device__ __forceinline__ void operator()(const AccT& acc, int wr, int wc, int fr, int fq) const {
        { const int tq_ = tidx(); wr = (tq_ >> 8) & 1; wc = (tq_ >> 6) & 3; fr = tq_ & 15; fq = (tq_ >> 4) & 3; }
        f32x4 gc[2][2];
        U4 for (int bj = 0; bj < 2; ++bj) U4 for (int n = 0; n < 2; ++n) gc[bj][n] = *(const f32x4*)(gate + EPI_COL);
        f32x4 xo[2][4];
        { const int ai = 0, m = 0; U4 for (int q = 0; q < 4; ++q) { const int bj = q >> 1, n = q & 1; xo[0][q] = *(const f32x4*)(xsrc + (size_t)EPI_ROW * 1024 + EPI_COL); } }
        U4 for (int bt = 0; bt < 8; ++bt) { const int cb = bt & 1, nb = cb ^ 1;
            if (bt + 1 < 8) { const int ai = (bt + 1) >> 2, m = (bt + 1) & 3; U4 for (int q = 0; q < 4; ++q) { const int bj = q >> 1, n = q & 1; xo[nb][q] = *(const f32x4*)(xsrc + (size_t)EPI_ROW * 1024 + EPI_COL); } }
            { const int ai = bt >> 2, m = bt & 3; U4 for (int q = 0; q < 4; ++q) { const int bj = q >> 1, n = q & 1; *(f32x4*)(xdst + (size_t)EPI_ROW * 1024 + EPI_COL) = xo[cb][q] + gc[bj][n] * acc[ai][bj][m][n]; } }
        }
    }
};
struct EpiSqrelu {
    bf16_t* H; int ldh;
    __device__ __forceinline__ void operator()(const AccT& acc, int wr, int wc, int fr, int fq) const {
        { const int tq_ = tidx(); wr = (tq_ >> 8) & 1; wc = (tq_ >> 6) & 3; fr = tq_ & 15; fq = (tq_ >> 4) & 3; }
        U4 for (int ai = 0; ai < 2; ++ai) U4 for (int m = 0; m < 4; ++m) U4 for (int bj = 0; bj < 2; ++bj) { const int n = 0; const int r = EPI_ROW, c = EPI_COL; f32x4 v0 = acc[ai][bj][m][0], v1 = acc[ai][bj][m][1];
#pragma unroll
            for (int j = 0; j < 4; ++j) { const float t0 = fmaxf(v0[j], 0.f), t1 = fmaxf(v1[j], 0.f); v0[j] = t0 * t0; v1[j] = t1 * t1; }
            u32x4 w; w.x = cvt_pk_bf16(v0[0], v0[1]); w.y = cvt_pk_bf16(v0[2], v0[3]); w.z = cvt_pk_bf16(v1[0], v1[1]); w.w = cvt_pk_bf16(v1[2], v1[3]); *(u32x4*)(H + (size_t)r * ldh + c) = w; }
    }
};

struct XMap { int NT, per_xcd, x, j, bpx;
    __device__ __forceinline__ void init(int bid, int ntt, int nt_) { NT = nt_; per_xcd = (ntt >> 3) * nt_; x = bid & 7; j = bid >> 3; bpx = (int)(gridDim.x >> 3); }
    __device__ __forceinline__ int rounds() const { return j < per_xcd ? (per_xcd - j + bpx - 1) / bpx : 0; }
    __device__ __forceinline__ void get(int i, int& tt, int& nt) const { const int q = i * bpx + j; tt = x + 8 * (q / NT); nt = q % NT; }
};
struct ProgInproj {
    const bf16_t* wt; const bf16_t* wg; const bf16_t* HX; bf16_t* T; bf16_t* PG; const float* biasT; const float* biasG; XMap MA, MB; int rA;
    __device__ __forceinline__ void desc(int i, UDesc& d) const { int tt, nt;
        if (i < rA) { MA.get(i, tt, nt); d.A = (const char*)(wt + (size_t)(nt * 256) * D); d.B = (const char*)(HX + (size_t)(tt * 256) * D); }
        else { MB.get(i - rA, tt, nt); d.A = (const char*)(HX + (size_t)(tt * 256) * D); d.B = (const char*)(wg + (size_t)(nt * 256) * D); }
        d.lda = D; d.ldb = D; d.K = D; }
    __device__ __forceinline__ void epi(int i, const AccT& acc, int wr, int wc, int fr, int fq) const { int tt, nt;
        if (i < rA) { MA.get(i, tt, nt); EpiStoreBf16 E{T + (size_t)(nt * 256) * TOK + (size_t)tt * 256, (size_t)TOK, biasT + nt * 256, true}; E(acc, wr, wc, fr, fq); }
        else { MB.get(i - rA, tt, nt); EpiStoreBf16 E{PG + (size_t)(tt * 256) * NG + nt * 256, (size_t)NG, biasG + nt * 256, false}; E(acc, wr, wc, fr, fq); } }
};
struct ProgMix {
    unsigned char* ws; unsigned char* scr; const float* bgate; unsigned tok0; int l;
    __device__ __forceinline__ void desc(int i, UDesc& d) const { const int nt = i / 6, j = i % 6, X = j >> 1;
        if (!(j & 1)) { d.A = (const char*)(ws + WS_HX) + (size_t)tok0 * D * 2; d.B = (const char*)(ws + WS_WGATE + l * SZ_WGATE) + (size_t)(X * 1024 + nt * 256) * D * 2; d.lda = D; d.ldb = D; d.K = D; }
        else { d.A = X == 0 ? (const char*)(scr + SC_TRY) : (X == 1 ? (const char*)(ws + WS_YG) + (size_t)tok0 * 1024 : (const char*)(scr + SC_TRP));
               d.B = (const char*)(ws + WS_WBR + (size_t)l * 3 * SZ_WBR) + (size_t)X * SZ_WBR + (size_t)(nt * 256) * 1024; d.lda = 512; d.ldb = 512; d.K = 512; } }
    __device__ __forceinline__ void epi(int i, const AccT& acc, int wr, int wc, int fr, int fq) const { const int nt = i / 6, j = i % 6, X = j >> 1;
        if (!(j & 1)) { EpiGate E{(f32x4*)(scr + SC_SG), bgate + X * 1024 + nt * 256}; E(acc, wr, wc, fr, fq); }
        else { EpiBranch E{(const f32x4*)(scr + SC_SG), (f32x4*)(scr + SC_ST), (bf16_t*)(scr + SC_MERGED) + nt * 256, X == 0, X == 2}; E(acc, wr, wc, fr, fq); } }
};
struct ProgResid {
    const bf16_t* A; int lda; const bf16_t* W; int ldw, K; size_t wstep; const float* xsrc; float* xdst; const float* gate;
    __device__ __forceinline__ void desc(int i, UDesc& d) const { d.A = (const char*)A; d.B = (const char*)(W + (size_t)i * wstep); d.lda = lda; d.ldb = ldw; d.K = K; }
    __device__ __forceinline__ void epi(int i, const AccT& acc, int wr, int wc, int fr, int fq) const { EpiResid E{xsrc + i * 256, xdst + i * 256, gate + i * 256}; E(acc, wr, wc, fr, fq); }
};
struct ProgUp {
    const bf16_t* XN; const bf16_t* W; bf16_t* HID;
    __device__ __forceinline__ void desc(int i, UDesc& d) const { d.A = (const char*)XN; d.B = (const char*)(W + (size_t)(i * 256) * D); d.lda = D; d.ldb = D; d.K = D; }
    __device__ __forceinline__ void epi(int i, const AccT& acc, int wr, int wc, int fr, int fq) const { EpiSqrelu E{HID + i * 256, 2048}; E(acc, wr, wc, fr, fq); }
};


struct TileIO { const float* xin; const float* ctxin; float* out; float* ctxs; const float* modl; int l;
    __device__ __forceinline__ const float* src(int tt) const { return tt < 256 ? (l == 0 ? xin : out) + (size_t)tt * 256 * D : ctxin + (size_t)(tt - 256) * 256 * D; }
    __device__ __forceinline__ float* dst(int tt) const { return tt < 256 ? out + (size_t)tt * 256 * D : ctxs + (size_t)(tt - 256) * 256 * D; }
    __device__ __forceinline__ const float* cur(int tt) const { return tt < 256 ? out + (size_t)tt * 256 * D : ctxs + (size_t)(tt - 256) * 256 * D; }
    __device__ __forceinline__ const float* mod(int tt) const { return modl + (size_t)(tt < 256 ? tt >> 3 : 32) * 6144; }
};
struct ProgMix2 {
    unsigned char* ws; unsigned char* stash; const float* bgate; XMap M; int l;
    __device__ __forceinline__ void desc(int ii, UDesc& d) const { int tt, nt; M.get(ii / 6, tt, nt); const int s6 = ii % 6, X = s6 >> 1;
        if (!(s6 & 1)) { d.A = (const char*)(ws + WS_HX) + (size_t)tt * 256 * D * 2; d.B = (const char*)(ws + WS_WGATE + l * SZ_WGATE) + (size_t)(X * 1024 + nt * 256) * D * 2; d.lda = D; d.ldb = D; d.K = D; }
        else { d.A = (const char*)(ws + (X == 0 ? WS_YHY : (X == 1 ? WS_YG : WS_YPL))) + (size_t)tt * 256 * 1024;
               d.B = (const char*)(ws + WS_WBR + (size_t)l * 3 * SZ_WBR) + (size_t)X * SZ_WBR + (size_t)(nt * 256) * 1024; d.lda = 512; d.ldb = 512; d.K = 512; } }
    __device__ __forceinline__ void epi(int ii, const AccT& acc, int wr, int wc, int fr, int fq) const { int tt, nt; M.get(ii / 6, tt, nt); const int s6 = ii % 6, X = s6 >> 1;
        if (!(s6 & 1)) { EpiGate E{(f32x4*)stash, bgate + X * 1024 + nt * 256}; E(acc, wr, wc, fr, fq); }
        else { EpiBranch E{(const f32x4*)stash, (f32x4*)(stash + 262144), (bf16_t*)(ws + WS_MERGED) + (size_t)tt * 256 * 1024 + nt * 256, X == 0, X == 2}; E(acc, wr, wc, fr, fq); } }
};
struct ProgOut2 {
    unsigned char* ws; TileIO io; XMap M; int l;
    __device__ __forceinline__ void desc(int i, UDesc& d) const { int tt, nt; M.get(i, tt, nt);
        d.A = (const char*)(ws + WS_MERGED) + (size_t)tt * 256 * 2048; d.B = (const char*)(ws + WS_WOUT + l * SZ_WOUT) + (size_t)(nt * 256) * D * 2; d.lda = D; d.ldb = D; d.K = D; }
    __device__ __forceinline__ void epi(int i, const AccT& acc, int wr, int wc, int fr, int fq) const { int tt, nt; M.get(i, tt, nt);
        EpiResid E{io.src(tt) + nt * 256, io.dst(tt) + nt * 256, io.mod(tt) + 2048 + nt * 256}; E(acc, wr, wc, fr, fq); }
};
struct ProgUp2 {
    unsigned char* ws; XMap M; int l;
    __device__ __forceinline__ void get(int i, int& tt, int& nt) const { const int ttg = i >> 1, ntg = i & 1; tt = M.x + 8 * (ttg * 4 + (M.j >> 3)); nt = ntg * 8 + (M.j & 7); }
    __device__ __forceinline__ void desc(int i, UDesc& d) const { int tt, nt; get(i, tt, nt);
        d.A = (const char*)(ws + WS_HX) + (size_t)tt * 256 * 2048; d.B = (const char*)(ws + WS_WUP + l * SZ_WUP) + (size_t)(nt * 256) * D * 2; d.lda = D; d.ldb = D; d.K = D; }
    __device__ __forceinline__ void epi(int i, const AccT& acc, int wr, int wc, int fr, int fq) const { int tt, nt; get(i, tt, nt);
        EpiSqrelu E{(bf16_t*)(ws + WS_HID) + (size_t)tt * 256 * DFF + nt * 256, DFF}; E(acc, wr, wc, fr, fq); }
};
struct ProgDown2 {
    unsigned char* ws; TileIO io; XMap M; int l;
    __device__ __forceinline__ void desc(int i, UDesc& d) const { int tt, nt; M.get(i, tt, nt);
        d.A = (const char*)(ws + WS_HID) + (size_t)tt * 256 * DFF * 2; d.B = (const char*)(ws + WS_WDN + l * SZ_WDN) + (size_t)(nt * 256) * DFF * 2; d.lda = DFF; d.ldb = DFF; d.K = DFF; }
    __device__ __forceinline__ void epi(int i, const AccT& acc, int wr, int wc, int fr, int fq) const { int tt, nt; M.get(i, tt, nt);
        EpiResid E{io.cur(tt) + nt * 256, io.dst(tt) + nt * 256, io.mod(tt) + 5120 + nt * 256}; E(acc, wr, wc, fr, fq); }
};

__device__ __forceinline__ void tconv(const float* src, int ld, int c0, int nvalid, int ncols, int K, bf16_t* dst, LAS float* tile) {
    const int tid = tidx(), ntn = ncols / 64, ntile = ntn * (K / 64);
    float v[8];
    { const int t = blockIdx.x; if (t < ntile) { const int k0 = (t / ntn) * 64, n0 = (t % ntn) * 64;
#pragma unroll
        for (int i = 0; i < 8; ++i) { const int k = i * 8 + (tid >> 6), n = tid & 63; v[i] = (n0 + n < nvalid) ? src[(size_t)(k0 + k) * ld + c0 + n0 + n] : 0.f; } } }
    for (int t = blockIdx.x; t < ntile; t += gridDim.x) {
        const int k0 = (t / ntn) * 64, n0 = (t % ntn) * 64;
        __syncthreads();
#pragma unroll
        for (int i = 0; i < 8; ++i) { const int k = i * 8 + (tid >> 6), n = tid & 63; tile[k * 65 + n] = v[i]; }
        { const int t2 = t + gridDim.x; if (t2 < ntile) { const int k2 = (t2 / ntn) * 64, n2 = (t2 % ntn) * 64;
#pragma unroll
            for (int i = 0; i < 8; ++i) { const int k = i * 8 + (tid >> 6), n = tid & 63; v[i] = (n2 + n < nvalid) ? src[(size_t)(k2 + k) * ld + c0 + n2 + n] : 0.f; } } }
        __syncthreads();
        const int n = tid >> 3, kc = (tid & 7) * 8;
        u32x4 w;
        w.x = cvt_pk_bf16(tile[(kc + 0) * 65 + n], tile[(kc + 1) * 65 + n]); w.y = cvt_pk_bf16(tile[(kc + 2) * 65 + n], tile[(kc + 3) * 65 + n]);
        w.z = cvt_pk_bf16(tile[(kc + 4) * 65 + n], tile[(kc + 5) * 65 + n]); w.w = cvt_pk_bf16(tile[(kc + 6) * 65 + n], tile[(kc + 7) * 65 + n]);
        *(u32x4*)(dst + (size_t)(n0 + n) * K + k0 + kc) = w;
    }
    __syncthreads();
}

__device__ __forceinline__ void job_poolcomb(const Params& p, int l) {
    const float* pw = p.in[I_PW] + (size_t)l * 4 * 128 * 128; const float* sc = p.in[I_PSC] + l * 512; const float* wb = p.in[I_WBP] + (size_t)l * 512 * 1024;
    bf16_t* dst = (bf16_t*)(p.ws + WS_WBR + (size_t)(l * 3 + 2) * SZ_WBR);
    for (int idx = blockIdx.x * NTHREADS + tidx(); idx < 512 * 256; idx += gridDim.x * NTHREADS) {
        const int n = (idx & 255) * 4, k = idx >> 8, g = k >> 7, c = k & 127;
        f32x4 a = (f32x4){0.f, 0.f, 0.f, 0.f};
#pragma unroll 8
        for (int d = 0; d < 128; ++d) { const float ps = pw[(g * 128 + c) * 128 + d] * sc[g * 128 + d]; a += ps * *(const f32x4*)(wb + (size_t)(g * 128 + d) * 1024 + n); }
        dst[(size_t)n * 512 + k] = f2bf(a[0]); dst[(size_t)(n + 1) * 512 + k] = f2bf(a[1]); dst[(size_t)(n + 2) * 512 + k] = f2bf(a[2]); dst[(size_t)(n + 3) * 512 + k] = f2bf(a[3]);
    }
}

__device__ __forceinline__ void job_bias(const Params& p) {
    float* bias = (float*)(p.ws + WS_BIAS);
    for (int idx = blockIdx.x * NTHREADS + tidx(); idx < 2 * (NTR + NG); idx += gridDim.x * NTHREADS) {
        const int l = idx / (NTR + NG), j = idx % (NTR + NG); const float* b = p.in[I_BIN] + l * N_IN;
        float v;
        if (j < 1536) v = b[j]; else if (j < NTR) v = b[POOL_OFF + (j - 1536)]; else { const int q = j - NTR; v = q < NGV ? b[GLA_OFF + q] : 0.f; }
        bias[idx] = v;
    }
}

__device__ __forceinline__ void job_mod(const Params& p, LAS float* sil) {
    if (blockIdx.x >= 192) return;
    const int tid = tidx(), lane = tid & 63, kg = tid >> 6;
    float* mod = (float*)(p.ws + WS_MOD);
    for (int it = blockIdx.x; it < 192; it += gridDim.x) {
        __syncthreads();
        for (int idx = tid; idx < 33 * 1024; idx += NTHREADS) { const int r = idx >> 10, k = idx & 1023; const float v = r < 32 ? p.in[I_C][r * 1024 + k] : p.in[I_CCTX][k]; sil[idx] = v / (1.f + expf(-v)); }
        __syncthreads();
        const int l = it / 96, n0 = (it % 96) * 64;
        const float* w = p.in[I_WMOD] + (size_t)l * 1024 * 6144 + n0 + lane;
        float acc[33];
#pragma unroll
        for (int r = 0; r < 33; ++r) acc[r] = 0.f;
#pragma unroll 2
        for (int k4 = 0; k4 < 32; ++k4) { const int k = kg * 128 + k4 * 4;
            const float w0 = w[(size_t)k * 6144], w1 = w[(size_t)(k + 1) * 6144], w2 = w[(size_t)(k + 2) * 6144], w3 = w[(size_t)(k + 3) * 6144];
#pragma unroll
            for (int r = 0; r < 33; ++r) { const f32x4 sv = *(const LAS f32x4*)(sil + r * 1024 + k); acc[r] += sv[0] * w0 + sv[1] * w1 + sv[2] * w2 + sv[3] * w3; } }
        __syncthreads();
#pragma unroll
        for (int r = 0; r < 33; ++r) sil[(kg * 33 + r) * 64 + lane] = acc[r];
        __syncthreads();
        const float bm = p.in[I_BMOD][l * 6144 + n0 + lane];
        for (int r = kg; r < 33; r += 8) { float sum = 0.f;
#pragma unroll
            for (int q = 0; q < 8; ++q) sum += sil[(q * 33 + r) * 64 + lane];
            mod[(size_t)l * 33 * 6144 + (size_t)r * 6144 + n0 + lane] = sum + bm; }
    }
    __syncthreads();
}

__device__ __forceinline__ void job_filters(const Params& p, LAS unsigned char* lds) {
    LAS float* a1 = (LAS float*)lds;
    LAS float* a2 = (LAS float*)(lds + 16384);
    LAS bf16_t* oT = (LAS bf16_t*)(lds + 16384 + 16640);
    LAS float* w2L = (LAS float*)(lds + 16384 + 16640 + 73728);
    const int tid = tidx();
    const int nitems = (32 + 4 + 32) * 4;
    const int nrep = gridDim.x == 256 ? 2 : (nitems + (int)gridDim.x - 1) / (int)gridDim.x;
    for (int rep = 0; rep < nrep; ++rep) {
        int it;
        if (gridDim.x == 256) it = rep == 0 ? (int)blockIdx.x : ((blockIdx.x >= 192 && blockIdx.x < 208) ? 256 + (int)blockIdx.x - 192 : -1);
        else it = (int)blockIdx.x + rep * (int)gridDim.x;
        if (it < 0 || it >= nitems) continue;
        const int oc = it & 3; int rt = it >> 2; int l, L, t0; bf16_t* dst;
        if (rt < 32) { l = 0; L = 2048; t0 = rt * 64; dst = (bf16_t*)(p.ws + WS_HFL); }
        else if (rt < 36) { l = 0; L = 256; t0 = (rt - 32) * 64; dst = (bf16_t*)(p.ws + WS_HFC); }
        else { l = 1; L = 2048; t0 = (rt - 36) * 64; dst = (bf16_t*)(p.ws + WS_HFL) + (size_t)4 * 512 * 2048; }
        const float* w1 = p.in[I_FW1] + l * 17 * 64; const float* b1 = p.in[I_FB1] + l * 64; const float* fq = p.in[I_FFREQ] + l * 64;
        const float* w2 = p.in[I_FW2] + l * 64 * 64; const float* b2 = p.in[I_FB2] + l * 64; const float* w3 = p.in[I_FW3] + (size_t)l * 64 * 2048;
        __syncthreads();
#pragma unroll
        for (int q = 0; q < 2; ++q) *(LAS f32x4*)(w2L + (tid + q * NTHREADS) * 4) = *(const f32x4*)(w2 + (tid + q * NTHREADS) * 4);
        { const int row = tid >> 3, jg = (tid & 7) * 8; const float t = (float)(t0 + row); float z[17];
          z[0] = t / (float)L;
#pragma unroll
          for (int bnd = 1; bnd <= 8; ++bnd) { const float ang = (6.283185307179586f / (float)L) * t * (float)bnd; z[bnd] = cosf(ang); z[8 + bnd] = sinf(ang); }
#pragma unroll
          for (int j = 0; j < 8; ++j) { float s_ = b1[jg + j];
#pragma unroll
              for (int i = 0; i < 17; ++i) s_ += z[i] * w1[i * 64 + jg + j];
              a1[row * 64 + jg + j] = sinf(fq[jg + j] * s_); } }
        __syncthreads();
        { const int row = tid >> 3, jg = (tid & 7) * 8; float acc8[8];
#pragma unroll
          for (int j = 0; j < 8; ++j) acc8[j] = b2[jg + j];
#pragma unroll 4
          for (int i4 = 0; i4 < 64; i4 += 4) { const f32x4 av = *(const LAS f32x4*)(a1 + row * 64 + i4);
#pragma unroll
              for (int ii = 0; ii < 4; ++ii) { const f32x4 wa = *(const LAS f32x4*)(w2L + (i4 + ii) * 64 + jg), wb = *(const LAS f32x4*)(w2L + (i4 + ii) * 64 + jg + 4);
                  acc8[0] += av[ii] * wa[0]; acc8[1] += av[ii] * wa[1]; acc8[2] += av[ii] * wa[2]; acc8[3] += av[ii] * wa[3];
                  acc8[4] += av[ii] * wb[0]; acc8[5] += av[ii] * wb[1]; acc8[6] += av[ii] * wb[2]; acc8[7] += av[ii] * wb[3]; } }
#pragma unroll
          for (int j = 0; j < 8; ++j) a2[row * 65 + jg + j] = sinf(fq[jg + j] * acc8[j]); }
        __syncthreads();
        { const int o = oc * 512 + tid, c = o & 511; float wreg[64];
#pragma unroll
          for (int j = 0; j < 64; ++j) wreg[j] = w3[(size_t)j * 2048 + o];
          const float delta = 3.0701134573253943f + (float)c * ((15.350567286626972f - 3.0701134573253943f) / 511.f);
          for (int row = 0; row < 64; ++row) { float s = 0.f;
#pragma unroll
              for (int j = 0; j < 64; ++j) s += a2[row * 65 + j] * wreg[j];
              const float win = expf(-((float)(t0 + row) / (float)L) * delta);
              oT[tid * 72 + row] = f2bf(s * win); } }
        __syncthreads();
        for (int q = tid; q < 4096; q += NTHREADS) { const int ol = q >> 3, ch = (q & 7) * 8; const int o = oc * 512 + ol, dir = o >> 10, ord = (o >> 9) & 1, c = o & 511;
            const u32x4 w = *(const LAS u32x4*)(oT + ol * 72 + ch);
            *(u32x4*)(dst + ((size_t)((ord * 2 + dir) * 512 + c)) * L + t0 + ch) = w; }
    }
    __syncthreads();
}

__device__ __forceinline__ void ada_write(const f32x4 (&v)[4], float inv, const float* g, const float* sh, const float* sc, bf16_t* dst, float* fdst, int lane) {
#pragma unroll
    for (int i = 0; i < 4; ++i) { const int c = i * 256 + lane * 4; const f32x4 gg = *(const f32x4*)(g + c); f32x4 y = v[i] * inv * gg;
        if (sh) { const f32x4 s1 = *(const f32x4*)(sc + c), s0 = *(const f32x4*)(sh + c); y = y * (1.f + s1) + s0;
            u32x2 w; w.x = cvt_pk_bf16(y[0], y[1]); w.y = cvt_pk_bf16(y[2], y[3]); *(u32x2*)(dst + c) = w; }
        else *(f32x4*)(fdst + c) = y; }
}
__device__ __forceinline__ void ada_row2(const float* xa, const float* xb, bool hb, const float* g, const float* sha, const float* sca, const float* shb, const float* scb,
                                         bf16_t* da, bf16_t* db, float* fa, float* fb, int lane) {
    f32x4 va[4], vb[4]; float sa = 0.f, sb = 0.f;
#pragma unroll
    for (int i = 0; i < 4; ++i) va[i] = *(const f32x4*)(xa + i * 256 + lane * 4);
#pragma unroll
    for (int i = 0; i < 4; ++i) vb[i] = hb ? *(const f32x4*)(xb + i * 256 + lane * 4) : (f32x4){0.f, 0.f, 0.f, 0.f};
#pragma unroll
    for (int i = 0; i < 4; ++i) { sa += va[i][0] * va[i][0] + va[i][1] * va[i][1] + va[i][2] * va[i][2] + va[i][3] * va[i][3]; sb += vb[i][0] * vb[i][0] + vb[i][1] * vb[i][1] + vb[i][2] * vb[i][2] + vb[i][3] * vb[i][3]; }
#pragma unroll
    for (int o = 32; o >= 1; o >>= 1) { sa += __shfl_xor(sa, o); sb += __shfl_xor(sb, o); }
    ada_write(va, rsqrtf(sa * (1.f / 1024.f) + EPS), g, sha, sca, da, fa, lane);
    if (hb) ada_write(vb, rsqrtf(sb * (1.f / 1024.f) + EPS), g, shb, scb, db, fb, lane);
}
__device__ __forceinline__ void ada_row(const float* x, const float* g, const float* sh, const float* sc, bf16_t* dst, float* fdst, int lane) {
    f32x4 v[4]; float ss = 0.f;
#pragma unroll
    for (int i = 0; i < 4; ++i) { v[i] = *(const f32x4*)(x + i * 256 + lane * 4); ss += v[i][0] * v[i][0] + v[i][1] * v[i][1] + v[i][2] * v[i][2] + v[i][3] * v[i][3]; }
    ss = wave_sum(ss);
    const float inv = rsqrtf(ss * (1.f / 1024.f) + EPS);
#pragma unroll
    for (int i = 0; i < 4; ++i) { const int c = i * 256 + lane * 4; const f32x4 gg = *(const f32x4*)(g + c); f32x4 y = v[i] * inv * gg;
        if (sh) { const f32x4 s1 = *(const f32x4*)(sc + c), s0 = *(const f32x4*)(sh + c); y = y * (1.f + s1) + s0;
            u32x2 w; w.x = cvt_pk_bf16(y[0], y[1]); w.y = cvt_pk_bf16(y[2], y[3]); *(u32x2*)(dst + c) = w; }
        else *(f32x4*)(fdst + c) = y; }
}

typedef float f32x16 __attribute__((ext_vector_type(16)));
template <int L, int NT>
__device__ __forceinline__ void hyena_mfma(const Params& p, int l, int c, bool ctx, LAS unsigned char* lds) {
    LAS unsigned char* U = lds;
    LAS unsigned* F = (LAS unsigned*)(lds + L * 64);
    LAS bf16_t* F16 = (LAS bf16_t*)F;
    const int tid = tidx(), lane = tid & 63, w = __builtin_amdgcn_readfirstlane(tid >> 6), li = lane & 31, kg = lane >> 5;
    bf16_t* T = (bf16_t*)(p.ws + WS_T);
    const size_t tokb = ctx ? (size_t)TOKL : 0;
    const bf16_t* hf = ctx ? (const bf16_t*)(p.ws + WS_HFC) : (const bf16_t*)(p.ws + WS_HFL) + (size_t)l * 4 * 512 * 2048;
    const float* sw = p.in[I_HSW] + (size_t)l * 3 * 1536; const float* sb = p.in[I_HSB] + l * 1536;
    __syncthreads();
    {
        const int cc = 1024 + c; const bf16_t* row = T + (size_t)cc * TOK + tokb;
        const float w0 = sw[cc], w1 = sw[1536 + cc], w2 = sw[3072 + cc], bb = sb[cc];
        constexpr int ITER = L / 128, BATCH = ITER >= 4 ? 4 : ITER;
        for (int it0 = 0; it0 < ITER; it0 += BATCH) {
            u32x4 rr[BATCH]; bf16_t hm[BATCH], hp[BATCH];
#pragma unroll
            for (int q = 0; q < BATCH; ++q) { const int idx = tid + (it0 + q) * NTHREADS, bq = idx & 31, t8 = idx >> 5; const bf16_t* pr = row + (size_t)bq * L + t8 * 8;
                rr[q] = *(const u32x4*)pr; hm[q] = t8 > 0 ? pr[-1] : (bf16_t)0; hp[q] = t8 < L / 8 - 1 ? pr[8] : (bf16_t)0; }
#pragma unroll
            for (int q = 0; q < BATCH; ++q) { const int idx = tid + (it0 + q) * NTHREADS; const u32x4 r = rr[q];
                float x[10]; x[0] = bf2f(hm[q]); x[9] = bf2f(hp[q]);
                x[1] = lo16(r.x); x[2] = hi16(r.x); x[3] = lo16(r.y); x[4] = hi16(r.y); x[5] = lo16(r.z); x[6] = hi16(r.z); x[7] = lo16(r.w); x[8] = hi16(r.w);
                float y[8];
#pragma unroll
                for (int j = 0; j < 8; ++j) y[j] = w0 * x[j] + w1 * x[j + 1] + w2 * x[j + 2] + bb;
                u32x4 o; o.x = cvt_pk_bf16(y[0], y[1]); o.y = cvt_pk_bf16(y[2], y[3]); o.z = cvt_pk_bf16(y[4], y[5]); o.w = cvt_pk_bf16(y[6], y[7]);
                *(LAS u32x4*)(U + (size_t)idx * 16) = o; }
        }
    }
    const int lane_dw = (li & 1) * L + ((8 * kg - li + L - (li & 1)) >> 1);
#define HY_LOADA(dst, f) do { const LAS unsigned* _q = F + (lane_dw - 8 * (f)); u32x4 _v; _v.x = _q[0]; _v.y = _q[1]; _v.z = _q[2]; _v.w = _q[3]; dst = __builtin_bit_cast(bf16x8, _v); } while (0)
#define HY_LOADB(dst, s0) dst = *(const LAS bf16x8*)(U + ((s0) >> 3) * 512 + lane * 16)
    for (int ord = 0; ord < 2; ++ord) {
        __syncthreads();
        for (int x0 = tid; x0 < 2 * L; x0 += 4 * NTHREADS) {
            bf16_t fv[4];
#pragma unroll
            for (int q = 0; q < 4; ++q) { const int x = x0 + q * NTHREADS; bf16_t v = 0;
                if (x >= 1 && x <= L) v = hf[((size_t)((ord * 2 + 0) * 512 + c)) * L + (L - x)];
                else if (x > L && x < 2 * L) v = hf[((size_t)((ord * 2 + 1) * 512 + c)) * L + (x - L)];
                fv[q] = v; }
#pragma unroll
            for (int q = 0; q < 4; ++q) { const int x = x0 + q * NTHREADS; const bf16_t v = fv[q];
                if (x < 2 * L) { F16[x] = v; if (x >= 1) F16[2 * L + x - 1] = v; if (x == 2 * L - 1) F16[4 * L - 1] = 0; } } }
        if (false) for (int x = tid; x < 0; ++x) {
            bf16_t v = 0;
            if (x >= 1 && x <= L) v = hf[((size_t)((ord * 2 + 0) * 512 + c)) * L + (L - x)];
            else if (x > L) v = hf[((size_t)((ord * 2 + 1) * 512 + c)) * L + (x - L)];
            F16[x] = v; if (x >= 1) F16[2 * L + x - 1] = v; if (x == 2 * L - 1) F16[4 * L - 1] = 0; }
        __syncthreads();
        f32x16 acc[NT];
#pragma unroll
        for (int i = 0; i < NT; ++i)
#pragma unroll
            for (int r = 0; r < 16; ++r) acc[i][r] = 0.f;
        bf16x8 E[NT], O[NT];
#pragma unroll
        for (int i = 1; i < NT; ++i) { HY_LOADA(E[i], 2 * (NT * w + i)); HY_LOADA(O[i], 2 * (NT * w + i) - 1); }
        for (int n8 = 0; n8 < L / 32; n8 += 8) {
#pragma unroll
            for (int u = 0; u < 8; ++u) { const int n = n8 + u; const int fe = 2 * (NT * w - n); bf16x8 Bf;
                HY_LOADA(E[(8 - u) & (NT - 1)], fe); HY_LOADB(Bf, 32 * n);
#pragma unroll
                for (int i = 0; i < NT; ++i) acc[i] = __builtin_amdgcn_mfma_f32_32x32x16_bf16(E[(i - u) & (NT - 1)], Bf, acc[i], 0, 0, 0);
                HY_LOADA(O[(8 - u) & (NT - 1)], fe - 1); HY_LOADB(Bf, 32 * n + 16);
#pragma unroll
                for (int i = 0; i < NT; ++i) acc[i] = __builtin_amdgcn_mfma_f32_32x32x16_bf16(O[(i - u) & (NT - 1)], Bf, acc[i], 0, 0, 0);
            }
        }
        __syncthreads();
        const int lane2 = tidx() & 63, li = lane2 & 31, kg = lane2 >> 5;
        const int xc = ord * 512 + c; const bf16_t* xrow = T + (size_t)xc * TOK + tokb + (size_t)li * L;
        bf16_t* orow = T + (size_t)c * TOK + tokb + (size_t)li * L;
        const float w0 = sw[xc], w1 = sw[1536 + xc], w2 = sw[3072 + xc], bb = sb[xc], sk = p.in[I_HSKIP][(l * 2 + ord) * 512 + c];
#pragma unroll
        for (int i = 0; i < NT; ++i) {
#pragma unroll
            for (int rh = 0; rh < 4; rh += 2) {
            u32x2 xr4[2]; bf16_t hm[2], hp[2];
#pragma unroll
            for (int r2 = 0; r2 < 2; ++r2) { const int rg = rh + r2; const int tb = 32 * (NT * w + i) + 8 * rg + 4 * kg;
                xr4[r2] = *(const u32x2*)(xrow + tb); hm[r2] = tb > 0 ? xrow[tb - 1] : (bf16_t)0; hp[r2] = tb + 4 < L ? xrow[tb + 4] : (bf16_t)0; }
#pragma unroll
            for (int r2 = 0; r2 < 2; ++r2) { const int rg = rh + r2; const int tb = 32 * (NT * w + i) + 8 * rg + 4 * kg; const u32x2 xr = xr4[r2];
                float x[6]; x[0] = bf2f(hm[r2]); x[5] = bf2f(hp[r2]);
                x[1] = lo16(xr.x); x[2] = hi16(xr.x); x[3] = lo16(xr.y); x[4] = hi16(xr.y);
                LAS u32x2* up = (LAS u32x2*)(U + ((tb >> 3) * 32 + li) * 16 + (tb & 7) * 2);
                const u32x2 uv = *up; const float uu[4] = {lo16(uv.x), hi16(uv.x), lo16(uv.y), hi16(uv.y)};
                float z[4];
#pragma unroll
                for (int j = 0; j < 4; ++j) z[j] = (w0 * x[j] + w1 * x[j + 1] + w2 * x[j + 2] + bb) * (acc[i][rg * 4 + j] + sk * uu[j]);
                u32x2 o; o.x = cvt_pk_bf16(z[0], z[1]); o.y = cvt_pk_bf16(z[2], z[3]);
                if (ord == 0) *up = o; else *(u32x2*)(orow + tb) = o; }
            }
        }
    }
#undef HY_LOADA
#undef HY_LOADB
    __syncthreads();
}

__device__ __forceinline__ void gla_item(const Params& p, int l, int b, int h, int dir, LAS float* lf) {
    const int tid = tidx(), qd = tid & 3, dv = tid >> 2;
    LAS float* qL = lf; LAS float* kL = lf + 2048; LAS float* aL = lf + 4096; LAS float* vL = lf + 6144; LAS float* oL = lf + 10240; LAS float* waL = lf + 14336; LAS float* baL = lf + 15360;
    const bf16_t* PG = (const bf16_t*)(p.ws + WS_PG);
    bf16_t* O = (bf16_t*)(p.ws + WS_OF) + (size_t)dir * TOK * 512;
    const float* wa = (dir ? p.in[I_WAB] : p.in[I_WAF]) + l * 16 * 256; const float* ba = (dir ? p.in[I_BAB] : p.in[I_BAF]) + l * 256;
    __syncthreads();
    for (int i = tid; i < 1024; i += NTHREADS) waL[i] = wa[(i >> 6) * 256 + h * 64 + (i & 63)];
    if (tid < 64) baL[tid] = ba[h * 64 + tid];
    float S[16];
#pragma unroll
    for (int i = 0; i < 16; ++i) S[i] = 0.f;
    const int sp = tid >> 4, sc4 = (tid & 15) * 4, sc8 = (tid & 15) * 8;
    for (int ck = 0; ck < 72; ++ck) {
        const int P = ck * 32 + sp; size_t row;
        if (P < 256) row = (size_t)TOKL + b * 256 + (dir ? 255 - P : P); else { const int tl = P - 256; row = (size_t)b * 2048 + (dir ? 2047 - tl : tl); }
        const bf16_t* pr = PG + row * NG;
        __syncthreads();
        { const u32x2 wq = *(const u32x2*)(pr + h * 64 + sc4), wk = *(const u32x2*)(pr + 256 + h * 64 + sc4);
          *(LAS f32x4*)(qL + sp * 64 + sc4) = (f32x4){lo16(wq.x) * 0.125f, hi16(wq.x) * 0.125f, lo16(wq.y) * 0.125f, hi16(wq.y) * 0.125f};
          *(LAS f32x4*)(kL + sp * 64 + sc4) = (f32x4){lo16(wk.x), hi16(wk.x), lo16(wk.y), hi16(wk.y)};
          const u32x4 wv = *(const u32x4*)(pr + 512 + h * 128 + sc8);
          *(LAS f32x4*)(vL + sp * 128 + sc8) = (f32x4){lo16(wv.x), hi16(wv.x), lo16(wv.y), hi16(wv.y)};
          *(LAS f32x4*)(vL + sp * 128 + sc8 + 4) = (f32x4){lo16(wv.z), hi16(wv.z), lo16(wv.w), hi16(wv.w)};
          const u32x4 g0 = *(const u32x4*)(pr + 1536 + dir * 16), g1 = *(const u32x4*)(pr + 1536 + dir * 16 + 8);
          float gt[16] = {lo16(g0.x), hi16(g0.x), lo16(g0.y), hi16(g0.y), lo16(g0.z), hi16(g0.z), lo16(g0.w), hi16(g0.w),
                          lo16(g1.x), hi16(g1.x), lo16(g1.y), hi16(g1.y), lo16(g1.z), hi16(g1.z), lo16(g1.w), hi16(g1.w)};
#pragma unroll
          for (int j = 0; j < 4; ++j) { float z = baL[sc4 + j];
#pragma unroll
              for (int r = 0; r < 16; ++r) z += gt[r] * waL[r * 64 + sc4 + j];
              const float ls = -(fmaxf(-z, 0.f) + log1pf(expf(-fabsf(z))));
              aL[sp * 64 + sc4 + j] = expf(ls * (1.f / 16.f)); } }
        __syncthreads();
        for (int pos = 0; pos < 32; ++pos) {
            const float vv = vL[pos * 128 + dv]; float part = 0.f;
#pragma unroll
            for (int i4 = 0; i4 < 4; ++i4) { const f32x4 aa = *(const LAS f32x4*)(aL + pos * 64 + qd * 16 + i4 * 4), kk = *(const LAS f32x4*)(kL + pos * 64 + qd * 16 + i4 * 4), qq = *(const LAS f32x4*)(qL + pos * 64 + qd * 16 + i4 * 4);
#pragma unroll
                for (int j = 0; j < 4; ++j) { S[i4 * 4 + j] = aa[j] * S[i4 * 4 + j] + kk[j] * vv; part += qq[j] * S[i4 * 4 + j]; } }
            part += __shfl_xor(part, 1); part += __shfl_xor(part, 2);
            if (qd == 0) oL[pos * 128 + dv] = part;
        }
        __syncthreads();
        { const f32x4 o0 = *(const LAS f32x4*)(oL + sp * 128 + sc8), o1 = *(const LAS f32x4*)(oL + sp * 128 + sc8 + 4);
          u32x4 w; w.x = cvt_pk_bf16(o0[0], o0[1]); w.y = cvt_pk_bf16(o0[2], o0[3]); w.z = cvt_pk_bf16(o1[0], o1[1]); w.w = cvt_pk_bf16(o1[2], o1[3]);
          *(u32x4*)(O + row * 512 + h * 128 + sc8) = w; }
    }
    __syncthreads();
}


__device__ __forceinline__ size_t gla_row(int P, int b, int dir) { return P < 256 ? (size_t)TOKL + b * 256 + (dir ? 255 - P : P) : (size_t)b * 2048 + (dir ? 2047 - (P - 256) : (P - 256)); }
__device__ __forceinline__ void gla_chunk_item(const Params& p, int l, int b, int h, int dir, LAS unsigned char* lds) {
    constexpr int RS = 72;
    LAS bf16_t* QD = (LAS bf16_t*)lds; LAS bf16_t* KI = QD + 64 * RS; LAS bf16_t* KET = KI + 64 * RS; LAS bf16_t* PP = KET + 64 * RS;
    LAS bf16_t* VT = PP + 64 * RS; LAS bf16_t* ST = VT + 128 * RS;
    LAS float* TOT = (LAS float*)(ST + 128 * RS); LAS float* DEC = TOT + 512; LAS float* WAL = DEC + 64; LAS float* BAL = WAL + 1024;
    const int tid = tidx(), lane = tid & 63, w = __builtin_amdgcn_readfirstlane(tid >> 6), i = tid >> 3, dg = tid & 7, d0 = dg * 8, l5 = lane & 31, hh = lane >> 5;
    const int ih = w >> 2, vq = w & 3;
    const bf16_t* PG = (const bf16_t*)(p.ws + WS_PG);
    bf16_t* O = (bf16_t*)(p.ws + WS_OF) + (size_t)dir * TOK * 512;
    const float* wa = (dir ? p.in[I_WAB] : p.in[I_WAF]) + l * 16 * 256; const float* ba = (dir ? p.in[I_BAB] : p.in[I_BAF]) + l * 256;
    __syncthreads();
    for (int q = tid; q < 1024; q += NTHREADS) WAL[q] = wa[(q >> 6) * 256 + h * 64 + (q & 63)];
    if (tid < 64) BAL[tid] = ba[h * 64 + tid];
    for (int q = tid; q < 73728 / 16; q += NTHREADS) *(LAS u32x4*)(lds + q * 16) = (u32x4){0u, 0u, 0u, 0u};
    f32x16 accS;
#pragma unroll
    for (int r = 0; r < 16; ++r) accS[r] = 0.f;
    u32x4 rq, rk, rg0, rg1, rv0, rv1;
    { const bf16_t* pr = PG + gla_row(i, b, dir) * NG;
      rq = *(const u32x4*)(pr + h * 64 + d0); rk = *(const u32x4*)(pr + 256 + h * 64 + d0); rg0 = *(const u32x4*)(pr + 1536 + dir * 16); rg1 = *(const u32x4*)(pr + 1536 + dir * 16 + 8);
      rv0 = *(const u32x4*)(pr + 512 + h * 128 + dg * 16); rv1 = *(const u32x4*)(pr + 512 + h * 128 + dg * 16 + 8); }
    __syncthreads();
    for (int ck = 0; ck < 36; ++ck) {
        float qf[8] = {lo16(rq.x), hi16(rq.x), lo16(rq.y), hi16(rq.y), lo16(rq.z), hi16(rq.z), lo16(rq.w), hi16(rq.w)};
        float kf[8] = {lo16(rk.x), hi16(rk.x), lo16(rk.y), hi16(rk.y), lo16(rk.z), hi16(rk.z), lo16(rk.w), hi16(rk.w)};
        float gt[16] = {lo16(rg0.x), hi16(rg0.x), lo16(rg0.y), hi16(rg0.y), lo16(rg0.z), hi16(rg0.z), lo16(rg0.w), hi16(rg0.w),
                        lo16(rg1.x), hi16(rg1.x), lo16(rg1.y), hi16(rg1.y), lo16(rg1.z), hi16(rg1.z), lo16(rg1.w), hi16(rg1.w)};
        float la[8];
#pragma unroll
        for (int j = 0; j < 8; ++j) { float z = BAL[d0 + j];
#pragma unroll
            for (int r = 0; r < 16; ++r) z += gt[r] * WAL[r * 64 + d0 + j];
            la[j] = -(fmaxf(-z, 0.f) + __logf(1.f + __expf(-fabsf(z)))) * (1.f / 16.f); }
#pragma unroll
        for (int st = 8; st < 64; st <<= 1) {
#pragma unroll
            for (int j = 0; j < 8; ++j) { const float y = __shfl_up(la[j], st); if (lane >= st) la[j] += y; } }
        if ((lane >> 3) == 7) { *(LAS f32x4*)(TOT + w * 64 + d0) = (f32x4){la[0], la[1], la[2], la[3]}; *(LAS f32x4*)(TOT + w * 64 + d0 + 4) = (f32x4){la[4], la[5], la[6], la[7]}; }
        __syncthreads();
        {
            float pre[8], bl[8];
#pragma unroll
            for (int j = 0; j < 8; ++j) { pre[j] = 0.f; bl[j] = 0.f; }
#pragma unroll
            for (int ww = 0; ww < 8; ++ww) { const f32x4 t0 = *(const LAS f32x4*)(TOT + ww * 64 + d0), t1 = *(const LAS f32x4*)(TOT + ww * 64 + d0 + 4);
                const float tv[8] = {t0[0], t0[1], t0[2], t0[3], t1[0], t1[1], t1[2], t1[3]};
#pragma unroll
                for (int j = 0; j < 8; ++j) { bl[j] += tv[j]; if (ww < w) pre[j] += tv[j]; } }
            float qd[8], ki[8], ke[8], eb[8];
#pragma unroll
            for (int j = 0; j < 8; ++j) { const float bc = la[j] + pre[j]; const float e1 = __expf(bc), e2 = __builtin_amdgcn_rcpf(e1); eb[j] = __expf(bl[j]);
                qd[j] = qf[j] * 0.125f * e1; ki[j] = kf[j] * e2; ke[j] = kf[j] * (eb[j] * e2); }
            u32x4 wq, wk;
            wq.x = cvt_pk_bf16(qd[0], qd[1]); wq.y = cvt_pk_bf16(qd[2], qd[3]); wq.z = cvt_pk_bf16(qd[4], qd[5]); wq.w = cvt_pk_bf16(qd[6], qd[7]);
            wk.x = cvt_pk_bf16(ki[0], ki[1]); wk.y = cvt_pk_bf16(ki[2], ki[3]); wk.z = cvt_pk_bf16(ki[4], ki[5]); wk.w = cvt_pk_bf16(ki[6], ki[7]);
            *(LAS u32x4*)(QD + i * RS + d0) = wq; *(LAS u32x4*)(KI + i * RS + d0) = wk;
#pragma unroll
            for (int j = 0; j < 8; j += 2) { const unsigned pk = cvt_pk_bf16(ke[j], ke[j + 1]); KET[(d0 + j) * RS + i] = (bf16_t)(pk & 0xffffu); KET[(d0 + j + 1) * RS + i] = (bf16_t)(pk >> 16); }
            const unsigned vv[8] = {rv0.x, rv0.y, rv0.z, rv0.w, rv1.x, rv1.y, rv1.z, rv1.w};
#pragma unroll
            for (int j = 0; j < 8; ++j) { VT[(dg * 16 + 2 * j) * RS + i] = (bf16_t)(vv[j] & 0xffffu); VT[(dg * 16 + 2 * j + 1) * RS + i] = (bf16_t)(vv[j] >> 16); }
            if (i == 0) { *(LAS f32x4*)(DEC + d0) = (f32x4){eb[0], eb[1], eb[2], eb[3]}; *(LAS f32x4*)(DEC + d0 + 4) = (f32x4){eb[4], eb[5], eb[6], eb[7]}; }
        }
        if (ck + 1 < 36) { const bf16_t* pr = PG + gla_row((ck + 1) * 64 + i, b, dir) * NG;
            rq = *(const u32x4*)(pr + h * 64 + d0); rk = *(const u32x4*)(pr + 256 + h * 64 + d0); rg0 = *(const u32x4*)(pr + 1536 + dir * 16); rg1 = *(const u32x4*)(pr + 1536 + dir * 16 + 8);
            rv0 = *(const u32x4*)(pr + 512 + h * 128 + dg * 16); rv1 = *(const u32x4*)(pr + 512 + h * 128 + dg * 16 + 8); }
        __syncthreads();
        f32x16 accO;
#pragma unroll
        for (int r = 0; r < 16; ++r) accO[r] = 0.f;
#pragma unroll
        for (int ks = 0; ks < 4; ++ks) { const bf16x8 A = *(const LAS bf16x8*)(QD + (ih * 32 + l5) * RS + ks * 16 + hh * 8), Bv = *(const LAS bf16x8*)(ST + (vq * 32 + l5) * RS + ks * 16 + hh * 8);
            accO = __builtin_amdgcn_mfma_f32_32x32x16_bf16(A, Bv, accO, 0, 0, 0); }
        if (w < 3) { const int si = w == 0 ? 0 : 1, sj = w == 2 ? 1 : 0; f32x16 accP;
#pragma unroll
            for (int r = 0; r < 16; ++r) accP[r] = 0.f;
#pragma unroll
            for (int ks = 0; ks < 4; ++ks) { const bf16x8 A = *(const LAS bf16x8*)(QD + (si * 32 + l5) * RS + ks * 16 + hh * 8), Bv = *(const LAS bf16x8*)(KI + (sj * 32 + l5) * RS + ks * 16 + hh * 8);
                accP = __builtin_amdgcn_mfma_f32_32x32x16_bf16(A, Bv, accP, 0, 0, 0); }
#pragma unroll
            for (int r = 0; r < 16; ++r) { const int ii = si * 32 + (r & 3) + 8 * (r >> 2) + 4 * hh, jj = sj * 32 + l5; PP[ii * RS + jj] = f2bf(jj <= ii ? accP[r] : 0.f); } }
        __syncthreads();
        { const int nk = ih == 0 ? 2 : 4;
          for (int ks = 0; ks < nk; ++ks) { const bf16x8 A = *(const LAS bf16x8*)(PP + (ih * 32 + l5) * RS + ks * 16 + hh * 8), Bv = *(const LAS bf16x8*)(VT + (vq * 32 + l5) * RS + ks * 16 + hh * 8);
              accO = __builtin_amdgcn_mfma_f32_32x32x16_bf16(A, Bv, accO, 0, 0, 0); } }
#pragma unroll
        for (int rg = 0; rg < 4; ++rg) { const f32x4 dv = *(const LAS f32x4*)(DEC + ih * 32 + 8 * rg + 4 * hh);
#pragma unroll
            for (int j = 0; j < 4; ++j) accS[rg * 4 + j] *= dv[j]; }
#pragma unroll
        for (int ks = 0; ks < 4; ++ks) { const bf16x8 A = *(const LAS bf16x8*)(KET + (ih * 32 + l5) * RS + ks * 16 + hh * 8), Bv = *(const LAS bf16x8*)(VT + (vq * 32 + l5) * RS + ks * 16 + hh * 8);
            accS = __builtin_amdgcn_mfma_f32_32x32x16_bf16(A, Bv, accS, 0, 0, 0); }
#pragma unroll
        for (int r = 0; r < 16; ++r) { const int ii = ih * 32 + (r & 3) + 8 * (r >> 2) + 4 * hh;
            O[gla_row(ck * 64 + ii, b, dir) * 512 + h * 128 + vq * 32 + l5] = f2bf(accO[r]); }
#pragma unroll
        for (int rg = 0; rg < 4; ++rg) { u32x2 o; o.x = cvt_pk_bf16(accS[rg * 4], accS[rg * 4 + 1]); o.y = cvt_pk_bf16(accS[rg * 4 + 2], accS[rg * 4 + 3]);
            *(LAS u32x2*)(ST + (vq * 32 + l5) * RS + ih * 32 + 8 * rg + 4 * hh) = o; }
        __syncthreads();
    }
    __syncthreads();
}

template <int W>
__device__ __forceinline__ void pool2d_wave(bf16_t* base, int lane) {
    float u[32], pv[33];
#pragma unroll
    for (int r = 0; r < 32; ++r) u[r] = bf2f(base[r * 64 + lane]);
    pv[0] = 0.f;
#pragma unroll
    for (int r = 0; r < 32; ++r) pv[r + 1] = pv[r] + u[r];
    const int cl = max(lane - W / 2, 0), chh = min(lane - W / 2 + W, 64);
#pragma unroll
    for (int r = 0; r < 32; ++r) {
        const int rl = (r - W / 2) < 0 ? 0 : (r - W / 2), rh = (r - W / 2 + W) > 32 ? 32 : (r - W / 2 + W);
        float x = pv[rh] - pv[rl];
#pragma unroll
        for (int d = 1; d < 64; d <<= 1) { const float y = __shfl_up(x, d); if (lane >= d) x += y; }
        const float hi = __shfl(x, chh - 1), lo = __shfl(x, cl > 0 ? cl - 1 : 0);
        const float s = hi - (cl > 0 ? lo : 0.f);
        const float cnt = (float)((rh - rl) * (chh - cl));
        base[r * 64 + lane] = f2bf(s / cnt - u[r]);
    }
}
__device__ __forceinline__ void pool1d_wave(bf16_t* base, int lane, int W) {
    float u[4], P[4];
#pragma unroll
    for (int j = 0; j < 4; ++j) u[j] = bf2f(base[j * 64 + lane]);
    float off = 0.f;
#pragma unroll
    for (int j = 0; j < 4; ++j) { float x = u[j];
#pragma unroll
        for (int d = 1; d < 64; d <<= 1) { const float y = __shfl_up(x, d); if (lane >= d) x += y; }
        P[j] = x + off; off += __shfl(x, 63); }
#pragma unroll
    for (int j = 0; j < 4; ++j) { const int t = j * 64 + lane; const int lo = max(t - W / 2, 0), hi = min(t - W / 2 + W, 256);
        const int ih = hi - 1, il = lo > 0 ? lo - 1 : 0;
        float vh = 0.f, vl = 0.f;
#pragma unroll
        for (int s = 0; s < 4; ++s) { const float a = __shfl(P[s], ih & 63), bq = __shfl(P[s], il & 63); if ((ih >> 6) == s) vh = a; if ((il >> 6) == s) vl = bq; }
        const float sum = vh - (lo > 0 ? vl : 0.f);
        u[j] = sum / (float)(hi - lo) - u[j]; }
#pragma unroll
    for (int j = 0; j < 4; ++j) base[j * 64 + lane] = f2bf(u[j]);
}

__global__ void __launch_bounds__(NTHREADS, 2) mega(Params p) {
    extern __shared__ __attribute__((aligned(16))) unsigned char lds_raw[];
    LAS unsigned char* lds = (LAS unsigned char*)lds_raw;
    LAS float* lf = (LAS float*)lds;
    cg::grid_group grid = cg::this_grid();
    unsigned bar_n = 0; unsigned* bar_ctr = (unsigned*)(p.ws + WS_BAR);
#define GBAR() do { bar_n += gridDim.x; gbar(bar_ctr, bar_n); } while (0)
    const int G = gridDim.x, bid = blockIdx.x;
#define WSPTRS const int tid = tidx(), lane = tid & 63, wid = tid >> 6; (void)lane; (void)wid; unsigned char* ws = opq(p.ws); bf16_t* HX = (bf16_t*)(ws + WS_HX); bf16_t* T = (bf16_t*)(ws + WS_T); bf16_t* YG = (bf16_t*)(ws + WS_YG); bf16_t* PG = (bf16_t*)(ws + WS_PG); \
    float* CTXS = (float*)(ws + WS_CTX); const float* MOD = (const float*)(ws + WS_MOD); const float* BIAS = (const float*)(ws + WS_BIAS); (void)HX; (void)T; (void)YG; (void)PG; (void)CTXS; (void)MOD; (void)BIAS;

#ifdef TIMEX
    unsigned long long tx0 = 0, tx1 = 0; int txn = 0;
#define TX_MARK() do { if (txn == TIMEX) tx0 = __builtin_amdgcn_s_memrealtime(); if (txn == TIMEX + 1) tx1 = __builtin_amdgcn_s_memrealtime(); ++txn; } while (0)
    unsigned long long cx0 = 0, cxacc = 0;
#define CX_BEGIN(k) do { if (TIMEX == 100 + (k) && l == 1) { __syncthreads(); cx0 = __builtin_amdgcn_s_memrealtime(); } } while (0)
#define CX_END(k) do { if (TIMEX == 100 + (k) && l == 1) { __syncthreads(); cxacc += __builtin_amdgcn_s_memrealtime() - cx0; } } while (0)
#else
#define TX_MARK() do {} while (0)
#define CX_BEGIN(k) do {} while (0)
#define CX_END(k) do {} while (0)
#endif
    TX_MARK();
    for (int l = 0; l < 2; ++l) {
        unsigned char* ws = opq(p.ws);
        const float* win = p.in[I_WIN] + (size_t)l * D * N_IN;
        bf16_t* wt = (bf16_t*)(ws + WS_WT + l * SZ_WT);
        tconv(win, N_IN, 0, 1536, 1536, D, wt, lf);
        tconv(win, N_IN, POOL_OFF, 512, 512, D, wt + (size_t)1536 * D, lf);
        tconv(win, N_IN, GLA_OFF, NGV, NG, D, (bf16_t*)(ws + WS_WG + l * SZ_WG), lf);
        tconv(win, N_IN, GATE_OFF, 3072, 3072, D, (bf16_t*)(ws + WS_WGATE + l * SZ_WGATE), lf);
        tconv(p.in[I_WBH] + (size_t)l * 512 * 1024, 1024, 0, 1024, 1024, 512, (bf16_t*)(ws + WS_WBR + (size_t)(l * 3 + 0) * SZ_WBR), lf);
        tconv(p.in[I_WBG] + (size_t)l * 512 * 1024, 1024, 0, 1024, 1024, 512, (bf16_t*)(ws + WS_WBR + (size_t)(l * 3 + 1) * SZ_WBR), lf);
        tconv(p.in[I_WOUT] + (size_t)l * D * D, D, 0, D, D, D, (bf16_t*)(ws + WS_WOUT + l * SZ_WOUT), lf);
        tconv(p.in[I_WUP] + (size_t)l * D * DFF, DFF, 0, DFF, DFF, D, (bf16_t*)(ws + WS_WUP + l * SZ_WUP), lf);
        tconv(p.in[I_WDN] + (size_t)l * DFF * D, D, 0, D, D, DFF, (bf16_t*)(ws + WS_WDN + l * SZ_WDN), lf);
        job_poolcomb(p, l);
    }
    job_bias(p);
    job_mod(p, lf);
    job_filters(p, lds);
    if (p.ws == nullptr) grid.sync();
    GBAR();

    { WSPTRS
    for (int row = bid * 8 + wid; row < TOK; row += 2 * G * 8) {
        const int rb = row + G * 8; const bool hb = rb < TOK; const int rb2 = hb ? rb : row;
        const bool la = row < TOKL, lb = rb2 < TOKL;
        const float* xa = la ? p.in[I_X] + (size_t)row * D : p.in[I_CTX] + (size_t)(row - TOKL) * D; const float* xb = lb ? p.in[I_X] + (size_t)rb2 * D : p.in[I_CTX] + (size_t)(rb2 - TOKL) * D;
        const float* ma = MOD + (size_t)(la ? row >> 11 : 32) * 6144; const float* mb = MOD + (size_t)(lb ? rb2 >> 11 : 32) * 6144;
        ada_row2(xa, xb, hb, p.in[I_NMIX], ma, ma + 1024, mb, mb + 1024, HX + (size_t)row * D, HX + (size_t)rb2 * D, nullptr, nullptr, lane);
    } }
    GBAR();
    TX_MARK();

    for (int l_ = 0; l_ < 2; ++l_) {
        const int l = opqi(l_);
        { WSPTRS
            const int ntokt = l == 0 ? 288 : 256;
            const int nA = ntokt * 8, nB = 288 * 7;
            const bf16_t* wt = (const bf16_t*)(ws + WS_WT + l * SZ_WT); const bf16_t* wg = (const bf16_t*)(ws + WS_WG + l * SZ_WG);
            const float* biasT = BIAS + l * (NTR + NG); const float* biasG = biasT + NTR;
            XMap MA, MB; MA.init(bid, ntokt, 8); MB.init(bid, 288, 7);
            ProgInproj P{wt, wg, HX, T, PG, biasT, biasG, MA, MB, MA.rounds()};
            gemm_stream(lds, MA.rounds() + MB.rounds(), P);
        }
        GBAR();
        TX_MARK();
        { WSPTRS
            for (int it = bid; it < 256; it += G) gla_chunk_item(p, l, it >> 3, (it >> 1) & 3, it & 1, lds);
            for (int it = bid; it < 512; it += G) hyena_mfma<2048, 8>(p, l, it, false, lds);
            if (l == 0) for (int it = bid; it < 512; it += G) hyena_mfma<256, 1>(p, l, it, true, lds);
            const int npl = l == 0 ? 32768 : 16384;
            for (int it = bid * 8 + wid; it < npl; it += G * 8) { const bool cx = it >= 16384; const int j = it & 16383, ch = j >> 5, b = j & 31, g = ch >> 7;
                bf16_t* base = T + (size_t)(1536 + ch) * TOK + (cx ? (size_t)TOKL + b * 256 : (size_t)b * 2048);
                if (cx) pool1d_wave(base, lane, 2 << g);
                else { if (g == 0) pool2d_wave<2>(base, lane); else if (g == 1) pool2d_wave<4>(base, lane); else if (g == 2) pool2d_wave<8>(base, lane); else pool2d_wave<16>(base, lane); } }
        }
        GBAR();
        TX_MARK();
        {
            WSPTRS
            const bf16_t* OF = (const bf16_t*)(ws + WS_OF); const bf16_t* OB = OF + (size_t)TOK * 512; const float* nw = p.in[I_GNW] + l * 128;
            const int ntok = l == 0 ? TOK : TOKL;
            for (int row = bid * 8 + wid; row < ntok; row += 2 * G * 8) {
                const int rowb = row + G * 8; const bool hb = rowb < ntok; const int rows[2] = {row, hb ? rowb : row};
                u32x4 av[2], bv[2], rv[2];
#pragma unroll
                for (int q = 0; q < 2; ++q) { av[q] = *(const u32x4*)(OF + (size_t)rows[q] * 512 + lane * 8); bv[q] = *(const u32x4*)(OB + (size_t)rows[q] * 512 + lane * 8); rv[q] = *(const u32x4*)(PG + (size_t)rows[q] * NG + 1024 + lane * 8); }
#pragma unroll
                for (int q = 0; q < 2; ++q) { if (q == 1 && !hb) break;
                    const u32x4 a = av[q], bq = bv[q], rr = rv[q];
                    float o[8] = {lo16(a.x) + lo16(bq.x), hi16(a.x) + hi16(bq.x), lo16(a.y) + lo16(bq.y), hi16(a.y) + hi16(bq.y), lo16(a.z) + lo16(bq.z), hi16(a.z) + hi16(bq.z), lo16(a.w) + lo16(bq.w), hi16(a.w) + hi16(bq.w)};
                    float r[8] = {lo16(rr.x), hi16(rr.x), lo16(rr.y), hi16(rr.y), lo16(rr.z), hi16(rr.z), lo16(rr.w), hi16(rr.w)};
                    float ss = 0.f;
#pragma unroll
                    for (int j = 0; j < 8; ++j) ss += o[j] * o[j];
                    ss += __shfl_xor(ss, 1); ss += __shfl_xor(ss, 2); ss += __shfl_xor(ss, 4); ss += __shfl_xor(ss, 8);
                    const float inv = rsqrtf(ss * (1.f / 128.f) + EPS);
                    float y[8];
#pragma unroll
                    for (int j = 0; j < 8; ++j) y[j] = o[j] * inv * nw[(lane & 15) * 8 + j] * (r[j] * sigmoidf_(r[j]));
                    u32x4 w; w.x = cvt_pk_bf16(y[0], y[1]); w.y = cvt_pk_bf16(y[2], y[3]); w.z = cvt_pk_bf16(y[4], y[5]); w.w = cvt_pk_bf16(y[6], y[7]);
                    *(u32x4*)(YG + (size_t)rows[q] * 512 + lane * 8) = w; }
            }
            LAS bf16_t* tl = (LAS bf16_t*)lds;
            const int nit = 2 * (l == 0 ? 288 : 256) * 8;
            for (int it = bid; it < nit; it += G) { const int ctile = it & 7, tt = (it >> 3) % (l == 0 ? 288 : 256), which = (it >> 3) / (l == 0 ? 288 : 256);
                const bf16_t* src = T + (size_t)(which ? 1536 : 0) * TOK + (size_t)tt * 256; bf16_t* dst = (bf16_t*)(ws + (which ? WS_YPL : WS_YHY)) + (size_t)tt * 256 * 512;
                __syncthreads();
#pragma unroll
                for (int i = 0; i < 4; ++i) { const int idx = tid + i * NTHREADS, c = idx >> 5, t8 = (idx & 31) * 8;
                    *(LAS u32x4*)(tl + c * 264 + t8) = *(const u32x4*)(src + (size_t)(ctile * 64 + c) * TOK + t8); }
                __syncthreads();
#pragma unroll
                for (int i = 0; i < 4; ++i) { const int idx = tid + i * NTHREADS, tk = idx >> 3, c8 = (idx & 7) * 8; unsigned w[4];
#pragma unroll
                    for (int j = 0; j < 4; ++j) w[j] = (unsigned)tl[(c8 + 2 * j) * 264 + tk] | ((unsigned)tl[(c8 + 2 * j + 1) * 264 + tk] << 16);
                    *(u32x4*)(dst + (size_t)tk * 512 + ctile * 64 + c8) = (u32x4){w[0], w[1], w[2], w[3]}; }
            }
            __syncthreads();
        }
        GBAR();
        TX_MARK();
        const int ntt = l == 0 ? 288 : 256;
        { WSPTRS
          XMap M; M.init(bid, ntt, 4);
          ProgMix2 P{ws, ws + WS_STASH + (size_t)bid * 524288, p.in[I_BIN] + l * N_IN + GATE_OFF, M, l};
          gemm_stream(lds, 6 * M.rounds(), P); }
        GBAR();
        { WSPTRS
          XMap M; M.init(bid, ntt, 4);
          TileIO io{p.in[I_X], p.in[I_CTX], p.out, CTXS, MOD + (size_t)l * 33 * 6144, l};
          ProgOut2 P{ws, io, M, l};
          gemm_stream(lds, M.rounds(), P); }
        GBAR();
        { WSPTRS
          const float* modl = MOD + (size_t)l * 33 * 6144; const int nrow = ntt * 256;
          for (int row = bid * 8 + wid; row < nrow; row += 2 * G * 8) { const int rb = row + G * 8; const bool hb = rb < nrow; const int rb2 = hb ? rb : row; const bool la = row < TOKL, lb = rb2 < TOKL;
              const float* xa = la ? p.out + (size_t)row * D : CTXS + (size_t)(row - TOKL) * D; const float* xb = lb ? p.out + (size_t)rb2 * D : CTXS + (size_t)(rb2 - TOKL) * D;
              const float* ma = modl + (size_t)(la ? row >> 11 : 32) * 6144; const float* mb = modl + (size_t)(lb ? rb2 >> 11 : 32) * 6144;
              ada_row2(xa, xb, hb, p.in[I_NFFN] + l * D, ma + 3072, ma + 4096, mb + 3072, mb + 4096, HX + (size_t)row * D, HX + (size_t)rb2 * D, nullptr, nullptr, lane); } }
        GBAR();
        { WSPTRS
          XMap M; M.init(bid, ntt, 16);
          ProgUp2 P{ws, M, l};
          gemm_stream(lds, M.rounds(), P); }
        GBAR();
        { WSPTRS
          XMap M; M.init(bid, ntt, 4);
          TileIO io{p.in[I_X], p.in[I_CTX], p.out, CTXS, MOD + (size_t)l * 33 * 6144, l};
          ProgDown2 P{ws, io, M, l};
          gemm_stream(lds, M.rounds(), P); }
        GBAR();
        { WSPTRS
          const int nrow = ntt * 256;
          for (int row = bid * 8 + wid; row < nrow; row += 2 * G * 8) { const int rb = row + G * 8; const bool hb = rb < nrow; const int rb2 = hb ? rb : row; const bool la = row < TOKL, lb = rb2 < TOKL;
              float* xa = la ? p.out + (size_t)row * D : CTXS + (size_t)(row - TOKL) * D; float* xb = lb ? p.out + (size_t)rb2 * D : CTXS + (size_t)(rb2 - TOKL) * D;
              if (l == 0) { const float* ma = MOD + (size_t)33 * 6144 + (size_t)(la ? row >> 11 : 32) * 6144; const float* mb = MOD + (size_t)33 * 6144 + (size_t)(lb ? rb2 >> 11 : 32) * 6144;
                  ada_row2(xa, xb, hb, p.in[I_NMIX] + D, ma, ma + 1024, mb, mb + 1024, HX + (size_t)row * D, HX + (size_t)rb2 * D, nullptr, nullptr, lane); }
              else ada_row2(xa, xb, hb, p.in[I_NFIN], nullptr, nullptr, nullptr, nullptr, nullptr, nullptr, xa, xb, lane); } }
        if (l == 0) GBAR();
        TX_MARK();
    }
#ifdef TIMEX
    if (blockIdx.x == 0 && threadIdx.x == 0) { const unsigned long long t = __builtin_amdgcn_s_memrealtime(); while (__builtin_amdgcn_s_memrealtime() - t < (unsigned long long)TIMEX_MULT * (TIMEX >= 100 ? cxacc : (tx1 - tx0))) __builtin_amdgcn_s_sleep(10); }
#endif
}

extern "C" void kernel_launch(void* const* d_in, const int* in_sizes, int n_in, void* d_out, int out_size,
                              void* d_ws, size_t ws_size, hipStream_t stream) {
    static int grid_blocks = 0;
    if (!grid_blocks) {
        int dev = 0, cus = 0, per_cu = 0;
        (void)hipGetDevice(&dev);
        (void)hipDeviceGetAttribute(&cus, hipDeviceAttributeMultiprocessorCount, dev);
        (void)hipFuncSetAttribute((const void*)mega, hipFuncAttributeMaxDynamicSharedMemorySize, LDS_BYTES);
        (void)hipOccupancyMaxActiveBlocksPerMultiprocessor(&per_cu, (const void*)mega, NTHREADS, LDS_BYTES);
        grid_blocks = cus > 256 ? 256 : cus;
        if (ws_size < WS_END || n_in != 33 || out_size != TOKL * D) { fprintf(stderr, "kernel_launch: unexpected sizes ws=%zu need=%zu n_in=%d out=%d\n", ws_size, (size_t)WS_END, n_in, out_size); grid_blocks = -1; }
    }
    if (grid_blocks < 0) return;
    Params p{};
    for (int i = 0; i < 33; ++i) p.in[i] = (const float*)d_in[i];
    p.out = (float*)d_out; p.ws = (unsigned char*)d_ws;
    (void)hipMemsetAsync((unsigned char*)d_ws + WS_BAR, 0, 256, stream);
    void* args[] = {&p};
    hipError_t e = hipLaunchCooperativeKernel((const void*)mega, dim3(grid_blocks), dim3(NTHREADS), args, LDS_BYTES, stream);
    if (e != hipSuccess) fprintf(stderr, "cooperative launch failed: %s (grid %d)\n", hipGetErrorString(e), grid_blocks);
}
```

```cpp
#include <hip/hip_runtime.h>
#include <hip/hip_cooperative_groups.h>
#include <cstdio>
#include <cstdint>
namespace cg = cooperative_groups;

#define LAS __attribute__((address_space(3)))
typedef unsigned short bf16_t;
typedef short bf16x8 __attribute__((ext_vector_type(8)));
typedef float f32x4 __attribute__((ext_vector_type(4)));
typedef unsigned u32x2 __attribute__((ext_vector_type(2)));
typedef unsigned u32x4 __attribute__((ext_vector_type(4)));

constexpr int NTHREADS = 512;
constexpr int LDS_BYTES = 147456;
constexpr int D = 1024, NB = 32, SEQ = 2048, CTXL = 256;
constexpr int TOKL = NB * SEQ, TOKC = NB * CTXL, TOK = TOKL + TOKC;
constexpr int N_IN = 6688, GLA_OFF = 1536, POOL_OFF = 3104, GATE_OFF = 3616;
constexpr int NTR = 2048, NG = 1792, NGV = 1568, DFF = 4096;
constexpr float EPS = 1e-6f;

constexpr size_t SZ_WT = (size_t)NTR * D * 2, SZ_WG = (size_t)NG * D * 2, SZ_WGATE = (size_t)3072 * D * 2, SZ_WBR = (size_t)1024 * 512 * 2;
constexpr size_t SZ_WOUT = (size_t)D * D * 2, SZ_WUP = (size_t)DFF * D * 2, SZ_WDN = (size_t)D * DFF * 2;
constexpr size_t WS_WT = 0;
constexpr size_t WS_WG = WS_WT + 2 * SZ_WT;
constexpr size_t WS_WGATE = WS_WG + 2 * SZ_WG;
constexpr size_t WS_WBR = WS_WGATE + 2 * SZ_WGATE;
constexpr size_t WS_WOUT = WS_WBR + 6 * SZ_WBR;
constexpr size_t WS_WUP = WS_WOUT + 2 * SZ_WOUT;
constexpr size_t WS_WDN = WS_WUP + 2 * SZ_WUP;
constexpr size_t WS_BIAS = WS_WDN + 2 * SZ_WDN;
constexpr size_t WS_MOD = WS_BIAS + 32768;
constexpr size_t WS_HFL = WS_MOD + (size_t)2 * 33 * 6144 * 4;
constexpr size_t WS_HFC = WS_HFL + (size_t)2 * 4 * 512 * 2048 * 2;
constexpr size_t WS_CTX = WS_HFC + (size_t)4 * 512 * 256 * 2;
constexpr size_t WS_HX = WS_CTX + (size_t)TOKC * D * 4;
constexpr size_t WS_T = WS_HX + (size_t)TOK * D * 2;
constexpr size_t WS_YG = WS_T + (size_t)NTR * TOK * 2;
constexpr size_t WS_PG = WS_YG + (size_t)TOK * 512 * 2;
constexpr size_t WS_OF = WS_PG + (size_t)TOK * NG * 2;
constexpr size_t WS_BAR = WS_OF + (size_t)2 * TOK * 512 * 2;
constexpr size_t WS_END = WS_BAR + 256;
constexpr size_t WS_YHY = WS_T + (size_t)512 * TOK * 2;
constexpr size_t WS_YPL = WS_T + (size_t)1024 * TOK * 2;
constexpr size_t WS_STASH = WS_PG;
constexpr size_t WS_MERGED = WS_OF;
constexpr size_t WS_HID = WS_T;
static_assert((size_t)TOK * DFF * 2 <= WS_OF - WS_T, "hidden");
constexpr size_t WS_SCR = WS_PG;
constexpr size_t SCR_PER = 1572864;
constexpr size_t SC_MERGED = 0, SC_TRY = 524288, SC_TRP = 786432, SC_SG = 1048576, SC_ST = 1310720, SC_HID = 524288;
static_assert(WS_END <= (size_t)1073741824, "ws");

struct Params { const float* in[33]; float* out; unsigned char* ws; };
enum { I_X = 0, I_C, I_CTX, I_CCTX, I_WMOD, I_BMOD, I_NMIX, I_NFFN, I_WIN, I_BIN, I_HSW, I_HSB, I_FW1, I_FB1, I_FFREQ, I_FW2, I_FB2, I_FW3, I_HSKIP,
       I_WAF, I_BAF, I_WAB, I_BAB, I_GNW, I_PW, I_PSC, I_WBH, I_WBG, I_WBP, I_WOUT, I_WUP, I_WDN, I_NFIN };

__device__ __forceinline__ float bf2f(bf16_t h) { return __uint_as_float((unsigned)h << 16); }
__device__ __forceinline__ unsigned cvt_pk_bf16(float lo, float hi) { unsigned r; asm volatile("v_cvt_pk_bf16_f32 %0, %1, %2" : "=v"(r) : "v"(lo), "v"(hi)); return r; }
__device__ __forceinline__ bf16_t f2bf(float f) { return (bf16_t)(cvt_pk_bf16(f, 0.f) & 0xffffu); }
__device__ __forceinline__ float lo16(unsigned u) { return __uint_as_float(u << 16); }
__device__ __forceinline__ float hi16(unsigned u) { return __uint_as_float(u & 0xffff0000u); }
__device__ __forceinline__ float sigmoidf_(float v) { return 1.f / (1.f + __expf(-v)); }
__device__ __forceinline__ unsigned char* opq(unsigned char* p) { asm volatile("" : "+s"(p)); return p; }
__device__ __forceinline__ int tidx() { int t = threadIdx.x; asm volatile("" : "+v"(t)); return t; }
__device__ __forceinline__ int opqi(int v) { asm volatile("" : "+s"(v)); return v; }
__device__ __forceinline__ void gbar(unsigned* ctr, unsigned target) {
    asm volatile("s_waitcnt vmcnt(0) lgkmcnt(0)" ::: "memory");
    __syncthreads();
    if (threadIdx.x < 64) {
        if (threadIdx.x == 0) {
            __builtin_amdgcn_fence(__ATOMIC_RELEASE, "agent");
            asm volatile("s_waitcnt vmcnt(0)" ::: "memory");
            __hip_atomic_fetch_add(ctr, 1u, __ATOMIC_RELAXED, __HIP_MEMORY_SCOPE_AGENT);
            while (__hip_atomic_load(ctr, __ATOMIC_RELAXED, __HIP_MEMORY_SCOPE_AGENT) < target) __builtin_amdgcn_s_sleep(1);
        }
        __builtin_amdgcn_fence(__ATOMIC_ACQUIRE, "agent");
        asm volatile("s_waitcnt vmcnt(0)" ::: "memory");
    }
    __syncthreads();
}
__device__ __forceinline__ float wave_sum(float v) {
#pragma unroll
    for (int o = 32; o >= 1; o >>= 1) v += __shfl_xor(v, o);
    return v;
}

constexpr int BK = 64, HALF = 128, HTB = HALF * BK * 2;
__device__ __forceinline__ int lds_byte(int r, int c) { const int st = (r >> 4) * 2 + (c >> 5), rr = r & 15, cc = c & 31, ob = rr * 64 + cc * 2; return st * 1024 + (ob ^ (((ob >> 9) & 1) << 5)); }
__device__ __forceinline__ void stage_rc(int b, int& R, int& C) { const int st = b / 1024, sb = b % 1024, swz = sb ^ (((sb >> 9) & 1) << 5); R = (st >> 1) * 16 + swz / 64; C = (st & 1) * 32 + (swz % 64) / 2; }

template <class Epi>
__device__ __forceinline__ void gemm_unit(LAS unsigned char* lds, const bf16_t* A, int lda, const bf16_t* Bt, int ldb, int K, const Epi& E) {
    const int tid = tidx(), wid = __builtin_amdgcn_readfirstlane(tid >> 6), lane = tid & 63, wr = wid >> 2, wc = wid & 3, fr = lane & 15, fq = lane >> 4;
    const int nt = K / BK;
    unsigned voffA[2], voffB[2];
#pragma unroll
    for (int i = 0; i < 2; ++i) { int R, C; stage_rc(tid * 16 + i * 8192, R, C); voffA[i] = (unsigned)(R * lda + C) * 2u; voffB[i] = (unsigned)(R * ldb + C) * 2u; }
    const size_t kstep = (size_t)(BK * 2);
    const size_t hstepA = (size_t)HALF * lda * 2, hstepB = (size_t)HALF * ldb * 2;
    const unsigned ldsw = (unsigned)wid * 1024u;
    const int aoff = lds_byte(wr * 64 + fr, fq * 8), boff = lds_byte(wc * 32 + fr, fq * 8);
#define G_SA(b, h) (((b) * 2 + (h)) * HTB)
#define G_SB(b, h) ((4 + (b) * 2 + (h)) * HTB)
#define G_STAGE(bufoff, gbase, voff) do { _Pragma("unroll") for (int _i = 0; _i < 2; ++_i) \
        __builtin_amdgcn_global_load_lds((const unsigned*)((const char*)(gbase) + (voff)[_i]), (LAS unsigned*)(lds + (bufoff) + ldsw + _i * 8192), 16, 0, 0); } while (0)
#define G_LDA(dst, b, h) do { _Pragma("unroll") for (int m = 0; m < 4; ++m) _Pragma("unroll") for (int k = 0; k < 2; ++k) dst[m][k] = *(const LAS bf16x8*)(lds + G_SA(b, h) + aoff + m * 2048 + k * 1024); } while (0)
#define G_LDB(dst, b, h) do { _Pragma("unroll") for (int n = 0; n < 2; ++n) _Pragma("unroll") for (int k = 0; k < 2; ++k) dst[n][k] = *(const LAS bf16x8*)(lds + G_SB(b, h) + boff + n * 2048 + k * 1024); } while (0)
#define G_MMA(ai, bj, At, Bt_) do { __builtin_amdgcn_s_setprio(1); _Pragma("unroll") for (int m = 0; m < 4; ++m) _Pragma("unroll") for (int n = 0; n < 2; ++n) _Pragma("unroll") for (int k = 0; k < 2; ++k) \
        acc[ai][bj][m][n] = __builtin_amdgcn_mfma_f32_16x16x32_bf16(Bt_[n][k], At[m][k], acc[ai][bj][m][n], 0, 0, 0); __builtin_amdgcn_s_setprio(0); } while (0)
#define G_WAIT_V(n) asm volatile("s_waitcnt vmcnt(" #n ")" ::: "memory")
#define G_WAIT_L(n) asm volatile("s_waitcnt lgkmcnt(" #n ")" ::: "memory")
#define G_BAR __builtin_amdgcn_s_barrier()
#define G_SCHED __builtin_amdgcn_sched_barrier(0)
    __syncthreads();
    f32x4 acc[2][2][4][2];
#pragma unroll
    for (int a = 0; a < 2; ++a)
#pragma unroll
        for (int b = 0; b < 2; ++b)
#pragma unroll
            for (int m = 0; m < 4; ++m)
#pragma unroll
                for (int n = 0; n < 2; ++n) acc[a][b][m][n] = (f32x4){0.f, 0.f, 0.f, 0.f};
    bf16x8 At[4][2], B0[2][2], B1[2][2];
    const char* cA = (const char*)A; const char* cB = (const char*)Bt;
    G_STAGE(G_SB(0, 0), cB, voffB); G_STAGE(G_SA(0, 0), cA, voffA); G_STAGE(G_SB(0, 1), cB + hstepB, voffB); G_STAGE(G_SA(0, 1), cA + hstepA, voffA);
    if (wr == 1) G_BAR;
    G_WAIT_V(4); G_BAR;
    G_STAGE(G_SB(1, 0), cB + kstep, voffB); G_STAGE(G_SA(1, 0), cA + kstep, voffA); G_STAGE(G_SB(1, 1), cB + hstepB + kstep, voffB);
    G_WAIT_V(6); G_BAR;
    for (int t = 0; t < nt; t += 2) {
        const bool last = (t == nt - 2);
        const char* a1 = cA + (size_t)(t + 1) * kstep;
        const char* a2 = last ? cA : cA + (size_t)(t + 2) * kstep; const char* b2 = last ? cB : cB + (size_t)(t + 2) * kstep;
        const char* a3 = a2 + kstep; const char* b3 = b2 + kstep;
        G_LDB(B0, 0, 0); G_SCHED; G_LDA(At, 0, 0); G_STAGE(G_SA(1, 1), a1 + hstepA, voffA);
        G_WAIT_L(8); G_BAR; G_WAIT_L(0); G_MMA(0, 0, At, B0); G_BAR; G_SCHED;
        G_LDB(B1, 0, 1); G_STAGE(G_SB(0, 0), b2, voffB);
        G_BAR; G_WAIT_L(0); G_MMA(0, 1, At, B1); G_BAR;
        G_LDA(At, 0, 1); G_STAGE(G_SA(0, 0), a2, voffA);
        G_BAR; G_WAIT_L(0); G_MMA(1, 0, At, B0); G_BAR; G_SCHED;
        G_STAGE(G_SB(0, 1), b2 + hstepB, voffB);
        G_WAIT_V(6); G_BAR; G_MMA(1, 1, At, B1); G_BAR;
        G_LDB(B0, 1, 0); G_SCHED; G_LDA(At, 1, 0); G_STAGE(G_SA(0, 1), a2 + hstepA, voffA);
        G_WAIT_L(8); G_BAR; G_WAIT_L(0); G_MMA(0, 0, At, B0); G_BAR; G_SCHED;
        G_LDB(B1, 1, 1); G_STAGE(G_SB(1, 0), b3, voffB);
        G_BAR; G_WAIT_L(0); G_MMA(0, 1, At, B1); G_BAR;
        G_LDA(At, 1, 1); G_STAGE(G_SA(1, 0), a3, voffA);
        G_BAR; G_WAIT_L(0); G_MMA(1, 0, At, B0); G_BAR; G_SCHED;
        G_STAGE(G_SB(1, 1), b3 + hstepB, voffB);
        G_WAIT_V(6); G_BAR; G_MMA(1, 1, At, B1); G_BAR;
    }
    E(acc, wr, wc, fr, fq);
    G_WAIT_V(0);
    if (wr == 0) G_BAR;
    G_BAR;
    __syncthreads();
}


__device__ __forceinline__ int perm32(int rho) { const int n = rho >> 4, i = rho & 15; return 8 * (i >> 2) + 4 * n + (i & 3); }
typedef f32x4 AccT[2][2][4][2];
struct UDesc { const char* A; const char* B; int lda, ldb, K; };
template <class Prog, bool SP2 = true, bool ALIGN_EPI = true>
__device__ __forceinline__ void gemm_stream(LAS unsigned char* lds, int nunits, const Prog& P) {
    if (nunits <= 0) return;
    const int tid = tidx(), wid = __builtin_amdgcn_readfirstlane(tid >> 6), lane = tid & 63, wr = wid >> 2, wc = wid & 3, fr = lane & 15, fq = lane >> 4;
    int sR, sRb, sC; { int R, C; stage_rc(tid * 16, R, C); sR = R * 2; sRb = ((R & ~31) + perm32(R & 31)) * 2; sC = C * 2; }
    const unsigned kstep = (unsigned)(BK * 2);
    const unsigned ldsw = (unsigned)wid * 1024u;
    const int aoff = lds_byte(wr * 64 + fr, fq * 8), boff = lds_byte(wc * 32 + fr, fq * 8);
#define S_STAGE(bufoff, gbase, v, q) do { \
        __builtin_amdgcn_global_load_lds((const unsigned*)((const char*)(gbase) + (v)), (LAS unsigned*)(lds + (bufoff) + ldsw), 16, 0, 0); \
        __builtin_amdgcn_global_load_lds((const unsigned*)((const char*)(gbase) + (q) + (v)), (LAS unsigned*)(lds + (bufoff) + ldsw + 8192), 16, 0, 0); } while (0)
    UDesc cur, nxt; P.desc(0, cur);
    unsigned vA = (unsigned)(sR * cur.lda + sC), vB = (unsigned)(sRb * cur.ldb + sC);
    __syncthreads();
    f32x4 acc[2][2][4][2];
#pragma unroll
    for (int a = 0; a < 2; ++a)
#pragma unroll
        for (int b = 0; b < 2; ++b)
#pragma unroll
            for (int m = 0; m < 4; ++m)
#pragma unroll
                for (int n = 0; n < 2; ++n) acc[a][b][m][n] = (f32x4){0.f, 0.f, 0.f, 0.f};
    bf16x8 At[4][2], B0[2][2], B1[2][2];
    { const char* cA = cur.A; const char* cB = cur.B; const unsigned hA = (unsigned)HALF * cur.lda * 2, hB = (unsigned)HALF * cur.ldb * 2, qA = hA >> 1, qB = hB >> 1;
      if constexpr (SP2) {
          S_STAGE(G_SB(0, 0), cB, vB, qB); S_STAGE(G_SB(0, 1), cB + hB, vB, qB); S_STAGE(G_SA(0, 0), cA, vA, qA); S_STAGE(G_SA(0, 1), cA + hA, vA, qA);
          if (wr == 1) G_BAR;
          G_WAIT_V(2); G_BAR;
          S_STAGE(G_SB(1, 0), cB + kstep, vB, qB); S_STAGE(G_SA(1, 0), cA + kstep, vA, qA); S_STAGE(G_SB(1, 1), cB + hB + kstep, vB, qB);
          G_WAIT_V(6); G_BAR;
      } else {
          S_STAGE(G_SB(0, 0), cB, vB, qB); S_STAGE(G_SA(0, 0), cA, vA, qA); S_STAGE(G_SB(0, 1), cB + hB, vB, qB); S_STAGE(G_SA(0, 1), cA + hA, vA, qA);
          if (wr == 1) G_BAR;
          G_WAIT_V(4); G_BAR;
          S_STAGE(G_SB(1, 0), cB + kstep, vB, qB); S_STAGE(G_SA(1, 0), cA + kstep, vA, qA); S_STAGE(G_SB(1, 1), cB + hB + kstep, vB, qB);
          G_WAIT_V(6); G_BAR;
      } }
    for (int ui = 0;; ++ui) {
        const bool has_next = ui + 1 < nunits;
        if (has_next) P.desc(ui + 1, nxt); else nxt = cur;
        const unsigned nA = (unsigned)(sR * nxt.lda + sC), nB = (unsigned)(sRb * nxt.ldb + sC);
        const char* cA = cur.A; const char* cB = cur.B; const unsigned hA = (unsigned)HALF * cur.lda * 2, hB = (unsigned)HALF * cur.ldb * 2;
        const unsigned nhA = (unsigned)HALF * nxt.lda * 2, nhB = (unsigned)HALF * nxt.ldb * 2;
        const int nt = cur.K / BK;
        for (int t = 0; t < nt; t += 2) {
            const bool last = (t == nt - 2);
            const char* a1 = cA + (unsigned)(t + 1) * kstep;
            const char* a2 = last ? nxt.A : cA + (unsigned)(t + 2) * kstep; const char* b2 = last ? nxt.B : cB + (unsigned)(t + 2) * kstep;
            const char* a3 = a2 + kstep; const char* b3 = b2 + kstep;
            const unsigned hA2 = last ? nhA : hA, hB2 = last ? nhB : hB, qA = hA >> 1, qA2 = hA2 >> 1, qB2 = hB2 >> 1;
            const unsigned xA = last ? nA : vA, xB = last ? nB : vB;
            if constexpr (SP2) {
            G_LDB(B0, 0, 0); G_LDB(B1, 0, 1); G_SCHED; G_LDA(At, 0, 0); S_STAGE(G_SA(1, 1), a1 + hA, vA, qA);
            G_WAIT_V(8); G_WAIT_L(0); G_BAR; G_MMA(0, 0, At, B0); G_MMA(0, 1, At, B1); G_BAR; G_SCHED;
            G_LDA(At, 0, 1); S_STAGE(G_SB(0, 0), b2, xB, qB2); S_STAGE(G_SB(0, 1), b2 + hB2, xB, qB2); S_STAGE(G_SA(0, 0), a2, xA, qA2);
            G_WAIT_V(8); G_WAIT_L(0); G_BAR; G_MMA(1, 0, At, B0); G_MMA(1, 1, At, B1); G_BAR; G_SCHED;
            G_LDB(B0, 1, 0); G_LDB(B1, 1, 1); G_SCHED; G_LDA(At, 1, 0); S_STAGE(G_SA(0, 1), a2 + hA2, xA, qA2);
            G_WAIT_V(8); G_WAIT_L(0); G_BAR; G_MMA(0, 0, At, B0); G_MMA(0, 1, At, B1); G_BAR; G_SCHED;
            G_LDA(At, 1, 1); S_STAGE(G_SB(1, 0), b3, xB, qB2); S_STAGE(G_SB(1, 1), b3 + hB2, xB, qB2); S_STAGE(G_SA(1, 0), a3, xA, qA2);
            G_WAIT_V(8); G_WAIT_L(0); G_BAR; G_MMA(1, 0, At, B0); G_MMA(1, 1, At, B1); G_BAR; G_SCHED;
            } else {
            G_LDB(B0, 0, 0); G_SCHED; G_LDA(At, 0, 0); S_STAGE(G_SA(1, 1), a1 + hA, vA, qA);
            G_WAIT_L(8); G_BAR; G_WAIT_L(0); G_MMA(0, 0, At, B0); G_BAR; G_SCHED;
            G_LDB(B1, 0, 1); S_STAGE(G_SB(0, 0), b2, xB, qB2);
            G_BAR; G_WAIT_L(0); G_MMA(0, 1, At, B1); G_BAR;
            G_LDA(At, 0, 1); S_STAGE(G_SA(0, 0), a2, xA, qA2);
            G_BAR; G_WAIT_L(0); G_MMA(1, 0, At, B0); G_BAR; G_SCHED;
            S_STAGE(G_SB(0, 1), b2 + hB2, xB, qB2);
            G_WAIT_V(6); G_BAR; G_MMA(1, 1, At, B1); G_BAR;
            G_LDB(B0, 1, 0); G_SCHED; G_LDA(At, 1, 0); S_STAGE(G_SA(0, 1), a2 + hA2, xA, qA2);
            G_WAIT_L(8); G_BAR; G_WAIT_L(0); G_MMA(0, 0, At, B0); G_BAR; G_SCHED;
            G_LDB(B1, 1, 1); S_STAGE(G_SB(1, 0), b3, xB, qB2);
            G_BAR; G_WAIT_L(0); G_MMA(0, 1, At, B1); G_BAR;
            G_LDA(At, 1, 1); S_STAGE(G_SA(1, 0), a3, xA, qA2);
            G_BAR; G_WAIT_L(0); G_MMA(1, 0, At, B0); G_BAR; G_SCHED;
            S_STAGE(G_SB(1, 1), b3 + hB2, xB, qB2);
            G_WAIT_V(6); G_BAR; G_MMA(1, 1, At, B1); G_BAR;
            }
        }
        if constexpr (ALIGN_EPI) { if (wr == 0) G_BAR; }
        P.epi(ui, acc, wr, wc, fr, fq);
        if (!has_next) break;
#pragma unroll
        for (int a = 0; a < 2; ++a)
#pragma unroll
            for (int b = 0; b < 2; ++b)
#pragma unroll
                for (int m = 0; m < 4; ++m)
#pragma unroll
                    for (int n = 0; n < 2; ++n) acc[a][b][m][n] = (f32x4){0.f, 0.f, 0.f, 0.f};
        cur = nxt; vA = nA; vB = nB;
        if constexpr (ALIGN_EPI) { if (wr == 1) G_BAR; }
    }
    G_WAIT_V(0);
    if constexpr (!ALIGN_EPI) { if (wr == 0) G_BAR; }
    G_BAR;
    __syncthreads();
#undef S_STAGE
}

#define EPI_LOOP _Pragma("unroll") for (int ai = 0; ai < 2; ++ai) _Pragma("unroll") for (int m = 0; m < 4; ++m) _Pragma("unroll") for (int bj = 0; bj < 2; ++bj) _Pragma("unroll") for (int n = 0; n < 2; ++n)
#define EPI_ROW (ai * 128 + wr * 64 + m * 16 + fr)
#define EPI_COL (bj * 128 + wc * 32 + 8 * fq + 4 * n)

#define U4 _Pragma("unroll")
struct EpiStoreBf16 {
    bf16_t* O; size_t ldo; const float* bias; bool rowb;
    __device__ __forceinline__ void operator()(const AccT& acc, int wr, int wc, int fr, int fq) const {
        { const int tq_ = tidx(); wr = (tq_ >> 8) & 1; wc = (tq_ >> 6) & 3; fr = tq_ & 15; fq = (tq_ >> 4) & 3; }
        float br[2][4]; f32x4 bc[2][2];
        U4 for (int ai = 0; ai < 2; ++ai) U4 for (int m = 0; m < 4; ++m) br[ai][m] = rowb ? bias[ai * 128 + wr * 64 + m * 16 + fr] : 0.f;
        U4 for (int bj = 0; bj < 2; ++bj) U4 for (int n = 0; n < 2; ++n) bc[bj][n] = rowb ? (f32x4){0.f, 0.f, 0.f, 0.f} : *(const f32x4*)(bias + EPI_COL);
        U4 for (int ai = 0; ai < 2; ++ai) U4 for (int m = 0; m < 4; ++m) U4 for (int bj = 0; bj < 2; ++bj) { const int n = 0; const int r = EPI_ROW, c = EPI_COL;
            const f32x4 v0 = acc[ai][bj][m][0] + bc[bj][0] + br[ai][m], v1 = acc[ai][bj][m][1] + bc[bj][1] + br[ai][m];
            u32x4 w; w.x = cvt_pk_bf16(v0[0], v0[1]); w.y = cvt_pk_bf16(v0[2], v0[3]); w.z = cvt_pk_bf16(v1[0], v1[1]); w.w = cvt_pk_bf16(v1[2], v1[3]); *(u32x4*)(O + (size_t)r * ldo + c) = w; }
    }
};
struct EpiGate {
    f32x4* SG; const float* bias;
    __device__ __forceinline__ void operator()(const AccT& acc, int wr, int wc, int fr, int fq) const {
        { const int tq_ = tidx(); wr = (tq_ >> 8) & 1; wc = (tq_ >> 6) & 3; fr = tq_ & 15; fq = (tq_ >> 4) & 3; }
        f32x4 bc[2][2];
        U4 for (int bj = 0; bj < 2; ++bj) U4 for (int n = 0; n < 2; ++n) bc[bj][n] = *(const f32x4*)(bias + EPI_COL);
        int i = 0; f32x4* SGt = SG + tidx();
        EPI_LOOP { f32x4 v = acc[ai][bj][m][n] + bc[bj][n];
            v[0] = sigmoidf_(v[0]); v[1] = sigmoidf_(v[1]); v[2] = sigmoidf_(v[2]); v[3] = sigmoidf_(v[3]);
            SGt[i * NTHREADS] = v; ++i; }
    }
};
struct EpiBranch {
    const f32x4* SG; f32x4* ST; bf16_t* MG; int first, last;
    __device__ __forceinline__ void operator()(const AccT& acc, int wr, int wc, int fr, int fq) const {
        { const int tq_ = tidx(); wr = (tq_ >> 8) & 1; wc = (tq_ >> 6) & 3; fr = tq_ & 15; fq = (tq_ >> 4) & 3; }
        const int tq = tidx(); const f32x4* SGt = SG + tq; f32x4* STt = ST + tq;
        f32x4 g[2][4], t[2][4];
        U4 for (int q = 0; q < 4; ++q) { g[0][q] = SGt[q * NTHREADS]; t[0][q] = first ? (f32x4){0.f, 0.f, 0.f, 0.f} : STt[q * NTHREADS]; }
        U4 for (int bt = 0; bt < 8; ++bt) { const int cb = bt & 1, nb = cb ^ 1, ai = bt >> 2, m = bt & 3;
            if (bt + 1 < 8) { U4 for (int q = 0; q < 4; ++q) { const int i = (bt + 1) * 4 + q; g[nb][q] = SGt[i * NTHREADS]; t[nb][q] = first ? (f32x4){0.f, 0.f, 0.f, 0.f} : STt[i * NTHREADS]; } }
            if (last) { U4 for (int bj = 0; bj < 2; ++bj) { const int n = 0; const int r = EPI_ROW, c = EPI_COL;
                    const f32x4 v0 = acc[ai][bj][m][0] * g[cb][bj * 2] + t[cb][bj * 2], v1 = acc[ai][bj][m][1] * g[cb][bj * 2 + 1] + t[cb][bj * 2 + 1];
                    u32x4 w; w.x = cvt_pk_bf16(v0[0], v0[1]); w.y = cvt_pk_bf16(v0[2], v0[3]); w.z = cvt_pk_bf16(v1[0], v1[1]); w.w = cvt_pk_bf16(v1[2], v1[3]); *(u32x4*)(MG + (size_t)r * 1024 + c) = w; } }
            else { U4 for (int q = 0; q < 4; ++q) { const int bj = q >> 1, n = q & 1, i = bt * 4 + q; STt[i * NTHREADS] = acc[ai][bj][m][n] * g[cb][q] + t[cb][q]; } }
        }
    }
};
struct EpiResid {
    const float* xsrc; float* xdst; const float* gate;
    __device__ __forceinline__ void operator()(const AccT& acc, int wr, int wc, int fr, int fq) const {
        { const int tq_ = tidx(); wr = (tq_ >> 8) & 1; wc = (tq_ >> 6) & 3; fr = tq_ & 15; fq = (tq_ >> 4) & 3; }
        f32x4 gc[2][2];
        U4 for (int bj = 0; bj < 2; ++bj) U4 for (int n = 0; n < 2; ++n) gc[bj][n] = *(const f32x4*)(gate + EPI_COL);
        f32x4 xo[2][4];
        { const int ai = 0, m = 0; U4 for (int q = 0; q < 4; ++q) { const int bj = q >> 1, n = q & 1; xo[0][q] = *(const f32x4*)(xsrc + (size_t)EPI_ROW * 1024 + EPI_COL); } }
        U4 for (int bt = 0; bt < 8; ++bt) { const int cb = bt & 1, nb = cb ^ 1;
            if (bt + 1 < 8) { const int ai = (bt + 1) >> 2, m = (bt + 1) & 3; U4 for (int q = 0; q < 4; ++q) { const int bj = q >> 1, n = q & 1; xo[nb][q] = *(const f32x4*)(xsrc + (size_t)EPI_ROW * 1024 + EPI_COL); } }
            { const int ai = bt >> 2, m = bt & 3; U4 for (int q = 0; q < 4; ++q) { const int bj = q >> 1, n = q & 1; *(f32x4*)(xdst + (size_t)EPI_ROW * 1024 + EPI_COL) = xo[cb][q] + gc[bj][n] * acc[ai][bj][m][n]; } }
        }
    }
};
struct EpiSqrelu {
    bf16_t* H; int ldh;
    __device__ __forceinline__ void operator()(const AccT& acc, int wr, int wc, int fr, int fq) const {
        { const int tq_ = tidx(); wr = (tq_ >> 8) & 1; wc = (tq_ >> 6) & 3; fr = tq_ & 15; fq = (tq_ >> 4) & 3; }
        U4 for (int ai = 0; ai < 2; ++ai) U4 for (int m = 0; m < 4; ++m) U4 for (int bj = 0; bj < 2; ++bj) { const int n = 0; const int r = EPI_ROW, c = EPI_COL; f32x4 v0 = acc[ai][bj][m][0], v1 = acc[ai][bj][m][1];
#pragma unroll
            for (int j = 0; j < 4; ++j) { const float t0 = fmaxf(v0[j], 0.f), t1 = fmaxf(v1[j], 0.f); v0[j] = t0 * t0; v1[j] = t1 * t1; }
            u32x4 w; w.x = cvt_pk_bf16(v0[0], v0[1]); w.y = cvt_pk_bf16(v0[2], v0[3]); w.z = cvt_pk_bf16(v1[0], v1[1]); w.w = cvt_pk_bf16(v1[2], v1[3]); *(u32x4*)(H + (size_t)r * ldh + c) = w; }
    }
};

struct XMap { int NT, per_xcd, x, j, bpx;
    __device__ __forceinline__ void init(int bid, int ntt, int nt_) { NT = nt_; per_xcd = (ntt >> 3) * nt_; x = bid & 7; j = bid >> 3; bpx = (int)(gridDim.x >> 3); }
    __device__ __forceinline__ int rounds() const { return j < per_xcd ? (per_xcd - j + bpx - 1) / bpx : 0; }
    __device__ __forceinline__ void get(int i, int& tt, int& nt) const { const int q = i * bpx + j; tt = x + 8 * (q / NT); nt = q % NT; }
};
struct ProgInproj {
    const bf16_t* wt; const bf16_t* wg; const bf16_t* HX; bf16_t* T; bf16_t* PG; const float* biasT; const float* biasG; XMap MA, MB; int rA;
    __device__ __forceinline__ void desc(int i, UDesc& d) const { int tt, nt;
        if (i < rA) { MA.get(i, tt, nt); d.A = (const char*)(wt + (size_t)(nt * 256) * D); d.B = (const char*)(HX + (size_t)(tt * 256) * D); }
        else { MB.get(i - rA, tt, nt); d.A = (const char*)(HX + (size_t)(tt * 256) * D); d.B = (const char*)(wg + (size_t)(nt * 256) * D); }
        d.lda = D; d.ldb = D; d.K = D; }
    __device__ __forceinline__ void epi(int i, const AccT& acc, int wr, int wc, int fr, int fq) const { int tt, nt;
        if (i < rA) { MA.get(i, tt, nt); EpiStoreBf16 E{T + (size_t)(nt * 256) * TOK + (size_t)tt * 256, (size_t)TOK, biasT + nt * 256, true}; E(acc, wr, wc, fr, fq); }
        else { MB.get(i - rA, tt, nt); EpiStoreBf16 E{PG + (size_t)(tt * 256) * NG + nt * 256, (size_t)NG, biasG + nt * 256, false}; E(acc, wr, wc, fr, fq); } }
};
struct ProgMix {
    unsigned char* ws; unsigned char* scr; const float* bgate; unsigned tok0; int l;
    __device__ __forceinline__ void desc(int i, UDesc& d) const { const int nt = i / 6, j = i % 6, X = j >> 1;
        if (!(j & 1)) { d.A = (const char*)(ws + WS_HX) + (size_t)tok0 * D * 2; d.B = (const char*)(ws + WS_WGATE + l * SZ_WGATE) + (size_t)(X * 1024 + nt * 256) * D * 2; d.lda = D; d.ldb = D; d.K = D; }
        else { d.A = X == 0 ? (const char*)(scr + SC_TRY) : (X == 1 ? (const char*)(ws + WS_YG) + (size_t)tok0 * 1024 : (const char*)(scr + SC_TRP));
               d.B = (const char*)(ws + WS_WBR + (size_t)l * 3 * SZ_WBR) + (size_t)X * SZ_WBR + (size_t)(nt * 256) * 1024; d.lda = 512; d.ldb = 512; d.K = 512; } }
    __device__ __forceinline__ void epi(int i, const AccT& acc, int wr, int wc, int fr, int fq) const { const int nt = i / 6, j = i % 6, X = j >> 1;
        if (!(j & 1)) { EpiGate E{(f32x4*)(scr + SC_SG), bgate + X * 1024 + nt * 256}; E(acc, wr, wc, fr, fq); }
        else { EpiBranch E{(const f32x4*)(scr + SC_SG), (f32x4*)(scr + SC_ST), (bf16_t*)(scr + SC_MERGED) + nt * 256, X == 0, X == 2}; E(acc, wr, wc, fr, fq); } }
};
struct ProgResid {
    const bf16_t* A; int lda; const bf16_t* W; int ldw, K; size_t wstep; const float* xsrc; float* xdst; const float* gate;
    __device__ __forceinline__ void desc(int i, UDesc& d) const { d.A = (const char*)A; d.B = (const char*)(W + (size_t)i * wstep); d.lda = lda; d.ldb = ldw; d.K = K; }
    __device__ __forceinline__ void epi(int i, const AccT& acc, int wr, int wc, int fr, int fq) const { EpiResid E{xsrc + i * 256, xdst + i * 256, gate + i * 256}; E(acc, wr, wc, fr, fq); }
};
struct ProgUp {
    const bf16_t* XN; const bf16_t* W; bf16_t* HID;
    __device__ __forceinline__ void desc(int i, UDesc& d) const { d.A = (const char*)XN; d.B = (const char*)(W + (size_t)(i * 256) * D); d.lda = D; d.ldb = D; d.K = D; }
    __device__ __forceinline__ void epi(int i, const AccT& acc, int wr, int wc, int fr, int fq) const { EpiSqrelu E{HID + i * 256, 2048}; E(acc, wr, wc, fr, fq); }
};


struct TileIO { const float* xin; const float* ctxin; float* out; float* ctxs; const float* modl; int l;
    __device__ __forceinline__ const float* src(int tt) const { return tt < 256 ? (l == 0 ? xin : out) + (size_t)tt * 256 * D : ctxin + (size_t)(tt - 256) * 256 * D; }
    __device__ __forceinline__ float* dst(int tt) const { return tt < 256 ? out + (size_t)tt * 256 * D : ctxs + (size_t)(tt - 256) * 256 * D; }
    __device__ __forceinline__ const float* cur(int tt) const { return tt < 256 ? out + (size_t)tt * 256 * D : ctxs + (size_t)(tt - 256) * 256 * D; }
    __device__ __forceinline__ const float* mod(int tt) const { return modl + (size_t)(tt < 256 ? tt >> 3 : 32) * 6144; }
};
struct ProgMix2 {
    unsigned char* ws; unsigned char* stash; const float* bgate; XMap M; int l;
    __device__ __forceinline__ void desc(int ii, UDesc& d) const { int tt, nt; M.get(ii / 6, tt, nt); const int s6 = ii % 6, X = s6 >> 1;
        if (!(s6 & 1)) { d.A = (const char*)(ws + WS_HX) + (size_t)tt * 256 * D * 2; d.B = (const char*)(ws + WS_WGATE + l * SZ_WGATE) + (size_t)(X * 1024 + nt * 256) * D * 2; d.lda = D; d.ldb = D; d.K = D; }
        else { d.A = (const char*)(ws + (X == 0 ? WS_YHY : (X == 1 ? WS_YG : WS_YPL))) + (size_t)tt * 256 * 1024;
               d.B = (const char*)(ws + WS_WBR + (size_t)l * 3 * SZ_WBR) + (size_t)X * SZ_WBR + (size_t)(nt * 256) * 1024; d.lda = 512; d.ldb = 512; d.K = 512; } }
    __device__ __forceinline__ void epi(int ii, const AccT& acc, int wr, int wc, int fr, int fq) const { int tt, nt; M.get(ii / 6, tt, nt); const int s6 = ii % 6, X = s6 >> 1;
        if (!(s6 & 1)) { EpiGate E{(f32x4*)stash, bgate + X * 1024 + nt * 256}; E(acc, wr, wc, fr, fq); }
        else { EpiBranch E{(const f32x4*)stash, (f32x4*)(stash + 262144), (bf16_t*)(ws + WS_MERGED) + (size_t)tt * 256 * 1024 + nt * 256, X == 0, X == 2}; E(acc, wr, wc, fr, fq); } }
};
struct ProgOut2 {
    unsigned char* ws; TileIO io; XMap M; int l;
    __device__ __forceinline__ void desc(int i, UDesc& d) const { int tt, nt; M.get(i, tt, nt);
        d.A = (const char*)(ws + WS_MERGED) + (size_t)tt * 256 * 2048; d.B = (const char*)(ws + WS_WOUT + l * SZ_WOUT) + (size_t)(nt * 256) * D * 2; d.lda = D; d.ldb = D; d.K = D; }
    __device__ __forceinline__ void epi(int i, const AccT& acc, int wr, int wc, int fr, int fq) const { int tt, nt; M.get(i, tt, nt);
        EpiResid E{io.src(tt) + nt * 256, io.dst(tt) + nt * 256, io.mod(tt) + 2048 + nt * 256}; E(acc, wr, wc, fr, fq); }
};
struct ProgUp2 {
    unsigned char* ws; XMap M; int l;
    __device__ __forceinline__ void get(int i, int& tt, int& nt) const { const int ttg = i >> 1, ntg = i & 1; tt = M.x + 8 * (ttg * 4 + (M.j >> 3)); nt = ntg * 8 + (M.j & 7); }
    __device__ __forceinline__ void desc(int i, UDesc& d) const { int tt, nt; get(i, tt, nt);
        d.A = (const char*)(ws + WS_HX) + (size_t)tt * 256 * 2048; d.B = (const char*)(ws + WS_WUP + l * SZ_WUP) + (size_t)(nt * 256) * D * 2; d.lda = D; d.ldb = D; d.K = D; }
    __device__ __forceinline__ void epi(int i, const AccT& acc, int wr, int wc, int fr, int fq) const { int tt, nt; get(i, tt, nt);
        EpiSqrelu E{(bf16_t*)(ws + WS_HID) + (size_t)tt * 256 * DFF + nt * 256, DFF}; E(acc, wr, wc, fr, fq); }
};
struct ProgDown2 {
    unsigned char* ws; TileIO io; XMap M; int l;
    __device__ __forceinline__ void desc(int i, UDesc& d) const { int tt, nt; M.get(i, tt, nt);
        d.A = (const char*)(ws + WS_HID) + (size_t)tt * 256 * DFF * 2; d.B = (const char*)(ws + WS_WDN + l * SZ_WDN) + (size_t)(nt * 256) * DFF * 2; d.lda = DFF; d.ldb = DFF; d.K = DFF; }
    __device__ __forceinline__ void epi(int i, const AccT& acc, int wr, int wc, int fr, int fq) const { int tt, nt; M.get(i, tt, nt);
        EpiResid E{io.cur(tt) + nt * 256, io.dst(tt) + nt * 256, io.mod(tt) + 5120 + nt * 256}; E(acc, wr, wc, fr, fq); }
};

__device__ __forceinline__ void tconv(const float* src, int ld, int c0, int nvalid, int ncols, int K, bf16_t* dst, LAS float* tile) {
    const int tid = tidx(), ntn = ncols / 64, ntile = ntn * (K / 64);
    float v[8];
    { const int t = blockIdx.x; if (t < ntile) { const int k0 = (t / ntn) * 64, n0 = (t % ntn) * 64;
#pragma unroll
        for (int i = 0; i < 8; ++i) { const int k = i * 8 + (tid >> 6), n = tid & 63; v[i] = (n0 + n < nvalid) ? src[(size_t)(k0 + k) * ld + c0 + n0 + n] : 0.f; } } }
    for (int t = blockIdx.x; t < ntile; t += gridDim.x) {
        const int k0 = (t / ntn) * 64, n0 = (t % ntn) * 64;
        __syncthreads();
#pragma unroll
        for (int i = 0; i < 8; ++i) { const int k = i * 8 + (tid >> 6), n = tid & 63; tile[k * 65 + n] = v[i]; }
        { const int t2 = t + gridDim.x; if (t2 < ntile) { const int k2 = (t2 / ntn) * 64, n2 = (t2 % ntn) * 64;
#pragma unroll
            for (int i = 0; i < 8; ++i) { const int k = i * 8 + (tid >> 6), n = tid & 63; v[i] = (n2 + n < nvalid) ? src[(size_t)(k2 + k) * ld + c0 + n2 + n] : 0.f; } } }
        __syncthreads();
        const int n = tid >> 3, kc = (tid & 7) * 8;
        u32x4 w;
        w.x = cvt_pk_bf16(tile[(kc + 0) * 65 + n], tile[(kc + 1) * 65 + n]); w.y = cvt_pk_bf16(tile[(kc + 2) * 65 + n], tile[(kc + 3) * 65 + n]);
        w.z = cvt_pk_bf16(tile[(kc + 4) * 65 + n], tile[(kc + 5) * 65 + n]); w.w = cvt_pk_bf16(tile[(kc + 6) * 65 + n], tile[(kc + 7) * 65 + n]);
        *(u32x4*)(dst + (size_t)(n0 + n) * K + k0 + kc) = w;
    }
    __syncthreads();
}

__device__ __forceinline__ void job_poolcomb(const Params& p, int l) {
    const float* pw = p.in[I_PW] + (size_t)l * 4 * 128 * 128; const float* sc = p.in[I_PSC] + l * 512; const float* wb = p.in[I_WBP] + (size_t)l * 512 * 1024;
    bf16_t* dst = (bf16_t*)(p.ws + WS_WBR + (size_t)(l * 3 + 2) * SZ_WBR);
    for (int idx = blockIdx.x * NTHREADS + tidx(); idx < 512 * 256; idx += gridDim.x * NTHREADS) {
        const int n = (idx & 255) * 4, k = idx >> 8, g = k >> 7, c = k & 127;
        f32x4 a = (f32x4){0.f, 0.f, 0.f, 0.f};
#pragma unroll 8
        for (int d = 0; d < 128; ++d) { const float ps = pw[(g * 128 + c) * 128 + d] * sc[g * 128 + d]; a += ps * *(const f32x4*)(wb + (size_t)(g * 128 + d) * 1024 + n); }
        dst[(size_t)n * 512 + k] = f2bf(a[0]); dst[(size_t)(n + 1) * 512 + k] = f2bf(a[1]); dst[(size_t)(n + 2) * 512 + k] = f2bf(a[2]); dst[(size_t)(n + 3) * 512 + k] = f2bf(a[3]);
    }
}

__device__ __forceinline__ void job_bias(const Params& p) {
    float* bias = (float*)(p.ws + WS_BIAS);
    for (int idx = blockIdx.x * NTHREADS + tidx(); idx < 2 * (NTR + NG); idx += gridDim.x * NTHREADS) {
        const int l = idx / (NTR + NG), j = idx % (NTR + NG); const float* b = p.in[I_BIN] + l * N_IN;
        float v;
        if (j < 1536) v = b[j]; else if (j < NTR) v = b[POOL_OFF + (j - 1536)]; else { const int q = j - NTR; v = q < NGV ? b[GLA_OFF + q] : 0.f; }
        bias[idx] = v;
    }
}

__device__ __forceinline__ void job_mod(const Params& p, LAS float* sil) {
    if (blockIdx.x >= 192) return;
    const int tid = tidx(), lane = tid & 63, kg = tid >> 6;
    float* mod = (float*)(p.ws + WS_MOD);
    for (int it = blockIdx.x; it < 192; it += gridDim.x) {
        __syncthreads();
        for (int idx = tid; idx < 33 * 1024; idx += NTHREADS) { const int r = idx >> 10, k = idx & 1023; const float v = r < 32 ? p.in[I_C][r * 1024 + k] : p.in[I_CCTX][k]; sil[idx] = v / (1.f + expf(-v)); }
        __syncthreads();
        const int l = it / 96, n0 = (it % 96) * 64;
        const float* w = p.in[I_WMOD] + (size_t)l * 1024 * 6144 + n0 + lane;
        float acc[33];
#pragma unroll
        for (int r = 0; r < 33; ++r) acc[r] = 0.f;
#pragma unroll 2
        for (int k4 = 0; k4 < 32; ++k4) { const int k = kg * 128 + k4 * 4;
            const float w0 = w[(size_t)k * 6144], w1 = w[(size_t)(k + 1) * 6144], w2 = w[(size_t)(k + 2) * 6144], w3 = w[(size_t)(k + 3) * 6144];
#pragma unroll
            for (int r = 0; r < 33; ++r) { const f32x4 sv = *(const LAS f32x4*)(sil + r * 1024 + k); acc[r] += sv[0] * w0 + sv[1] * w1 + sv[2] * w2 + sv[3] * w3; } }
        __syncthreads();
#pragma unroll
        for (int r = 0; r < 33; ++r) sil[(kg * 33 + r) * 64 + lane] = acc[r];
        __syncthreads();
        const float bm = p.in[I_BMOD][l * 6144 + n0 + lane];
        for (int r = kg; r < 33; r += 8) { float sum = 0.f;
#pragma unroll
            for (int q = 0; q < 8; ++q) sum += sil[(q * 33 + r) * 64 + lane];
            mod[(size_t)l * 33 * 6144 + (size_t)r * 6144 + n0 + lane] = sum + bm; }
    }
    __syncthreads();
}

__device__ __forceinline__ void job_filters(const Params& p, LAS unsigned char* lds) {
    LAS float* a1 = (LAS float*)lds;
    LAS float* a2 = (LAS float*)(lds + 16384);
    LAS bf16_t* oT = (LAS bf16_t*)(lds + 16384 + 16640);
    LAS float* w2L = (LAS float*)(lds + 16384 + 16640 + 73728);
    const int tid = tidx();
    const int nitems = (32 + 4 + 32) * 4;
    const int nrep = gridDim.x == 256 ? 2 : (nitems + (int)gridDim.x - 1) / (int)gridDim.x;
    for (int rep = 0; rep < nrep; ++rep) {
        int it;
        if (gridDim.x == 256) it = rep == 0 ? (int)blockIdx.x : ((blockIdx.x >= 192 && blockIdx.x < 208) ? 256 + (int)blockIdx.x - 192 : -1);
        else it = (int)blockIdx.x + rep * (int)gridDim.x;
        if (it < 0 || it >= nitems) continue;
        const int oc = it & 3; int rt = it >> 2; int l, L, t0; bf16_t* dst;
        if (rt < 32) { l = 0; L = 2048; t0 = rt * 64; dst = (bf16_t*)(p.ws + WS_HFL); }
        else if (rt < 36) { l = 0; L = 256; t0 = (rt - 32) * 64; dst = (bf16_t*)(p.ws + WS_HFC); }
        else { l = 1; L = 2048; t0 = (rt - 36) * 64; dst = (bf16_t*)(p.ws + WS_HFL) + (size_t)4 * 512 * 2048; }
        const float* w1 = p.in[I_FW1] + l * 17 * 64; const float* b1 = p.in[I_FB1] + l * 64; const float* fq = p.in[I_FFREQ] + l * 64;
        const float* w2 = p.in[I_FW2] + l * 64 * 64; const float* b2 = p.in[I_FB2] + l * 64; const float* w3 = p.in[I_FW3] + (size_t)l * 64 * 2048;
        __syncthreads();
#pragma unroll
        for (int q = 0; q < 2; ++q) *(LAS f32x4*)(w2L + (tid + q * NTHREADS) * 4) = *(const f32x4*)(w2 + (tid + q * NTHREADS) * 4);
        { const int row = tid >> 3, jg = (tid & 7) * 8; const float t = (float)(t0 + row); float z[17];
          z[0] = t / (float)L;
#pragma unroll
          for (int bnd = 1; bnd <= 8; ++bnd) { const float ang = (6.283185307179586f / (float)L) * t * (float)bnd; z[bnd] = cosf(ang); z[8 + bnd] = sinf(ang); }
#pragma unroll
          for (int j = 0; j < 8; ++j) { float s_ = b1[jg + j];
#pragma unroll
              for (int i = 0; i < 17; ++i) s_ += z[i] * w1[i * 64 + jg + j];
              a1[row * 64 + jg + j] = sinf(fq[jg + j] * s_); } }
        __syncthreads();
        { const int row = tid >> 3, jg = (tid & 7) * 8; float acc8[8];
#pragma unroll
          for (int j = 0; j < 8; ++j) acc8[j] = b2[jg + j];
#pragma unroll 4
          for (int i4 = 0; i4 < 64; i4 += 4) { const f32x4 av = *(const LAS f32x4*)(a1 + row * 64 + i4);
#pragma unroll
              for (int ii = 0; ii < 4; ++ii) { const f32x4 wa = *(const LAS f32x4*)(w2L + (i4 + ii) * 64 + jg), wb = *(const LAS f32x4*)(w2L + (i4 + ii) * 64 + jg + 4);
                  acc8[0] += av[ii] * wa[0]; acc8[1] += av[ii] * wa[1]; acc8[2] += av[ii] * wa[2]; acc8[3] += av[ii] * wa[3];
                  acc8[4] += av[ii] * wb[0]; acc8[5] += av[ii] * wb[1]; acc8[6] += av[ii] * wb[2]; acc8[7] += av[ii] * wb[3]; } }
#pragma unroll
          for (int j = 0; j < 8; ++j) a2[row * 65 + jg + j] = sinf(fq[jg + j] * acc8[j]); }
        __syncthreads();
        { const int o = oc * 512 + tid, c = o & 511; float wreg[64];
#pragma unroll
          for (int j = 0; j < 64; ++j) wreg[j] = w3[(size_t)j * 2048 + o];
          const float delta = 3.0701134573253943f + (float)c * ((15.350567286626972f - 3.0701134573253943f) / 511.f);
          for (int row = 0; row < 64; ++row) { float s = 0.f;
#pragma unroll
              for (int j = 0; j < 64; ++j) s += a2[row * 65 + j] * wreg[j];
              const float win = expf(-((float)(t0 + row) / (float)L) * delta);
              oT[tid * 72 + row] = f2bf(s * win); } }
        __syncthreads();
        for (int q = tid; q < 4096; q += NTHREADS) { const int ol = q >> 3, ch = (q & 7) * 8; const int o = oc * 512 + ol, dir = o >> 10, ord = (o >> 9) & 1, c = o & 511;
            const u32x4 w = *(const LAS u32x4*)(oT + ol * 72 + ch);
            *(u32x4*)(dst + ((size_t)((ord * 2 + dir) * 512 + c)) * L + t0 + ch) = w; }
    }
    __syncthreads();
}

__device__ __forceinline__ void ada_write(const f32x4 (&v)[4], float inv, const float* g, const float* sh, const float* sc, bf16_t* dst, float* fdst, int lane) {
#pragma unroll
    for (int i = 0; i < 4; ++i) { const int c = i * 256 + lane * 4; const f32x4 gg = *(const f32x4*)(g + c); f32x4 y = v[i] * inv * gg;
        if (sh) { const f32x4 s1 = *(const f32x4*)(sc + c), s0 = *(const f32x4*)(sh + c); y = y * (1.f + s1) + s0;
            u32x2 w; w.x = cvt_pk_bf16(y[0], y[1]); w.y = cvt_pk_bf16(y[2], y[3]); *(u32x2*)(dst + c) = w; }
        else *(f32x4*)(fdst + c) = y; }
}
__device__ __forceinline__ void ada_row2(const float* xa, const float* xb, bool hb, const float* g, const float* sha, const float* sca, const float* shb, const float* scb,
                                         bf16_t* da, bf16_t* db, float* fa, float* fb, int lane) {
    f32x4 va[4], vb[4]; float sa = 0.f, sb = 0.f;
#pragma unroll
    for (int i = 0; i < 4; ++i) va[i] = *(const f32x4*)(xa + i * 256 + lane * 4);
#pragma unroll
    for (int i = 0; i < 4; ++i) vb[i] = hb ? *(const f32x4*)(xb + i * 256 + lane * 4) : (f32x4){0.f, 0.f, 0.f, 0.f};
#pragma unroll
    for (int i = 0; i < 4; ++i) { sa += va[i][0] * va[i][0] + va[i][1] * va[i][1] + va[i][2] * va[i][2] + va[i][3] * va[i][3]; sb += vb[i][0] * vb[i][0] + vb[i][1] * vb[i][1] + vb[i][2] * vb[i][2] + vb[i][3] * vb[i][3]; }
#pragma unroll
    for (int o = 32; o >= 1; o >>= 1) { sa += __shfl_xor(sa, o); sb += __shfl_xor(sb, o); }
    ada_write(va, rsqrtf(sa * (1.f / 1024.f) + EPS), g, sha, sca, da, fa, lane);
    if (hb) ada_write(vb, rsqrtf(sb * (1.f / 1024.f) + EPS), g, shb, scb, db, fb, lane);
}
__device__ __forceinline__ void ada_row(const float* x, const float* g, const float* sh, const float* sc, bf16_t* dst, float* fdst, int lane) {
    f32x4 v[4]; float ss = 0.f;
#pragma unroll
    for (int i = 0; i < 4; ++i) { v[i] = *(const f32x4*)(x + i * 256 + lane * 4); ss += v[i][0] * v[i][0] + v[i][1] * v[i][1] + v[i][2] * v[i][2] + v[i][3] * v[i][3]; }
    ss = wave_sum(ss);
    const float inv = rsqrtf(ss * (1.f / 1024.f) + EPS);
#pragma unroll
    for (int i = 0; i < 4; ++i) { const int c = i * 256 + lane * 4; const f32x4 gg = *(const f32x4*)(g + c); f32x4 y = v[i] * inv * gg;
        if (sh) { const f32x4 s1 = *(const f32x4*)(sc + c), s0 = *(const f32x4*)(sh + c); y = y * (1.f + s1) + s0;
            u32x2 w; w.x = cvt_pk_bf16(y[0], y[1]); w.y = cvt_pk_bf16(y[2], y[3]); *(u32x2*)(dst + c) = w; }
        else *(f32x4*)(fdst + c) = y; }
}

typedef float f32x16 __attribute__((ext_vector_type(16)));
template <int L, int NT>
__device__ __forceinline__ void hyena_mfma(const Params& p, int l, int c, bool ctx, LAS unsigned char* lds) {
    LAS unsigned char* U = lds;
    LAS unsigned* F = (LAS unsigned*)(lds + L * 64);
    LAS bf16_t* F16 = (LAS bf16_t*)F;
    const int tid = tidx(), lane = tid & 63, w = __builtin_amdgcn_readfirstlane(tid >> 6), li = lane & 31, kg = lane >> 5;
    bf16_t* T = (bf16_t*)(p.ws + WS_T);
    const size_t tokb = ctx ? (size_t)TOKL : 0;
    const bf16_t* hf = ctx ? (const bf16_t*)(p.ws + WS_HFC) : (const bf16_t*)(p.ws + WS_HFL) + (size_t)l * 4 * 512 * 2048;
    const float* sw = p.in[I_HSW] + (size_t)l * 3 * 1536; const float* sb = p.in[I_HSB] + l * 1536;
    __syncthreads();
    {
        const int cc = 1024 + c; const bf16_t* row = T + (size_t)cc * TOK + tokb;
        const float w0 = sw[cc], w1 = sw[1536 + cc], w2 = sw[3072 + cc], bb = sb[cc];
        constexpr int ITER = L / 128, BATCH = ITER >= 4 ? 4 : ITER;
        for (int it0 = 0; it0 < ITER; it0 += BATCH) {
            u32x4 rr[BATCH]; bf16_t hm[BATCH], hp[BATCH];
#pragma unroll
            for (int q = 0; q < BATCH; ++q) { const int idx = tid + (it0 + q) * NTHREADS, bq = idx & 31, t8 = idx >> 5; const bf16_t* pr = row + (size_t)bq * L + t8 * 8;
                rr[q] = *(const u32x4*)pr; hm[q] = t8 > 0 ? pr[-1] : (bf16_t)0; hp[q] = t8 < L / 8 - 1 ? pr[8] : (bf16_t)0; }
#pragma unroll
            for (int q = 0; q < BATCH; ++q) { const int idx = tid + (it0 + q) * NTHREADS; const u32x4 r = rr[q];
                float x[10]; x[0] = bf2f(hm[q]); x[9] = bf2f(hp[q]);
                x[1] = lo16(r.x); x[2] = hi16(r.x); x[3] = lo16(r.y); x[4] = hi16(r.y); x[5] = lo16(r.z); x[6] = hi16(r.z); x[7] = lo16(r.w); x[8] = hi16(r.w);
                float y[8];
#pragma unroll
                for (int j = 0; j < 8; ++j) y[j] = w0 * x[j] + w1 * x[j + 1] + w2 * x[j + 2] + bb;
                u32x4 o; o.x = cvt_pk_bf16(y[0], y[1]); o.y = cvt_pk_bf16(y[2], y[3]); o.z = cvt_pk_bf16(y[4], y[5]); o.w = cvt_pk_bf16(y[6], y[7]);
                *(LAS u32x4*)(U + (size_t)idx * 16) = o; }
        }
    }
    const int lane_dw = (li & 1) * L + ((8 * kg - li + L - (li & 1)) >> 1);
#define HY_LOADA(dst, f) do { const LAS unsigned* _q = F + (lane_dw - 8 * (f)); u32x4 _v; _v.x = _q[0]; _v.y = _q[1]; _v.z = _q[2]; _v.w = _q[3]; dst = __builtin_bit_cast(bf16x8, _v); } while (0)
#define HY_LOADB(dst, s0) dst = *(const LAS bf16x8*)(U + ((s0) >> 3) * 512 + lane * 16)
    for (int ord = 0; ord < 2; ++ord) {
        __syncthreads();
        for (int x0 = tid; x0 < 2 * L; x0 += 4 * NTHREADS) {
            bf16_t fv[4];
#pragma unroll
            for (int q = 0; q < 4; ++q) { const int x = x0 + q * NTHREADS; bf16_t v = 0;
                if (x >= 1 && x <= L) v = hf[((size_t)((ord * 2 + 0) * 512 + c)) * L + (L - x)];
                else if (x > L && x < 2 * L) v = hf[((size_t)((ord * 2 + 1) * 512 + c)) * L + (x - L)];
                fv[q] = v; }
#pragma unroll
            for (int q = 0; q < 4; ++q) { const int x = x0 + q * NTHREADS; const bf16_t v = fv[q];
                if (x < 2 * L) { F16[x] = v; if (x >= 1) F16[2 * L + x - 1] = v; if (x == 2 * L - 1) F16[4 * L - 1] = 0; } } }
        if (false) for (int x = tid; x < 0; ++x) {
            bf16_t v = 0;
            if (x >= 1 && x <= L) v = hf[((size_t)((ord * 2 + 0) * 512 + c)) * L + (L - x)];
            else if (x > L) v = hf[((size_t)((ord * 2 + 1) * 512 + c)) * L + (x - L)];
            F16[x] = v; if (x >= 1) F16[2 * L + x - 1] = v; if (x == 2 * L - 1) F16[4 * L - 1] = 0; }
        __syncthreads();
        f32x16 acc[NT];
#pragma unroll
        for (int i = 0; i < NT; ++i)
#pragma unroll
            for (int r = 0; r < 16; ++r) acc[i][r] = 0.f;
        bf16x8 E[NT], O[NT];
#pragma unroll
        for (int i = 1; i < NT; ++i) { HY_LOADA(E[i], 2 * (NT * w + i)); HY_LOADA(O[i], 2 * (NT * w + i) - 1); }
        for (int n8 = 0; n8 < L / 32; n8 += 8) {
#pragma unroll
            for (int u = 0; u < 8; ++u) { const int n = n8 + u; const int fe = 2 * (NT * w - n); bf16x8 Bf;
                HY_LOADA(E[(8 - u) & (NT - 1)], fe); HY_LOADB(Bf, 32 * n);
#pragma unroll
                for (int i = 0; i < NT; ++i) acc[i] = __builtin_amdgcn_mfma_f32_32x32x16_bf16(E[(i - u) & (NT - 1)], Bf, acc[i], 0, 0, 0);
                HY_LOADA(O[(8 - u) & (NT - 1)], fe - 1); HY_LOADB(Bf, 32 * n + 16);
#pragma unroll
                for (int i = 0; i < NT; ++i) acc[i] = __builtin_amdgcn_mfma_f32_32x32x16_bf16(O[(i - u) & (NT - 1)], Bf, acc[i], 0, 0, 0);
            }
        }
        __syncthreads();
        const int lane2 = tidx() & 63, li = lane2 & 31, kg = lane2 >> 5;
        const int xc = ord * 512 + c; const bf16_t* xrow = T + (size_t)xc * TOK + tokb + (size_t)li * L;
        bf16_t* orow = T + (size_t)c * TOK + tokb + (size_t)li * L;
        const float w0 = sw[xc], w1 = sw[1536 + xc], w2 = sw[3072 + xc], bb = sb[xc], sk = p.in[I_HSKIP][(l * 2 + ord) * 512 + c];
#pragma unroll
        for (int i = 0; i < NT; ++i) {
#pragma unroll
            for (int rh = 0; rh < 4; rh += 2) {
            u32x2 xr4[2]; bf16_t hm[2], hp[2];
#pragma unroll
            for (int r2 = 0; r2 < 2; ++r2) { const int rg = rh + r2; const int tb = 32 * (NT * w + i) + 8 * rg + 4 * kg;
                xr4[r2] = *(const u32x2*)(xrow + tb); hm[r2] = tb > 0 ? xrow[tb - 1] : (bf16_t)0; hp[r2] = tb + 4 < L ? xrow[tb + 4] : (bf16_t)0; }
#pragma unroll
            for (int r2 = 0; r2 < 2; ++r2) { const int rg = rh + r2; const int tb = 32 * (NT * w + i) + 8 * rg + 4 * kg; const u32x2 xr = xr4[r2];
                float x[6]; x[0] = bf2f(hm[r2]); x[5] = bf2f(hp[r2]);
                x[1] = lo16(xr.x); x[2] = hi16(xr.x); x[3] = lo16(xr.y); x[4] = hi16(xr.y);
                LAS u32x2* up = (LAS u32x2*)(U + ((tb >> 3) * 32 + li) * 16 + (tb & 7) * 2);
                const u32x2 uv = *up; const float uu[4] = {lo16(uv.x), hi16(uv.x), lo16(uv.y), hi16(uv.y)};
                float z[4];
#pragma unroll
                for (int j = 0; j < 4; ++j) z[j] = (w0 * x[j] + w1 * x[j + 1] + w2 * x[j + 2] + bb) * (acc[i][rg * 4 + j] + sk * uu[j]);
                u32x2 o; o.x = cvt_pk_bf16(z[0], z[1]); o.y = cvt_pk_bf16(z[2], z[3]);
                if (ord == 0) *up = o; else *(u32x2*)(orow + tb) = o; }
            }
        }
    }
#undef HY_LOADA
#undef HY_LOADB
    __syncthreads();
}

__device__ __forceinline__ void gla_item(const Params& p, int l, int b, int h, int dir, LAS float* lf) {
    const int tid = tidx(), qd = tid & 3, dv = tid >> 2;
    LAS float* qL = lf; LAS float* kL = lf + 2048; LAS float* aL = lf + 4096; LAS float* vL = lf + 6144; LAS float* oL = lf + 10240; LAS float* waL = lf + 14336; LAS float* baL = lf + 15360;
    const bf16_t* PG = (const bf16_t*)(p.ws + WS_PG);
    bf16_t* O = (bf16_t*)(p.ws + WS_OF) + (size_t)dir * TOK * 512;
    const float* wa = (dir ? p.in[I_WAB] : p.in[I_WAF]) + l * 16 * 256; const float* ba = (dir ? p.in[I_BAB] : p.in[I_BAF]) + l * 256;
    __syncthreads();
    for (int i = tid; i < 1024; i += NTHREADS) waL[i] = wa[(i >> 6) * 256 + h * 64 + (i & 63)];
    if (tid < 64) baL[tid] = ba[h * 64 + tid];
    float S[16];
#pragma unroll
    for (int i = 0; i < 16; ++i) S[i] = 0.f;
    const int sp = tid >> 4, sc4 = (tid & 15) * 4, sc8 = (tid & 15) * 8;
    for (int ck = 0; ck < 72; ++ck) {
        const int P = ck * 32 + sp; size_t row;
        if (P < 256) row = (size_t)TOKL + b * 256 + (dir ? 255 - P : P); else { const int tl = P - 256; row = (size_t)b * 2048 + (dir ? 2047 - tl : tl); }
        const bf16_t* pr = PG + row * NG;
        __syncthreads();
        { const u32x2 wq = *(const u32x2*)(pr + h * 64 + sc4), wk = *(const u32x2*)(pr + 256 + h * 64 + sc4);
          *(LAS f32x4*)(qL + sp * 64 + sc4) = (f32x4){lo16(wq.x) * 0.125f, hi16(wq.x) * 0.125f, lo16(wq.y) * 0.125f, hi16(wq.y) * 0.125f};
          *(LAS f32x4*)(kL + sp * 64 + sc4) = (f32x4){lo16(wk.x), hi16(wk.x), lo16(wk.y), hi16(wk.y)};
          const u32x4 wv = *(const u32x4*)(pr + 512 + h * 128 + sc8);
          *(LAS f32x4*)(vL + sp * 128 + sc8) = (f32x4){lo16(wv.x), hi16(wv.x), lo16(wv.y), hi16(wv.y)};
          *(LAS f32x4*)(vL + sp * 128 + sc8 + 4) = (f32x4){lo16(wv.z), hi16(wv.z), lo16(wv.w), hi16(wv.w)};
          const u32x4 g0 = *(const u32x4*)(pr + 1536 + dir * 16), g1 = *(const u32x4*)(pr + 1536 + dir * 16 + 8);
          float gt[16] = {lo16(g0.x), hi16(g0.x), lo16(g0.y), hi16(g0.y), lo16(g0.z), hi16(g0.z), lo16(g0.w), hi16(g0.w),
                          lo16(g1.x), hi16(g1.x), lo16(g1.y), hi16(g1.y), lo16(g1.z), hi16(g1.z), lo16(g1.w), hi16(g1.w)};
#pragma unroll
          for (int j = 0; j < 4; ++j) { float z = baL[sc4 + j];
#pragma unroll
              for (int r = 0; r < 16; ++r) z += gt[r] * waL[r * 64 + sc4 + j];
              const float ls = -(fmaxf(-z, 0.f) + log1pf(expf(-fabsf(z))));
              aL[sp * 64 + sc4 + j] = expf(ls * (1.f / 16.f)); } }
        __syncthreads();
        for (int pos = 0; pos < 32; ++pos) {
            const float vv = vL[pos * 128 + dv]; float part = 0.f;
#pragma unroll
            for (int i4 = 0; i4 < 4; ++i4) { const f32x4 aa = *(const LAS f32x4*)(aL + pos * 64 + qd * 16 + i4 * 4), kk = *(const LAS f32x4*)(kL + pos * 64 + qd * 16 + i4 * 4), qq = *(const LAS f32x4*)(qL + pos * 64 + qd * 16 + i4 * 4);
#pragma unroll
                for (int j = 0; j < 4; ++j) { S[i4 * 4 + j] = aa[j] * S[i4 * 4 + j] + kk[j] * vv; part += qq[j] * S[i4 * 4 + j]; } }
            part += __shfl_xor(part, 1); part += __shfl_xor(part, 2);
            if (qd == 0) oL[pos * 128 + dv] = part;
        }
        __syncthreads();
        { const f32x4 o0 = *(const LAS f32x4*)(oL + sp * 128 + sc8), o1 = *(const LAS f32x4*)(oL + sp * 128 + sc8 + 4);
          u32x4 w; w.x = cvt_pk_bf16(o0[0], o0[1]); w.y = cvt_pk_bf16(o0[2], o0[3]); w.z = cvt_pk_bf16(o1[0], o1[1]); w.w = cvt_pk_bf16(o1[2], o1[3]);
          *(u32x4*)(O + row * 512 + h * 128 + sc8) = w; }
    }
    __syncthreads();
}


__device__ __forceinline__ size_t gla_row(int P, int b, int dir) { return P < 256 ? (size_t)TOKL + b * 256 + (dir ? 255 - P : P) : (size_t)b * 2048 + (dir ? 2047 - (P - 256) : (P - 256)); }
__device__ __forceinline__ void gla_chunk_item(const Params& p, int l, int b, int h, int dir, LAS unsigned char* lds) {
    constexpr int RS = 72;
    LAS bf16_t* QD = (LAS bf16_t*)lds; LAS bf16_t* KI = QD + 64 * RS; LAS bf16_t* KET = KI + 64 * RS; LAS bf16_t* PP = KET + 64 * RS;
    LAS bf16_t* VT = PP + 64 * RS; LAS bf16_t* ST = VT + 128 * RS;
    LAS float* TOT = (LAS float*)(ST + 128 * RS); LAS float* DEC = TOT + 512; LAS float* WAL = DEC + 64; LAS float* BAL = WAL + 1024;
    const int tid = tidx(), lane = tid & 63, w = __builtin_amdgcn_readfirstlane(tid >> 6), i = tid >> 3, dg = tid & 7, d0 = dg * 8, l5 = lane & 31, hh = lane >> 5;
    const int ih = w >> 2, vq = w & 3;
    const bf16_t* PG = (const bf16_t*)(p.ws + WS_PG);
    bf16_t* O = (bf16_t*)(p.ws + WS_OF) + (size_t)dir * TOK * 512;
    const float* wa = (dir ? p.in[I_WAB] : p.in[I_WAF]) + l * 16 * 256; const float* ba = (dir ? p.in[I_BAB] : p.in[I_BAF]) + l * 256;
    __syncthreads();
    for (int q = tid; q < 1024; q += NTHREADS) WAL[q] = wa[(q >> 6) * 256 + h * 64 + (q & 63)];
    if (tid < 64) BAL[tid] = ba[h * 64 + tid];
    for (int q = tid; q < 73728 / 16; q += NTHREADS) *(LAS u32x4*)(lds + q * 16) = (u32x4){0u, 0u, 0u, 0u};
    f32x16 accS;
#pragma unroll
    for (int r = 0; r < 16; ++r) accS[r] = 0.f;
    u32x4 rq, rk, rg0, rg1, rv0, rv1;
    { const bf16_t* pr = PG + gla_row(i, b, dir) * NG;
      rq = *(const u32x4*)(pr + h * 64 + d0); rk = *(const u32x4*)(pr + 256 + h * 64 + d0); rg0 = *(const u32x4*)(pr + 1536 + dir * 16); rg1 = *(const u32x4*)(pr + 1536 + dir * 16 + 8);
      rv0 = *(const u32x4*)(pr + 512 + h * 128 + dg * 16); rv1 = *(const u32x4*)(pr + 512 + h * 128 + dg * 16 + 8); }
    __syncthreads();
    for (int ck = 0; ck < 36; ++ck) {
        float qf[8] = {lo16(rq.x), hi16(rq.x), lo16(rq.y), hi16(rq.y), lo16(rq.z), hi16(rq.z), lo16(rq.w), hi16(rq.w)};
        float kf[8] = {lo16(rk.x), hi16(rk.x), lo16(rk.y), hi16(rk.y), lo16(rk.z), hi16(rk.z), lo16(rk.w), hi16(rk.w)};
        float gt[16] = {lo16(rg0.x), hi16(rg0.x), lo16(rg0.y), hi16(rg0.y), lo16(rg0.z), hi16(rg0.z), lo16(rg0.w), hi16(rg0.w),
                        lo16(rg1.x), hi16(rg1.x), lo16(rg1.y), hi16(rg1.y), lo16(rg1.z), hi16(rg1.z), lo16(rg1.w), hi16(rg1.w)};
        float la[8];
#pragma unroll
        for (int j = 0; j < 8; ++j) { float z = BAL[d0 + j];
#pragma unroll
            for (int r = 0; r < 16; ++r) z += gt[r] * WAL[r * 64 + d0 + j];
            la[j] = -(fmaxf(-z, 0.f) + __logf(1.f + __expf(-fabsf(z)))) * (1.f / 16.f); }
#pragma unroll
        for (int st = 8; st < 64; st <<= 1) {
#pragma unroll
            for (int j = 0; j < 8; ++j) { const float y = __shfl_up(la[j], st); if (lane >= st) la[j] += y; } }
        if ((lane >> 3) == 7) { *(LAS f32x4*)(TOT + w * 64 + d0) = (f32x4){la[0], la[1], la[2], la[3]}; *(LAS f32x4*)(TOT + w * 64 + d0 + 4) = (f32x4){la[4], la[5], la[6], la[7]}; }
        __syncthreads();
        {
            float pre[8], bl[8];
#pragma unroll
            for (int j = 0; j < 8; ++j) { pre[j] = 0.f; bl[j] = 0.f; }
#pragma unroll
            for (int ww = 0; ww < 8; ++ww) { const f32x4 t0 = *(const LAS f32x4*)(TOT + ww * 64 + d0), t1 = *(const LAS f32x4*)(TOT + ww * 64 + d0 + 4);
                const float tv[8] = {t0[0], t0[1], t0[2], t0[3], t1[0], t1[1], t1[2], t1[3]};
#pragma unroll
                for (int j = 0; j < 8; ++j) { bl[j] += tv[j]; if (ww < w) pre[j] += tv[j]; } }
            float qd[8], ki[8], ke[8], eb[8];
#pragma unroll
            for (int j = 0; j < 8; ++j) { const float bc = la[j] + pre[j]; const float e1 = __expf(bc), e2 = __builtin_amdgcn_rcpf(e1); eb[j] = __expf(bl[j]);
                qd[j] = qf[j] * 0.125f * e1; ki[j] = kf[j] * e2; ke[j] = kf[j] * (eb[j] * e2); }
            u32x4 wq, wk;
            wq.x = cvt_pk_bf16(qd[0], qd[1]); wq.y = cvt_pk_bf16(qd[2], qd[3]); wq.z = cvt_pk_bf16(qd[4], qd[5]); wq.w = cvt_pk_bf16(qd[6], qd[7]);
            wk.x = cvt_pk_bf16(ki[0], ki[1]); wk.y = cvt_pk_bf16(ki[2], ki[3]); wk.z = cvt_pk_bf16(ki[4], ki[5]); wk.w = cvt_pk_bf16(ki[6], ki[7]);
            *(LAS u32x4*)(QD + i * RS + d0) = wq; *(LAS u32x4*)(KI + i * RS + d0) = wk;
#pragma unroll
            for (int j = 0; j < 8; j += 2) { const unsigned pk = cvt_pk_bf16(ke[j], ke[j + 1]); KET[(d0 + j) * RS + i] = (bf16_t)(pk & 0xffffu); KET[(d0 + j + 1) * RS + i] = (bf16_t)(pk >> 16); }
            const unsigned vv[8] = {rv0.x, rv0.y, rv0.z, rv0.w, rv1.x, rv1.y, rv1.z, rv1.w};
#pragma unroll
            for (int j = 0; j < 8; ++j) { VT[(dg * 16 + 2 * j) * RS + i] = (bf16_t)(vv[j] & 0xffffu); VT[(dg * 16 + 2 * j + 1) * RS + i] = (bf16_t)(vv[j] >> 16); }
            if (i == 0) { *(LAS f32x4*)(DEC + d0) = (f32x4){eb[0], eb[1], eb[2], eb[3]}; *(LAS f32x4*)(DEC + d0 + 4) = (f32x4){eb[4], eb[5], eb[6], eb[7]}; }
        }
        if (ck + 1 < 36) { const bf16_t* pr = PG + gla_row((ck + 1) * 64 + i, b, dir) * NG;
            rq = *(const u32x4*)(pr + h * 64 + d0); rk = *(const u32x4*)(pr + 256 + h * 64 + d0); rg0 = *(const u32x4*)(pr + 1536 + dir * 16); rg1 = *(const u32x4*)(pr + 1536 + dir * 16 + 8);
            rv0 = *(const u32x4*)(pr + 512 + h * 128 + dg * 16); rv1 = *(const u32x4*)(pr + 512 + h * 128 + dg * 16 + 8); }
        __syncthreads();
        f32x16 accO;
#pragma unroll
        for (int r = 0; r < 16; ++r) accO[r] = 0.f;
#pragma unroll
        for (int ks = 0; ks < 4; ++ks) { const bf16x8 A = *(const LAS bf16x8*)(QD + (ih * 32 + l5) * RS + ks * 16 + hh * 8), Bv = *(const LAS bf16x8*)(ST + (vq * 32 + l5) * RS + ks * 16 + hh * 8);
            accO = __builtin_amdgcn_mfma_f32_32x32x16_bf16(A, Bv, accO, 0, 0, 0); }
        if (w < 3) { const int si = w == 0 ? 0 : 1, sj = w == 2 ? 1 : 0; f32x16 accP;
#pragma unroll
            for (int r = 0; r < 16; ++r) accP[r] = 0.f;
#pragma unroll
            for (int ks = 0; ks < 4; ++ks) { const bf16x8 A = *(const LAS bf16x8*)(QD + (si * 32 + l5) * RS + ks * 16 + hh * 8), Bv = *(const LAS bf16x8*)(KI + (sj * 32 + l5) * RS + ks * 16 + hh * 8);
                accP = __builtin_amdgcn_mfma_f32_32x32x16_bf16(A, Bv, accP, 0, 0, 0); }
#pragma unroll
            for (int r = 0; r < 16; ++r) { const int ii = si * 32 + (r & 3) + 8 * (r >> 2) + 4 * hh, jj = sj * 32 + l5; PP[ii * RS + jj] = f2bf(jj <= ii ? accP[r] : 0.f); } }
        __syncthreads();
        { const int nk = ih == 0 ? 2 : 4;
          for (int ks = 0; ks < nk; ++ks) { const bf16x8 A = *(const LAS bf16x8*)(PP + (ih * 32 + l5) * RS + ks * 16 + hh * 8), Bv = *(const LAS bf16x8*)(VT + (vq * 32 + l5) * RS + ks * 16 + hh * 8);
              accO = __builtin_amdgcn_mfma_f32_32x32x16_bf16(A, Bv, accO, 0, 0, 0); } }
#pragma unroll
        for (int rg = 0; rg < 4; ++rg) { const f32x4 dv = *(const LAS f32x4*)(DEC + ih * 32 + 8 * rg + 4 * hh);
#pragma unroll
            for (int j = 0; j < 4; ++j) accS[rg * 4 + j] *= dv[j]; }
#pragma unroll
        for (int ks = 0; ks < 4; ++ks) { const bf16x8 A = *(const LAS bf16x8*)(KET + (ih * 32 + l5) * RS + ks * 16 + hh * 8), Bv = *(const LAS bf16x8*)(VT + (vq * 32 + l5) * RS + ks * 16 + hh * 8);
            accS = __builtin_amdgcn_mfma_f32_32x32x16_bf16(A, Bv, accS, 0, 0, 0); }
#pragma unroll
        for (int r = 0; r < 16; ++r) { const int ii = ih * 32 + (r & 3) + 8 * (r >> 2) + 4 * hh;
            O[gla_row(ck * 64 + ii, b, dir) * 512 + h * 128 + vq * 32 + l5] = f2bf(accO[r]); }
#pragma unroll
        for (int rg = 0; rg < 4; ++rg) { u32x2 o; o.x = cvt_pk_bf16(accS[rg * 4], accS[rg * 4 + 1]); o.y = cvt_pk_bf16(accS[rg * 4 + 2], accS[rg * 4 + 3]);
            *(LAS u32x2*)(ST + (vq * 32 + l5) * RS + ih * 32 + 8 * rg + 4 * hh) = o; }
        __syncthreads();
    }
    __syncthreads();
}

template <int W>
__device__ __forceinline__ void pool2d_wave(bf16_t* base, int lane) {
    float u[32], pv[33];
#pragma unroll
    for (int r = 0; r < 32; ++r) u[r] = bf2f(base[r * 64 + lane]);
    pv[0] = 0.f;
#pragma unroll
    for (int r = 0; r < 32; ++r) pv[r + 1] = pv[r] + u[r];
    const int cl = max(lane - W / 2, 0), chh = min(lane - W / 2 + W, 64);
#pragma unroll
    for (int r = 0; r < 32; ++r) {
        const int rl = (r - W / 2) < 0 ? 0 : (r - W / 2), rh = (r - W / 2 + W) > 32 ? 32 : (r - W / 2 + W);
        float x = pv[rh] - pv[rl];
#pragma unroll
        for (int d = 1; d < 64; d <<= 1) { const float y = __shfl_up(x, d); if (lane >= d) x += y; }
        const float hi = __shfl(x, chh - 1), lo = __shfl(x, cl > 0 ? cl - 1 : 0);
        const float s = hi - (cl > 0 ? lo : 0.f);
        const float cnt = (float)((rh - rl) * (chh - cl));
        base[r * 64 + lane] = f2bf(s / cnt - u[r]);
    }
}
__device__ __forceinline__ void pool1d_wave(bf16_t* base, int lane, int W) {
    float u[4], P[4];
#pragma unroll
    for (int j = 0; j < 4; ++j) u[j] = bf2f(base[j * 64 + lane]);
    float off = 0.f;
#pragma unroll
    for (int j = 0; j < 4; ++j) { float x = u[j];
#pragma unroll
        for (int d = 1; d < 64; d <<= 1) { const float y = __shfl_up(x, d); if (lane >= d) x += y; }
        P[j] = x + off; off += __shfl(x, 63); }
#pragma unroll
    for (int j = 0; j < 4; ++j) { const int t = j * 64 + lane; const int lo = max(t - W / 2, 0), hi = min(t - W / 2 + W, 256);
        const int ih = hi - 1, il = lo > 0 ? lo - 1 : 0;
        float vh = 0.f, vl = 0.f;
#pragma unroll
        for (int s = 0; s < 4; ++s) { const float a = __shfl(P[s], ih & 63), bq = __shfl(P[s], il & 63); if ((ih >> 6) == s) vh = a; if ((il >> 6) == s) vl = bq; }
        const float sum = vh - (lo > 0 ? vl : 0.f);
        u[j] = sum / (float)(hi - lo) - u[j]; }
#pragma unroll
    for (int j = 0; j < 4; ++j) base[j * 64 + lane] = f2bf(u[j]);
}

__global__ void __launch_bounds__(NTHREADS, 2) mega(Params p) {
    extern __shared__ __attribute__((aligned(16))) unsigned char lds_raw[];
    LAS unsigned char* lds = (LAS unsigned char*)lds_raw;
    LAS float* lf = (LAS float*)lds;
    cg::grid_group grid = cg::this_grid();
    unsigned bar_n = 0; unsigned* bar_ctr = (unsigned*)(p.ws + WS_BAR);
#define GBAR() do { bar_n += gridDim.x; gbar(bar_ctr, bar_n); } while (0)
    const int G = gridDim.x, bid = blockIdx.x;
#define WSPTRS const int tid = tidx(), lane = tid & 63, wid = tid >> 6; (void)lane; (void)wid; unsigned char* ws = opq(p.ws); bf16_t* HX = (bf16_t*)(ws + WS_HX); bf16_t* T = (bf16_t*)(ws + WS_T); bf16_t* YG = (bf16_t*)(ws + WS_YG); bf16_t* PG = (bf16_t*)(ws + WS_PG); \
    float* CTXS = (float*)(ws + WS_CTX); const float* MOD = (const float*)(ws + WS_MOD); const float* BIAS = (const float*)(ws + WS_BIAS); (void)HX; (void)T; (void)YG; (void)PG; (void)CTXS; (void)MOD; (void)BIAS;

#ifdef TIMEX
    unsigned long long tx0 = 0, tx1 = 0; int txn = 0;
#define TX_MARK() do { if (txn == TIMEX) tx0 = __builtin_amdgcn_s_memrealtime(); if (txn == TIMEX + 1) tx1 = __builtin_amdgcn_s_memrealtime(); ++txn; } while (0)
    unsigned long long cx0 = 0, cxacc = 0;
#define CX_BEGIN(k) do { if (TIMEX == 100 + (k) && l == 1) { __syncthreads(); cx0 = __builtin_amdgcn_s_memrealtime(); } } while (0)
#define CX_END(k) do { if (TIMEX == 100 + (k) && l == 1) { __syncthreads(); cxacc += __builtin_amdgcn_s_memrealtime() - cx0; } } while (0)
#else
#define TX_MARK() do {} while (0)
#define CX_BEGIN(k) do {} while (0)
#define CX_END(k) do {} while (0)
#endif
    TX_MARK();
    for (int l = 0; l < 2; ++l) {
        unsigned char* ws = opq(p.ws);
        const float* win = p.in[I_WIN] + (size_t)l * D * N_IN;
        bf16_t* wt = (bf16_t*)(ws + WS_WT + l * SZ_WT);
        tconv(win, N_IN, 0, 1536, 1536, D, wt, lf);
        tconv(win, N_IN, POOL_OFF, 512, 512, D, wt + (size_t)1536 * D, lf);
        tconv(win, N_IN, GLA_OFF, NGV, NG, D, (bf16_t*)(ws + WS_WG + l * SZ_WG), lf);
        tconv(win, N_IN, GATE_OFF, 3072, 3072, D, (bf16_t*)(ws + WS_WGATE + l * SZ_WGATE), lf);
        tconv(p.in[I_WBH] + (size_t)l * 512 * 1024, 1024, 0, 1024, 1024, 512, (bf16_t*)(ws + WS_WBR + (size_t)(l * 3 + 0) * SZ_WBR), lf);
        tconv(p.in[I_WBG] + (size_t)l * 512 * 1024, 1024, 0, 1024, 1024, 512, (bf16_t*)(ws + WS_WBR + (size_t)(l * 3 + 1) * SZ_WBR), lf);
        tconv(p.in[I_WOUT] + (size_t)l * D * D, D, 0, D, D, D, (bf16_t*)(ws + WS_WOUT + l * SZ_WOUT), lf);
        tconv(p.in[I_WUP] + (size_t)l * D * DFF, DFF, 0, DFF, DFF, D, (bf16_t*)(ws + WS_WUP + l * SZ_WUP), lf);
        tconv(p.in[I_WDN] + (size_t)l * DFF * D, D, 0, D, D, DFF, (bf16_t*)(ws + WS_WDN + l * SZ_WDN), lf);
        job_poolcomb(p, l);
    }
    job_bias(p);
    job_mod(p, lf);
    job_filters(p, lds);
    if (p.ws == nullptr) grid.sync();
    GBAR();

    { WSPTRS
    for (int row = bid * 8 + wid; row < TOK; row += 2 * G * 8) {
        const int rb = row + G * 8; const bool hb = rb < TOK; const int rb2 = hb ? rb : row;
        const bool la = row < TOKL, lb = rb2 < TOKL;
        const float* xa = la ? p.in[I_X] + (size_t)row * D : p.in[I_CTX] + (size_t)(row - TOKL) * D; const float* xb = lb ? p.in[I_X] + (size_t)rb2 * D : p.in[I_CTX] + (size_t)(rb2 - TOKL) * D;
        const float* ma = MOD + (size_t)(la ? row >> 11 : 32) * 6144; const float* mb = MOD + (size_t)(lb ? rb2 >> 11 : 32) * 6144;
        ada_row2(xa, xb, hb, p.in[I_NMIX], ma, ma + 1024, mb, mb + 1024, HX + (size_t)row * D, HX + (size_t)rb2 * D, nullptr, nullptr, lane);
    } }
    GBAR();
    TX_MARK();

    for (int l_ = 0; l_ < 2; ++l_) {
        const int l = opqi(l_);
        { WSPTRS
            const int ntokt = l == 0 ? 288 : 256;
            const int nA = ntokt * 8, nB = 288 * 7;
            const bf16_t* wt = (const bf16_t*)(ws + WS_WT + l * SZ_WT); const bf16_t* wg = (const bf16_t*)(ws + WS_WG + l * SZ_WG);
            const float* biasT = BIAS + l * (NTR + NG); const float* biasG = biasT + NTR;
            XMap MA, MB; MA.init(bid, ntokt, 8); MB.init(bid, 288, 7);
            ProgInproj P{wt, wg, HX, T, PG, biasT, biasG, MA, MB, MA.rounds()};
            gemm_stream(lds, MA.rounds() + MB.rounds(), P);
        }
        GBAR();
        TX_MARK();
        { WSPTRS
            for (int it = bid; it < 256; it += G) gla_chunk_item(p, l, it >> 3, (it >> 1) & 3, it & 1, lds);
            for (int it = bid; it < 512; it += G) hyena_mfma<2048, 8>(p, l, it, false, lds);
            if (l == 0) for (int it = bid; it < 512; it += G) hyena_mfma<256, 1>(p, l, it, true, lds);
            const int npl = l == 0 ? 32768 : 16384;
            for (int it = bid * 8 + wid; it < npl; it += G * 8) { const bool cx = it >= 16384; const int j = it & 16383, ch = j >> 5, b = j & 31, g = ch >> 7;
                bf16_t* base = T + (size_t)(1536 + ch) * TOK + (cx ? (size_t)TOKL + b * 256 : (size_t)b * 2048);
                if (cx) pool1d_wave(base, lane, 2 << g);
                else { if (g == 0) pool2d_wave<2>(base, lane); else if (g == 1) pool2d_wave<4>(base, lane); else if (g == 2) pool2d_wave<8>(base, lane); else pool2d_wave<16>(base, lane); } }
        }
        GBAR();
        TX_MARK();
        {
            WSPTRS
            const bf16_t* OF = (const bf16_t*)(ws + WS_OF); const bf16_t* OB = OF + (size_t)TOK * 512; const float* nw = p.in[I_GNW] + l * 128;
            const int ntok = l == 0 ? TOK : TOKL;
            for (int row = bid * 8 + wid; row < ntok; row += 2 * G * 8) {
                const int rowb = row + G * 8; const bool hb = rowb < ntok; const int rows[2] = {row, hb ? rowb : row};
                u32x4 av[2], bv[2], rv[2];
#pragma unroll
                for (int q = 0; q < 2; ++q) { av[q] = *(const u32x4*)(OF + (size_t)rows[q] * 512 + lane * 8); bv[q] = *(const u32x4*)(OB + (size_t)rows[q] * 512 + lane * 8); rv[q] = *(const u32x4*)(PG + (size_t)rows[q] * NG + 1024 + lane * 8); }
#pragma unroll
                for (int q = 0; q < 2; ++q) { if (q == 1 && !hb) break;
                    const u32x4 a = av[q], bq = bv[q], rr = rv[q];
                    float o[8] = {lo16(a.x) + lo16(bq.x), hi16(a.x) + hi16(bq.x), lo16(a.y) + lo16(bq.y), hi16(a.y) + hi16(bq.y), lo16(a.z) + lo16(bq.z), hi16(a.z) + hi16(bq.z), lo16(a.w) + lo16(bq.w), hi16(a.w) + hi16(bq.w)};
                    float r[8] = {lo16(rr.x), hi16(rr.x), lo16(rr.y), hi16(rr.y), lo16(rr.z), hi16(rr.z), lo16(rr.w), hi16(rr.w)};
                    float ss = 0.f;
#pragma unroll
                    for (int j = 0; j < 8; ++j) ss += o[j] * o[j];
                    ss += __shfl_xor(ss, 1); ss += __shfl_xor(ss, 2); ss += __shfl_xor(ss, 4); ss += __shfl_xor(ss, 8);
                    const float inv = rsqrtf(ss * (1.f / 128.f) + EPS);
                    float y[8];
#pragma unroll
                    for (int j = 0; j < 8; ++j) y[j] = o[j] * inv * nw[(lane & 15) * 8 + j] * (r[j] * sigmoidf_(r[j]));
                    u32x4 w; w.x = cvt_pk_bf16(y[0], y[1]); w.y = cvt_pk_bf16(y[2], y[3]); w.z = cvt_pk_bf16(y[4], y[5]); w.w = cvt_pk_bf16(y[6], y[7]);
                    *(u32x4*)(YG + (size_t)rows[q] * 512 + lane * 8) = w; }
            }
            LAS bf16_t* tl = (LAS bf16_t*)lds;
            const int nit = 2 * (l == 0 ? 288 : 256) * 8;
            for (int it = bid; it < nit; it += G) { const int ctile = it & 7, tt = (it >> 3) % (l == 0 ? 288 : 256), which = (it >> 3) / (l == 0 ? 288 : 256);
                const bf16_t* src = T + (size_t)(which ? 1536 : 0) * TOK + (size_t)tt * 256; bf16_t* dst = (bf16_t*)(ws + (which ? WS_YPL : WS_YHY)) + (size_t)tt * 256 * 512;
                __syncthreads();
#pragma unroll
                for (int i = 0; i < 4; ++i) { const int idx = tid + i * NTHREADS, c = idx >> 5, t8 = (idx & 31) * 8;
                    *(LAS u32x4*)(tl + c * 264 + t8) = *(const u32x4*)(src + (size_t)(ctile * 64 + c) * TOK + t8); }
                __syncthreads();
#pragma unroll
                for (int i = 0; i < 4; ++i) { const int idx = tid + i * NTHREADS, tk = idx >> 3, c8 = (idx & 7) * 8; unsigned w[4];
#pragma unroll
                    for (int j = 0; j < 4; ++j) w[j] = (unsigned)tl[(c8 + 2 * j) * 264 + tk] | ((unsigned)tl[(c8 + 2 * j + 1) * 264 + tk] << 16);
                    *(u32x4*)(dst + (size_t)tk * 512 + ctile * 64 + c8) = (u32x4){w[0], w[1], w[2], w[3]}; }
            }
            __syncthreads();
        }
        GBAR();
        TX_MARK();
        const int ntt = l == 0 ? 288 : 256;
        { WSPTRS
          XMap M; M.init(bid, ntt, 4);
          ProgMix2 P{ws, ws + WS_STASH + (size_t)bid * 524288, p.in[I_BIN] + l * N_IN + GATE_OFF, M, l};
          gemm_stream(lds, 6 * M.rounds(), P); }
        GBAR();
        { WSPTRS
          XMap M; M.init(bid, ntt, 4);
          TileIO io{p.in[I_X], p.in[I_CTX], p.out, CTXS, MOD + (size_t)l * 33 * 6144, l};
          ProgOut2 P{ws, io, M, l};
          gemm_stream(lds, M.rounds(), P); }
        GBAR();
        { WSPTRS
          const float* modl = MOD + (size_t)l * 33 * 6144; const int nrow = ntt * 256;
          for (int row = bid * 8 + wid; row < nrow; row += 2 * G * 8) { const int rb = row + G * 8; const bool hb = rb < nrow; const int rb2 = hb ? rb : row; const bool la = row < TOKL, lb = rb2 < TOKL;
              const float* xa = la ? p.out + (size_t)row * D : CTXS + (size_t)(row - TOKL) * D; const float* xb = lb ? p.out + (size_t)rb2 * D : CTXS + (size_t)(rb2 - TOKL) * D;
              const float* ma = modl + (size_t)(la ? row >> 11 : 32) * 6144; const float* mb = modl + (size_t)(lb ? rb2 >> 11 : 32) * 6144;
              ada_row2(xa, xb, hb, p.in[I_NFFN] + l * D, ma + 3072, ma + 4096, mb + 3072, mb + 4096, HX + (size_t)row * D, HX + (size_t)rb2 * D, nullptr, nullptr, lane); } }
        GBAR();
        { WSPTRS
          XMap M; M.init(bid, ntt, 16);
          ProgUp2 P{ws, M, l};
          gemm_stream(lds, M.rounds(), P); }
        GBAR();
        { WSPTRS
          XMap M; M.init(bid, ntt, 4);
          TileIO io{p.in[I_X], p.in[I_CTX], p.out, CTXS, MOD + (size_t)l * 33 * 6144, l};
          ProgDown2 P{ws, io, M, l};
          gemm_stream(lds, M.rounds(), P); }
        GBAR();
        { WSPTRS
          const int nrow = ntt * 256;
          for (int row = bid * 8 + wid; row < nrow; row += 2 * G * 8) { const int rb = row + G * 8; const bool hb = rb < nrow; const int rb2 = hb ? rb : row; const bool la = row < TOKL, lb = rb2 < TOKL;
              float* xa = la ? p.out + (size_t)row * D : CTXS + (size_t)(row - TOKL) * D; float* xb = lb ? p.out + (size_t)rb2 * D : CTXS + (size_t)(rb2 - TOKL) * D;
              if (l == 0) { const float* ma = MOD + (size_t)33 * 6144 + (size_t)(la ? row >> 11 : 32) * 6144; const float* mb = MOD + (size_t)33 * 6144 + (size_t)(lb ? rb2 >> 11 : 32) * 6144;
                  ada_row2(xa, xb, hb, p.in[I_NMIX] + D, ma, ma + 1024, mb, mb + 1024, HX + (size_t)row * D, HX + (size_t)rb2 * D, nullptr, nullptr, lane); }
              else ada_row2(xa, xb, hb, p.in[I_NFIN], nullptr, nullptr, nullptr, nullptr, nullptr, nullptr, xa, xb, lane); } }
        if (l == 0) GBAR();
        TX_MARK();
    }
#ifdef TIMEX
    if (blockIdx.x == 0 && threadIdx.x == 0) { const unsigned long long t = __builtin_amdgcn_s_memrealtime(); while (__builtin_amdgcn_s_memrealtime() - t < (unsigned long long)TIMEX_MULT * (TIMEX >= 100 ? cxacc : (tx1 - tx0))) __builtin_amdgcn_s_sleep(10); }
#endif
}

extern "C" void kernel_launch(void* const* d_in, const int* in_sizes, int n_in, void* d_out, int out_size,
                              void* d_ws, size_t ws_size, hipStream_t stream) {
    static int grid_blocks = 0;
    if (!grid_blocks) {
        int dev = 0, cus = 0, per_cu = 0;
        (void)hipGetDevice(&dev);
        (void)hipDeviceGetAttribute(&cus, hipDeviceAttributeMultiprocessorCount, dev);
        (void)hipFuncSetAttribute((const void*)mega, hipFuncAttributeMaxDynamicSharedMemorySize, LDS_BYTES);
        (void)hipOccupancyMaxActiveBlocksPerMultiprocessor(&per_cu, (const void*)mega, NTHREADS, LDS_BYTES);
        grid_blocks = cus > 256 ? 256 : cus;
        if (ws_size < WS_END || n_in != 33 || out_size != TOKL * D) { fprintf(stderr, "kernel_launch: unexpected sizes ws=%zu need=%zu n_in=%d out=%d\n", ws_size, (size_t)WS_END, n_in, out_size); grid_blocks = -1; }
    }
    if (grid_blocks < 0) return;
    Params p{};
    for (int i = 0; i < 33; ++i) p.in[i] = (const float*)d_in[i];
    p.out = (float*)d_out; p.ws = (unsigned char*)d_ws;
    (void)hipMemsetAsync((unsigned char*)d_ws + WS_BAR, 0, 256, stream);
    void* args[] = {&p};
    hipError_t e = hipLaunchCooperativeKernel((const void*)mega, dim3(grid_blocks), dim3(NTHREADS), args, LDS_BYTES, stream);
    if (e != hipSuccess) fprintf(stderr, "cooperative launch failed: %s (grid %d)\n", hipGetErrorString(e), grid_blocks);
}
```

```cpp
#include <hip/hip_runtime.h>
#include <hip/hip_cooperative_groups.h>
#include <cstdio>
#include <cstdint>
namespace cg = cooperative_groups;

#define LAS __attribute__((address_space(3)))
typedef unsigned short bf16_t;
typedef short bf16x8 __attribute__((ext_vector_type(8)));
typedef float f32x4 __attribute__((ext_vector_type(4)));
typedef unsigned u32x2 __attribute__((ext_vector_type(2)));
typedef unsigned u32x4 __attribute__((ext_vector_type(4)));

constexpr int NTHREADS = 512;
constexpr int LDS_BYTES = 147456;
constexpr int D = 1024, NB = 32, SEQ = 2048, CTXL = 256;
constexpr int TOKL = NB * SEQ, TOKC = NB * CTXL, TOK = TOKL + TOKC;
constexpr int N_IN = 6688, GLA_OFF = 1536, POOL_OFF = 3104, GATE_OFF = 3616;
constexpr int NTR = 2048, NG = 1792, NGV = 1568, DFF = 4096;
constexpr float EPS = 1e-6f;

constexpr size_t SZ_WT = (size_t)NTR * D * 2, SZ_WG = (size_t)NG * D * 2, SZ_WGATE = (size_t)3072 * D * 2, SZ_WBR = (size_t)1024 * 512 * 2;
constexpr size_t SZ_WOUT = (size_t)D * D * 2, SZ_WUP = (size_t)DFF * D * 2, SZ_WDN = (size_t)D * DFF * 2;
constexpr size_t WS_WT = 0;
constexpr size_t WS_WG = WS_WT + 2 * SZ_WT;
constexpr size_t WS_WGATE = WS_WG + 2 * SZ_WG;
constexpr size_t WS_WBR = WS_WGATE + 2 * SZ_WGATE;
constexpr size_t WS_WOUT = WS_WBR + 6 * SZ_WBR;
constexpr size_t WS_WUP = WS_WOUT + 2 * SZ_WOUT;
constexpr size_t WS_WDN = WS_WUP + 2 * SZ_WUP;
constexpr size_t WS_BIAS = WS_WDN + 2 * SZ_WDN;
constexpr size_t WS_MOD = WS_BIAS + 32768;
constexpr size_t WS_HFL = WS_MOD + (size_t)2 * 33 * 6144 * 4;
constexpr size_t WS_HFC = WS_HFL + (size_t)2 * 4 * 512 * 2048 * 2;
constexpr size_t WS_CTX = WS_HFC + (size_t)4 * 512 * 256 * 2;
constexpr size_t WS_HX = WS_CTX + (size_t)TOKC * D * 4;
constexpr size_t WS_T = WS_HX + (size_t)TOK * D * 2;
constexpr size_t WS_YG = WS_T + (size_t)NTR * TOK * 2;
constexpr size_t WS_PG = WS_YG + (size_t)TOK * 512 * 2;
constexpr size_t WS_OF = WS_PG + (size_t)TOK * NG * 2;
constexpr size_t WS_BAR = WS_OF + (size_t)2 * TOK * 512 * 2;
constexpr size_t WS_END = WS_BAR + 8192;
constexpr size_t WS_YHY = WS_T + (size_t)512 * TOK * 2;
constexpr size_t WS_YPL = WS_T + (size_t)1024 * TOK * 2;
constexpr size_t WS_STASH = WS_PG;
constexpr size_t WS_MERGED = WS_OF;
constexpr size_t WS_HID = WS_T;
static_assert((size_t)TOK * DFF * 2 <= WS_OF - WS_T, "hidden");
constexpr size_t WS_SCR = WS_PG;
constexpr size_t SCR_PER = 1572864;
constexpr size_t SC_MERGED = 0, SC_TRY = 524288, SC_TRP = 786432, SC_SG = 1048576, SC_ST = 1310720, SC_HID = 524288;
static_assert(WS_END <= (size_t)1073741824, "ws");

struct Params { const float* in[33]; float* out; unsigned char* ws; };
enum { I_X = 0, I_C, I_CTX, I_CCTX, I_WMOD, I_BMOD, I_NMIX, I_NFFN, I_WIN, I_BIN, I_HSW, I_HSB, I_FW1, I_FB1, I_FFREQ, I_FW2, I_FB2, I_FW3, I_HSKIP,
       I_WAF, I_BAF, I_WAB, I_BAB, I_GNW, I_PW, I_PSC, I_WBH, I_WBG, I_WBP, I_WOUT, I_WUP, I_WDN, I_NFIN };

__device__ __forceinline__ float bf2f(bf16_t h) { return __uint_as_float((unsigned)h << 16); }
__device__ __forceinline__ unsigned cvt_pk_bf16(float lo, float hi) { unsigned r; asm volatile("v_cvt_pk_bf16_f32 %0, %1, %2" : "=v"(r) : "v"(lo), "v"(hi)); return r; }
__device__ __forceinline__ bf16_t f2bf(float f) { return (bf16_t)(cvt_pk_bf16(f, 0.f) & 0xffffu); }
__device__ __forceinline__ float lo16(unsigned u) { return __uint_as_float(u << 16); }
__device__ __forceinline__ float hi16(unsigned u) { return __uint_as_float(u & 0xffff0000u); }
__device__ __forceinline__ float sigmoidf_(float v) { return 1.f / (1.f + __expf(-v)); }
__device__ __forceinline__ unsigned char* opq(unsigned char* p) { asm volatile("" : "+s"(p)); return p; }
__device__ __forceinline__ int tidx() { int t = threadIdx.x; asm volatile("" : "+v"(t)); return t; }
__device__ __forceinline__ int opqi(int v) { asm volatile("" : "+s"(v)); return v; }
__device__ __forceinline__ void gbar(unsigned* ctr, unsigned target) {
    asm volatile("s_waitcnt vmcnt(0) lgkmcnt(0)" ::: "memory");
    __syncthreads();
    if (threadIdx.x < 64) {
        if (threadIdx.x == 0) {
            __builtin_amdgcn_fence(__ATOMIC_RELEASE, "agent");
            asm volatile("s_waitcnt vmcnt(0)" ::: "memory");
            __hip_atomic_fetch_add(ctr, 1u, __ATOMIC_RELAXED, __HIP_MEMORY_SCOPE_AGENT);
            while (__hip_atomic_load(ctr, __ATOMIC_RELAXED, __HIP_MEMORY_SCOPE_AGENT) < target) __builtin_amdgcn_s_sleep(1);
        }
        __builtin_amdgcn_fence(__ATOMIC_ACQUIRE, "agent");
        asm volatile("s_waitcnt vmcnt(0)" ::: "memory");
    }
    __syncthreads();
}
__device__ __forceinline__ void gbar_h(unsigned* ctl, unsigned xcc, unsigned nloc, unsigned nx, unsigned k) {
    asm volatile("s_waitcnt vmcnt(0) lgkmcnt(0)" ::: "memory");
    __syncthreads();
    if (threadIdx.x < 64) {
        if (threadIdx.x == 0) {
            unsigned* xsub = ctl + 1024 + 16 * xcc; unsigned* xgen = ctl + 1280 + 16 * xcc; unsigned* top = ctl + 1536; unsigned* topgen = ctl + 1600;
            const unsigned old = __hip_atomic_fetch_add(xsub, 1u, __ATOMIC_RELAXED, __HIP_MEMORY_SCOPE_AGENT);
            if (old + 1u == k * nloc) {
                __builtin_amdgcn_fence(__ATOMIC_RELEASE, "agent");
                asm volatile("s_waitcnt vmcnt(0)" ::: "memory");
                const unsigned og = __hip_atomic_fetch_add(top, 1u, __ATOMIC_RELAXED, __HIP_MEMORY_SCOPE_AGENT);
                if (og + 1u == k * nx) __hip_atomic_fetch_add(topgen, 1u, __ATOMIC_RELAXED, __HIP_MEMORY_SCOPE_AGENT);
                else while (__hip_atomic_load(topgen, __ATOMIC_RELAXED, __HIP_MEMORY_SCOPE_AGENT) < k) __builtin_amdgcn_s_sleep(1);
                __hip_atomic_fetch_add(xgen, 1u, __ATOMIC_RELAXED, __HIP_MEMORY_SCOPE_AGENT);
            } else {
                while (__hip_atomic_load(xgen, __ATOMIC_RELAXED, __HIP_MEMORY_SCOPE_AGENT) < k) __builtin_amdgcn_s_sleep(1);
            }
        }
        __builtin_amdgcn_fence(__ATOMIC_ACQUIRE, "agent");
        asm volatile("s_waitcnt vmcnt(0)" ::: "memory");
    }
    __syncthreads();
}
__device__ __forceinline__ float wave_sum(float v) {
#pragma unroll
    for (int o = 32; o >= 1; o >>= 1) v += __shfl_xor(v, o);
    return v;
}

constexpr int BK = 64, HALF = 128, HTB = HALF * BK * 2;
__device__ __forceinline__ int lds_byte(int r, int c) { const int st = (r >> 4) * 2 + (c >> 5), rr = r & 15, cc = c & 31, ob = rr * 64 + cc * 2; return st * 1024 + (ob ^ (((ob >> 9) & 1) << 5)); }
__device__ __forceinline__ void stage_rc(int b, int& R, int& C) { const int st = b / 1024, sb = b % 1024, swz = sb ^ (((sb >> 9) & 1) << 5); R = (st >> 1) * 16 + swz / 64; C = (st & 1) * 32 + (swz % 64) / 2; }

template <class Epi>
__device__ __forceinline__ void gemm_unit(LAS unsigned char* lds, const bf16_t* A, int lda, const bf16_t* Bt, int ldb, int K, const Epi& E) {
    const int tid = tidx(), wid = __builtin_amdgcn_readfirstlane(tid >> 6), lane = tid & 63, wr = wid >> 2, wc = wid & 3, fr = lane & 15, fq = lane >> 4;
    const int nt = K / BK;
    unsigned voffA[2], voffB[2];
#pragma unroll
    for (int i = 0; i < 2; ++i) { int R, C; stage_rc(tid * 16 + i * 8192, R, C); voffA[i] = (unsigned)(R * lda + C) * 2u; voffB[i] = (unsigned)(R * ldb + C) * 2u; }
    const size_t kstep = (size_t)(BK * 2);
    const size_t hstepA = (size_t)HALF * lda * 2, hstepB = (size_t)HALF * ldb * 2;
    const unsigned ldsw = (unsigned)wid * 1024u;
    const int aoff = lds_byte(wr * 64 + fr, fq * 8), boff = lds_byte(wc * 32 + fr, fq * 8);
#define G_SA(b, h) (((b) * 2 + (h)) * HTB)
#define G_SB(b, h) ((4 + (b) * 2 + (h)) * HTB)
#define G_STAGE(bufoff, gbase, voff) do { _Pragma("unroll") for (int _i = 0; _i < 2; ++_i) \
        __builtin_amdgcn_global_load_lds((const unsigned*)((const char*)(gbase) + (voff)[_i]), (LAS unsigned*)(lds + (bufoff) + ldsw + _i * 8192), 16, 0, 0); } while (0)
#define G_LDA(dst, b, h) do { _Pragma("unroll") for (int m = 0; m < 4; ++m) _Pragma("unroll") for (int k = 0; k < 2; ++k) dst[m][k] = *(const LAS bf16x8*)(lds + G_SA(b, h) + aoff + m * 2048 + k * 1024); } while (0)
#define G_LDB(dst, b, h) do { _Pragma("unroll") for (int n = 0; n < 2; ++n) _Pragma("unroll") for (int k = 0; k < 2; ++k) dst[n][k] = *(const LAS bf16x8*)(lds + G_SB(b, h) + boff + n * 2048 + k * 1024); } while (0)
#define G_MMA(ai, bj, At, Bt_) do { __builtin_amdgcn_s_setprio(1); _Pragma("unroll") for (int m = 0; m < 4; ++m) _Pragma("unroll") for (int n = 0; n < 2; ++n) _Pragma("unroll") for (int k = 0; k < 2; ++k) \
        acc[ai][bj][m][n] = __builtin_amdgcn_mfma_f32_16x16x32_bf16(Bt_[n][k], At[m][k], acc[ai][bj][m][n], 0, 0, 0); __builtin_amdgcn_s_setprio(0); } while (0)
#define G_WAIT_V(n) asm volatile("s_waitcnt vmcnt(" #n ")" ::: "memory")
#define G_WAIT_L(n) asm volatile("s_waitcnt lgkmcnt(" #n ")" ::: "memory")
#define G_BAR __builtin_amdgcn_s_barrier()
#define G_SCHED __builtin_amdgcn_sched_barrier(0)
    __syncthreads();
    f32x4 acc[2][2][4][2];
#pragma unroll
    for (int a = 0; a < 2; ++a)
#pragma unroll
        for (int b = 0; b < 2; ++b)
#pragma unroll
            for (int m = 0; m < 4; ++m)
#pragma unroll
                for (int n = 0; n < 2; ++n) acc[a][b][m][n] = (f32x4){0.f, 0.f, 0.f, 0.f};
    bf16x8 At[4][2], B0[2][2], B1[2][2];
    const char* cA = (const char*)A; const char* cB = (const char*)Bt;
    G_STAGE(G_SB(0, 0), cB, voffB); G_STAGE(G_SA(0, 0), cA, voffA); G_STAGE(G_SB(0, 1), cB + hstepB, voffB); G_STAGE(G_SA(0, 1), cA + hstepA, voffA);
    if (wr == 1) G_BAR;
    G_WAIT_V(4); G_BAR;
    G_STAGE(G_SB(1, 0), cB + kstep, voffB); G_STAGE(G_SA(1, 0), cA + kstep, voffA); G_STAGE(G_SB(1, 1), cB + hstepB + kstep, voffB);
    G_WAIT_V(6); G_BAR;
    for (int t = 0; t < nt; t += 2) {
        const bool last = (t == nt - 2);
        const char* a1 = cA + (size_t)(t + 1) * kstep;
        const char* a2 = last ? cA : cA + (size_t)(t + 2) * kstep; const char* b2 = last ? cB : cB + (size_t)(t + 2) * kstep;
        const char* a3 = a2 + kstep; const char* b3 = b2 + kstep;
        G_LDB(B0, 0, 0); G_SCHED; G_LDA(At, 0, 0); G_STAGE(G_SA(1, 1), a1 + hstepA, voffA);
        G_WAIT_L(8); G_BAR; G_WAIT_L(0); G_MMA(0, 0, At, B0); G_BAR; G_SCHED;
        G_LDB(B1, 0, 1); G_STAGE(G_SB(0, 0), b2, voffB);
        G_BAR; G_WAIT_L(0); G_MMA(0, 1, At, B1); G_BAR;
        G_LDA(At, 0, 1); G_STAGE(G_SA(0, 0), a2, voffA);
        G_BAR; G_WAIT_L(0); G_MMA(1, 0, At, B0); G_BAR; G_SCHED;
        G_STAGE(G_SB(0, 1), b2 + hstepB, voffB);
        G_WAIT_V(6); G_BAR; G_MMA(1, 1, At, B1); G_BAR;
        G_LDB(B0, 1, 0); G_SCHED; G_LDA(At, 1, 0); G_STAGE(G_SA(0, 1), a2 + hstepA, voffA);
        G_WAIT_L(8); G_BAR; G_WAIT_L(0); G_MMA(0, 0, At, B0); G_BAR; G_SCHED;
        G_LDB(B1, 1, 1); G_STAGE(G_SB(1, 0), b3, voffB);
        G_BAR; G_WAIT_L(0); G_MMA(0, 1, At, B1); G_BAR;
        G_LDA(At, 1, 1); G_STAGE(G_SA(1, 0), a3, voffA);
        G_BAR; G_WAIT_L(0); G_MMA(1, 0, At, B0); G_BAR; G_SCHED;
        G_STAGE(G_SB(1, 1), b3 + hstepB, voffB);
        G_WAIT_V(6); G_BAR; G_MMA(1, 1, At, B1); G_BAR;
    }
    E(acc, wr, wc, fr, fq);
    G_WAIT_V(0);
    if (wr == 0) G_BAR;
    G_BAR;
    __syncthreads();
}


__device__ __forceinline__ int perm32(int rho) { const int n = rho >> 4, i = rho & 15; return 8 * (i >> 2) + 4 * n + (i & 3); }
typedef f32x4 AccT[2][2][4][2];
struct UDesc { const char* A; const char* B; int lda, ldb, K; };
template <class Prog, bool SP2 = true, bool ALIGN_EPI = true>
__device__ __forceinline__ void gemm_stream(LAS unsigned char* lds, int nunits, const Prog& P) {
    if (nunits <= 0) return;
    const int tid = tidx(), wid = __builtin_amdgcn_readfirstlane(tid >> 6), lane = tid & 63, wr = wid >> 2, wc = wid & 3, fr = lane & 15, fq = lane >> 4;
    int sR, sRb, sC; { int R, C; stage_rc(tid * 16, R, C); sR = R * 2; sRb = ((R & ~31) + perm32(R & 31)) * 2; sC = C * 2; }
    const unsigned kstep = (unsigned)(BK * 2);
    const unsigned ldsw = (unsigned)wid * 1024u;
    const int aoff = lds_byte(wr * 64 + fr, fq * 8), boff = lds_byte(wc * 32 + fr, fq * 8);
#define S_STAGE(bufoff, gbase, v, q) do { \
        __builtin_amdgcn_global_load_lds((const unsigned*)((const char*)(gbase) + (v)), (LAS unsigned*)(lds + (bufoff) + ldsw), 16, 0, 0); \
        __builtin_amdgcn_global_load_lds((const unsigned*)((const char*)(gbase) + (q) + (v)), (LAS unsigned*)(lds + (bufoff) + ldsw + 8192), 16, 0, 0); } while (0)
    UDesc cur, nxt; P.desc(0, cur);
    unsigned vA = (unsigned)(sR * cur.lda + sC), vB = (unsigned)(sRb * cur.ldb + sC);
    __syncthreads();
    f32x4 acc[2][2][4][2];
#pragma unroll
    for (int a = 0; a < 2; ++a)
#pragma unroll
        for (int b = 0; b < 2; ++b)
#pragma unroll
            for (int m = 0; m < 4; ++m)
#pragma unroll
                for (int n = 0; n < 2; ++n) acc[a][b][m][n] = (f32x4){0.f, 0.f, 0.f, 0.f};
    bf16x8 At[4][2], B0[2][2], B1[2][2];
    { const char* cA = cur.A; const char* cB = cur.B; const unsigned hA = (unsigned)HALF * cur.lda * 2, hB = (unsigned)HALF * cur.ldb * 2, qA = hA >> 1, qB = hB >> 1;
      if constexpr (SP2) {
          S_STAGE(G_SB(0, 0), cB, vB, qB); S_STAGE(G_SB(0, 1), cB + hB, vB, qB); S_STAGE(G_SA(0, 0), cA, vA, qA); S_STAGE(G_SA(0, 1), cA + hA, vA, qA);
          if (wr == 1) G_BAR;
          G_WAIT_V(2); G_BAR;
          S_STAGE(G_SB(1, 0), cB + kstep, vB, qB); S_STAGE(G_SA(1, 0), cA + kstep, vA, qA); S_STAGE(G_SB(1, 1), cB + hB + kstep, vB, qB);
          G_WAIT_V(6); G_BAR;
      } else {
          S_STAGE(G_SB(0, 0), cB, vB, qB); S_STAGE(G_SA(0, 0), cA, vA, qA); S_STAGE(G_SB(0, 1), cB + hB, vB, qB); S_STAGE(G_SA(0, 1), cA + hA, vA, qA);
          if (wr == 1) G_BAR;
          G_WAIT_V(4); G_BAR;
          S_STAGE(G_SB(1, 0), cB + kstep, vB, qB); S_STAGE(G_SA(1, 0), cA + kstep, vA, qA); S_STAGE(G_SB(1, 1), cB + hB + kstep, vB, qB);
          G_WAIT_V(6); G_BAR;
      } }
    for (int ui = 0;; ++ui) {
        const bool has_next = ui + 1 < nunits;
        if (has_next) P.desc(ui + 1, nxt); else nxt = cur;
        const unsigned nA = (unsigned)(sR * nxt.lda + sC), nB = (unsigned)(sRb * nxt.ldb + sC);
        const char* cA = cur.A; const char* cB = cur.B; const unsigned hA = (unsigned)HALF * cur.lda * 2, hB = (unsigned)HALF * cur.ldb * 2;
        const unsigned nhA = (unsigned)HALF * nxt.lda * 2, nhB = (unsigned)HALF * nxt.ldb * 2;
        const int nt = cur.K / BK;
        for (int t = 0; t < nt; t += 2) {
            const bool last = (t == nt - 2);
            const char* a1 = cA + (unsigned)(t + 1) * kstep;
            const char* a2 = last ? nxt.A : cA + (unsigned)(t + 2) * kstep; const char* b2 = last ? nxt.B : cB + (unsigned)(t + 2) * kstep;
            const char* a3 = a2 + kstep; const char* b3 = b2 + kstep;
            const unsigned hA2 = last ? nhA : hA, hB2 = last ? nhB : hB, qA = hA >> 1, qA2 = hA2 >> 1, qB2 = hB2 >> 1;
            const unsigned xA = last ? nA : vA, xB = last ? nB : vB;
            if constexpr (SP2) {
            G_LDB(B0, 0, 0); G_LDB(B1, 0, 1); G_SCHED; G_LDA(At, 0, 0); S_STAGE(G_SA(1, 1), a1 + hA, vA, qA);
            G_WAIT_V(8); G_WAIT_L(0); G_BAR; G_MMA(0, 0, At, B0); G_MMA(0, 1, At, B1); G_BAR; G_SCHED;
            G_LDA(At, 0, 1); S_STAGE(G_SB(0, 0), b2, xB, qB2); S_STAGE(G_SB(0, 1), b2 + hB2, xB, qB2); S_STAGE(G_SA(0, 0), a2, xA, qA2);
            G_WAIT_V(8); G_WAIT_L(0); G_BAR; G_MMA(1, 0, At, B0); G_MMA(1, 1, At, B1); G_BAR; G_SCHED;
            G_LDB(B0, 1, 0); G_LDB(B1, 1, 1); G_SCHED; G_LDA(At, 1, 0); S_STAGE(G_SA(0, 1), a2 + hA2, xA, qA2);
            G_WAIT_V(8); G_WAIT_L(0); G_BAR; G_MMA(0, 0, At, B0); G_MMA(0, 1, At, B1); G_BAR; G_SCHED;
            G_LDA(At, 1, 1); S_STAGE(G_SB(1, 0), b3, xB, qB2); S_STAGE(G_SB(1, 1), b3 + hB2, xB, qB2); S_STAGE(G_SA(1, 0), a3, xA, qA2);
            G_WAIT_V(8); G_WAIT_L(0); G_BAR; G_MMA(1, 0, At, B0); G_MMA(1, 1, At, B1); G_BAR; G_SCHED;
            } else {
            G_LDB(B0, 0, 0); G_SCHED; G_LDA(At, 0, 0); S_STAGE(G_SA(1, 1), a1 + hA, vA, qA);
            G_WAIT_L(8); G_BAR; G_WAIT_L(0); G_MMA(0, 0, At, B0); G_BAR; G_SCHED;
            G_LDB(B1, 0, 1); S_STAGE(G_SB(0, 0), b2, xB, qB2);
            G_BAR; G_WAIT_L(0); G_MMA(0, 1, At, B1); G_BAR;
            G_LDA(At, 0, 1); S_STAGE(G_SA(0, 0), a2, xA, qA2);
            G_BAR; G_WAIT_L(0); G_MMA(1, 0, At, B0); G_BAR; G_SCHED;
            S_STAGE(G_SB(0, 1), b2 + hB2, xB, qB2);
            G_WAIT_V(6); G_BAR; G_MMA(1, 1, At, B1); G_BAR;
            G_LDB(B0, 1, 0); G_SCHED; G_LDA(At, 1, 0); S_STAGE(G_SA(0, 1), a2 + hA2, xA, qA2);
            G_WAIT_L(8); G_BAR; G_WAIT_L(0); G_MMA(0, 0, At, B0); G_BAR; G_SCHED;
            G_LDB(B1, 1, 1); S_STAGE(G_SB(1, 0), b3, xB, qB2);
            G_BAR; G_WAIT_L(0); G_MMA(0, 1, At, B1); G_BAR;
            G_LDA(At, 1, 1); S_STAGE(G_SA(1, 0), a3, xA, qA2);
            G_BAR; G_WAIT_L(0); G_MMA(1, 0, At, B0); G_BAR; G_SCHED;
            S_STAGE(G_SB(1, 1), b3 + hB2, xB, qB2);
            G_WAIT_V(6); G_BAR; G_MMA(1, 1, At, B1); G_BAR;
            }
        }
        if constexpr (ALIGN_EPI) { if (wr == 0) G_BAR; }
        P.epi(ui, acc, wr, wc, fr, fq);
        if (!has_next) break;
#pragma unroll
        for (int a = 0; a < 2; ++a)
#pragma unroll
            for (int b = 0; b < 2; ++b)
#pragma unroll
                for (int m = 0; m < 4; ++m)
#pragma unroll
                    for (int n = 0; n < 2; ++n) acc[a][b][m][n] = (f32x4){0.f, 0.f, 0.f, 0.f};
        cur = nxt; vA = nA; vB = nB;
        if constexpr (ALIGN_EPI) { if (wr == 1) G_BAR; }
    }
    G_WAIT_V(0);
    if constexpr (!ALIGN_EPI) { if (wr == 0) G_BAR; }
    G_BAR;
    __syncthreads();
#undef S_STAGE
}

#define EPI_LOOP _Pragma("unroll") for (int ai = 0; ai < 2; ++ai) _Pragma("unroll") for (int m = 0; m < 4; ++m) _Pragma("unroll") for (int bj = 0; bj < 2; ++bj) _Pragma("unroll") for (int n = 0; n < 2; ++n)
#define EPI_ROW (ai * 128 + wr * 64 + m * 16 + fr)
#define EPI_COL (bj * 128 + wc * 32 + 8 * fq + 4 * n)

#define U4 _Pragma("unroll")
struct EpiStoreBf16 {
    bf16_t* O; size_t ldo; const float* bias; bool rowb;
    __device__ __forceinline__ void operator()(const AccT& acc, int wr, int wc, int fr, int fq) const {
        { const int tq_ = tidx(); wr = (tq_ >> 8) & 1; wc = (tq_ >> 6) & 3; fr = tq_ & 15; fq = (tq_ >> 4) & 3; }
        float br[2][4]; f32x4 bc[2][2];
        U4 for (int ai = 0; ai < 2; ++ai) U4 for (int m = 0; m < 4; ++m) br[ai][m] = rowb ? bias[ai * 128 + wr * 64 + m * 16 + fr] : 0.f;
        U4 for (int bj = 0; bj < 2; ++bj) U4 for (int n = 0; n < 2; ++n) bc[bj][n] = rowb ? (f32x4){0.f, 0.f, 0.f, 0.f} : *(const f32x4*)(bias + EPI_COL);
        U4 for (int ai = 0; ai < 2; ++ai) U4 for (int m = 0; m < 4; ++m) U4 for (int bj = 0; bj < 2; ++bj) { const int n = 0; const int r = EPI_ROW, c = EPI_COL;
            const f32x4 v0 = acc[ai][bj][m][0] + bc[bj][0] + br[ai][m], v1 = acc[ai][bj][m][1] + bc[bj][1] + br[ai][m];
            u32x4 w; w.x = cvt_pk_bf16(v0[0], v0[1]); w.y = cvt_pk_bf16(v0[2], v0[3]); w.z = cvt_pk_bf16(v1[0], v1[1]); w.w = cvt_pk_bf16(v1[2], v1[3]); *(u32x4*)(O + (size_t)r * ldo + c) = w; }
    }
};
struct EpiGate {
    f32x4* SG; const float* bias;
    __device__ __forceinline__ void operator()(const AccT& acc, int wr, int wc, int fr, int fq) const {
        { const int tq_ = tidx(); wr = (tq_ >> 8) & 1; wc = (tq_ >> 6) & 3; fr = tq_ & 15; fq = (tq_ >> 4) & 3; }
        f32x4 bc[2][2];
        U4 for (int bj = 0; bj < 2; ++bj) U4 for (int n = 0; n < 2; ++n) bc[bj][n] = *(const f32x4*)(bias + EPI_COL);
        int i = 0; f32x4* SGt = SG + tidx();
        EPI_LOOP { f32x4 v = acc[ai][bj][m][n] + bc[bj][n];
            v[0] = sigmoidf_(v[0]); v[1] = sigmoidf_(v[1]); v[2] = sigmoidf_(v[2]); v[3] = sigmoidf_(v[3]);
            SGt[i * NTHREADS] = v; ++i; }
    }
};
struct EpiBranch {
    const f32x4* SG; f32x4* ST; bf16_t* MG; int first, last;
    __device__ __forceinline__ void operator()(const AccT& acc, int wr, int wc, int fr, int fq) const {
        { const int tq_ = tidx(); wr = (tq_ >> 8) & 1; wc = (tq_ >> 6) & 3; fr = tq_ & 15; fq = (tq_ >> 4) & 3; }
        const int tq = tidx(); const f32x4* SGt = SG + tq; f32x4* STt = ST + tq;
        f32x4 g[2][4], t[2][4];
        U4 for (int q = 0; q < 4; ++q) { g[0][q] = SGt[q * NTHREADS]; t[0][q] = first ? (f32x4){0.f, 0.f, 0.f, 0.f} : STt[q * NTHREADS]; }
        U4 for (int bt = 0; bt < 8; ++bt) { const int cb = bt & 1, nb = cb ^ 1, ai = bt >> 2, m = bt & 3;
            if (bt + 1 < 8) { U4 for (int q = 0; q < 4; ++q) { const int i = (bt + 1) * 4 + q; g[nb][q] = SGt[i * NTHREADS]; t[nb][q] = first ? (f32x4){0.f, 0.f, 0.f, 0.f} : STt[i * NTHREADS]; } }
            if (last) { U4 for (int bj = 0; bj < 2; ++bj) { const int n = 0; const int r = EPI_ROW, c = EPI_COL;
                    const f32x4 v0 = acc[ai][bj][m][0] * g[cb][bj * 2] + t[cb][bj * 2], v1 = acc[ai][bj][m][1] * g[cb][bj * 2 + 1] + t[cb][bj * 2 + 1];
                    u32x4 w; w.x = cvt_pk_bf16(v0[0], v0[1]); w.y = cvt_pk_bf16(v0[2], v0[3]); w.z = cvt_pk_bf16(v1[0], v1[1]); w.w = cvt_pk_bf16(v1[2], v1[3]); *(u32x4*)(MG + (size_t)r * 1024 + c) = w; } }
            else { U4 for (int q = 0; q < 4; ++q) { const int bj = q >> 1, n = q & 1, i = bt * 4 + q; STt[i * NTHREADS] = acc[ai][bj][m][n] * g[cb][q] + t[cb][q]; } }
        }
    }
};
struct EpiResid {
    const float* xsrc; float* xdst; const float* gate;
    __device__ __forceinline__ void operator()(const AccT& acc, int wr, int wc, int fr, int fq) const {
        { const int tq_ = tidx(); wr = (tq_ >> 8) & 1; wc = (tq_ >> 6) & 3; fr = tq_ & 15; fq = (tq_ >> 4) & 3; }
        f32x4 gc[2][2];
        U4 for (int bj = 0; bj < 2; ++bj) U4 for (int n = 0; n < 2; ++n) gc[bj][n] = *(const f32x4*)(gate + EPI_COL);
        f32x4 xo[2][4];
        { const int ai = 0, m = 0; U4 for (int q = 0; q < 4; ++q) { const int bj = q >> 1, n = q & 1; xo[0][q] = *(const f32x4*)(xsrc + (size_t)EPI_ROW * 1024 + EPI_COL); } }
        U4 for (int bt = 0; bt < 8; ++bt) { const int cb = bt & 1, nb = cb ^ 1;
            if (bt + 1 < 8) { const int ai = (bt + 1) >> 2, m = (bt + 1) & 3; U4 for (int q = 0; q < 4; ++q) { const int bj = q >> 1, n = q & 1; xo[nb][q] = *(const f32x4*)(xsrc + (size_t)EPI_ROW * 1024 + EPI_COL); } }
            { const int ai = bt >> 2, m = bt & 3; U4 for (int q = 0; q < 4; ++q) { const int bj = q >> 1, n = q & 1; *(f32x4*)(xdst + (size_t)EPI_ROW * 1024 + EPI_COL) = xo[cb][q] + gc[bj][n] * acc[ai][bj][m][n]; } }
        }
    }
};
struct EpiSqrelu {
    bf16_t* H; int ldh;
    __device__ __forceinline__ void operator()(const AccT& acc, int wr, int wc, int fr, int fq) const {
        { const int tq_ = tidx(); wr = (tq_ >> 8) & 1; wc = (tq_ >> 6) & 3; fr = tq_ & 15; fq = (tq_ >> 4) & 3; }
        U4 for (int ai = 0; ai < 2; ++ai) U4 for (int m = 0; m < 4; ++m) U4 for (int bj = 0; bj < 2; ++bj) { const int n = 0; const int r = EPI_ROW, c = EPI_COL; f32x4 v0 = acc[ai][bj][m][0], v1 = acc[ai][bj][m][1];
#pragma unroll
            for (int j = 0; j < 4; ++j) { const float t0 = fmaxf(v0[j], 0.f), t1 = fmaxf(v1[j], 0.f); v0[j] = t0 * t0; v1[j] = t1 * t1; }
            u32x4 w; w.x = cvt_pk_bf16(v0[0], v0[1]); w.y = cvt_pk_bf16(v0[2], v0[3]); w.z = cvt_pk_bf16(v1[0], v1[1]); w.w = cvt_pk_bf16(v1[2], v1[3]); *(u32x4*)(H + (size_t)r * ldh + c) = w; }
    }
};

struct XMap { int NT, per_xcd, x, j, bpx;
    __device__ __forceinline__ void init(int xj, int ntt, int nt_) { NT = nt_; per_xcd = (ntt >> 3) * nt_; x = xj & 7; j = xj >> 3; bpx = (int)(gridDim.x >> 3); }
    __device__ __forceinline__ int rounds() const { return j < per_xcd ? (per_xcd - j + bpx - 1) / bpx : 0; }
    __device__ __forceinline__ void get(int i, int& tt, int& nt) const { const int q = i * bpx + j; tt = x + 8 * (q / NT); nt = q % NT; }
};
struct ProgInproj {
    const bf16_t* wt; const bf16_t* wg; const bf16_t* HX; bf16_t* T; bf16_t* PG; const float* biasT; const float* biasG; XMap MA, MB; int rA;
    __device__ __forceinline__ void desc(int i, UDesc& d) const { int tt, nt;
        if (i < rA) { MA.get(i, tt, nt); d.A = (const char*)(wt + (size_t)(nt * 256) * D); d.B = (const char*)(HX + (size_t)(tt * 256) * D); }
        else { MB.get(i - rA, tt, nt); d.A = (const char*)(HX + (size_t)(tt * 256) * D); d.B = (const char*)(wg + (size_t)(nt * 256) * D); }
        d.lda = D; d.ldb = D; d.K = D; }
    __device__ __forceinline__ void epi(int i, const AccT& acc, int wr, int wc, int fr, int fq) const { int tt, nt;
        if (i < rA) { MA.get(i, tt, nt); EpiStoreBf16 E{T + (size_t)(nt * 256) * TOK + (size_t)tt * 256, (size_t)TOK, biasT + nt * 256, true}; E(acc, wr, wc, fr, fq); }
        else { MB.get(i - rA, tt, nt); EpiStoreBf16 E{PG + (size_t)(tt * 256) * NG + nt * 256, (size_t)NG, biasG + nt * 256, false}; E(acc, wr, wc, fr, fq); } }
};
struct ProgMix {
    unsigned char* ws; unsigned char* scr; const float* bgate; unsigned tok0; int l;
    __device__ __forceinline__ void desc(int i, UDesc& d) const { const int nt = i / 6, j = i % 6, X = j >> 1;
        if (!(j & 1)) { d.A = (const char*)(ws + WS_HX) + (size_t)tok0 * D * 2; d.B = (const char*)(ws + WS_WGATE + l * SZ_WGATE) + (size_t)(X * 1024 + nt * 256) * D * 2; d.lda = D; d.ldb = D; d.K = D; }
        else { d.A = X == 0 ? (const char*)(scr + SC_TRY) : (X == 1 ? (const char*)(ws + WS_YG) + (size_t)tok0 * 1024 : (const char*)(scr + SC_TRP));
               d.B = (const char*)(ws + WS_WBR + (size_t)l * 3 * SZ_WBR) + (size_t)X * SZ_WBR + (size_t)(nt * 256) * 1024; d.lda = 512; d.ldb = 512; d.K = 512; } }
    __device__ __forceinline__ void epi(int i, const AccT& acc, int wr, int wc, int fr, int fq) const { const int nt = i / 6, j = i % 6, X = j >> 1;
        if (!(j & 1)) { EpiGate E{(f32x4*)(scr + SC_SG), bgate + X * 1024 + nt * 256}; E(acc, wr, wc, fr, fq); }
        else { EpiBranch E{(const f32x4*)(scr + SC_SG), (f32x4*)(scr + SC_ST), (bf16_t*)(scr + SC_MERGED) + nt * 256, X == 0, X == 2}; E(acc, wr, wc, fr, fq); } }
};
struct ProgResid {
    const bf16_t* A; int lda; const bf16_t* W; int ldw, K; size_t wstep; const float* xsrc; float* xdst; const float* gate;
    __device__ __forceinline__ void desc(int i, UDesc& d) const { d.A = (const char*)A; d.B = (const char*)(W + (size_t)i * wstep); d.lda = lda; d.ldb = ldw; d.K = K; }
    __device__ __forceinline__ void epi(int i, const AccT& acc, int wr, int wc, int fr, int fq) const { EpiResid E{xsrc + i * 256, xdst + i * 256, gate + i * 256}; E(acc, wr, wc, fr, fq); }
};
struct ProgUp {
    const bf16_t* XN; const bf16_t* W; bf16_t* HID;
    __device__ __forceinline__ void desc(int i, UDesc& d) const { d.A = (const char*)XN; d.B = (const char*)(W + (size_t)(i * 256) * D); d.lda = D; d.ldb = D; d.K = D; }
    __device__ __forceinline__ void epi(int i, const AccT& acc, int wr, int wc, int fr, int fq) const { EpiSqrelu E{HID + i * 256, 2048}; E(acc, wr, wc, fr, fq); }
};


struct TileIO { const float* xin; const float* ctxin; float* out; float* ctxs; const float* modl; int l;
    __device__ __forceinline__ const float* src(int tt) const { return tt < 256 ? (l == 0 ? xin : out) + (size_t)tt * 256 * D : ctxin + (size_t)(tt - 256) * 256 * D; }
    __device__ __forceinline__ float* dst(int tt) const { return tt < 256 ? out + (size_t)tt * 256 * D : ctxs + (size_t)(tt - 256) * 256 * D; }
    __device__ __forceinline__ const float* cur(int tt) const { return tt < 256 ? out + (size_t)tt * 256 * D : ctxs + (size_t)(tt - 256) * 256 * D; }
    __device__ __forceinline__ const float* mod(int tt) const { return modl + (size_t)(tt < 256 ? tt >> 3 : 32) * 6144; }
};
struct ProgMix2 {
    unsigned char* ws; unsigned char* stash; const float* bgate; XMap M; int l;
    __device__ __forceinline__ void desc(int ii, UDesc& d) const { int tt, nt; M.get(ii / 6, tt, nt); const int s6 = ii % 6, X = s6 >> 1;
        if (!(s6 & 1)) { d.A = (const char*)(ws + WS_HX) + (size_t)tt * 256 * D * 2; d.B = (const char*)(ws + WS_WGATE + l * SZ_WGATE) + (size_t)(X * 1024 + nt * 256) * D * 2; d.lda = D; d.ldb = D; d.K = D; }
        else { d.A = (const char*)(ws + (X == 0 ? WS_YHY : (X == 1 ? WS_YG : WS_YPL))) + (size_t)tt * 256 * 1024;
               d.B = (const char*)(ws + WS_WBR + (size_t)l * 3 * SZ_WBR) + (size_t)X * SZ_WBR + (size_t)(nt * 256) * 1024; d.lda = 512; d.ldb = 512; d.K = 512; } }
    __device__ __forceinline__ void epi(int ii, const AccT& acc, int wr, int wc, int fr, int fq) const { int tt, nt; M.get(ii / 6, tt, nt); const int s6 = ii % 6, X = s6 >> 1;
        if (!(s6 & 1)) { EpiGate E{(f32x4*)stash, bgate + X * 1024 + nt * 256}; E(acc, wr, wc, fr, fq); }
        else { EpiBranch E{(const f32x4*)stash, (f32x4*)(stash + 262144), (bf16_t*)(ws + WS_MERGED) + (size_t)tt * 256 * 1024 + nt * 256, X == 0, X == 2}; E(acc, wr, wc, fr, fq); } }
};
struct ProgOut2 {
    unsigned char* ws; TileIO io; XMap M; int l;
    __device__ __forceinline__ void desc(int i, UDesc& d) const { int tt, nt; M.get(i, tt, nt);
        d.A = (const char*)(ws + WS_MERGED) + (size_t)tt * 256 * 2048; d.B = (const char*)(ws + WS_WOUT + l * SZ_WOUT) + (size_t)(nt * 256) * D * 2; d.lda = D; d.ldb = D; d.K = D; }
    __device__ __forceinline__ void epi(int i, const AccT& acc, int wr, int wc, int fr, int fq) const { int tt, nt; M.get(i, tt, nt);
        EpiResid E{io.src(tt) + nt * 256, io.dst(tt) + nt * 256, io.mod(tt) + 2048 + nt * 256}; E(acc, wr, wc, fr, fq); }
};
struct ProgUp2 {
    unsigned char* ws; XMap M; int l;
    __device__ __forceinline__ void get(int i, int& tt, int& nt) const { const int ttg = i >> 1, ntg = i & 1; tt = M.x + 8 * (ttg * 4 + (M.j >> 3)); nt = ntg * 8 + (M.j & 7); }
    __device__ __forceinline__ void desc(int i, UDesc& d) const { int tt, nt; get(i, tt, nt);
        d.A = (const char*)(ws + WS_HX) + (size_t)tt * 256 * 2048; d.B = (const char*)(ws + WS_WUP + l * SZ_WUP) + (size_t)(nt * 256) * D * 2; d.lda = D; d.ldb = D; d.K = D; }
    __device__ __forceinline__ void epi(int i, const AccT& acc, int wr, int wc, int fr, int fq) const { int tt, nt; get(i, tt, nt);
        EpiSqrelu E{(bf16_t*)(ws + WS_HID) + (size_t)tt * 256 * DFF + nt * 256, DFF}; E(acc, wr, wc, fr, fq); }
};
struct ProgDown2 {
    unsigned char* ws; TileIO io; XMap M; int l;
    __device__ __forceinline__ void desc(int i, UDesc& d) const { int tt, nt; M.get(i, tt, nt);
        d.A = (const char*)(ws + WS_HID) + (size_t)tt * 256 * DFF * 2; d.B = (const char*)(ws + WS_WDN + l * SZ_WDN) + (size_t)(nt * 256) * DFF * 2; d.lda = DFF; d.ldb = DFF; d.K = DFF; }
    __device__ __forceinline__ void epi(int i, const AccT& acc, int wr, int wc, int fr, int fq) const { int tt, nt; M.get(i, tt, nt);
        EpiResid E{io.cur(tt) + nt * 256, io.dst(tt) + nt * 256, io.mod(tt) + 5120 + nt * 256}; E(acc, wr, wc, fr, fq); }
};

__device__ __forceinline__ void tconv(const float* src, int ld, int c0, int nvalid, int ncols, int K, bf16_t* dst, LAS float* tile) {
    const int tid = tidx(), ntn = ncols / 64, ntile = ntn * (K / 64);
    float v[8];
    { const int t = blockIdx.x; if (t < ntile) { const int k0 = (t / ntn) * 64, n0 = (t % ntn) * 64;
#pragma unroll
        for (int i = 0; i < 8; ++i) { const int k = i * 8 + (tid >> 6), n = tid & 63; v[i] = (n0 + n < nvalid) ? src[(size_t)(k0 + k) * ld + c0 + n0 + n] : 0.f; } } }
    for (int t = blockIdx.x; t < ntile; t += gridDim.x) {
        const int k0 = (t / ntn) * 64, n0 = (t % ntn) * 64;
        __syncthreads();
#pragma unroll
        for (int i = 0; i < 8; ++i) { const int k = i * 8 + (tid >> 6), n = tid & 63; tile[k * 65 + n] = v[i]; }
        { const int t2 = t + gridDim.x; if (t2 < ntile) { const int k2 = (t2 / ntn) * 64, n2 = (t2 % ntn) * 64;
#pragma unroll
            for (int i = 0; i < 8; ++i) { const int k = i * 8 + (tid >> 6), n = tid & 63; v[i] = (n2 + n < nvalid) ? src[(size_t)(k2 + k) * ld + c0 + n2 + n] : 0.f; } } }
        __syncthreads();
        const int n = tid >> 3, kc = (tid & 7) * 8;
        u32x4 w;
        w.x = cvt_pk_bf16(tile[(kc + 0) * 65 + n], tile[(kc + 1) * 65 + n]); w.y = cvt_pk_bf16(tile[(kc + 2) * 65 + n], tile[(kc + 3) * 65 + n]);
        w.z = cvt_pk_bf16(tile[(kc + 4) * 65 + n], tile[(kc + 5) * 65 + n]); w.w = cvt_pk_bf16(tile[(kc + 6) * 65 + n], tile[(kc + 7) * 65 + n]);
        *(u32x4*)(dst + (size_t)(n0 + n) * K + k0 + kc) = w;
    }
    __syncthreads();
}

__device__ __forceinline__ void job_poolcomb(const Params& p, int l) {
    const float* pw = p.in[I_PW] + (size_t)l * 4 * 128 * 128; const float* sc = p.in[I_PSC] + l * 512; const float* wb = p.in[I_WBP] + (size_t)l * 512 * 1024;
    bf16_t* dst = (bf16_t*)(p.ws + WS_WBR + (size_t)(l * 3 + 2) * SZ_WBR);
    for (int idx = blockIdx.x * NTHREADS + tidx(); idx < 512 * 256; idx += gridDim.x * NTHREADS) {
        const int n = (idx & 255) * 4, k = idx >> 8, g = k >> 7, c = k & 127;
        f32x4 a = (f32x4){0.f, 0.f, 0.f, 0.f};
#pragma unroll 8
        for (int d = 0; d < 128; ++d) { const float ps = pw[(g * 128 + c) * 128 + d] * sc[g * 128 + d]; a += ps * *(const f32x4*)(wb + (size_t)(g * 128 + d) * 1024 + n); }
        dst[(size_t)n * 512 + k] = f2bf(a[0]); dst[(size_t)(n + 1) * 512 + k] = f2bf(a[1]); dst[(size_t)(n + 2) * 512 + k] = f2bf(a[2]); dst[(size_t)(n + 3) * 512 + k] = f2bf(a[3]);
    }
}

__device__ __forceinline__ void job_bias(const Params& p) {
    float* bias = (float*)(p.ws + WS_BIAS);
    for (int idx = blockIdx.x * NTHREADS + tidx(); idx < 2 * (NTR + NG); idx += gridDim.x * NTHREADS) {
        const int l = idx / (NTR + NG), j = idx % (NTR + NG); const float* b = p.in[I_BIN] + l * N_IN;
        float v;
        if (j < 1536) v = b[j]; else if (j < NTR) v = b[POOL_OFF + (j - 1536)]; else { const int q = j - NTR; v = q < NGV ? b[GLA_OFF + q] : 0.f; }
        bias[idx] = v;
    }
}

__device__ __forceinline__ void job_mod(const Params& p, LAS float* sil) {
    if (blockIdx.x >= 192) return;
    const int tid = tidx(), lane = tid & 63, kg = tid >> 6;
    float* mod = (float*)(p.ws + WS_MOD);
    for (int it = blockIdx.x; it < 192; it += gridDim.x) {
        __syncthreads();
        for (int idx = tid; idx < 33 * 1024; idx += NTHREADS) { const int r = idx >> 10, k = idx & 1023; const float v = r < 32 ? p.in[I_C][r * 1024 + k] : p.in[I_CCTX][k]; sil[idx] = v / (1.f + expf(-v)); }
        __syncthreads();
        const int l = it / 96, n0 = (it % 96) * 64;
        const float* w = p.in[I_WMOD] + (size_t)l * 1024 * 6144 + n0 + lane;
        float acc[33];
#pragma unroll
        for (int r = 0; r < 33; ++r) acc[r] = 0.f;
#pragma unroll 2
        for (int k4 = 0; k4 < 32; ++k4) { const int k = kg * 128 + k4 * 4;
            const float w0 = w[(size_t)k * 6144], w1 = w[(size_t)(k + 1) * 6144], w2 = w[(size_t)(k + 2) * 6144], w3 = w[(size_t)(k + 3) * 6144];
#pragma unroll
            for (int r = 0; r < 33; ++r) { const f32x4 sv = *(const LAS f32x4*)(sil + r * 1024 + k); acc[r] += sv[0] * w0 + sv[1] * w1 + sv[2] * w2 + sv[3] * w3; } }
        __syncthreads();
#pragma unroll
        for (int r = 0; r < 33; ++r) sil[(kg * 33 + r) * 64 + lane] = acc[r];
        __syncthreads();
        const float bm = p.in[I_BMOD][l * 6144 + n0 + lane];
        for (int r = kg; r < 33; r += 8) { float sum = 0.f;
#pragma unroll
            for (int q = 0; q < 8; ++q) sum += sil[(q * 33 + r) * 64 + lane];
            mod[(size_t)l * 33 * 6144 + (size_t)r * 6144 + n0 + lane] = sum + bm; }
    }
    __syncthreads();
}

__device__ __forceinline__ void job_filters(const Params& p, LAS unsigned char* lds) {
    LAS float* a1 = (LAS float*)lds;
    LAS float* a2 = (LAS float*)(lds + 16384);
    LAS bf16_t* oT = (LAS bf16_t*)(lds + 16384 + 16640);
    LAS float* w2L = (LAS float*)(lds + 16384 + 16640 + 73728);
    const int tid = tidx();
    const int nitems = (32 + 4 + 32) * 4;
    const int nrep = gridDim.x == 256 ? 2 : (nitems + (int)gridDim.x - 1) / (int)gridDim.x;
    for (int rep = 0; rep < nrep; ++rep) {
        int it;
        if (gridDim.x == 256) it = rep == 0 ? (int)blockIdx.x : ((blockIdx.x >= 192 && blockIdx.x < 208) ? 256 + (int)blockIdx.x - 192 : -1);
        else it = (int)blockIdx.x + rep * (int)gridDim.x;
        if (it < 0 || it >= nitems) continue;
        const int oc = it & 3; int rt = it >> 2; int l, L, t0; bf16_t* dst;
        if (rt < 32) { l = 0; L = 2048; t0 = rt * 64; dst = (bf16_t*)(p.ws + WS_HFL); }
        else if (rt < 36) { l = 0; L = 256; t0 = (rt - 32) * 64; dst = (bf16_t*)(p.ws + WS_HFC); }
        else { l = 1; L = 2048; t0 = (rt - 36) * 64; dst = (bf16_t*)(p.ws + WS_HFL) + (size_t)4 * 512 * 2048; }
        const float* w1 = p.in[I_FW1] + l * 17 * 64; const float* b1 = p.in[I_FB1] + l * 64; const float* fq = p.in[I_FFREQ] + l * 64;
        const float* w2 = p.in[I_FW2] + l * 64 * 64; const float* b2 = p.in[I_FB2] + l * 64; const float* w3 = p.in[I_FW3] + (size_t)l * 64 * 2048;
        __syncthreads();
#pragma unroll
        for (int q = 0; q < 2; ++q) *(LAS f32x4*)(w2L + (tid + q * NTHREADS) * 4) = *(const f32x4*)(w2 + (tid + q * NTHREADS) * 4);
        { const int row = tid >> 3, jg = (tid & 7) * 8; const float t = (float)(t0 + row); float z[17];
          z[0] = t / (float)L;
#pragma unroll
          for (int bnd = 1; bnd <= 8; ++bnd) { const float ang = (6.283185307179586f / (float)L) * t * (float)bnd; z[bnd] = cosf(ang); z[8 + bnd] = sinf(ang); }
#pragma unroll
          for (int j = 0; j < 8; ++j) { float s_ = b1[jg + j];
#pragma unroll
              for (int i = 0; i < 17; ++i) s_ += z[i] * w1[i * 64 + jg + j];
              a1[row * 64 + jg + j] = sinf(fq[jg + j] * s_); } }
        __syncthreads();
        { const int row = tid >> 3, jg = (tid & 7) * 8; float acc8[8];
#pragma unroll
          for (int j = 0; j < 8; ++j) acc8[j] = b2[jg + j];
#pragma unroll 4
          for (int i4 = 0; i4 < 64; i4 += 4) { const f32x4 av = *(const LAS f32x4*)(a1 + row * 64 + i4);
#pragma unroll
              for (int ii = 0; ii < 4; ++ii) { const f32x4 wa = *(const LAS f32x4*)(w2L + (i4 + ii) * 64 + jg), wb = *(const LAS f32x4*)(w2L + (i4 + ii) * 64 + jg + 4);
                  acc8[0] += av[ii] * wa[0]; acc8[1] += av[ii] * wa[1]; acc8[2] += av[ii] * wa[2]; acc8[3] += av[ii] * wa[3];
                  acc8[4] += av[ii] * wb[0]; acc8[5] += av[ii] * wb[1]; acc8[6] += av[ii] * wb[2]; acc8[7] += av[ii] * wb[3]; } }
#pragma unroll
          for (int j = 0; j < 8; ++j) a2[row * 65 + jg + j] = sinf(fq[jg + j] * acc8[j]); }
        __syncthreads();
        { const int o = oc * 512 + tid, c = o & 511; float wreg[64];
#pragma unroll
          for (int j = 0; j < 64; ++j) wreg[j] = w3[(size_t)j * 2048 + o];
          const float delta = 3.0701134573253943f + (float)c * ((15.350567286626972f - 3.0701134573253943f) / 511.f);
          for (int row = 0; row < 64; ++row) { float s = 0.f;
#pragma unroll
              for (int j = 0; j < 64; ++j) s += a2[row * 65 + j] * wreg[j];
              const float win = expf(-((float)(t0 + row) / (float)L) * delta);
              oT[tid * 72 + row] = f2bf(s * win); } }
        __syncthreads();
        for (int q = tid; q < 4096; q += NTHREADS) { const int ol = q >> 3, ch = (q & 7) * 8; const int o = oc * 512 + ol, dir = o >> 10, ord = (o >> 9) & 1, c = o & 511;
            const u32x4 w = *(const LAS u32x4*)(oT + ol * 72 + ch);
            *(u32x4*)(dst + ((size_t)((ord * 2 + dir) * 512 + c)) * L + t0 + ch) = w; }
    }
    __syncthreads();
}

__device__ __forceinline__ void ada_write(const f32x4 (&v)[4], float inv, const float* g, const float* sh, const float* sc, bf16_t* dst, float* fdst, int lane) {
#pragma unroll
    for (int i = 0; i < 4; ++i) { const int c = i * 256 + lane * 4; const f32x4 gg = *(const f32x4*)(g + c); f32x4 y = v[i] * inv * gg;
        if (sh) { const f32x4 s1 = *(const f32x4*)(sc + c), s0 = *(const f32x4*)(sh + c); y = y * (1.f + s1) + s0;
            u32x2 w; w.x = cvt_pk_bf16(y[0], y[1]); w.y = cvt_pk_bf16(y[2], y[3]); *(u32x2*)(dst + c) = w; }
        else *(f32x4*)(fdst + c) = y; }
}
__device__ __forceinline__ void ada_row2(const float* xa, const float* xb, bool hb, const float* g, const float* sha, const float* sca, const float* shb, const float* scb,
                                         bf16_t* da, bf16_t* db, float* fa, float* fb, int lane) {
    f32x4 va[4], vb[4]; float sa = 0.f, sb = 0.f;
#pragma unroll
    for (int i = 0; i < 4; ++i) va[i] = *(const f32x4*)(xa + i * 256 + lane * 4);
#pragma unroll
    for (int i = 0; i < 4; ++i) vb[i] = hb ? *(const f32x4*)(xb + i * 256 + lane * 4) : (f32x4){0.f, 0.f, 0.f, 0.f};
#pragma unroll
    for (int i = 0; i < 4; ++i) { sa += va[i][0] * va[i][0] + va[i][1] * va[i][1] + va[i][2] * va[i][2] + va[i][3] * va[i][3]; sb += vb[i][0] * vb[i][0] + vb[i][1] * vb[i][1] + vb[i][2] * vb[i][2] + vb[i][3] * vb[i][3]; }
#pragma unroll
    for (int o = 32; o >= 1; o >>= 1) { sa += __shfl_xor(sa, o); sb += __shfl_xor(sb, o); }
    ada_write(va, rsqrtf(sa * (1.f / 1024.f) + EPS), g, sha, sca, da, fa, lane);
    if (hb) ada_write(vb, rsqrtf(sb * (1.f / 1024.f) + EPS), g, shb, scb, db, fb, lane);
}
__device__ __forceinline__ void ada_row(const float* x, const float* g, const float* sh, const float* sc, bf16_t* dst, float* fdst, int lane) {
    f32x4 v[4]; float ss = 0.f;
#pragma unroll
    for (int i = 0; i < 4; ++i) { v[i] = *(const f32x4*)(x + i * 256 + lane * 4); ss += v[i][0] * v[i][0] + v[i][1] * v[i][1] + v[i][2] * v[i][2] + v[i][3] * v[i][3]; }
    ss = wave_sum(ss);
    const float inv = rsqrtf(ss * (1.f / 1024.f) + EPS);
#pragma unroll
    for (int i = 0; i < 4; ++i) { const int c = i * 256 + lane * 4; const f32x4 gg = *(const f32x4*)(g + c); f32x4 y = v[i] * inv * gg;
        if (sh) { const f32x4 s1 = *(const f32x4*)(sc + c), s0 = *(const f32x4*)(sh + c); y = y * (1.f + s1) + s0;
            u32x2 w; w.x = cvt_pk_bf16(y[0], y[1]); w.y = cvt_pk_bf16(y[2], y[3]); *(u32x2*)(dst + c) = w; }
        else *(f32x4*)(fdst + c) = y; }
}

typedef float f32x16 __attribute__((ext_vector_type(16)));
template <int L, int NT>
__device__ __forceinline__ void hyena_mfma(const Params& p, int l, int c, bool ctx, LAS unsigned char* lds) {
    LAS unsigned char* U = lds;
    LAS unsigned* F = (LAS unsigned*)(lds + L * 64);
    LAS bf16_t* F16 = (LAS bf16_t*)F;
    const int tid = tidx(), lane = tid & 63, w = __builtin_amdgcn_readfirstlane(tid >> 6), li = lane & 31, kg = lane >> 5;
    bf16_t* T = (bf16_t*)(p.ws + WS_T);
    const size_t tokb = ctx ? (size_t)TOKL : 0;
    const bf16_t* hf = ctx ? (const bf16_t*)(p.ws + WS_HFC) : (const bf16_t*)(p.ws + WS_HFL) + (size_t)l * 4 * 512 * 2048;
    const float* sw = p.in[I_HSW] + (size_t)l * 3 * 1536; const float* sb = p.in[I_HSB] + l * 1536;
    __syncthreads();
    {
        const int cc = 1024 + c; const bf16_t* row = T + (size_t)cc * TOK + tokb;
        const float w0 = sw[cc], w1 = sw[1536 + cc], w2 = sw[3072 + cc], bb = sb[cc];
        constexpr int ITER = L / 128, BATCH = ITER >= 4 ? 4 : ITER;
        for (int it0 = 0; it0 < ITER; it0 += BATCH) {
            u32x4 rr[BATCH]; bf16_t hm[BATCH], hp[BATCH];
#pragma unroll
            for (int q = 0; q < BATCH; ++q) { const int idx = tid + (it0 + q) * NTHREADS, bq = idx & 31, t8 = idx >> 5; const bf16_t* pr = row + (size_t)bq * L + t8 * 8;
                rr[q] = *(const u32x4*)pr; hm[q] = t8 > 0 ? pr[-1] : (bf16_t)0; hp[q] = t8 < L / 8 - 1 ? pr[8] : (bf16_t)0; }
#pragma unroll
            for (int q = 0; q < BATCH; ++q) { const int idx = tid + (it0 + q) * NTHREADS; const u32x4 r = rr[q];
                float x[10]; x[0] = bf2f(hm[q]); x[9] = bf2f(hp[q]);
                x[1] = lo16(r.x); x[2] = hi16(r.x); x[3] = lo16(r.y); x[4] = hi16(r.y); x[5] = lo16(r.z); x[6] = hi16(r.z); x[7] = lo16(r.w); x[8] = hi16(r.w);
                float y[8];
#pragma unroll
                for (int j = 0; j < 8; ++j) y[j] = w0 * x[j] + w1 * x[j + 1] + w2 * x[j + 2] + bb;
                u32x4 o; o.x = cvt_pk_bf16(y[0], y[1]); o.y = cvt_pk_bf16(y[2], y[3]); o.z = cvt_pk_bf16(y[4], y[5]); o.w = cvt_pk_bf16(y[6], y[7]);
                *(LAS u32x4*)(U + (size_t)idx * 16) = o; }
        }
    }
    const int lane_dw = (li & 1) * L + ((8 * kg - li + L - (li & 1)) >> 1);
#define HY_LOADA(dst, f) do { const LAS unsigned* _q = F + (lane_dw - 8 * (f)); u32x4 _v; _v.x = _q[0]; _v.y = _q[1]; _v.z = _q[2]; _v.w = _q[3]; dst = __builtin_bit_cast(bf16x8, _v); } while (0)
#define HY_LOADB(dst, s0) dst = *(const LAS bf16x8*)(U + ((s0) >> 3) * 512 + lane * 16)
    for (int ord = 0; ord < 2; ++ord) {
        __syncthreads();
        for (int x0 = tid; x0 < 2 * L; x0 += 4 * NTHREADS) {
            bf16_t fv[4];
#pragma unroll
            for (int q = 0; q < 4; ++q) { const int x = x0 + q * NTHREADS; bf16_t v = 0;
                if (x >= 1 && x <= L) v = hf[((size_t)((ord * 2 + 0) * 512 + c)) * L + (L - x)];
                else if (x > L && x < 2 * L) v = hf[((size_t)((ord * 2 + 1) * 512 + c)) * L + (x - L)];
                fv[q] = v; }
#pragma unroll
            for (int q = 0; q < 4; ++q) { const int x = x0 + q * NTHREADS; const bf16_t v = fv[q];
                if (x < 2 * L) { F16[x] = v; if (x >= 1) F16[2 * L + x - 1] = v; if (x == 2 * L - 1) F16[4 * L - 1] = 0; } } }
        if (false) for (int x = tid; x < 0; ++x) {
            bf16_t v = 0;
            if (x >= 1 && x <= L) v = hf[((size_t)((ord * 2 + 0) * 512 + c)) * L + (L - x)];
            else if (x > L) v = hf[((size_t)((ord * 2 + 1) * 512 + c)) * L + (x - L)];
            F16[x] = v; if (x >= 1) F16[2 * L + x - 1] = v; if (x == 2 * L - 1) F16[4 * L - 1] = 0; }
        __syncthreads();
        f32x16 acc[NT];
#pragma unroll
        for (int i = 0; i < NT; ++i)
#pragma unroll
            for (int r = 0; r < 16; ++r) acc[i][r] = 0.f;
        bf16x8 E[NT], O[NT];
#pragma unroll
        for (int i = 1; i < NT; ++i) { HY_LOADA(E[i], 2 * (NT * w + i)); HY_LOADA(O[i], 2 * (NT * w + i) - 1); }
        for (int n8 = 0; n8 < L / 32; n8 += 8) {
#pragma unroll
            for (int u = 0; u < 8; ++u) { const int n = n8 + u; const int fe = 2 * (NT * w - n); bf16x8 Bf;
                HY_LOADA(E[(8 - u) & (NT - 1)], fe); HY_LOADB(Bf, 32 * n);
#pragma unroll
                for (int i = 0; i < NT; ++i) acc[i] = __builtin_amdgcn_mfma_f32_32x32x16_bf16(E[(i - u) & (NT - 1)], Bf, acc[i], 0, 0, 0);
                HY_LOADA(O[(8 - u) & (NT - 1)], fe - 1); HY_LOADB(Bf, 32 * n + 16);
#pragma unroll
                for (int i = 0; i < NT; ++i) acc[i] = __builtin_amdgcn_mfma_f32_32x32x16_bf16(O[(i - u) & (NT - 1)], Bf, acc[i], 0, 0, 0);
            }
        }
        __syncthreads();
        const int lane2 = tidx() & 63, li = lane2 & 31, kg = lane2 >> 5;
        const int xc = ord * 512 + c; const bf16_t* xrow = T + (size_t)xc * TOK + tokb + (size_t)li * L;
        bf16_t* orow = T + (size_t)c * TOK + tokb + (size_t)li * L;
        const float w0 = sw[xc], w1 = sw[1536 + xc], w2 = sw[3072 + xc], bb = sb[xc], sk = p.in[I_HSKIP][(l * 2 + ord) * 512 + c];
#pragma unroll
        for (int i = 0; i < NT; ++i) {
#pragma unroll
            for (int rh = 0; rh < 4; rh += 2) {
            u32x2 xr4[2]; bf16_t hm[2], hp[2];
#pragma unroll
            for (int r2 = 0; r2 < 2; ++r2) { const int rg = rh + r2; const int tb = 32 * (NT * w + i) + 8 * rg + 4 * kg;
                xr4[r2] = *(const u32x2*)(xrow + tb); hm[r2] = tb > 0 ? xrow[tb - 1] : (bf16_t)0; hp[r2] = tb + 4 < L ? xrow[tb + 4] : (bf16_t)0; }
#pragma unroll
            for (int r2 = 0; r2 < 2; ++r2) { const int rg = rh + r2; const int tb = 32 * (NT * w + i) + 8 * rg + 4 * kg; const u32x2 xr = xr4[r2];
                float x[6]; x[0] = bf2f(hm[r2]); x[5] = bf2f(hp[r2]);
                x[1] = lo16(xr.x); x[2] = hi16(xr.x); x[3] = lo16(xr.y); x[4] = hi16(xr.y);
                LAS u32x2* up = (LAS u32x2*)(U + ((tb >> 3) * 32 + li) * 16 + (tb & 7) * 2);
                const u32x2 uv = *up; const float uu[4] = {lo16(uv.x), hi16(uv.x), lo16(uv.y), hi16(uv.y)};
                float z[4];
#pragma unroll
                for (int j = 0; j < 4; ++j) z[j] = (w0 * x[j] + w1 * x[j + 1] + w2 * x[j + 2] + bb) * (acc[i][rg * 4 + j] + sk * uu[j]);
                u32x2 o; o.x = cvt_pk_bf16(z[0], z[1]); o.y = cvt_pk_bf16(z[2], z[3]);
                if (ord == 0) *up = o; else *(u32x2*)(orow + tb) = o; }
            }
        }
    }
#undef HY_LOADA
#undef HY_LOADB
    __syncthreads();
}

__device__ __forceinline__ void gla_item(const Params& p, int l, int b, int h, int dir, LAS float* lf) {
    const int tid = tidx(), qd = tid & 3, dv = tid >> 2;
    LAS float* qL = lf; LAS float* kL = lf + 2048; LAS float* aL = lf + 4096; LAS float* vL = lf + 6144; LAS float* oL = lf + 10240; LAS float* waL = lf + 14336; LAS float* baL = lf + 15360;
    const bf16_t* PG = (const bf16_t*)(p.ws + WS_PG);
    bf16_t* O = (bf16_t*)(p.ws + WS_OF) + (size_t)dir * TOK * 512;
    const float* wa = (dir ? p.in[I_WAB] : p.in[I_WAF]) + l * 16 * 256; const float* ba = (dir ? p.in[I_BAB] : p.in[I_BAF]) + l * 256;
    __syncthreads();
    for (int i = tid; i < 1024; i += NTHREADS) waL[i] = wa[(i >> 6) * 256 + h * 64 + (i & 63)];
    if (tid < 64) baL[tid] = ba[h * 64 + tid];
    float S[16];
#pragma unroll
    for (int i = 0; i < 16; ++i) S[i] = 0.f;
    const int sp = tid >> 4, sc4 = (tid & 15) * 4, sc8 = (tid & 15) * 8;
    for (int ck = 0; ck < 72; ++ck) {
        const int P = ck * 32 + sp; size_t row;
        if (P < 256) row = (size_t)TOKL + b * 256 + (dir ? 255 - P : P); else { const int tl = P - 256; row = (size_t)b * 2048 + (dir ? 2047 - tl : tl); }
        const bf16_t* pr = PG + row * NG;
        __syncthreads();
        { const u32x2 wq = *(const u32x2*)(pr + h * 64 + sc4), wk = *(const u32x2*)(pr + 256 + h * 64 + sc4);
          *(LAS f32x4*)(qL + sp * 64 + sc4) = (f32x4){lo16(wq.x) * 0.125f, hi16(wq.x) * 0.125f, lo16(wq.y) * 0.125f, hi16(wq.y) * 0.125f};
          *(LAS f32x4*)(kL + sp * 64 + sc4) = (f32x4){lo16(wk.x), hi16(wk.x), lo16(wk.y), hi16(wk.y)};
          const u32x4 wv = *(const u32x4*)(pr + 512 + h * 128 + sc8);
          *(LAS f32x4*)(vL + sp * 128 + sc8) = (f32x4){lo16(wv.x), hi16(wv.x), lo16(wv.y), hi16(wv.y)};
          *(LAS f32x4*)(vL + sp * 128 + sc8 + 4) = (f32x4){lo16(wv.z), hi16(wv.z), lo16(wv.w), hi16(wv.w)};
          const u32x4 g0 = *(const u32x4*)(pr + 1536 + dir * 16), g1 = *(const u32x4*)(pr + 1536 + dir * 16 + 8);
          float gt[16] = {lo16(g0.x), hi16(g0.x), lo16(g0.y), hi16(g0.y), lo16(g0.z), hi16(g0.z), lo16(g0.w), hi16(g0.w),
                          lo16(g1.x), hi16(g1.x), lo16(g1.y), hi16(g1.y), lo16(g1.z), hi16(g1.z), lo16(g1.w), hi16(g1.w)};
#pragma unroll
          for (int j = 0; j < 4; ++j) { float z = baL[sc4 + j];
#pragma unroll
              for (int r = 0; r < 16; ++r) z += gt[r] * waL[r * 64 + sc4 + j];
              const float ls = -(fmaxf(-z, 0.f) + log1pf(expf(-fabsf(z))));
              aL[sp * 64 + sc4 + j] = expf(ls * (1.f / 16.f)); } }
        __syncthreads();
        for (int pos = 0; pos < 32; ++pos) {
            const float vv = vL[pos * 128 + dv]; float part = 0.f;
#pragma unroll
            for (int i4 = 0; i4 < 4; ++i4) { const f32x4 aa = *(const LAS f32x4*)(aL + pos * 64 + qd * 16 + i4 * 4), kk = *(const LAS f32x4*)(kL + pos * 64 + qd * 16 + i4 * 4), qq = *(const LAS f32x4*)(qL + pos * 64 + qd * 16 + i4 * 4);
#pragma unroll
                for (int j = 0; j < 4; ++j) { S[i4 * 4 + j] = aa[j] * S[i4 * 4 + j] + kk[j] * vv; part += qq[j] * S[i4 * 4 + j]; } }
            part += __shfl_xor(part, 1); part += __shfl_xor(part, 2);
            if (qd == 0) oL[pos * 128 + dv] = part;
        }
        __syncthreads();
        { const f32x4 o0 = *(const LAS f32x4*)(oL + sp * 128 + sc8), o1 = *(const LAS f32x4*)(oL + sp * 128 + sc8 + 4);
          u32x4 w; w.x = cvt_pk_bf16(o0[0], o0[1]); w.y = cvt_pk_bf16(o0[2], o0[3]); w.z = cvt_pk_bf16(o1[0], o1[1]); w.w = cvt_pk_bf16(o1[2], o1[3]);
          *(u32x4*)(O + row * 512 + h * 128 + sc8) = w; }
    }
    __syncthreads();
}


__device__ __forceinline__ size_t gla_row(int P, int b, int dir) { return P < 256 ? (size_t)TOKL + b * 256 + (dir ? 255 - P : P) : (size_t)b * 2048 + (dir ? 2047 - (P - 256) : (P - 256)); }
__device__ __forceinline__ void gla_chunk_item(const Params& p, int l, int b, int h, int dir, LAS unsigned char* lds) {
    constexpr int RS = 72;
    LAS bf16_t* QD = (LAS bf16_t*)lds; LAS bf16_t* KI = QD + 64 * RS; LAS bf16_t* KET = KI + 64 * RS; LAS bf16_t* PP = KET + 64 * RS;
    LAS bf16_t* VT = PP + 64 * RS; LAS bf16_t* ST = VT + 128 * RS;
    LAS float* TOT = (LAS float*)(ST + 128 * RS); LAS float* DEC = TOT + 512; LAS float* WAL = DEC + 64; LAS float* BAL = WAL + 1024;
    const int tid = tidx(), lane = tid & 63, w = __builtin_amdgcn_readfirstlane(tid >> 6), i = tid >> 3, dg = tid & 7, d0 = dg * 8, l5 = lane & 31, hh = lane >> 5;
    const int ih = w >> 2, vq = w & 3;
    const bf16_t* PG = (const bf16_t*)(p.ws + WS_PG);
    bf16_t* O = (bf16_t*)(p.ws + WS_OF) + (size_t)dir * TOK * 512;
    const float* wa = (dir ? p.in[I_WAB] : p.in[I_WAF]) + l * 16 * 256; const float* ba = (dir ? p.in[I_BAB] : p.in[I_BAF]) + l * 256;
    __syncthreads();
    for (int q = tid; q < 1024; q += NTHREADS) WAL[q] = wa[(q >> 6) * 256 + h * 64 + (q & 63)];
    if (tid < 64) BAL[tid] = ba[h * 64 + tid];
    for (int q = tid; q < 73728 / 16; q += NTHREADS) *(LAS u32x4*)(lds + q * 16) = (u32x4){0u, 0u, 0u, 0u};
    f32x16 accS;
#pragma unroll
    for (int r = 0; r < 16; ++r) accS[r] = 0.f;
    u32x4 rq, rk, rg0, rg1, rv0, rv1;
    { const bf16_t* pr = PG + gla_row(i, b, dir) * NG;
      rq = *(const u32x4*)(pr + h * 64 + d0); rk = *(const u32x4*)(pr + 256 + h * 64 + d0); rg0 = *(const u32x4*)(pr + 1536 + dir * 16); rg1 = *(const u32x4*)(pr + 1536 + dir * 16 + 8);
      rv0 = *(const u32x4*)(pr + 512 + h * 128 + dg * 16); rv1 = *(const u32x4*)(pr + 512 + h * 128 + dg * 16 + 8); }
    __syncthreads();
    for (int ck = 0; ck < 36; ++ck) {
        float qf[8] = {lo16(rq.x), hi16(rq.x), lo16(rq.y), hi16(rq.y), lo16(rq.z), hi16(rq.z), lo16(rq.w), hi16(rq.w)};
        float kf[8] = {lo16(rk.x), hi16(rk.x), lo16(rk.y), hi16(rk.y), lo16(rk.z), hi16(rk.z), lo16(rk.w), hi16(rk.w)};
        float gt[16] = {lo16(rg0.x), hi16(rg0.x), lo16(rg0.y), hi16(rg0.y), lo16(rg0.z), hi16(rg0.z), lo16(rg0.w), hi16(rg0.w),
                        lo16(rg1.x), hi16(rg1.x), lo16(rg1.y), hi16(rg1.y), lo16(rg1.z), hi16(rg1.z), lo16(rg1.w), hi16(rg1.w)};
        float la[8];
#pragma unroll
        for (int j = 0; j < 8; ++j) { float z = BAL[d0 + j];
#pragma unroll
            for (int r = 0; r < 16; ++r) z += gt[r] * WAL[r * 64 + d0 + j];
            la[j] = -(fmaxf(-z, 0.f) + __logf(1.f + __expf(-fabsf(z)))) * (1.f / 16.f); }
#pragma unroll
        for (int st = 8; st < 64; st <<= 1) {
#pragma unroll
            for (int j = 0; j < 8; ++j) { const float y = __shfl_up(la[j], st); if (lane >= st) la[j] += y; } }
        if ((lane >> 3) == 7) { *(LAS f32x4*)(TOT + w * 64 + d0) = (f32x4){la[0], la[1], la[2], la[3]}; *(LAS f32x4*)(TOT + w * 64 + d0 + 4) = (f32x4){la[4], la[5], la[6], la[7]}; }
        __syncthreads();
        {
            float pre[8], bl[8];
#pragma unroll
            for (int j = 0; j < 8; ++j) { pre[j] = 0.f; bl[j] = 0.f; }
#pragma unroll
            for (int ww = 0; ww < 8; ++ww) { const f32x4 t0 = *(const LAS f32x4*)(TOT + ww * 64 + d0), t1 = *(const LAS f32x4*)(TOT + ww * 64 + d0 + 4);
                const float tv[8] = {t0[0], t0[1], t0[2], t0[3], t1[0], t1[1], t1[2], t1[3]};
#pragma unroll
                for (int j = 0; j < 8; ++j) { bl[j] += tv[j]; if (ww < w) pre[j] += tv[j]; } }
            float qd[8], ki[8], ke[8], eb[8];
#pragma unroll
            for (int j = 0; j < 8; ++j) { const float bc = la[j] + pre[j]; const float e1 = __expf(bc), e2 = __builtin_amdgcn_rcpf(e1); eb[j] = __expf(bl[j]);
                qd[j] = qf[j] * 0.125f * e1; ki[j] = kf[j] * e2; ke[j] = kf[j] * (eb[j] * e2); }
            u32x4 wq, wk;
            wq.x = cvt_pk_bf16(qd[0], qd[1]); wq.y = cvt_pk_bf16(qd[2], qd[3]); wq.z = cvt_pk_bf16(qd[4], qd[5]); wq.w = cvt_pk_bf16(qd[6], qd[7]);
            wk.x = cvt_pk_bf16(ki[0], ki[1]); wk.y = cvt_pk_bf16(ki[2], ki[3]); wk.z = cvt_pk_bf16(ki[4], ki[5]); wk.w = cvt_pk_bf16(ki[6], ki[7]);
            *(LAS u32x4*)(QD + i * RS + d0) = wq; *(LAS u32x4*)(KI + i * RS + d0) = wk;
#pragma unroll
            for (int j = 0; j < 8; j += 2) { const unsigned pk = cvt_pk_bf16(ke[j], ke[j + 1]); KET[(d0 + j) * RS + i] = (bf16_t)(pk & 0xffffu); KET[(d0 + j + 1) * RS + i] = (bf16_t)(pk >> 16); }
            const unsigned vv[8] = {rv0.x, rv0.y, rv0.z, rv0.w, rv1.x, rv1.y, rv1.z, rv1.w};
#pragma unroll
            for (int j = 0; j < 8; ++j) { VT[(dg * 16 + 2 * j) * RS + i] = (bf16_t)(vv[j] & 0xffffu); VT[(dg * 16 + 2 * j + 1) * RS + i] = (bf16_t)(vv[j] >> 16); }
            if (i == 0) { *(LAS f32x4*)(DEC + d0) = (f32x4){eb[0], eb[1], eb[2], eb[3]}; *(LAS f32x4*)(DEC + d0 + 4) = (f32x4){eb[4], eb[5], eb[6], eb[7]}; }
        }
        if (ck + 1 < 36) { const bf16_t* pr = PG + gla_row((ck + 1) * 64 + i, b, dir) * NG;
            rq = *(const u32x4*)(pr + h * 64 + d0); rk = *(const u32x4*)(pr + 256 + h * 64 + d0); rg0 = *(const u32x4*)(pr + 1536 + dir * 16); rg1 = *(const u32x4*)(pr + 1536 + dir * 16 + 8);
            rv0 = *(const u32x4*)(pr + 512 + h * 128 + dg * 16); rv1 = *(const u32x4*)(pr + 512 + h * 128 + dg * 16 + 8); }
        __syncthreads();
        f32x16 accO;
#pragma unroll
        for (int r = 0; r < 16; ++r) accO[r] = 0.f;
#pragma unroll
        for (int ks = 0; ks < 4; ++ks) { const bf16x8 A = *(const LAS bf16x8*)(QD + (ih * 32 + l5) * RS + ks * 16 + hh * 8), Bv = *(const LAS bf16x8*)(ST + (vq * 32 + l5) * RS + ks * 16 + hh * 8);
            accO = __builtin_amdgcn_mfma_f32_32x32x16_bf16(A, Bv, accO, 0, 0, 0); }
        if (w < 3) { const int si = w == 0 ? 0 : 1, sj = w == 2 ? 1 : 0; f32x16 accP;
#pragma unroll
            for (int r = 0; r < 16; ++r) accP[r] = 0.f;
#pragma unroll
            for (int ks = 0; ks < 4; ++ks) { const bf16x8 A = *(const LAS bf16x8*)(QD + (si * 32 + l5) * RS + ks * 16 + hh * 8), Bv = *(const LAS bf16x8*)(KI + (sj * 32 + l5) * RS + ks * 16 + hh * 8);
                accP = __builtin_amdgcn_mfma_f32_32x32x16_bf16(A, Bv, accP, 0, 0, 0); }
#pragma unroll
            for (int r = 0; r < 16; ++r) { const int ii = si * 32 + (r & 3) + 8 * (r >> 2) + 4 * hh, jj = sj * 32 + l5; PP[ii * RS + jj] = f2bf(jj <= ii ? accP[r] : 0.f); } }
        __syncthreads();
        { const int nk = ih == 0 ? 2 : 4;
          for (int ks = 0; ks < nk; ++ks) { const bf16x8 A = *(const LAS bf16x8*)(PP + (ih * 32 + l5) * RS + ks * 16 + hh * 8), Bv = *(const LAS bf16x8*)(VT + (vq * 32 + l5) * RS + ks * 16 + hh * 8);
              accO = __builtin_amdgcn_mfma_f32_32x32x16_bf16(A, Bv, accO, 0, 0, 0); } }
#pragma unroll
        for (int rg = 0; rg < 4; ++rg) { const f32x4 dv = *(const LAS f32x4*)(DEC + ih * 32 + 8 * rg + 4 * hh);
#pragma unroll
            for (int j = 0; j < 4; ++j) accS[rg * 4 + j] *= dv[j]; }
#pragma unroll
        for (int ks = 0; ks < 4; ++ks) { const bf16x8 A = *(const LAS bf16x8*)(KET + (ih * 32 + l5) * RS + ks * 16 + hh * 8), Bv = *(const LAS bf16x8*)(VT + (vq * 32 + l5) * RS + ks * 16 + hh * 8);
            accS = __builtin_amdgcn_mfma_f32_32x32x16_bf16(A, Bv, accS, 0, 0, 0); }
#pragma unroll
        for (int r = 0; r < 16; ++r) { const int ii = ih * 32 + (r & 3) + 8 * (r >> 2) + 4 * hh;
            O[gla_row(ck * 64 + ii, b, dir) * 512 + h * 128 + vq * 32 + l5] = f2bf(accO[r]); }
#pragma unroll
        for (int rg = 0; rg < 4; ++rg) { u32x2 o; o.x = cvt_pk_bf16(accS[rg * 4], accS[rg * 4 + 1]); o.y = cvt_pk_bf16(accS[rg * 4 + 2], accS[rg * 4 + 3]);
            *(LAS u32x2*)(ST + (vq * 32 + l5) * RS + ih * 32 + 8 * rg + 4 * hh) = o; }
        __syncthreads();
    }
    __syncthreads();
}

template <int W>
__device__ __forceinline__ void pool2d_wave(bf16_t* base, int lane) {
    float u[32], pv[33];
#pragma unroll
    for (int r = 0; r < 32; ++r) u[r] = bf2f(base[r * 64 + lane]);
    pv[0] = 0.f;
#pragma unroll
    for (int r = 0; r < 32; ++r) pv[r + 1] = pv[r] + u[r];
    const int cl = max(lane - W / 2, 0), chh = min(lane - W / 2 + W, 64);
#pragma unroll
    for (int r = 0; r < 32; ++r) {
        const int rl = (r - W / 2) < 0 ? 0 : (r - W / 2), rh = (r - W / 2 + W) > 32 ? 32 : (r - W / 2 + W);
        float x = pv[rh] - pv[rl];
#pragma unroll
        for (int d = 1; d < 64; d <<= 1) { const float y = __shfl_up(x, d); if (lane >= d) x += y; }
        const float hi = __shfl(x, chh - 1), lo = __shfl(x, cl > 0 ? cl - 1 : 0);
        const float s = hi - (cl > 0 ? lo : 0.f);
        const float cnt = (float)((rh - rl) * (chh - cl));
        base[r * 64 + lane] = f2bf(s / cnt - u[r]);
    }
}
__device__ __forceinline__ void pool1d_wave(bf16_t* base, int lane, int W) {
    float u[4], P[4];
#pragma unroll
    for (int j = 0; j < 4; ++j) u[j] = bf2f(base[j * 64 + lane]);
    float off = 0.f;
#pragma unroll
    for (int j = 0; j < 4; ++j) { float x = u[j];
#pragma unroll
        for (int d = 1; d < 64; d <<= 1) { const float y = __shfl_up(x, d); if (lane >= d) x += y; }
        P[j] = x + off; off += __shfl(x, 63); }
#pragma unroll
    for (int j = 0; j < 4; ++j) { const int t = j * 64 + lane; const int lo = max(t - W / 2, 0), hi = min(t - W / 2 + W, 256);
        const int ih = hi - 1, il = lo > 0 ? lo - 1 : 0;
        float vh = 0.f, vl = 0.f;
#pragma unroll
        for (int s = 0; s < 4; ++s) { const float a = __shfl(P[s], ih & 63), bq = __shfl(P[s], il & 63); if ((ih >> 6) == s) vh = a; if ((il >> 6) == s) vl = bq; }
        const float sum = vh - (lo > 0 ? vl : 0.f);
        u[j] = sum / (float)(hi - lo) - u[j]; }
#pragma unroll
    for (int j = 0; j < 4; ++j) base[j * 64 + lane] = f2bf(u[j]);
}

__global__ void __launch_bounds__(NTHREADS, 2) mega(Params p) {
    extern __shared__ __attribute__((aligned(16))) unsigned char lds_raw[];
    LAS unsigned char* lds = (LAS unsigned char*)lds_raw;
    LAS float* lf = (LAS float*)lds;
    cg::grid_group grid = cg::this_grid();
    unsigned bar_n = 0; unsigned* bar_ctr = (unsigned*)(p.ws + WS_BAR);
unsigned hb_k = 0, hb_xcc = 0, hb_nloc = 0, hb_nx = 0;
#define GBAR() do { if (hb_nloc == 0u) { bar_n += gridDim.x; gbar(bar_ctr, bar_n); } else { ++hb_k; gbar_h(bar_ctr, hb_xcc, hb_nloc, hb_nx, hb_k); } } while (0)
    const int G = gridDim.x, bid = blockIdx.x;
#define WSPTRS const int tid = tidx(), lane = tid & 63, wid = tid >> 6; (void)lane; (void)wid; unsigned char* ws = opq(p.ws); bf16_t* HX = (bf16_t*)(ws + WS_HX); bf16_t* T = (bf16_t*)(ws + WS_T); bf16_t* YG = (bf16_t*)(ws + WS_YG); bf16_t* PG = (bf16_t*)(ws + WS_PG); \
    float* CTXS = (float*)(ws + WS_CTX); const float* MOD = (const float*)(ws + WS_MOD); const float* BIAS = (const float*)(ws + WS_BIAS); (void)HX; (void)T; (void)YG; (void)PG; (void)CTXS; (void)MOD; (void)BIAS;

#ifdef TIMEX
    unsigned long long tx0 = 0, tx1 = 0; int txn = 0;
#define TX_MARK() do { if (txn == TIMEX) tx0 = __builtin_amdgcn_s_memrealtime(); if (txn == TIMEX + 1) tx1 = __builtin_amdgcn_s_memrealtime(); ++txn; } while (0)
    unsigned long long cx0 = 0, cxacc = 0;
#define CX_BEGIN(k) do { if (TIMEX == 100 + (k) && l == 1) { __syncthreads(); cx0 = __builtin_amdgcn_s_memrealtime(); } } while (0)
#define CX_END(k) do { if (TIMEX == 100 + (k) && l == 1) { __syncthreads(); cxacc += __builtin_amdgcn_s_memrealtime() - cx0; } } while (0)
#else
#define TX_MARK() do {} while (0)
#define CX_BEGIN(k) do {} while (0)
#define CX_END(k) do {} while (0)
#endif
    if (threadIdx.x == 0) { unsigned* ctl = (unsigned*)(p.ws + WS_BAR); const unsigned xcc = (unsigned)__builtin_amdgcn_s_getreg((3 << 11) | 20) & 7u;
        const unsigned rank = __hip_atomic_fetch_add(ctl + 16 + xcc, 1u, __ATOMIC_RELAXED, __HIP_MEMORY_SCOPE_AGENT);
        __hip_atomic_store(ctl + 256 + 2 * blockIdx.x, xcc, __ATOMIC_RELAXED, __HIP_MEMORY_SCOPE_AGENT); __hip_atomic_store(ctl + 257 + 2 * blockIdx.x, rank, __ATOMIC_RELAXED, __HIP_MEMORY_SCOPE_AGENT); }
    int xj = (int)blockIdx.x;
    TX_MARK();
    for (int l = 0; l < 2; ++l) {
        unsigned char* ws = opq(p.ws);
        const float* win = p.in[I_WIN] + (size_t)l * D * N_IN;
        bf16_t* wt = (bf16_t*)(ws + WS_WT + l * SZ_WT);
        tconv(win, N_IN, 0, 1536, 1536, D, wt, lf);
        tconv(win, N_IN, POOL_OFF, 512, 512, D, wt + (size_t)1536 * D, lf);
        tconv(win, N_IN, GLA_OFF, NGV, NG, D, (bf16_t*)(ws + WS_WG + l * SZ_WG), lf);
        tconv(win, N_IN, GATE_OFF, 3072, 3072, D, (bf16_t*)(ws + WS_WGATE + l * SZ_WGATE), lf);
        tconv(p.in[I_WBH] + (size_t)l * 512 * 1024, 1024, 0, 1024, 1024, 512, (bf16_t*)(ws + WS_WBR + (size_t)(l * 3 + 0) * SZ_WBR), lf);
        tconv(p.in[I_WBG] + (size_t)l * 512 * 1024, 1024, 0, 1024, 1024, 512, (bf16_t*)(ws + WS_WBR + (size_t)(l * 3 + 1) * SZ_WBR), lf);
        tconv(p.in[I_WOUT] + (size_t)l * D * D, D, 0, D, D, D, (bf16_t*)(ws + WS_WOUT + l * SZ_WOUT), lf);
        tconv(p.in[I_WUP] + (size_t)l * D * DFF, DFF, 0, DFF, DFF, D, (bf16_t*)(ws + WS_WUP + l * SZ_WUP), lf);
        tconv(p.in[I_WDN] + (size_t)l * DFF * D, D, 0, D, D, DFF, (bf16_t*)(ws + WS_WDN + l * SZ_WDN), lf);
        job_poolcomb(p, l);
    }
    job_bias(p);
    job_mod(p, lf);
    job_filters(p, lds);
    if (p.ws == nullptr) grid.sync();
    GBAR();
    { unsigned* ctl = (unsigned*)(p.ws + WS_BAR); bool ok = (gridDim.x & 7u) == 0u;
      for (int q = 0; q < 8; ++q) ok = ok && (__hip_atomic_load(ctl + 16 + q, __ATOMIC_RELAXED, __HIP_MEMORY_SCOPE_AGENT) == (gridDim.x >> 3));
      const unsigned mx = __hip_atomic_load(ctl + 256 + 2 * blockIdx.x, __ATOMIC_RELAXED, __HIP_MEMORY_SCOPE_AGENT), mr = __hip_atomic_load(ctl + 257 + 2 * blockIdx.x, __ATOMIC_RELAXED, __HIP_MEMORY_SCOPE_AGENT);
      if (ok) xj = __builtin_amdgcn_readfirstlane((int)((mr << 3) | mx));
      unsigned sum = 0u, nxc = 0u;
      for (int q = 0; q < 8; ++q) { const unsigned cq = __hip_atomic_load(ctl + 16 + q, __ATOMIC_RELAXED, __HIP_MEMORY_SCOPE_AGENT); sum += cq; nxc += cq ? 1u : 0u; }
      if (sum == gridDim.x) { hb_xcc = (unsigned)__builtin_amdgcn_readfirstlane((int)mx); hb_nloc = (unsigned)__builtin_amdgcn_readfirstlane((int)__hip_atomic_load(ctl + 16 + mx, __ATOMIC_RELAXED, __HIP_MEMORY_SCOPE_AGENT)); hb_nx = nxc; } }

    { WSPTRS
    for (int row = bid * 8 + wid; row < TOK; row += 2 * G * 8) {
        const int rb = row + G * 8; const bool hb = rb < TOK; const int rb2 = hb ? rb : row;
        const bool la = row < TOKL, lb = rb2 < TOKL;
        const float* xa = la ? p.in[I_X] + (size_t)row * D : p.in[I_CTX] + (size_t)(row - TOKL) * D; const float* xb = lb ? p.in[I_X] + (size_t)rb2 * D : p.in[I_CTX] + (size_t)(rb2 - TOKL) * D;
        const float* ma = MOD + (size_t)(la ? row >> 11 : 32) * 6144; const float* mb = MOD + (size_t)(lb ? rb2 >> 11 : 32) * 6144;
        ada_row2(xa, xb, hb, p.in[I_NMIX], ma, ma + 1024, mb, mb + 1024, HX + (size_t)row * D, HX + (size_t)rb2 * D, nullptr, nullptr, lane);
    } }
    GBAR();
    TX_MARK();

    for (int l_ = 0; l_ < 2; ++l_) {
        const int l = opqi(l_);
        { WSPTRS
            const int ntokt = l == 0 ? 288 : 256;
            const int nA = ntokt * 8, nB = 288 * 7;
            const bf16_t* wt = (const bf16_t*)(ws + WS_WT + l * SZ_WT); const bf16_t* wg = (const bf16_t*)(ws + WS_WG + l * SZ_WG);
            const float* biasT = BIAS + l * (NTR + NG); const float* biasG = biasT + NTR;
            XMap MA, MB; MA.init(xj, ntokt, 8); MB.init(xj, 288, 7);
            ProgInproj P{wt, wg, HX, T, PG, biasT, biasG, MA, MB, MA.rounds()};
            gemm_stream(lds, MA.rounds() + MB.rounds(), P);
        }
        GBAR();
        TX_MARK();
        { WSPTRS
            for (int it = bid; it < 256; it += G) gla_chunk_item(p, l, it >> 3, (it >> 1) & 3, it & 1, lds);
            for (int it = bid; it < 512; it += G) hyena_mfma<2048, 8>(p, l, it, false, lds);
            if (l == 0) for (int it = bid; it < 512; it += G) hyena_mfma<256, 1>(p, l, it, true, lds);
            const int npl = l == 0 ? 32768 : 16384;
            for (int it = bid * 8 + wid; it < npl; it += G * 8) { const bool cx = it >= 16384; const int j = it & 16383, ch = j >> 5, b = j & 31, g = ch >> 7;
                bf16_t* base = T + (size_t)(1536 + ch) * TOK + (cx ? (size_t)TOKL + b * 256 : (size_t)b * 2048);
                if (cx) pool1d_wave(base, lane, 2 << g);
                else { if (g == 0) pool2d_wave<2>(base, lane); else if (g == 1) pool2d_wave<4>(base, lane); else if (g == 2) pool2d_wave<8>(base, lane); else pool2d_wave<16>(base, lane); } }
        }
        GBAR();
        TX_MARK();
        {
            WSPTRS
            const bf16_t* OF = (const bf16_t*)(ws + WS_OF); const bf16_t* OB = OF + (size_t)TOK * 512; const float* nw = p.in[I_GNW] + l * 128;
            const int ntok = l == 0 ? TOK : TOKL;
            for (int row = bid * 8 + wid; row < ntok; row += 2 * G * 8) {
                const int rowb = row + G * 8; const bool hb = rowb < ntok; const int rows[2] = {row, hb ? rowb : row};
                u32x4 av[2], bv[2], rv[2];
#pragma unroll
                for (int q = 0; q < 2; ++q) { av[q] = *(const u32x4*)(OF + (size_t)rows[q] * 512 + lane * 8); bv[q] = *(const u32x4*)(OB + (size_t)rows[q] * 512 + lane * 8); rv[q] = *(const u32x4*)(PG + (size_t)rows[q] * NG + 1024 + lane * 8); }
#pragma unroll
                for (int q = 0; q < 2; ++q) { if (q == 1 && !hb) break;
                    const u32x4 a = av[q], bq = bv[q], rr = rv[q];
                    float o[8] = {lo16(a.x) + lo16(bq.x), hi16(a.x) + hi16(bq.x), lo16(a.y) + lo16(bq.y), hi16(a.y) + hi16(bq.y), lo16(a.z) + lo16(bq.z), hi16(a.z) + hi16(bq.z), lo16(a.w) + lo16(bq.w), hi16(a.w) + hi16(bq.w)};
                    float r[8] = {lo16(rr.x), hi16(rr.x), lo16(rr.y), hi16(rr.y), lo16(rr.z), hi16(rr.z), lo16(rr.w), hi16(rr.w)};
                    float ss = 0.f;
#pragma unroll
                    for (int j = 0; j < 8; ++j) ss += o[j] * o[j];
                    ss += __shfl_xor(ss, 1); ss += __shfl_xor(ss, 2); ss += __shfl_xor(ss, 4); ss += __shfl_xor(ss, 8);
                    const float inv = rsqrtf(ss * (1.f / 128.f) + EPS);
                    float y[8];
#pragma unroll
                    for (int j = 0; j < 8; ++j) y[j] = o[j] * inv * nw[(lane & 15) * 8 + j] * (r[j] * sigmoidf_(r[j]));
                    u32x4 w; w.x = cvt_pk_bf16(y[0], y[1]); w.y = cvt_pk_bf16(y[2], y[3]); w.z = cvt_pk_bf16(y[4], y[5]); w.w = cvt_pk_bf16(y[6], y[7]);
                    *(u32x4*)(YG + (size_t)rows[q] * 512 + lane * 8) = w; }
            }
            LAS bf16_t* tl = (LAS bf16_t*)lds;
            const int nit = 2 * (l == 0 ? 288 : 256) * 8;
            for (int it = bid; it < nit; it += G) { const int ctile = it & 7, tt = (it >> 3) % (l == 0 ? 288 : 256), which = (it >> 3) / (l == 0 ? 288 : 256);
                const bf16_t* src = T + (size_t)(which ? 1536 : 0) * TOK + (size_t)tt * 256; bf16_t* dst = (bf16_t*)(ws + (which ? WS_YPL : WS_YHY)) + (size_t)tt * 256 * 512;
                __syncthreads();
#pragma unroll
                for (int i = 0; i < 4; ++i) { const int idx = tid + i * NTHREADS, c = idx >> 5, t8 = (idx & 31) * 8;
                    *(LAS u32x4*)(tl + c * 264 + t8) = *(const u32x4*)(src + (size_t)(ctile * 64 + c) * TOK + t8); }
                __syncthreads();
#pragma unroll
                for (int i = 0; i < 4; ++i) { const int idx = tid + i * NTHREADS, tk = idx >> 3, c8 = (idx & 7) * 8; unsigned w[4];
#pragma unroll
                    for (int j = 0; j < 4; ++j) w[j] = (unsigned)tl[(c8 + 2 * j) * 264 + tk] | ((unsigned)tl[(c8 + 2 * j + 1) * 264 + tk] << 16);
                    *(u32x4*)(dst + (size_t)tk * 512 + ctile * 64 + c8) = (u32x4){w[0], w[1], w[2], w[3]}; }
            }
            __syncthreads();
        }
        GBAR();
        TX_MARK();
        const int ntt = l == 0 ? 288 : 256;
        { WSPTRS
          XMap M; M.init(xj, ntt, 4);
          ProgMix2 P{ws, ws + WS_STASH + (size_t)bid * 524288, p.in[I_BIN] + l * N_IN + GATE_OFF, M, l};
          gemm_stream(lds, 6 * M.rounds(), P); }
        GBAR();
        { WSPTRS
          XMap M; M.init(xj, ntt, 4);
          TileIO io{p.in[I_X], p.in[I_CTX], p.out, CTXS, MOD + (size_t)l * 33 * 6144, l};
          ProgOut2 P{ws, io, M, l};
          gemm_stream(lds, M.rounds(), P); }
        GBAR();
        { WSPTRS
          const float* modl = MOD + (size_t)l * 33 * 6144; const int nrow = ntt * 256;
          for (int row = bid * 8 + wid; row < nrow; row += 2 * G * 8) { const int rb = row + G * 8; const bool hb = rb < nrow; const int rb2 = hb ? rb : row; const bool la = row < TOKL, lb = rb2 < TOKL;
              const float* xa = la ? p.out + (size_t)row * D : CTXS + (size_t)(row - TOKL) * D; const float* xb = lb ? p.out + (size_t)rb2 * D : CTXS + (size_t)(rb2 - TOKL) * D;
              const float* ma = modl + (size_t)(la ? row >> 11 : 32) * 6144; const float* mb = modl + (size_t)(lb ? rb2 >> 11 : 32) * 6144;
              ada_row2(xa, xb, hb, p.in[I_NFFN] + l * D, ma + 3072, ma + 4096, mb + 3072, mb + 4096, HX + (size_t)row * D, HX + (size_t)rb2 * D, nullptr, nullptr, lane); } }
        GBAR();
        { WSPTRS
          XMap M; M.init(xj, ntt, 16);
          ProgUp2 P{ws, M, l};
          gemm_stream(lds, M.rounds(), P); }
        GBAR();
        { WSPTRS
          XMap M; M.init(xj, ntt, 4);
          TileIO io{p.in[I_X], p.in[I_CTX], p.out, CTXS, MOD + (size_t)l * 33 * 6144, l};
          ProgDown2 P{ws, io, M, l};
          gemm_stream(lds, M.rounds(), P); }
        GBAR();
        { WSPTRS
          const int nrow = ntt * 256;
          for (int row = bid * 8 + wid; row < nrow; row += 2 * G * 8) { const int rb = row + G * 8; const bool hb = rb < nrow; const int rb2 = hb ? rb : row; const bool la = row < TOKL, lb = rb2 < TOKL;
              float* xa = la ? p.out + (size_t)row * D : CTXS + (size_t)(row - TOKL) * D; float* xb = lb ? p.out + (size_t)rb2 * D : CTXS + (size_t)(rb2 - TOKL) * D;
              if (l == 0) { const float* ma = MOD + (size_t)33 * 6144 + (size_t)(la ? row >> 11 : 32) * 6144; const float* mb = MOD + (size_t)33 * 6144 + (size_t)(lb ? rb2 >> 11 : 32) * 6144;
                  ada_row2(xa, xb, hb, p.in[I_NMIX] + D, ma, ma + 1024, mb, mb + 1024, HX + (size_t)row * D, HX + (size_t)rb2 * D, nullptr, nullptr, lane); }
              else ada_row2(xa, xb, hb, p.in[I_NFIN], nullptr, nullptr, nullptr, nullptr, nullptr, nullptr, xa, xb, lane); } }
        if (l == 0) GBAR();
        TX_MARK();
    }
#ifdef TIMEX
    if (blockIdx.x == 0 && threadIdx.x == 0) { const unsigned long long t = __builtin_amdgcn_s_memrealtime(); while (__builtin_amdgcn_s_memrealtime() - t < (unsigned long long)TIMEX_MULT * (TIMEX >= 100 ? cxacc : (tx1 - tx0))) __builtin_amdgcn_s_sleep(10); }
#endif
}

extern "C" void kernel_launch(void* const* d_in, const int* in_sizes, int n_in, void* d_out, int out_size,
                              void* d_ws, size_t ws_size, hipStream_t stream) {
    static int grid_blocks = 0;
    if (!grid_blocks) {
        int dev = 0, cus = 0, per_cu = 0;
        (void)hipGetDevice(&dev);
        (void)hipDeviceGetAttribute(&cus, hipDeviceAttributeMultiprocessorCount, dev);
        (void)hipFuncSetAttribute((const void*)mega, hipFuncAttributeMaxDynamicSharedMemorySize, LDS_BYTES);
        (void)hipOccupancyMaxActiveBlocksPerMultiprocessor(&per_cu, (const void*)mega, NTHREADS, LDS_BYTES);
        grid_blocks = cus > 256 ? 256 : cus;
        if (ws_size < WS_END || n_in != 33 || out_size != TOKL * D) { fprintf(stderr, "kernel_launch: unexpected sizes ws=%zu need=%zu n_in=%d out=%d\n", ws_size, (size_t)WS_END, n_in, out_size); grid_blocks = -1; }
    }
    if (grid_blocks < 0) return;
    Params p{};
    for (int i = 0; i < 33; ++i) p.in[i] = (const float*)d_in[i];
    p.out = (float*)d_out; p.ws = (unsigned char*)d_ws;
    (void)hipMemsetAsync((unsigned char*)d_ws + WS_BAR, 0, 8192, stream);
    void* args[] = {&p};
    hipError_t e = hipLaunchCooperativeKernel((const void*)mega, dim3(grid_blocks), dim3(NTHREADS), args, LDS_BYTES, stream);
    if (e != hipSuccess) fprintf(stderr, "cooperative launch failed: %s (grid %d)\n", hipGetErrorString(e), grid_blocks);
}
```

```cpp
#include <hip/hip_runtime.h>
#include <hip/hip_cooperative_groups.h>
#include <cstdio>
#include <cstdint>
namespace cg = cooperative_groups;

#define LAS __attribute__((address_space(3)))
typedef unsigned short bf16_t;
typedef short bf16x8 __attribute__((ext_vector_type(8)));
typedef float f32x4 __attribute__((ext_vector_type(4)));
typedef unsigned u32x2 __attribute__((ext_vector_type(2)));
typedef unsigned u32x4 __attribute__((ext_vector_type(4)));

constexpr int NTHREADS = 512;
constexpr int LDS_BYTES = 147456;
constexpr int D = 1024, NB = 32, SEQ = 2048, CTXL = 256;
constexpr int TOKL = NB * SEQ, TOKC = NB * CTXL, TOK = TOKL + TOKC;
constexpr int N_IN = 6688, GLA_OFF = 1536, POOL_OFF = 3104, GATE_OFF = 3616;
constexpr int NTR = 2048, NG = 1792, NGV = 1568, DFF = 4096;
constexpr float EPS = 1e-6f;

constexpr size_t SZ_WT = (size_t)NTR * D * 2, SZ_WG = (size_t)NG * D * 2, SZ_WGATE = (size_t)3072 * D * 2, SZ_WBR = (size_t)1024 * 512 * 2;
constexpr size_t SZ_WOUT = (size_t)D * D * 2, SZ_WUP = (size_t)DFF * D * 2, SZ_WDN = (size_t)D * DFF * 2;
constexpr size_t WS_WT = 0;
constexpr size_t WS_WG = WS_WT + 2 * SZ_WT;
constexpr size_t WS_WGATE = WS_WG + 2 * SZ_WG;
constexpr size_t WS_WBR = WS_WGATE + 2 * SZ_WGATE;
constexpr size_t WS_WOUT = WS_WBR + 6 * SZ_WBR;
constexpr size_t WS_WUP = WS_WOUT + 2 * SZ_WOUT;
constexpr size_t WS_WDN = WS_WUP + 2 * SZ_WUP;
constexpr size_t WS_BIAS = WS_WDN + 2 * SZ_WDN;
constexpr size_t WS_MOD = WS_BIAS + 32768;
constexpr size_t WS_HFL = WS_MOD + (size_t)2 * 33 * 6144 * 4;
constexpr size_t WS_HFC = WS_HFL + (size_t)2 * 4 * 512 * 2048 * 2;
constexpr size_t WS_CTX = WS_HFC + (size_t)4 * 512 * 256 * 2;
constexpr size_t WS_HX = WS_CTX + (size_t)TOKC * D * 4;
constexpr size_t WS_T = WS_HX + (size_t)TOK * D * 2;
constexpr size_t WS_YG = WS_T + (size_t)NTR * TOK * 2;
constexpr size_t WS_PG = WS_YG + (size_t)TOK * 512 * 2;
constexpr size_t WS_OF = WS_PG + (size_t)TOK * NG * 2;
constexpr size_t WS_BAR = WS_OF + (size_t)2 * TOK * 512 * 2;
constexpr size_t WS_END = WS_BAR + 8192;
constexpr size_t WS_YHY = WS_T + (size_t)512 * TOK * 2;
constexpr size_t WS_YPL = WS_T + (size_t)1024 * TOK * 2;
constexpr size_t WS_STASH = WS_PG;
constexpr size_t WS_MERGED = WS_OF;
constexpr size_t WS_HID = WS_T;
static_assert((size_t)TOK * DFF * 2 <= WS_OF - WS_T, "hidden");
constexpr size_t WS_SCR = WS_PG;
constexpr size_t SCR_PER = 1572864;
constexpr size_t SC_MERGED = 0, SC_TRY = 524288, SC_TRP = 786432, SC_SG = 1048576, SC_ST = 1310720, SC_HID = 524288;
static_assert(WS_END <= (size_t)1073741824, "ws");

struct Params { const float* in[33]; float* out; unsigned char* ws; };
enum { I_X = 0, I_C, I_CTX, I_CCTX, I_WMOD, I_BMOD, I_NMIX, I_NFFN, I_WIN, I_BIN, I_HSW, I_HSB, I_FW1, I_FB1, I_FFREQ, I_FW2, I_FB2, I_FW3, I_HSKIP,
       I_WAF, I_BAF, I_WAB, I_BAB, I_GNW, I_PW, I_PSC, I_WBH, I_WBG, I_WBP, I_WOUT, I_WUP, I_WDN, I_NFIN };

__device__ __forceinline__ float bf2f(bf16_t h) { return __uint_as_float((unsigned)h << 16); }
__device__ __forceinline__ unsigned cvt_pk_bf16(float lo, float hi) { unsigned r; asm volatile("v_cvt_pk_bf16_f32 %0, %1, %2" : "=v"(r) : "v"(lo), "v"(hi)); return r; }
__device__ __forceinline__ bf16_t f2bf(float f) { return (bf16_t)(cvt_pk_bf16(f, 0.f) & 0xffffu); }
__device__ __forceinline__ float lo16(unsigned u) { return __uint_as_float(u << 16); }
__device__ __forceinline__ float hi16(unsigned u) { return __uint_as_float(u & 0xffff0000u); }
__device__ __forceinline__ float sigmoidf_(float v) { return 1.f / (1.f + __expf(-v)); }
__device__ __forceinline__ unsigned char* opq(unsigned char* p) { asm volatile("" : "+s"(p)); return p; }
__device__ __forceinline__ int tidx() { int t = threadIdx.x; asm volatile("" : "+v"(t)); return t; }
__device__ __forceinline__ int opqi(int v) { asm volatile("" : "+s"(v)); return v; }
__device__ __forceinline__ void gbar(unsigned* ctr, unsigned target) {
    asm volatile("s_waitcnt vmcnt(0) lgkmcnt(0)" ::: "memory");
    __syncthreads();
    if (threadIdx.x < 64) {
        if (threadIdx.x == 0) {
            __builtin_amdgcn_fence(__ATOMIC_RELEASE, "agent");
            asm volatile("s_waitcnt vmcnt(0)" ::: "memory");
            __hip_atomic_fetch_add(ctr, 1u, __ATOMIC_RELAXED, __HIP_MEMORY_SCOPE_AGENT);
            while (__hip_atomic_load(ctr, __ATOMIC_RELAXED, __HIP_MEMORY_SCOPE_AGENT) < target) __builtin_amdgcn_s_sleep(1);
        }
        __builtin_amdgcn_fence(__ATOMIC_ACQUIRE, "agent");
        asm volatile("s_waitcnt vmcnt(0)" ::: "memory");
    }
    __syncthreads();
}
__device__ __forceinline__ void gbar_h(unsigned* ctl, unsigned xcc, unsigned nloc, unsigned nx, unsigned k) {
    asm volatile("s_waitcnt vmcnt(0) lgkmcnt(0)" ::: "memory");
    __syncthreads();
    if (threadIdx.x < 64) {
        if (threadIdx.x == 0) {
            unsigned* xsub = ctl + 1024 + 16 * xcc; unsigned* xgen = ctl + 1280 + 16 * xcc; unsigned* top = ctl + 1536; unsigned* topgen = ctl + 1600;
            const unsigned old = __hip_atomic_fetch_add(xsub, 1u, __ATOMIC_RELAXED, __HIP_MEMORY_SCOPE_AGENT);
            if (old + 1u == k * nloc) {
                __builtin_amdgcn_fence(__ATOMIC_RELEASE, "agent");
                asm volatile("s_waitcnt vmcnt(0)" ::: "memory");
                const unsigned og = __hip_atomic_fetch_add(top, 1u, __ATOMIC_RELAXED, __HIP_MEMORY_SCOPE_AGENT);
                if (og + 1u == k * nx) __hip_atomic_fetch_add(topgen, 1u, __ATOMIC_RELAXED, __HIP_MEMORY_SCOPE_AGENT);
                else while (__hip_atomic_load(topgen, __ATOMIC_RELAXED, __HIP_MEMORY_SCOPE_AGENT) < k) __builtin_amdgcn_s_sleep(1);
                __hip_atomic_fetch_add(xgen, 1u, __ATOMIC_RELAXED, __HIP_MEMORY_SCOPE_AGENT);
            } else {
                while (__hip_atomic_load(xgen, __ATOMIC_RELAXED, __HIP_MEMORY_SCOPE_AGENT) < k) __builtin_amdgcn_s_sleep(1);
            }
        }
        __builtin_amdgcn_fence(__ATOMIC_ACQUIRE, "agent");
        asm volatile("s_waitcnt vmcnt(0)" ::: "memory");
    }
    __syncthreads();
}
__device__ __forceinline__ float wave_sum(float v) {
#pragma unroll
    for (int o = 32; o >= 1; o >>= 1) v += __shfl_xor(v, o);
    return v;
}

constexpr int BK = 64, HALF = 128, HTB = HALF * BK * 2;
__device__ __forceinline__ int lds_byte(int r, int c) { const int st = (r >> 4) * 2 + (c >> 5), rr = r & 15, cc = c & 31, ob = rr * 64 + cc * 2; return st * 1024 + (ob ^ (((ob >> 9) & 1) << 5)); }
__device__ __forceinline__ void stage_rc(int b, int& R, int& C) { const int st = b / 1024, sb = b % 1024, swz = sb ^ (((sb >> 9) & 1) << 5); R = (st >> 1) * 16 + swz / 64; C = (st & 1) * 32 + (swz % 64) / 2; }

template <class Epi>
__device__ __forceinline__ void gemm_unit(LAS unsigned char* lds, const bf16_t* A, int lda, const bf16_t* Bt, int ldb, int K, const Epi& E) {
    const int tid = tidx(), wid = __builtin_amdgcn_readfirstlane(tid >> 6), lane = tid & 63, wr = wid >> 2, wc = wid & 3, fr = lane & 15, fq = lane >> 4;
    const int nt = K / BK;
    unsigned voffA[2], voffB[2];
#pragma unroll
    for (int i = 0; i < 2; ++i) { int R, C; stage_rc(tid * 16 + i * 8192, R, C); voffA[i] = (unsigned)(R * lda + C) * 2u; voffB[i] = (unsigned)(R * ldb + C) * 2u; }
    const size_t kstep = (size_t)(BK * 2);
    const size_t hstepA = (size_t)HALF * lda * 2, hstepB = (size_t)HALF * ldb * 2;
    const unsigned ldsw = (unsigned)wid * 1024u;
    const int aoff = lds_byte(wr * 64 + fr, fq * 8), boff = lds_byte(wc * 32 + fr, fq * 8);
#define G_SA(b, h) (((b) * 2 + (h)) * HTB)
#define G_SB(b, h) ((4 + (b) * 2 + (h)) * HTB)
#define G_STAGE(bufoff, gbase, voff) do { _Pragma("unroll") for (int _i = 0; _i < 2; ++_i) \
        __builtin_amdgcn_global_load_lds((const unsigned*)((const char*)(gbase) + (voff)[_i]), (LAS unsigned*)(lds + (bufoff) + ldsw + _i * 8192), 16, 0, 0); } while (0)
#define G_LDA(dst, b, h) do { _Pragma("unroll") for (int m = 0; m < 4; ++m) _Pragma("unroll") for (int k = 0; k < 2; ++k) dst[m][k] = *(const LAS bf16x8*)(lds + G_SA(b, h) + aoff + m * 2048 + k * 1024); } while (0)
#define G_LDB(dst, b, h) do { _Pragma("unroll") for (int n = 0; n < 2; ++n) _Pragma("unroll") for (int k = 0; k < 2; ++k) dst[n][k] = *(const LAS bf16x8*)(lds + G_SB(b, h) + boff + n * 2048 + k * 1024); } while (0)
#define G_MMA(ai, bj, At, Bt_) do { __builtin_amdgcn_s_setprio(1); _Pragma("unroll") for (int m = 0; m < 4; ++m) _Pragma("unroll") for (int n = 0; n < 2; ++n) _Pragma("unroll") for (int k = 0; k < 2; ++k) \
        acc[ai][bj][m][n] = __builtin_amdgcn_mfma_f32_16x16x32_bf16(Bt_[n][k], At[m][k], acc[ai][bj][m][n], 0, 0, 0); __builtin_amdgcn_s_setprio(0); } while (0)
#define G_WAIT_V(n) asm volatile("s_waitcnt vmcnt(" #n ")" ::: "memory")
#define G_WAIT_L(n) asm volatile("s_waitcnt lgkmcnt(" #n ")" ::: "memory")
#define G_BAR __builtin_amdgcn_s_barrier()
#define G_SCHED __builtin_amdgcn_sched_barrier(0)
    __syncthreads();
    f32x4 acc[2][2][4][2];
#pragma unroll
    for (int a = 0; a < 2; ++a)
#pragma unroll
        for (int b = 0; b < 2; ++b)
#pragma unroll
            for (int m = 0; m < 4; ++m)
#pragma unroll
                for (int n = 0; n < 2; ++n) acc[a][b][m][n] = (f32x4){0.f, 0.f, 0.f, 0.f};
    bf16x8 At[4][2], B0[2][2], B1[2][2];
    const char* cA = (const char*)A; const char* cB = (const char*)Bt;
    G_STAGE(G_SB(0, 0), cB, voffB); G_STAGE(G_SA(0, 0), cA, voffA); G_STAGE(G_SB(0, 1), cB + hstepB, voffB); G_STAGE(G_SA(0, 1), cA + hstepA, voffA);
    if (wr == 1) G_BAR;
    G_WAIT_V(4); G_BAR;
    G_STAGE(G_SB(1, 0), cB + kstep, voffB); G_STAGE(G_SA(1, 0), cA + kstep, voffA); G_STAGE(G_SB(1, 1), cB + hstepB + kstep, voffB);
    G_WAIT_V(6); G_BAR;
    for (int t = 0; t < nt; t += 2) {
        const bool last = (t == nt - 2);
        const char* a1 = cA + (size_t)(t + 1) * kstep;
        const char* a2 = last ? cA : cA + (size_t)(t + 2) * kstep; const char* b2 = last ? cB : cB + (size_t)(t + 2) * kstep;
        const char* a3 = a2 + kstep; const char* b3 = b2 + kstep;
        G_LDB(B0, 0, 0); G_SCHED; G_LDA(At, 0, 0); G_STAGE(G_SA(1, 1), a1 + hstepA, voffA);
        G_WAIT_L(8); G_BAR; G_WAIT_L(0); G_MMA(0, 0, At, B0); G_BAR; G_SCHED;
        G_LDB(B1, 0, 1); G_STAGE(G_SB(0, 0), b2, voffB);
        G_BAR; G_WAIT_L(0); G_MMA(0, 1, At, B1); G_BAR;
        G_LDA(At, 0, 1); G_STAGE(G_SA(0, 0), a2, voffA);
        G_BAR; G_WAIT_L(0); G_MMA(1, 0, At, B0); G_BAR; G_SCHED;
        G_STAGE(G_SB(0, 1), b2 + hstepB, voffB);
        G_WAIT_V(6); G_BAR; G_MMA(1, 1, At, B1); G_BAR;
        G_LDB(B0, 1, 0); G_SCHED; G_LDA(At, 1, 0); G_STAGE(G_SA(0, 1), a2 + hstepA, voffA);
        G_WAIT_L(8); G_BAR; G_WAIT_L(0); G_MMA(0, 0, At, B0); G_BAR; G_SCHED;
        G_LDB(B1, 1, 1); G_STAGE(G_SB(1, 0), b3, voffB);
        G_BAR; G_WAIT_L(0); G_MMA(0, 1, At, B1); G_BAR;
        G_LDA(At, 1, 1); G_STAGE(G_SA(1, 0), a3, voffA);
        G_BAR; G_WAIT_L(0); G_MMA(1, 0, At, B0); G_BAR; G_SCHED;
        G_STAGE(G_SB(1, 1), b3 + hstepB, voffB);
        G_WAIT_V(6); G_BAR; G_MMA(1, 1, At, B1); G_BAR;
    }
    E(acc, wr, wc, fr, fq);
    G_WAIT_V(0);
    if (wr == 0) G_BAR;
    G_BAR;
    __syncthreads();
}


__device__ __forceinline__ int perm32(int rho) { const int n = rho >> 4, i = rho & 15; return 8 * (i >> 2) + 4 * n + (i & 3); }
typedef f32x4 AccT[2][2][4][2];
struct UDesc { const char* A; const char* B; int lda, ldb, K; };
template <class Prog, bool SP2 = true, bool ALIGN_EPI = true>
__device__ __forceinline__ void gemm_stream(LAS unsigned char* lds, int nunits, const Prog& P) {
    if (nunits <= 0) return;
    const int tid = tidx(), wid = __builtin_amdgcn_readfirstlane(tid >> 6), lane = tid & 63, wr = wid >> 2, wc = wid & 3, fr = lane & 15, fq = lane >> 4;
    int sR, sRb, sC; { int R, C; stage_rc(tid * 16, R, C); sR = R * 2; sRb = ((R & ~31) + perm32(R & 31)) * 2; sC = C * 2; }
    const unsigned kstep = (unsigned)(BK * 2);
    const unsigned ldsw = (unsigned)wid * 1024u;
    const int aoff = lds_byte(wr * 64 + fr, fq * 8), boff = lds_byte(wc * 32 + fr, fq * 8);
#define S_STAGE(bufoff, gbase, v, q) do { \
        __builtin_amdgcn_global_load_lds((const unsigned*)((const char*)(gbase) + (v)), (LAS unsigned*)(lds + (bufoff) + ldsw), 16, 0, 0); \
        __builtin_amdgcn_global_load_lds((const unsigned*)((const char*)(gbase) + (q) + (v)), (LAS unsigned*)(lds + (bufoff) + ldsw + 8192), 16, 0, 0); } while (0)
    UDesc cur, nxt; P.desc(0, cur);
    unsigned vA = (unsigned)(sR * cur.lda + sC), vB = (unsigned)(sRb * cur.ldb + sC);
    __syncthreads();
    f32x4 acc[2][2][4][2];
#pragma unroll
    for (int a = 0; a < 2; ++a)
#pragma unroll
        for (int b = 0; b < 2; ++b)
#pragma unroll
            for (int m = 0; m < 4; ++m)
#pragma unroll
                for (int n = 0; n < 2; ++n) acc[a][b][m][n] = (f32x4){0.f, 0.f, 0.f, 0.f};
    bf16x8 At[4][2], B0[2][2], B1[2][2];
    { const char* cA = cur.A; const char* cB = cur.B; const unsigned hA = (unsigned)HALF * cur.lda * 2, hB = (unsigned)HALF * cur.ldb * 2, qA = hA >> 1, qB = hB >> 1;
      if constexpr (SP2) {
          S_STAGE(G_SB(0, 0), cB, vB, qB); S_STAGE(G_SB(0, 1), cB + hB, vB, qB); S_STAGE(G_SA(0, 0), cA, vA, qA); S_STAGE(G_SA(0, 1), cA + hA, vA, qA);
          if (wr == 1) G_BAR;
          G_WAIT_V(2); G_BAR;
          S_STAGE(G_SB(1, 0), cB + kstep, vB, qB); S_STAGE(G_SA(1, 0), cA + kstep, vA, qA); S_STAGE(G_SB(1, 1), cB + hB + kstep, vB, qB);
          G_WAIT_V(6); G_BAR;
      } else {
          S_STAGE(G_SB(0, 0), cB, vB, qB); S_STAGE(G_SA(0, 0), cA, vA, qA); S_STAGE(G_SB(0, 1), cB + hB, vB, qB); S_STAGE(G_SA(0, 1), cA + hA, vA, qA);
          if (wr == 1) G_BAR;
          G_WAIT_V(4); G_BAR;
          S_STAGE(G_SB(1, 0), cB + kstep, vB, qB); S_STAGE(G_SA(1, 0), cA + kstep, vA, qA); S_STAGE(G_SB(1, 1), cB + hB + kstep, vB, qB);
          G_WAIT_V(6); G_BAR;
      } }
    for (int ui = 0;; ++ui) {
        const bool has_next = ui + 1 < nunits;
        if (has_next) P.desc(ui + 1, nxt); else nxt = cur;
        const unsigned nA = (unsigned)(sR * nxt.lda + sC), nB = (unsigned)(sRb * nxt.ldb + sC);
        const char* cA = cur.A; const char* cB = cur.B; const unsigned hA = (unsigned)HALF * cur.lda * 2, hB = (unsigned)HALF * cur.ldb * 2;
        const unsigned nhA = (unsigned)HALF * nxt.lda * 2, nhB = (unsigned)HALF * nxt.ldb * 2;
        const int nt = cur.K / BK;
        for (int t = 0; t < nt; t += 2) {
            const bool last = (t == nt - 2);
            const char* a1 = cA + (unsigned)(t + 1) * kstep;
            const char* a2 = last ? nxt.A : cA + (unsigned)(t + 2) * kstep; const char* b2 = last ? nxt.B : cB + (unsigned)(t + 2) * kstep;
            const char* a3 = a2 + kstep; const char* b3 = b2 + kstep;
            const unsigned hA2 = last ? nhA : hA, hB2 = last ? nhB : hB, qA = hA >> 1, qA2 = hA2 >> 1, qB2 = hB2 >> 1;
            const unsigned xA = last ? nA : vA, xB = last ? nB : vB;
            if constexpr (SP2) {
            G_LDB(B0, 0, 0); G_LDB(B1, 0, 1); G_SCHED; G_LDA(At, 0, 0); S_STAGE(G_SA(1, 1), a1 + hA, vA, qA);
            G_WAIT_V(8); G_WAIT_L(0); G_BAR; G_MMA(0, 0, At, B0); G_MMA(0, 1, At, B1); G_BAR; G_SCHED;
            G_LDA(At, 0, 1); S_STAGE(G_SB(0, 0), b2, xB, qB2); S_STAGE(G_SB(0, 1), b2 + hB2, xB, qB2); S_STAGE(G_SA(0, 0), a2, xA, qA2);
            G_WAIT_V(8); G_WAIT_L(0); G_BAR; G_MMA(1, 0, At, B0); G_MMA(1, 1, At, B1); G_BAR; G_SCHED;
            G_LDB(B0, 1, 0); G_LDB(B1, 1, 1); G_SCHED; G_LDA(At, 1, 0); S_STAGE(G_SA(0, 1), a2 + hA2, xA, qA2);
            G_WAIT_V(8); G_WAIT_L(0); G_BAR; G_MMA(0, 0, At, B0); G_MMA(0, 1, At, B1); G_BAR; G_SCHED;
            G_LDA(At, 1, 1); S_STAGE(G_SB(1, 0), b3, xB, qB2); S_STAGE(G_SB(1, 1), b3 + hB2, xB, qB2); S_STAGE(G_SA(1, 0), a3, xA, qA2);
            G_WAIT_V(8); G_WAIT_L(0); G_BAR; G_MMA(1, 0, At, B0); G_MMA(1, 1, At, B1); G_BAR; G_SCHED;
            } else {
            G_LDB(B0, 0, 0); G_SCHED; G_LDA(At, 0, 0); S_STAGE(G_SA(1, 1), a1 + hA, vA, qA);
            G_WAIT_L(8); G_BAR; G_WAIT_L(0); G_MMA(0, 0, At, B0); G_BAR; G_SCHED;
            G_LDB(B1, 0, 1); S_STAGE(G_SB(0, 0), b2, xB, qB2);
            G_BAR; G_WAIT_L(0); G_MMA(0, 1, At, B1); G_BAR;
            G_LDA(At, 0, 1); S_STAGE(G_SA(0, 0), a2, xA, qA2);
            G_BAR; G_WAIT_L(0); G_MMA(1, 0, At, B0); G_BAR; G_SCHED;
            S_STAGE(G_SB(0, 1), b2 + hB2, xB, qB2);
            G_WAIT_V(6); G_BAR; G_MMA(1, 1, At, B1); G_BAR;
            G_LDB(B0, 1, 0); G_SCHED; G_LDA(At, 1, 0); S_STAGE(G_SA(0, 1), a2 + hA2, xA, qA2);
            G_WAIT_L(8); G_BAR; G_WAIT_L(0); G_MMA(0, 0, At, B0); G_BAR; G_SCHED;
            G_LDB(B1, 1, 1); S_STAGE(G_SB(1, 0), b3, xB, qB2);
            G_BAR; G_WAIT_L(0); G_MMA(0, 1, At, B1); G_BAR;
            G_LDA(At, 1, 1); S_STAGE(G_SA(1, 0), a3, xA, qA2);
            G_BAR; G_WAIT_L(0); G_MMA(1, 0, At, B0); G_BAR; G_SCHED;
            S_STAGE(G_SB(1, 1), b3 + hB2, xB, qB2);
            G_WAIT_V(6); G_BAR; G_MMA(1, 1, At, B1); G_BAR;
            }
        }
        if constexpr (ALIGN_EPI) { if (wr == 0) G_BAR; }
        P.epi(ui, acc, wr, wc, fr, fq);
        if (!has_next) break;
#pragma unroll
        for (int a = 0; a < 2; ++a)
#pragma unroll
            for (int b = 0; b < 2; ++b)
#pragma unroll
                for (int m = 0; m < 4; ++m)
#pragma unroll
                    for (int n = 0; n < 2; ++n) acc[a][b][m][n] = (f32x4){0.f, 0.f, 0.f, 0.f};
        cur = nxt; vA = nA; vB = nB;
        if constexpr (ALIGN_EPI) { if (wr == 1) G_BAR; }
    }
    G_WAIT_V(0);
    if constexpr (!ALIGN_EPI) { if (wr == 0) G_BAR; }
    G_BAR;
    __syncthreads();
#undef S_STAGE
}

#define EPI_LOOP _Pragma("unroll") for (int ai = 0; ai < 2; ++ai) _Pragma("unroll") for (int m = 0; m < 4; ++m) _Pragma("unroll") for (int bj = 0; bj < 2; ++bj) _Pragma("unroll") for (int n = 0; n < 2; ++n)
#define EPI_ROW (ai * 128 + wr * 64 + m * 16 + fr)
#define EPI_COL (bj * 128 + wc * 32 + 8 * fq + 4 * n)

#define U4 _Pragma("unroll")
struct EpiStoreBf16 {
    bf16_t* O; size_t ldo; const float* bias; bool rowb;
    __device__ __forceinline__ void operator()(const AccT& acc, int wr, int wc, int fr, int fq) const {
        { const int tq_ = tidx(); wr = (tq_ >> 8) & 1; wc = (tq_ >> 6) & 3; fr = tq_ & 15; fq = (tq_ >> 4) & 3; }
        float br[2][4]; f32x4 bc[2][2];
        U4 for (int ai = 0; ai < 2; ++ai) U4 for (int m = 0; m < 4; ++m) br[ai][m] = rowb ? bias[ai * 128 + wr * 64 + m * 16 + fr] : 0.f;
        U4 for (int bj = 0; bj < 2; ++bj) U4 for (int n = 0; n < 2; ++n) bc[bj][n] = rowb ? (f32x4){0.f, 0.f, 0.f, 0.f} : *(const f32x4*)(bias + EPI_COL);
        U4 for (int ai = 0; ai < 2; ++ai) U4 for (int m = 0; m < 4; ++m) U4 for (int bj = 0; bj < 2; ++bj) { const int n = 0; const int r = EPI_ROW, c = EPI_COL;
            const f32x4 v0 = acc[ai][bj][m][0] + bc[bj][0] + br[ai][m], v1 = acc[ai][bj][m][1] + bc[bj][1] + br[ai][m];
            u32x4 w; w.x = cvt_pk_bf16(v0[0], v0[1]); w.y = cvt_pk_bf16(v0[2], v0[3]); w.z = cvt_pk_bf16(v1[0], v1[1]); w.w = cvt_pk_bf16(v1[2], v1[3]); *(u32x4*)(O + (size_t)r * ldo + c) = w; }
    }
};
struct EpiGate {
    f32x4* SG; const float* bias;
    __device__ __forceinline__ void operator()(const AccT& acc, int wr, int wc, int fr, int fq) const {
        { const int tq_ = tidx(); wr = (tq_ >> 8) & 1; wc = (tq_ >> 6) & 3; fr = tq_ & 15; fq = (tq_ >> 4) & 3; }
        f32x4 bc[2][2];
        U4 for (int bj = 0; bj < 2; ++bj) U4 for (int n = 0; n < 2; ++n) bc[bj][n] = *(const f32x4*)(bias + EPI_COL);
        int i = 0; f32x4* SGt = SG + tidx();
        EPI_LOOP { f32x4 v = acc[ai][bj][m][n] + bc[bj][n];
            v[0] = sigmoidf_(v[0]); v[1] = sigmoidf_(v[1]); v[2] = sigmoidf_(v[2]); v[3] = sigmoidf_(v[3]);
            SGt[i * NTHREADS] = v; ++i; }
    }
};
struct EpiBranch {
    const f32x4* SG; f32x4* ST; bf16_t* MG; int first, last;
    __device__ __forceinline__ void operator()(const AccT& acc, int wr, int wc, int fr, int fq) const {
        { const int tq_ = tidx(); wr = (tq_ >> 8) & 1; wc = (tq_ >> 6) & 3; fr = tq_ & 15; fq = (tq_ >> 4) & 3; }
        const int tq = tidx(); const f32x4* SGt = SG + tq; f32x4* STt = ST + tq;
        f32x4 g[2][4], t[2][4];
        U4 for (int q = 0; q < 4; ++q) { g[0][q] = SGt[q * NTHREADS]; t[0][q] = first ? (f32x4){0.f, 0.f, 0.f, 0.f} : STt[q * NTHREADS]; }
        U4 for (int bt = 0; bt < 8; ++bt) { const int cb = bt & 1, nb = cb ^ 1, ai = bt >> 2, m = bt & 3;
            if (bt + 1 < 8) { U4 for (int q = 0; q < 4; ++q) { const int i = (bt + 1) * 4 + q; g[nb][q] = SGt[i * NTHREADS]; t[nb][q] = first ? (f32x4){0.f, 0.f, 0.f, 0.f} : STt[i * NTHREADS]; } }
            if (last) { U4 for (int bj = 0; bj < 2; ++bj) { const int n = 0; const int r = EPI_ROW, c = EPI_COL;
                    const f32x4 v0 = acc[ai][bj][m][0] * g[cb][bj * 2] + t[cb][bj * 2], v1 = acc[ai][bj][m][1] * g[cb][bj * 2 + 1] + t[cb][bj * 2 + 1];
                    u32x4 w; w.x = cvt_pk_bf16(v0[0], v0[1]); w.y = cvt_pk_bf16(v0[2], v0[3]); w.z = cvt_pk_bf16(v1[0], v1[1]); w.w = cvt_pk_bf16(v1[2], v1[3]); *(u32x4*)(MG + (size_t)r * 1024 + c) = w; } }
            else { U4 for (int q = 0; q < 4; ++q) { const int bj = q >> 1, n = q & 1, i = bt * 4 + q; STt[i * NTHREADS] = acc[ai][bj][m][n] * g[cb][q] + t[cb][q]; } }
        }
    }
};
struct EpiResid {
    const float* xsrc; float* xdst; const float* gate;
    __device__ __forceinline__ void operator()(const AccT& acc, int wr, int wc, int fr, int fq) const {
        { const int tq_ = tidx(); wr = (tq_ >> 8) & 1; wc = (tq_ >> 6) & 3; fr = tq_ & 15; fq = (tq_ >> 4) & 3; }
        f32x4 gc[2][2];
        U4 for (int bj = 0; bj < 2; ++bj) U4 for (int n = 0; n < 2; ++n) gc[bj][n] = *(const f32x4*)(gate + EPI_COL);
        f32x4 xo[2][4];
        { const int ai = 0, m = 0; U4 for (int q = 0; q < 4; ++q) { const int bj = q >> 1, n = q & 1; xo[0][q] = *(const f32x4*)(xsrc + (size_t)EPI_ROW * 1024 + EPI_COL); } }
        U4 for (int bt = 0; bt < 8; ++bt) { const int cb = bt & 1, nb = cb ^ 1;
            if (bt + 1 < 8) { const int ai = (bt + 1) >> 2, m = (bt + 1) & 3; U4 for (int q = 0; q < 4; ++q) { const int bj = q >> 1, n = q & 1; xo[nb][q] = *(const f32x4*)(xsrc + (size_t)EPI_ROW * 1024 + EPI_COL); } }
            { const int ai = bt >> 2, m = bt & 3; U4 for (int q = 0; q < 4; ++q) { const int bj = q >> 1, n = q & 1; *(f32x4*)(xdst + (size_t)EPI_ROW * 1024 + EPI_COL) = xo[cb][q] + gc[bj][n] * acc[ai][bj][m][n]; } }
        }
    }
};
struct EpiSqrelu {
    bf16_t* H; int ldh;
    __device__ __forceinline__ void operator()(const AccT& acc, int wr, int wc, int fr, int fq) const {
        { const int tq_ = tidx(); wr = (tq_ >> 8) & 1; wc = (tq_ >> 6) & 3; fr = tq_ & 15; fq = (tq_ >> 4) & 3; }
        U4 for (int ai = 0; ai < 2; ++ai) U4 for (int m = 0; m < 4; ++m) U4 for (int bj = 0; bj < 2; ++bj) { const int n = 0; const int r = EPI_ROW, c = EPI_COL; f32x4 v0 = acc[ai][bj][m][0], v1 = acc[ai][bj][m][1];
#pragma unroll
            for (int j = 0; j < 4; ++j) { const float t0 = fmaxf(v0[j], 0.f), t1 = fmaxf(v1[j], 0.f); v0[j] = t0 * t0; v1[j] = t1 * t1; }
            u32x4 w; w.x = cvt_pk_bf16(v0[0], v0[1]); w.y = cvt_pk_bf16(v0[2], v0[3]); w.z = cvt_pk_bf16(v1[0], v1[1]); w.w = cvt_pk_bf16(v1[2], v1[3]); *(u32x4*)(H + (size_t)r * ldh + c) = w; }
    }
};

struct XMap { int NT, per_xcd, x, j, bpx;
    __device__ __forceinline__ void init(int xj, int ntt, int nt_) { NT = nt_; per_xcd = (ntt >> 3) * nt_; x = xj & 7; j = xj >> 3; bpx = (int)(gridDim.x >> 3); }
    __device__ __forceinline__ int rounds() const { return j < per_xcd ? (per_xcd - j + bpx - 1) / bpx : 0; }
    __device__ __forceinline__ void get(int i, int& tt, int& nt) const { const int q = i * bpx + j; tt = x + 8 * (q / NT); nt = q % NT; }
};
struct ProgInproj {
    const bf16_t* wt; const bf16_t* wg; const bf16_t* HX; bf16_t* T; bf16_t* PG; const float* biasT; const float* biasG; XMap MA, MB; int rA;
    __device__ __forceinline__ void desc(int i, UDesc& d) const { int tt, nt;
        if (i < rA) { MA.get(i, tt, nt); d.A = (const char*)(wt + (size_t)(nt * 256) * D); d.B = (const char*)(HX + (size_t)(tt * 256) * D); }
        else { MB.get(i - rA, tt, nt); d.A = (const char*)(HX + (size_t)(tt * 256) * D); d.B = (const char*)(wg + (size_t)(nt * 256) * D); }
        d.lda = D; d.ldb = D; d.K = D; }
    __device__ __forceinline__ void epi(int i, const AccT& acc, int wr, int wc, int fr, int fq) const { int tt, nt;
        if (i < rA) { MA.get(i, tt, nt); EpiStoreBf16 E{T + (size_t)(nt * 256) * TOK + (size_t)tt * 256, (size_t)TOK, biasT + nt * 256, true}; E(acc, wr, wc, fr, fq); }
        else { MB.get(i - rA, tt, nt); EpiStoreBf16 E{PG + (size_t)(tt * 256) * NG + nt * 256, (size_t)NG, biasG + nt * 256, false}; E(acc, wr, wc, fr, fq); } }
};
struct ProgMix {
    unsigned char* ws; unsigned char* scr; const float* bgate; unsigned tok0; int l;
    __device__ __forceinline__ void desc(int i, UDesc& d) const { const int nt = i / 6, j = i % 6, X = j >> 1;
        if (!(j & 1)) { d.A = (const char*)(ws + WS_HX) + (size_t)tok0 * D * 2; d.B = (const char*)(ws + WS_WGATE + l * SZ_WGATE) + (size_t)(X * 1024 + nt * 256) * D * 2; d.lda = D; d.ldb = D; d.K = D; }
        else { d.A = X == 0 ? (const char*)(scr + SC_TRY) : (X == 1 ? (const char*)(ws + WS_YG) + (size_t)tok0 * 1024 : (const char*)(scr + SC_TRP));
               d.B = (const char*)(ws + WS_WBR + (size_t)l * 3 * SZ_WBR) + (size_t)X * SZ_WBR + (size_t)(nt * 256) * 1024; d.lda = 512; d.ldb = 512; d.K = 512; } }
    __device__ __forceinline__ void epi(int i, const AccT& acc, int wr, int wc, int fr, int fq) const { const int nt = i / 6, j = i % 6, X = j >> 1;
        if (!(j & 1)) { EpiGate E{(f32x4*)(scr + SC_SG), bgate + X * 1024 + nt * 256}; E(acc, wr, wc, fr, fq); }
        else { EpiBranch E{(const f32x4*)(scr + SC_SG), (f32x4*)(scr + SC_ST), (bf16_t*)(scr + SC_MERGED) + nt * 256, X == 0, X == 2}; E(acc, wr, wc, fr, fq); } }
};
struct ProgResid {
    const bf16_t* A; int lda; const bf16_t* W; int ldw, K; size_t wstep; const float* xsrc; float* xdst; const float* gate;
    __device__ __forceinline__ void desc(int i, UDesc& d) const { d.A = (const char*)A; d.B = (const char*)(W + (size_t)i * wstep); d.lda = lda; d.ldb = ldw; d.K = K; }
    __device__ __forceinline__ void epi(int i, const AccT& acc, int wr, int wc, int fr, int fq) const { EpiResid E{xsrc + i * 256, xdst + i * 256, gate + i * 256}; E(acc, wr, wc, fr, fq); }
};
struct ProgUp {
    const bf16_t* XN; const bf16_t* W; bf16_t* HID;
    __device__ __forceinline__ void desc(int i, UDesc& d) const { d.A = (const char*)XN; d.B = (const char*)(W + (size_t)(i * 256) * D); d.lda = D; d.ldb = D; d.K = D; }
    __device__ __forceinline__ void epi(int i, const AccT& acc, int wr, int wc, int fr, int fq) const { EpiSqrelu E{HID + i * 256, 2048}; E(acc, wr, wc, fr, fq); }
};


struct TileIO { const float* xin; const float* ctxin; float* out; float* ctxs; const float* modl; int l;
    __device__ __forceinline__ const float* src(int tt) const { return tt < 256 ? (l == 0 ? xin : out) + (size_t)tt * 256 * D : ctxin + (size_t)(tt - 256) * 256 * D; }
    __device__ __forceinline__ float* dst(int tt) const { return tt < 256 ? out + (size_t)tt * 256 * D : ctxs + (size_t)(tt - 256) * 256 * D; }
    __device__ __forceinline__ const float* cur(int tt) const { return tt < 256 ? out + (size_t)tt * 256 * D : ctxs + (size_t)(tt - 256) * 256 * D; }
    __device__ __forceinline__ const float* mod(int tt) const { return modl + (size_t)(tt < 256 ? tt >> 3 : 32) * 6144; }
};
struct ProgMix2 {
    unsigned char* ws; unsigned char* stash; const float* bgate; XMap M; int l;
    __device__ __forceinline__ void desc(int ii, UDesc& d) const { int tt, nt; M.get(ii / 6, tt, nt); const int s6 = ii % 6, X = s6 >> 1;
        if (!(s6 & 1)) { d.A = (const char*)(ws + WS_HX) + (size_t)tt * 256 * D * 2; d.B = (const char*)(ws + WS_WGATE + l * SZ_WGATE) + (size_t)(X * 1024 + nt * 256) * D * 2; d.lda = D; d.ldb = D; d.K = D; }
        else { d.A = (const char*)(ws + (X == 0 ? WS_YHY : (X == 1 ? WS_YG : WS_YPL))) + (size_t)tt * 256 * 1024;
               d.B = (const char*)(ws + WS_WBR + (size_t)l * 3 * SZ_WBR) + (size_t)X * SZ_WBR + (size_t)(nt * 256) * 1024; d.lda = 512; d.ldb = 512; d.K = 512; } }
    __device__ __forceinline__ void epi(int ii, const AccT& acc, int wr, int wc, int fr, int fq) const { int tt, nt; M.get(ii / 6, tt, nt); const int s6 = ii % 6, X = s6 >> 1;
        if (!(s6 & 1)) { EpiGate E{(f32x4*)stash, bgate + X * 1024 + nt * 256}; E(acc, wr, wc, fr, fq); }
        else { EpiBranch E{(const f32x4*)stash, (f32x4*)(stash + 262144), (bf16_t*)(ws + WS_MERGED) + (size_t)tt * 256 * 1024 + nt * 256, X == 0, X == 2}; E(acc, wr, wc, fr, fq); } }
};
struct ProgOut2 {
    unsigned char* ws; TileIO io; XMap M; int l;
    __device__ __forceinline__ void desc(int i, UDesc& d) const { int tt, nt; M.get(i, tt, nt);
        d.A = (const char*)(ws + WS_MERGED) + (size_t)tt * 256 * 2048; d.B = (const char*)(ws + WS_WOUT + l * SZ_WOUT) + (size_t)(nt * 256) * D * 2; d.lda = D; d.ldb = D; d.K = D; }
    __device__ __forceinline__ void epi(int i, const AccT& acc, int wr, int wc, int fr, int fq) const { int tt, nt; M.get(i, tt, nt);
        EpiResid E{io.src(tt) + nt * 256, io.dst(tt) + nt * 256, io.mod(tt) + 2048 + nt * 256}; E(acc, wr, wc, fr, fq); }
};
struct ProgUp2 {
    unsigned char* ws; XMap M; int l;
    __device__ __forceinline__ void get(int i, int& tt, int& nt) const { if (M.bpx != 32) { M.get(i, tt, nt); return; }
        const int ttg = i >> 1, ntg = i & 1; tt = M.x + 8 * (ttg * 4 + (M.j >> 3)); nt = ntg * 8 + (M.j & 7); }
    __device__ __forceinline__ void desc(int i, UDesc& d) const { int tt, nt; get(i, tt, nt);
        d.A = (const char*)(ws + WS_HX) + (size_t)tt * 256 * 2048; d.B = (const char*)(ws + WS_WUP + l * SZ_WUP) + (size_t)(nt * 256) * D * 2; d.lda = D; d.ldb = D; d.K = D; }
    __device__ __forceinline__ void epi(int i, const AccT& acc, int wr, int wc, int fr, int fq) const { int tt, nt; get(i, tt, nt);
        EpiSqrelu E{(bf16_t*)(ws + WS_HID) + (size_t)tt * 256 * DFF + nt * 256, DFF}; E(acc, wr, wc, fr, fq); }
};
struct ProgDown2 {
    unsigned char* ws; TileIO io; XMap M; int l;
    __device__ __forceinline__ void desc(int i, UDesc& d) const { int tt, nt; M.get(i, tt, nt);
        d.A = (const char*)(ws + WS_HID) + (size_t)tt * 256 * DFF * 2; d.B = (const char*)(ws + WS_WDN + l * SZ_WDN) + (size_t)(nt * 256) * DFF * 2; d.lda = DFF; d.ldb = DFF; d.K = DFF; }
    __device__ __forceinline__ void epi(int i, const AccT& acc, int wr, int wc, int fr, int fq) const { int tt, nt; M.get(i, tt, nt);
        EpiResid E{io.cur(tt) + nt * 256, io.dst(tt) + nt * 256, io.mod(tt) + 5120 + nt * 256}; E(acc, wr, wc, fr, fq); }
};

__device__ __forceinline__ void tconv(const float* src, int ld, int c0, int nvalid, int ncols, int K, bf16_t* dst, LAS float* tile) {
    const int tid = tidx(), ntn = ncols / 64, ntile = ntn * (K / 64);
    float v[8];
    { const int t = blockIdx.x; if (t < ntile) { const int k0 = (t / ntn) * 64, n0 = (t % ntn) * 64;
#pragma unroll
        for (int i = 0; i < 8; ++i) { const int k = i * 8 + (tid >> 6), n = tid & 63; v[i] = (n0 + n < nvalid) ? src[(size_t)(k0 + k) * ld + c0 + n0 + n] : 0.f; } } }
    for (int t = blockIdx.x; t < ntile; t += gridDim.x) {
        const int k0 = (t / ntn) * 64, n0 = (t % ntn) * 64;
        __syncthreads();
#pragma unroll
        for (int i = 0; i < 8; ++i) { const int k = i * 8 + (tid >> 6), n = tid & 63; tile[k * 65 + n] = v[i]; }
        { const int t2 = t + gridDim.x; if (t2 < ntile) { const int k2 = (t2 / ntn) * 64, n2 = (t2 % ntn) * 64;
#pragma unroll
            for (int i = 0; i < 8; ++i) { const int k = i * 8 + (tid >> 6), n = tid & 63; v[i] = (n2 + n < nvalid) ? src[(size_t)(k2 + k) * ld + c0 + n2 + n] : 0.f; } } }
        __syncthreads();
        const int n = tid >> 3, kc = (tid & 7) * 8;
        u32x4 w;
        w.x = cvt_pk_bf16(tile[(kc + 0) * 65 + n], tile[(kc + 1) * 65 + n]); w.y = cvt_pk_bf16(tile[(kc + 2) * 65 + n], tile[(kc + 3) * 65 + n]);
        w.z = cvt_pk_bf16(tile[(kc + 4) * 65 + n], tile[(kc + 5) * 65 + n]); w.w = cvt_pk_bf16(tile[(kc + 6) * 65 + n], tile[(kc + 7) * 65 + n]);
        *(u32x4*)(dst + (size_t)(n0 + n) * K + k0 + kc) = w;
    }
    __syncthreads();
}

__device__ __forceinline__ void job_poolcomb(const Params& p, int l) {
    const float* pw = p.in[I_PW] + (size_t)l * 4 * 128 * 128; const float* sc = p.in[I_PSC] + l * 512; const float* wb = p.in[I_WBP] + (size_t)l * 512 * 1024;
    bf16_t* dst = (bf16_t*)(p.ws + WS_WBR + (size_t)(l * 3 + 2) * SZ_WBR);
    for (int idx = blockIdx.x * NTHREADS + tidx(); idx < 512 * 256; idx += gridDim.x * NTHREADS) {
        const int n = (idx & 255) * 4, k = idx >> 8, g = k >> 7, c = k & 127;
        f32x4 a = (f32x4){0.f, 0.f, 0.f, 0.f};
#pragma unroll 8
        for (int d = 0; d < 128; ++d) { const float ps = pw[(g * 128 + c) * 128 + d] * sc[g * 128 + d]; a += ps * *(const f32x4*)(wb + (size_t)(g * 128 + d) * 1024 + n); }
        dst[(size_t)n * 512 + k] = f2bf(a[0]); dst[(size_t)(n + 1) * 512 + k] = f2bf(a[1]); dst[(size_t)(n + 2) * 512 + k] = f2bf(a[2]); dst[(size_t)(n + 3) * 512 + k] = f2bf(a[3]);
    }
}

__device__ __forceinline__ void job_bias(const Params& p) {
    float* bias = (float*)(p.ws + WS_BIAS);
    for (int idx = blockIdx.x * NTHREADS + tidx(); idx < 2 * (NTR + NG); idx += gridDim.x * NTHREADS) {
        const int l = idx / (NTR + NG), j = idx % (NTR + NG); const float* b = p.in[I_BIN] + l * N_IN;
        float v;
        if (j < 1536) v = b[j]; else if (j < NTR) v = b[POOL_OFF + (j - 1536)]; else { const int q = j - NTR; v = q < NGV ? b[GLA_OFF + q] : 0.f; }
        bias[idx] = v;
    }
}

__device__ __forceinline__ void job_mod(const Params& p, LAS float* sil) {
    if (blockIdx.x >= 192) return;
    const int tid = tidx(), lane = tid & 63, kg = tid >> 6;
    float* mod = (float*)(p.ws + WS_MOD);
    for (int it = blockIdx.x; it < 192; it += gridDim.x) {
        __syncthreads();
        for (int idx = tid; idx < 33 * 1024; idx += NTHREADS) { const int r = idx >> 10, k = idx & 1023; const float v = r < 32 ? p.in[I_C][r * 1024 + k] : p.in[I_CCTX][k]; sil[idx] = v / (1.f + expf(-v)); }
        __syncthreads();
        const int l = it / 96, n0 = (it % 96) * 64;
        const float* w = p.in[I_WMOD] + (size_t)l * 1024 * 6144 + n0 + lane;
        float acc[33];
#pragma unroll
        for (int r = 0; r < 33; ++r) acc[r] = 0.f;
#pragma unroll 2
        for (int k4 = 0; k4 < 32; ++k4) { const int k = kg * 128 + k4 * 4;
            const float w0 = w[(size_t)k * 6144], w1 = w[(size_t)(k + 1) * 6144], w2 = w[(size_t)(k + 2) * 6144], w3 = w[(size_t)(k + 3) * 6144];
#pragma unroll
            for (int r = 0; r < 33; ++r) { const f32x4 sv = *(const LAS f32x4*)(sil + r * 1024 + k); acc[r] += sv[0] * w0 + sv[1] * w1 + sv[2] * w2 + sv[3] * w3; } }
        __syncthreads();
#pragma unroll
        for (int r = 0; r < 33; ++r) sil[(kg * 33 + r) * 64 + lane] = acc[r];
        __syncthreads();
        const float bm = p.in[I_BMOD][l * 6144 + n0 + lane];
        for (int r = kg; r < 33; r += 8) { float sum = 0.f;
#pragma unroll
            for (int q = 0; q < 8; ++q) sum += sil[(q * 33 + r) * 64 + lane];
            mod[(size_t)l * 33 * 6144 + (size_t)r * 6144 + n0 + lane] = sum + bm; }
    }
    __syncthreads();
}

__device__ __forceinline__ void job_filters(const Params& p, LAS unsigned char* lds) {
    LAS float* a1 = (LAS float*)lds;
    LAS float* a2 = (LAS float*)(lds + 16384);
    LAS bf16_t* oT = (LAS bf16_t*)(lds + 16384 + 16640);
    LAS float* w2L = (LAS float*)(lds + 16384 + 16640 + 73728);
    const int tid = tidx();
    const int nitems = (32 + 4 + 32) * 4;
    const int nrep = gridDim.x == 256 ? 2 : (nitems + (int)gridDim.x - 1) / (int)gridDim.x;
    for (int rep = 0; rep < nrep; ++rep) {
        int it;
        if (gridDim.x == 256) it = rep == 0 ? (int)blockIdx.x : ((blockIdx.x >= 192 && blockIdx.x < 208) ? 256 + (int)blockIdx.x - 192 : -1);
        else it = (int)blockIdx.x + rep * (int)gridDim.x;
        if (it < 0 || it >= nitems) continue;
        const int oc = it & 3; int rt = it >> 2; int l, L, t0; bf16_t* dst;
        if (rt < 32) { l = 0; L = 2048; t0 = rt * 64; dst = (bf16_t*)(p.ws + WS_HFL); }
        else if (rt < 36) { l = 0; L = 256; t0 = (rt - 32) * 64; dst = (bf16_t*)(p.ws + WS_HFC); }
        else { l = 1; L = 2048; t0 = (rt - 36) * 64; dst = (bf16_t*)(p.ws + WS_HFL) + (size_t)4 * 512 * 2048; }
        const float* w1 = p.in[I_FW1] + l * 17 * 64; const float* b1 = p.in[I_FB1] + l * 64; const float* fq = p.in[I_FFREQ] + l * 64;
        const float* w2 = p.in[I_FW2] + l * 64 * 64; const float* b2 = p.in[I_FB2] + l * 64; const float* w3 = p.in[I_FW3] + (size_t)l * 64 * 2048;
        __syncthreads();
#pragma unroll
        for (int q = 0; q < 2; ++q) *(LAS f32x4*)(w2L + (tid + q * NTHREADS) * 4) = *(const f32x4*)(w2 + (tid + q * NTHREADS) * 4);
        { const int row = tid >> 3, jg = (tid & 7) * 8; const float t = (float)(t0 + row); float z[17];
          z[0] = t / (float)L;
#pragma unroll
          for (int bnd = 1; bnd <= 8; ++bnd) { const float ang = (6.283185307179586f / (float)L) * t * (float)bnd; z[bnd] = cosf(ang); z[8 + bnd] = sinf(ang); }
#pragma unroll
          for (int j = 0; j < 8; ++j) { float s_ = b1[jg + j];
#pragma unroll
              for (int i = 0; i < 17; ++i) s_ += z[i] * w1[i * 64 + jg + j];
              a1[row * 64 + jg + j] = sinf(fq[jg + j] * s_); } }
        __syncthreads();
        { const int row = tid >> 3, jg = (tid & 7) * 8; float acc8[8];
#pragma unroll
          for (int j = 0; j < 8; ++j) acc8[j] = b2[jg + j];
#pragma unroll 4
          for (int i4 = 0; i4 < 64; i4 += 4) { const f32x4 av = *(const LAS f32x4*)(a1 + row * 64 + i4);
#pragma unroll
              for (int ii = 0; ii < 4; ++ii) { const f32x4 wa = *(const LAS f32x4*)(w2L + (i4 + ii) * 64 + jg), wb = *(const LAS f32x4*)(w2L + (i4 + ii) * 64 + jg + 4);
                  acc8[0] += av[ii] * wa[0]; acc8[1] += av[ii] * wa[1]; acc8[2] += av[ii] * wa[2]; acc8[3] += av[ii] * wa[3];
                  acc8[4] += av[ii] * wb[0]; acc8[5] += av[ii] * wb[1]; acc8[6] += av[ii] * wb[2]; acc8[7] += av[ii] * wb[3]; } }
#pragma unroll
          for (int j = 0; j < 8; ++j) a2[row * 65 + jg + j] = sinf(fq[jg + j] * acc8[j]); }
        __syncthreads();
        { const int o = oc * 512 + tid, c = o & 511; float wreg[64];
#pragma unroll
          for (int j = 0; j < 64; ++j) wreg[j] = w3[(size_t)j * 2048 + o];
          const float delta = 3.0701134573253943f + (float)c * ((15.350567286626972f - 3.0701134573253943f) / 511.f);
          for (int row = 0; row < 64; ++row) { float s = 0.f;
#pragma unroll
              for (int j = 0; j < 64; ++j) s += a2[row * 65 + j] * wreg[j];
              const float win = expf(-((float)(t0 + row) / (float)L) * delta);
              oT[tid * 72 + row] = f2bf(s * win); } }
        __syncthreads();
        for (int q = tid; q < 4096; q += NTHREADS) { const int ol = q >> 3, ch = (q & 7) * 8; const int o = oc * 512 + ol, dir = o >> 10, ord = (o >> 9) & 1, c = o & 511;
            const u32x4 w = *(const LAS u32x4*)(oT + ol * 72 + ch);
            *(u32x4*)(dst + ((size_t)((ord * 2 + dir) * 512 + c)) * L + t0 + ch) = w; }
    }
    __syncthreads();
}

__device__ __forceinline__ void ada_write(const f32x4 (&v)[4], float inv, const float* g, const float* sh, const float* sc, bf16_t* dst, float* fdst, int lane) {
#pragma unroll
    for (int i = 0; i < 4; ++i) { const int c = i * 256 + lane * 4; const f32x4 gg = *(const f32x4*)(g + c); f32x4 y = v[i] * inv * gg;
        if (sh) { const f32x4 s1 = *(const f32x4*)(sc + c), s0 = *(const f32x4*)(sh + c); y = y * (1.f + s1) + s0;
            u32x2 w; w.x = cvt_pk_bf16(y[0], y[1]); w.y = cvt_pk_bf16(y[2], y[3]); *(u32x2*)(dst + c) = w; }
        else *(f32x4*)(fdst + c) = y; }
}
__device__ __forceinline__ void ada_row2(const float* xa, const float* xb, bool hb, const float* g, const float* sha, const float* sca, const float* shb, const float* scb,
                                         bf16_t* da, bf16_t* db, float* fa, float* fb, int lane) {
    f32x4 va[4], vb[4]; float sa = 0.f, sb = 0.f;
#pragma unroll
    for (int i = 0; i < 4; ++i) va[i] = *(const f32x4*)(xa + i * 256 + lane * 4);
#pragma unroll
    for (int i = 0; i < 4; ++i) vb[i] = hb ? *(const f32x4*)(xb + i * 256 + lane * 4) : (f32x4){0.f, 0.f, 0.f, 0.f};
#pragma unroll
    for (int i = 0; i < 4; ++i) { sa += va[i][0] * va[i][0] + va[i][1] * va[i][1] + va[i][2] * va[i][2] + va[i][3] * va[i][3]; sb += vb[i][0] * vb[i][0] + vb[i][1] * vb[i][1] + vb[i][2] * vb[i][2] + vb[i][3] * vb[i][3]; }
#pragma unroll
    for (int o = 32; o >= 1; o >>= 1) { sa += __shfl_xor(sa, o); sb += __shfl_xor(sb, o); }
    ada_write(va, rsqrtf(sa * (1.f / 1024.f) + EPS), g, sha, sca, da, fa, lane);
    if (hb) ada_write(vb, rsqrtf(sb * (1.f / 1024.f) + EPS), g, shb, scb, db, fb, lane);
}
__device__ __forceinline__ void ada_row(const float* x, const float* g, const float* sh, const float* sc, bf16_t* dst, float* fdst, int lane) {
    f32x4 v[4]; float ss = 0.f;
#pragma unroll
    for (int i = 0; i < 4; ++i) { v[i] = *(const f32x4*)(x + i * 256 + lane * 4); ss += v[i][0] * v[i][0] + v[i][1] * v[i][1] + v[i][2] * v[i][2] + v[i][3] * v[i][3]; }
    ss = wave_sum(ss);
    const float inv = rsqrtf(ss * (1.f / 1024.f) + EPS);
#pragma unroll
    for (int i = 0; i < 4; ++i) { const int c = i * 256 + lane * 4; const f32x4 gg = *(const f32x4*)(g + c); f32x4 y = v[i] * inv * gg;
        if (sh) { const f32x4 s1 = *(const f32x4*)(sc + c), s0 = *(const f32x4*)(sh + c); y = y * (1.f + s1) + s0;
            u32x2 w; w.x = cvt_pk_bf16(y[0], y[1]); w.y = cvt_pk_bf16(y[2], y[3]); *(u32x2*)(dst + c) = w; }
        else *(f32x4*)(fdst + c) = y; }
}

typedef float f32x16 __attribute__((ext_vector_type(16)));
template <int L, int NT>
__device__ __forceinline__ void hyena_mfma(const Params& p, int l, int c, bool ctx, LAS unsigned char* lds) {
    LAS unsigned char* U = lds;
    LAS unsigned* F = (LAS unsigned*)(lds + L * 64);
    LAS bf16_t* F16 = (LAS bf16_t*)F;
    const int tid = tidx(), lane = tid & 63, w = __builtin_amdgcn_readfirstlane(tid >> 6), li = lane & 31, kg = lane >> 5;
    bf16_t* T = (bf16_t*)(p.ws + WS_T);
    const size_t tokb = ctx ? (size_t)TOKL : 0;
    const bf16_t* hf = ctx ? (const bf16_t*)(p.ws + WS_HFC) : (const bf16_t*)(p.ws + WS_HFL) + (size_t)l * 4 * 512 * 2048;
    const float* sw = p.in[I_HSW] + (size_t)l * 3 * 1536; const float* sb = p.in[I_HSB] + l * 1536;
    __syncthreads();
    {
        const int cc = 1024 + c; const bf16_t* row = T + (size_t)cc * TOK + tokb;
        const float w0 = sw[cc], w1 = sw[1536 + cc], w2 = sw[3072 + cc], bb = sb[cc];
        constexpr int ITER = L / 128, BATCH = ITER >= 4 ? 4 : ITER;
        for (int it0 = 0; it0 < ITER; it0 += BATCH) {
            u32x4 rr[BATCH]; bf16_t hm[BATCH], hp[BATCH];
#pragma unroll
            for (int q = 0; q < BATCH; ++q) { const int idx = tid + (it0 + q) * NTHREADS, bq = idx & 31, t8 = idx >> 5; const bf16_t* pr = row + (size_t)bq * L + t8 * 8;
                rr[q] = *(const u32x4*)pr; hm[q] = t8 > 0 ? pr[-1] : (bf16_t)0; hp[q] = t8 < L / 8 - 1 ? pr[8] : (bf16_t)0; }
#pragma unroll
            for (int q = 0; q < BATCH; ++q) { const int idx = tid + (it0 + q) * NTHREADS; const u32x4 r = rr[q];
                float x[10]; x[0] = bf2f(hm[q]); x[9] = bf2f(hp[q]);
                x[1] = lo16(r.x); x[2] = hi16(r.x); x[3] = lo16(r.y); x[4] = hi16(r.y); x[5] = lo16(r.z); x[6] = hi16(r.z); x[7] = lo16(r.w); x[8] = hi16(r.w);
                float y[8];
#pragma unroll
                for (int j = 0; j < 8; ++j) y[j] = w0 * x[j] + w1 * x[j + 1] + w2 * x[j + 2] + bb;
                u32x4 o; o.x = cvt_pk_bf16(y[0], y[1]); o.y = cvt_pk_bf16(y[2], y[3]); o.z = cvt_pk_bf16(y[4], y[5]); o.w = cvt_pk_bf16(y[6], y[7]);
                *(LAS u32x4*)(U + (size_t)idx * 16) = o; }
        }
    }
    const int lane_dw = (li & 1) * L + ((8 * kg - li + L - (li & 1)) >> 1);
#define HY_LOADA(dst, f) do { const LAS unsigned* _q = F + (lane_dw - 8 * (f)); u32x4 _v; _v.x = _q[0]; _v.y = _q[1]; _v.z = _q[2]; _v.w = _q[3]; dst = __builtin_bit_cast(bf16x8, _v); } while (0)
#define HY_LOADB(dst, s0) dst = *(const LAS bf16x8*)(U + ((s0) >> 3) * 512 + lane * 16)
    for (int ord = 0; ord < 2; ++ord) {
        __syncthreads();
        for (int x0 = tid; x0 < 2 * L; x0 += 4 * NTHREADS) {
            bf16_t fv[4];
#pragma unroll
            for (int q = 0; q < 4; ++q) { const int x = x0 + q * NTHREADS; bf16_t v = 0;
                if (x >= 1 && x <= L) v = hf[((size_t)((ord * 2 + 0) * 512 + c)) * L + (L - x)];
                else if (x > L && x < 2 * L) v = hf[((size_t)((ord * 2 + 1) * 512 + c)) * L + (x - L)];
                fv[q] = v; }
#pragma unroll
            for (int q = 0; q < 4; ++q) { const int x = x0 + q * NTHREADS; const bf16_t v = fv[q];
                if (x < 2 * L) { F16[x] = v; if (x >= 1) F16[2 * L + x - 1] = v; if (x == 2 * L - 1) F16[4 * L - 1] = 0; } } }
        if (false) for (int x = tid; x < 0; ++x) {
            bf16_t v = 0;
            if (x >= 1 && x <= L) v = hf[((size_t)((ord * 2 + 0) * 512 + c)) * L + (L - x)];
            else if (x > L) v = hf[((size_t)((ord * 2 + 1) * 512 + c)) * L + (x - L)];
            F16[x] = v; if (x >= 1) F16[2 * L + x - 1] = v; if (x == 2 * L - 1) F16[4 * L - 1] = 0; }
        __syncthreads();
        f32x16 acc[NT];
#pragma unroll
        for (int i = 0; i < NT; ++i)
#pragma unroll
            for (int r = 0; r < 16; ++r) acc[i][r] = 0.f;
        bf16x8 E[NT], O[NT];
#pragma unroll
        for (int i = 1; i < NT; ++i) { HY_LOADA(E[i], 2 * (NT * w + i)); HY_LOADA(O[i], 2 * (NT * w + i) - 1); }
        for (int n8 = 0; n8 < L / 32; n8 += 8) {
#pragma unroll
            for (int u = 0; u < 8; ++u) { const int n = n8 + u; const int fe = 2 * (NT * w - n); bf16x8 Bf;
                HY_LOADA(E[(8 - u) & (NT - 1)], fe); HY_LOADB(Bf, 32 * n);
#pragma unroll
                for (int i = 0; i < NT; ++i) acc[i] = __builtin_amdgcn_mfma_f32_32x32x16_bf16(E[(i - u) & (NT - 1)], Bf, acc[i], 0, 0, 0);
                HY_LOADA(O[(8 - u) & (NT - 1)], fe - 1); HY_LOADB(Bf, 32 * n + 16);
#pragma unroll
                for (int i = 0; i < NT; ++i) acc[i] = __builtin_amdgcn_mfma_f32_32x32x16_bf16(O[(i - u) & (NT - 1)], Bf, acc[i], 0, 0, 0);
            }
        }
        __syncthreads();
        const int lane2 = tidx() & 63, li = lane2 & 31, kg = lane2 >> 5;
        const int xc = ord * 512 + c; const bf16_t* xrow = T + (size_t)xc * TOK + tokb + (size_t)li * L;
        bf16_t* orow = T + (size_t)c * TOK + tokb + (size_t)li * L;
        const float w0 = sw[xc], w1 = sw[1536 + xc], w2 = sw[3072 + xc], bb = sb[xc], sk = p.in[I_HSKIP][(l * 2 + ord) * 512 + c];
#pragma unroll
        for (int i = 0; i < NT; ++i) {
#pragma unroll
            for (int rh = 0; rh < 4; rh += 2) {
            u32x2 xr4[2]; bf16_t hm[2], hp[2];
#pragma unroll
            for (int r2 = 0; r2 < 2; ++r2) { const int rg = rh + r2; const int tb = 32 * (NT * w + i) + 8 * rg + 4 * kg;
                xr4[r2] = *(const u32x2*)(xrow + tb); hm[r2] = tb > 0 ? xrow[tb - 1] : (bf16_t)0; hp[r2] = tb + 4 < L ? xrow[tb + 4] : (bf16_t)0; }
#pragma unroll
            for (int r2 = 0; r2 < 2; ++r2) { const int rg = rh + r2; const int tb = 32 * (NT * w + i) + 8 * rg + 4 * kg; const u32x2 xr = xr4[r2];
                float x[6]; x[0] = bf2f(hm[r2]); x[5] = bf2f(hp[r2]);
                x[1] = lo16(xr.x); x[2] = hi16(xr.x); x[3] = lo16(xr.y); x[4] = hi16(xr.y);
                LAS u32x2* up = (LAS u32x2*)(U + ((tb >> 3) * 32 + li) * 16 + (tb & 7) * 2);
                const u32x2 uv = *up; const float uu[4] = {lo16(uv.x), hi16(uv.x), lo16(uv.y), hi16(uv.y)};
                float z[4];
#pragma unroll
                for (int j = 0; j < 4; ++j) z[j] = (w0 * x[j] + w1 * x[j + 1] + w2 * x[j + 2] + bb) * (acc[i][rg * 4 + j] + sk * uu[j]);
                u32x2 o; o.x = cvt_pk_bf16(z[0], z[1]); o.y = cvt_pk_bf16(z[2], z[3]);
                if (ord == 0) *up = o; else *(u32x2*)(orow + tb) = o; }
            }
        }
    }
#undef HY_LOADA
#undef HY_LOADB
    __syncthreads();
}

__device__ __forceinline__ void gla_item(const Params& p, int l, int b, int h, int dir, LAS float* lf) {
    const int tid = tidx(), qd = tid & 3, dv = tid >> 2;
    LAS float* qL = lf; LAS float* kL = lf + 2048; LAS float* aL = lf + 4096; LAS float* vL = lf + 6144; LAS float* oL = lf + 10240; LAS float* waL = lf + 14336; LAS float* baL = lf + 15360;
    const bf16_t* PG = (const bf16_t*)(p.ws + WS_PG);
    bf16_t* O = (bf16_t*)(p.ws + WS_OF) + (size_t)dir * TOK * 512;
    const float* wa = (dir ? p.in[I_WAB] : p.in[I_WAF]) + l * 16 * 256; const float* ba = (dir ? p.in[I_BAB] : p.in[I_BAF]) + l * 256;
    __syncthreads();
    for (int i = tid; i < 1024; i += NTHREADS) waL[i] = wa[(i >> 6) * 256 + h * 64 + (i & 63)];
    if (tid < 64) baL[tid] = ba[h * 64 + tid];
    float S[16];
#pragma unroll
    for (int i = 0; i < 16; ++i) S[i] = 0.f;
    const int sp = tid >> 4, sc4 = (tid & 15) * 4, sc8 = (tid & 15) * 8;
    for (int ck = 0; ck < 72; ++ck) {
        const int P = ck * 32 + sp; size_t row;
        if (P < 256) row = (size_t)TOKL + b * 256 + (dir ? 255 - P : P); else { const int tl = P - 256; row = (size_t)b * 2048 + (dir ? 2047 - tl : tl); }
        const bf16_t* pr = PG + row * NG;
        __syncthreads();
        { const u32x2 wq = *(const u32x2*)(pr + h * 64 + sc4), wk = *(const u32x2*)(pr + 256 + h * 64 + sc4);
          *(LAS f32x4*)(qL + sp * 64 + sc4) = (f32x4){lo16(wq.x) * 0.125f, hi16(wq.x) * 0.125f, lo16(wq.y) * 0.125f, hi16(wq.y) * 0.125f};
          *(LAS f32x4*)(kL + sp * 64 + sc4) = (f32x4){lo16(wk.x), hi16(wk.x), lo16(wk.y), hi16(wk.y)};
          const u32x4 wv = *(const u32x4*)(pr + 512 + h * 128 + sc8);
          *(LAS f32x4*)(vL + sp * 128 + sc8) = (f32x4){lo16(wv.x), hi16(wv.x), lo16(wv.y), hi16(wv.y)};
          *(LAS f32x4*)(vL + sp * 128 + sc8 + 4) = (f32x4){lo16(wv.z), hi16(wv.z), lo16(wv.w), hi16(wv.w)};
          const u32x4 g0 = *(const u32x4*)(pr + 1536 + dir * 16), g1 = *(const u32x4*)(pr + 1536 + dir * 16 + 8);
          float gt[16] = {lo16(g0.x), hi16(g0.x), lo16(g0.y), hi16(g0.y), lo16(g0.z), hi16(g0.z), lo16(g0.w), hi16(g0.w),
                          lo16(g1.x), hi16(g1.x), lo16(g1.y), hi16(g1.y), lo16(g1.z), hi16(g1.z), lo16(g1.w), hi16(g1.w)};
#pragma unroll
          for (int j = 0; j < 4; ++j) { float z = baL[sc4 + j];
#pragma unroll
              for (int r = 0; r < 16; ++r) z += gt[r] * waL[r * 64 + sc4 + j];
              const float ls = -(fmaxf(-z, 0.f) + log1pf(expf(-fabsf(z))));
              aL[sp * 64 + sc4 + j] = expf(ls * (1.f / 16.f)); } }
        __syncthreads();
        for (int pos = 0; pos < 32; ++pos) {
            const float vv = vL[pos * 128 + dv]; float part = 0.f;
#pragma unroll
            for (int i4 = 0; i4 < 4; ++i4) { const f32x4 aa = *(const LAS f32x4*)(aL + pos * 64 + qd * 16 + i4 * 4), kk = *(const LAS f32x4*)(kL + pos * 64 + qd * 16 + i4 * 4), qq = *(const LAS f32x4*)(qL + pos * 64 + qd * 16 + i4 * 4);
#pragma unroll
                for (int j = 0; j < 4; ++j) { S[i4 * 4 + j] = aa[j] * S[i4 * 4 + j] + kk[j] * vv; part += qq[j] * S[i4 * 4 + j]; } }
            part += __shfl_xor(part, 1); part += __shfl_xor(part, 2);
            if (qd == 0) oL[pos * 128 + dv] = part;
        }
        __syncthreads();
        { const f32x4 o0 = *(const LAS f32x4*)(oL + sp * 128 + sc8), o1 = *(const LAS f32x4*)(oL + sp * 128 + sc8 + 4);
          u32x4 w; w.x = cvt_pk_bf16(o0[0], o0[1]); w.y = cvt_pk_bf16(o0[2], o0[3]); w.z = cvt_pk_bf16(o1[0], o1[1]); w.w = cvt_pk_bf16(o1[2], o1[3]);
          *(u32x4*)(O + row * 512 + h * 128 + sc8) = w; }
    }
    __syncthreads();
}


__device__ __forceinline__ size_t gla_row(int P, int b, int dir) { return P < 256 ? (size_t)TOKL + b * 256 + (dir ? 255 - P : P) : (size_t)b * 2048 + (dir ? 2047 - (P - 256) : (P - 256)); }
__device__ __forceinline__ void gla_chunk_item(const Params& p, int l, int b, int h, int dir, LAS unsigned char* lds) {
    constexpr int RS = 72;
    LAS bf16_t* QD = (LAS bf16_t*)lds; LAS bf16_t* KI = QD + 64 * RS; LAS bf16_t* KET = KI + 64 * RS; LAS bf16_t* PP = KET + 64 * RS;
    LAS bf16_t* VT = PP + 64 * RS; LAS bf16_t* ST = VT + 128 * RS;
    LAS float* TOT = (LAS float*)(ST + 128 * RS); LAS float* DEC = TOT + 512; LAS float* WAL = DEC + 64; LAS float* BAL = WAL + 1024;
    const int tid = tidx(), lane = tid & 63, w = __builtin_amdgcn_readfirstlane(tid >> 6), i = tid >> 3, dg = tid & 7, d0 = dg * 8, l5 = lane & 31, hh = lane >> 5;
    const int ih = w >> 2, vq = w & 3;
    const bf16_t* PG = (const bf16_t*)(p.ws + WS_PG);
    bf16_t* O = (bf16_t*)(p.ws + WS_OF) + (size_t)dir * TOK * 512;
    const float* wa = (dir ? p.in[I_WAB] : p.in[I_WAF]) + l * 16 * 256; const float* ba = (dir ? p.in[I_BAB] : p.in[I_BAF]) + l * 256;
    __syncthreads();
    for (int q = tid; q < 1024; q += NTHREADS) WAL[q] = wa[(q >> 6) * 256 + h * 64 + (q & 63)];
    if (tid < 64) BAL[tid] = ba[h * 64 + tid];
    for (int q = tid; q < 73728 / 16; q += NTHREADS) *(LAS u32x4*)(lds + q * 16) = (u32x4){0u, 0u, 0u, 0u};
    f32x16 accS;
#pragma unroll
    for (int r = 0; r < 16; ++r) accS[r] = 0.f;
    u32x4 rq, rk, rg0, rg1, rv0, rv1;
    { const bf16_t* pr = PG + gla_row(i, b, dir) * NG;
      rq = *(const u32x4*)(pr + h * 64 + d0); rk = *(const u32x4*)(pr + 256 + h * 64 + d0); rg0 = *(const u32x4*)(pr + 1536 + dir * 16); rg1 = *(const u32x4*)(pr + 1536 + dir * 16 + 8);
      rv0 = *(const u32x4*)(pr + 512 + h * 128 + dg * 16); rv1 = *(const u32x4*)(pr + 512 + h * 128 + dg * 16 + 8); }
    __syncthreads();
    for (int ck = 0; ck < 36; ++ck) {
        float qf[8] = {lo16(rq.x), hi16(rq.x), lo16(rq.y), hi16(rq.y), lo16(rq.z), hi16(rq.z), lo16(rq.w), hi16(rq.w)};
        float kf[8] = {lo16(rk.x), hi16(rk.x), lo16(rk.y), hi16(rk.y), lo16(rk.z), hi16(rk.z), lo16(rk.w), hi16(rk.w)};
        float gt[16] = {lo16(rg0.x), hi16(rg0.x), lo16(rg0.y), hi16(rg0.y), lo16(rg0.z), hi16(rg0.z), lo16(rg0.w), hi16(rg0.w),
                        lo16(rg1.x), hi16(rg1.x), lo16(rg1.y), hi16(rg1.y), lo16(rg1.z), hi16(rg1.z), lo16(rg1.w), hi16(rg1.w)};
        float la[8];
#pragma unroll
        for (int j = 0; j < 8; ++j) { float z = BAL[d0 + j];
#pragma unroll
            for (int r = 0; r < 16; ++r) z += gt[r] * WAL[r * 64 + d0 + j];
            la[j] = -(fmaxf(-z, 0.f) + __logf(1.f + __expf(-fabsf(z)))) * (1.f / 16.f); }
#pragma unroll
        for (int st = 8; st < 64; st <<= 1) {
#pragma unroll
            for (int j = 0; j < 8; ++j) { const float y = __shfl_up(la[j], st); if (lane >= st) la[j] += y; } }
        if ((lane >> 3) == 7) { *(LAS f32x4*)(TOT + w * 64 + d0) = (f32x4){la[0], la[1], la[2], la[3]}; *(LAS f32x4*)(TOT + w * 64 + d0 + 4) = (f32x4){la[4], la[5], la[6], la[7]}; }
        __syncthreads();
        {
            float pre[8], bl[8];
#pragma unroll
            for (int j = 0; j < 8; ++j) { pre[j] = 0.f; bl[j] = 0.f; }
#pragma unroll
            for (int ww = 0; ww < 8; ++ww) { const f32x4 t0 = *(const LAS f32x4*)(TOT + ww * 64 + d0), t1 = *(const LAS f32x4*)(TOT + ww * 64 + d0 + 4);
                const float tv[8] = {t0[0], t0[1], t0[2], t0[3], t1[0], t1[1], t1[2], t1[3]};
#pragma unroll
                for (int j = 0; j < 8; ++j) { bl[j] += tv[j]; if (ww < w) pre[j] += tv[j]; } }
            float qd[8], ki[8], ke[8], eb[8];
#pragma unroll
            for (int j = 0; j < 8; ++j) { const float bc = la[j] + pre[j]; const float e1 = __expf(bc), e2 = __builtin_amdgcn_rcpf(e1); eb[j] = __expf(bl[j]);
                qd[j] = qf[j] * 0.125f * e1; ki[j] = kf[j] * e2; ke[j] = kf[j] * (eb[j] * e2); }
            u32x4 wq, wk;
            wq.x = cvt_pk_bf16(qd[0], qd[1]); wq.y = cvt_pk_bf16(qd[2], qd[3]); wq.z = cvt_pk_bf16(qd[4], qd[5]); wq.w = cvt_pk_bf16(qd[6], qd[7]);
            wk.x = cvt_pk_bf16(ki[0], ki[1]); wk.y = cvt_pk_bf16(ki[2], ki[3]); wk.z = cvt_pk_bf16(ki[4], ki[5]); wk.w = cvt_pk_bf16(ki[6], ki[7]);
            *(LAS u32x4*)(QD + i * RS + d0) = wq; *(LAS u32x4*)(KI + i * RS + d0) = wk;
#pragma unroll
            for (int j = 0; j < 8; j += 2) { const unsigned pk = cvt_pk_bf16(ke[j], ke[j + 1]); KET[(d0 + j) * RS + i] = (bf16_t)(pk & 0xffffu); KET[(d0 + j + 1) * RS + i] = (bf16_t)(pk >> 16); }
            const unsigned vv[8] = {rv0.x, rv0.y, rv0.z, rv0.w, rv1.x, rv1.y, rv1.z, rv1.w};
#pragma unroll
            for (int j = 0; j < 8; ++j) { VT[(dg * 16 + 2 * j) * RS + i] = (bf16_t)(vv[j] & 0xffffu); VT[(dg * 16 + 2 * j + 1) * RS + i] = (bf16_t)(vv[j] >> 16); }
            if (i == 0) { *(LAS f32x4*)(DEC + d0) = (f32x4){eb[0], eb[1], eb[2], eb[3]}; *(LAS f32x4*)(DEC + d0 + 4) = (f32x4){eb[4], eb[5], eb[6], eb[7]}; }
        }
        if (ck + 1 < 36) { const bf16_t* pr = PG + gla_row((ck + 1) * 64 + i, b, dir) * NG;
            rq = *(const u32x4*)(pr + h * 64 + d0); rk = *(const u32x4*)(pr + 256 + h * 64 + d0); rg0 = *(const u32x4*)(pr + 1536 + dir * 16); rg1 = *(const u32x4*)(pr + 1536 + dir * 16 + 8);
            rv0 = *(const u32x4*)(pr + 512 + h * 128 + dg * 16); rv1 = *(const u32x4*)(pr + 512 + h * 128 + dg * 16 + 8); }
        __syncthreads();
        f32x16 accO;
#pragma unroll
        for (int r = 0; r < 16; ++r) accO[r] = 0.f;
#pragma unroll
        for (int ks = 0; ks < 4; ++ks) { const bf16x8 A = *(const LAS bf16x8*)(QD + (ih * 32 + l5) * RS + ks * 16 + hh * 8), Bv = *(const LAS bf16x8*)(ST + (vq * 32 + l5) * RS + ks * 16 + hh * 8);
            accO = __builtin_amdgcn_mfma_f32_32x32x16_bf16(A, Bv, accO, 0, 0, 0); }
        if (w < 3) { const int si = w == 0 ? 0 : 1, sj = w == 2 ? 1 : 0; f32x16 accP;
#pragma unroll
            for (int r = 0; r < 16; ++r) accP[r] = 0.f;
#pragma unroll
            for (int ks = 0; ks < 4; ++ks) { const bf16x8 A = *(const LAS bf16x8*)(QD + (si * 32 + l5) * RS + ks * 16 + hh * 8), Bv = *(const LAS bf16x8*)(KI + (sj * 32 + l5) * RS + ks * 16 + hh * 8);
                accP = __builtin_amdgcn_mfma_f32_32x32x16_bf16(A, Bv, accP, 0, 0, 0); }
#pragma unroll
            for (int r = 0; r < 16; ++r) { const int ii = si * 32 + (r & 3) + 8 * (r >> 2) + 4 * hh, jj = sj * 32 + l5; PP[ii * RS + jj] = f2bf(jj <= ii ? accP[r] : 0.f); } }
        __syncthreads();
        { const int nk = ih == 0 ? 2 : 4;
          for (int ks = 0; ks < nk; ++ks) { const bf16x8 A = *(const LAS bf16x8*)(PP + (ih * 32 + l5) * RS + ks * 16 + hh * 8), Bv = *(const LAS bf16x8*)(VT + (vq * 32 + l5) * RS + ks * 16 + hh * 8);
              accO = __builtin_amdgcn_mfma_f32_32x32x16_bf16(A, Bv, accO, 0, 0, 0); } }
#pragma unroll
        for (int rg = 0; rg < 4; ++rg) { const f32x4 dv = *(const LAS f32x4*)(DEC + ih * 32 + 8 * rg + 4 * hh);
#pragma unroll
            for (int j = 0; j < 4; ++j) accS[rg * 4 + j] *= dv[j]; }
#pragma unroll
        for (int ks = 0; ks < 4; ++ks) { const bf16x8 A = *(const LAS bf16x8*)(KET + (ih * 32 + l5) * RS + ks * 16 + hh * 8), Bv = *(const LAS bf16x8*)(VT + (vq * 32 + l5) * RS + ks * 16 + hh * 8);
            accS = __builtin_amdgcn_mfma_f32_32x32x16_bf16(A, Bv, accS, 0, 0, 0); }
#pragma unroll
        for (int r = 0; r < 16; ++r) { const int ii = ih * 32 + (r & 3) + 8 * (r >> 2) + 4 * hh;
            O[gla_row(ck * 64 + ii, b, dir) * 512 + h * 128 + vq * 32 + l5] = f2bf(accO[r]); }
#pragma unroll
        for (int rg = 0; rg < 4; ++rg) { u32x2 o; o.x = cvt_pk_bf16(accS[rg * 4], accS[rg * 4 + 1]); o.y = cvt_pk_bf16(accS[rg * 4 + 2], accS[rg * 4 + 3]);
            *(LAS u32x2*)(ST + (vq * 32 + l5) * RS + ih * 32 + 8 * rg + 4 * hh) = o; }
        __syncthreads();
    }
    __syncthreads();
}

template <int W>
__device__ __forceinline__ void pool2d_wave(bf16_t* base, int lane) {
    float u[32], pv[33];
#pragma unroll
    for (int r = 0; r < 32; ++r) u[r] = bf2f(base[r * 64 + lane]);
    pv[0] = 0.f;
#pragma unroll
    for (int r = 0; r < 32; ++r) pv[r + 1] = pv[r] + u[r];
    const int cl = max(lane - W / 2, 0), chh = min(lane - W / 2 + W, 64);
#pragma unroll
    for (int r = 0; r < 32; ++r) {
        const int rl = (r - W / 2) < 0 ? 0 : (r - W / 2), rh = (r - W / 2 + W) > 32 ? 32 : (r - W / 2 + W);
        float x = pv[rh] - pv[rl];
#pragma unroll
        for (int d = 1; d < 64; d <<= 1) { const float y = __shfl_up(x, d); if (lane >= d) x += y; }
        const float hi = __shfl(x, chh - 1), lo = __shfl(x, cl > 0 ? cl - 1 : 0);
        const float s = hi - (cl > 0 ? lo : 0.f);
        const float cnt = (float)((rh - rl) * (chh - cl));
        base[r * 64 + lane] = f2bf(s / cnt - u[r]);
    }
}
__device__ __forceinline__ void pool1d_wave(bf16_t* base, int lane, int W) {
    float u[4], P[4];
#pragma unroll
    for (int j = 0; j < 4; ++j) u[j] = bf2f(base[j * 64 + lane]);
    float off = 0.f;
#pragma unroll
    for (int j = 0; j < 4; ++j) { float x = u[j];
#pragma unroll
        for (int d = 1; d < 64; d <<= 1) { const float y = __shfl_up(x, d); if (lane >= d) x += y; }
        P[j] = x + off; off += __shfl(x, 63); }
#pragma unroll
    for (int j = 0; j < 4; ++j) { const int t = j * 64 + lane; const int lo = max(t - W / 2, 0), hi = min(t - W / 2 + W, 256);
        const int ih = hi - 1, il = lo > 0 ? lo - 1 : 0;
        float vh = 0.f, vl = 0.f;
#pragma unroll
        for (int s = 0; s < 4; ++s) { const float a = __shfl(P[s], ih & 63), bq = __shfl(P[s], il & 63); if ((ih >> 6) == s) vh = a; if ((il >> 6) == s) vl = bq; }
        const float sum = vh - (lo > 0 ? vl : 0.f);
        u[j] = sum / (float)(hi - lo) - u[j]; }
#pragma unroll
    for (int j = 0; j < 4; ++j) base[j * 64 + lane] = f2bf(u[j]);
}

__global__ void __launch_bounds__(NTHREADS, 2) mega(Params p) {
    extern __shared__ __attribute__((aligned(16))) unsigned char lds_raw[];
    LAS unsigned char* lds = (LAS unsigned char*)lds_raw;
    LAS float* lf = (LAS float*)lds;
    cg::grid_group grid = cg::this_grid();
    unsigned bar_n = 0; unsigned* bar_ctr = (unsigned*)(p.ws + WS_BAR);
unsigned hb_k = 0, hb_xcc = 0, hb_nloc = 0, hb_nx = 0;
#define GBAR() do { if (hb_nloc == 0u) { bar_n += gridDim.x; gbar(bar_ctr, bar_n); } else { ++hb_k; gbar_h(bar_ctr, hb_xcc, hb_nloc, hb_nx, hb_k); } } while (0)
    const int G = gridDim.x, bid = blockIdx.x;
#define WSPTRS const int tid = tidx(), lane = tid & 63, wid = tid >> 6; (void)lane; (void)wid; unsigned char* ws = opq(p.ws); bf16_t* HX = (bf16_t*)(ws + WS_HX); bf16_t* T = (bf16_t*)(ws + WS_T); bf16_t* YG = (bf16_t*)(ws + WS_YG); bf16_t* PG = (bf16_t*)(ws + WS_PG); \
    float* CTXS = (float*)(ws + WS_CTX); const float* MOD = (const float*)(ws + WS_MOD); const float* BIAS = (const float*)(ws + WS_BIAS); (void)HX; (void)T; (void)YG; (void)PG; (void)CTXS; (void)MOD; (void)BIAS;

#ifdef TIMEX
    unsigned long long tx0 = 0, tx1 = 0; int txn = 0;
#define TX_MARK() do { if (txn == TIMEX) tx0 = __builtin_amdgcn_s_memrealtime(); if (txn == TIMEX + 1) tx1 = __builtin_amdgcn_s_memrealtime(); ++txn; } while (0)
    unsigned long long cx0 = 0, cxacc = 0;
#define CX_BEGIN(k) do { if (TIMEX == 100 + (k) && l == 1) { __syncthreads(); cx0 = __builtin_amdgcn_s_memrealtime(); } } while (0)
#define CX_END(k) do { if (TIMEX == 100 + (k) && l == 1) { __syncthreads(); cxacc += __builtin_amdgcn_s_memrealtime() - cx0; } } while (0)
#else
#define TX_MARK() do {} while (0)
#define CX_BEGIN(k) do {} while (0)
#define CX_END(k) do {} while (0)
#endif
    if (threadIdx.x == 0) { unsigned* ctl = (unsigned*)(p.ws + WS_BAR); const unsigned xcc = (unsigned)__builtin_amdgcn_s_getreg((3 << 11) | 20) & 7u;
        const unsigned rank = __hip_atomic_fetch_add(ctl + 16 + xcc, 1u, __ATOMIC_RELAXED, __HIP_MEMORY_SCOPE_AGENT);
        __hip_atomic_store(ctl + 256 + 2 * blockIdx.x, xcc, __ATOMIC_RELAXED, __HIP_MEMORY_SCOPE_AGENT); __hip_atomic_store(ctl + 257 + 2 * blockIdx.x, rank, __ATOMIC_RELAXED, __HIP_MEMORY_SCOPE_AGENT); }
    int xj = (int)blockIdx.x;
    TX_MARK();
    for (int l = 0; l < 2; ++l) {
        unsigned char* ws = opq(p.ws);
        const float* win = p.in[I_WIN] + (size_t)l * D * N_IN;
        bf16_t* wt = (bf16_t*)(ws + WS_WT + l * SZ_WT);
        tconv(win, N_IN, 0, 1536, 1536, D, wt, lf);
        tconv(win, N_IN, POOL_OFF, 512, 512, D, wt + (size_t)1536 * D, lf);
        tconv(win, N_IN, GLA_OFF, NGV, NG, D, (bf16_t*)(ws + WS_WG + l * SZ_WG), lf);
        tconv(win, N_IN, GATE_OFF, 3072, 3072, D, (bf16_t*)(ws + WS_WGATE + l * SZ_WGATE), lf);
        tconv(p.in[I_WBH] + (size_t)l * 512 * 1024, 1024, 0, 1024, 1024, 512, (bf16_t*)(ws + WS_WBR + (size_t)(l * 3 + 0) * SZ_WBR), lf);
        tconv(p.in[I_WBG] + (size_t)l * 512 * 1024, 1024, 0, 1024, 1024, 512, (bf16_t*)(ws + WS_WBR + (size_t)(l * 3 + 1) * SZ_WBR), lf);
        tconv(p.in[I_WOUT] + (size_t)l * D * D, D, 0, D, D, D, (bf16_t*)(ws + WS_WOUT + l * SZ_WOUT), lf);
        tconv(p.in[I_WUP] + (size_t)l * D * DFF, DFF, 0, DFF, DFF, D, (bf16_t*)(ws + WS_WUP + l * SZ_WUP), lf);
        tconv(p.in[I_WDN] + (size_t)l * DFF * D, D, 0, D, D, DFF, (bf16_t*)(ws + WS_WDN + l * SZ_WDN), lf);
        job_poolcomb(p, l);
    }
    job_bias(p);
    job_mod(p, lf);
    job_filters(p, lds);
    if (p.ws == nullptr) grid.sync();
    GBAR();
    { unsigned* ctl = (unsigned*)(p.ws + WS_BAR); bool ok = (gridDim.x & 7u) == 0u;
      for (int q = 0; q < 8; ++q) ok = ok && (__hip_atomic_load(ctl + 16 + q, __ATOMIC_RELAXED, __HIP_MEMORY_SCOPE_AGENT) == (gridDim.x >> 3));
      const unsigned mx = __hip_atomic_load(ctl + 256 + 2 * blockIdx.x, __ATOMIC_RELAXED, __HIP_MEMORY_SCOPE_AGENT), mr = __hip_atomic_load(ctl + 257 + 2 * blockIdx.x, __ATOMIC_RELAXED, __HIP_MEMORY_SCOPE_AGENT);
      if (ok) xj = __builtin_amdgcn_readfirstlane((int)((mr << 3) | mx));
      unsigned sum = 0u, nxc = 0u;
      for (int q = 0; q < 8; ++q) { const unsigned cq = __hip_atomic_load(ctl + 16 + q, __ATOMIC_RELAXED, __HIP_MEMORY_SCOPE_AGENT); sum += cq; nxc += cq ? 1u : 0u; }
      if (sum == gridDim.x) { hb_xcc = (unsigned)__builtin_amdgcn_readfirstlane((int)mx); hb_nloc = (unsigned)__builtin_amdgcn_readfirstlane((int)__hip_atomic_load(ctl + 16 + mx, __ATOMIC_RELAXED, __HIP_MEMORY_SCOPE_AGENT)); hb_nx = nxc; } }

    { WSPTRS
    for (int row = bid * 8 + wid; row < TOK; row += 2 * G * 8) {
        const int rb = row + G * 8; const bool hb = rb < TOK; const int rb2 = hb ? rb : row;
        const bool la = row < TOKL, lb = rb2 < TOKL;
        const float* xa = la ? p.in[I_X] + (size_t)row * D : p.in[I_CTX] + (size_t)(row - TOKL) * D; const float* xb = lb ? p.in[I_X] + (size_t)rb2 * D : p.in[I_CTX] + (size_t)(rb2 - TOKL) * D;
        const float* ma = MOD + (size_t)(la ? row >> 11 : 32) * 6144; const float* mb = MOD + (size_t)(lb ? rb2 >> 11 : 32) * 6144;
        ada_row2(xa, xb, hb, p.in[I_NMIX], ma, ma + 1024, mb, mb + 1024, HX + (size_t)row * D, HX + (size_t)rb2 * D, nullptr, nullptr, lane);
    } }
    GBAR();
    TX_MARK();

    for (int l_ = 0; l_ < 2; ++l_) {
        const int l = opqi(l_);
        { WSPTRS
            const int ntokt = l == 0 ? 288 : 256;
            const int nA = ntokt * 8, nB = 288 * 7;
            const bf16_t* wt = (const bf16_t*)(ws + WS_WT + l * SZ_WT); const bf16_t* wg = (const bf16_t*)(ws + WS_WG + l * SZ_WG);
            const float* biasT = BIAS + l * (NTR + NG); const float* biasG = biasT + NTR;
            XMap MA, MB; MA.init(xj, ntokt, 8); MB.init(xj, 288, 7);
            ProgInproj P{wt, wg, HX, T, PG, biasT, biasG, MA, MB, MA.rounds()};
            gemm_stream(lds, MA.rounds() + MB.rounds(), P);
        }
        GBAR();
        TX_MARK();
        { WSPTRS
            for (int it = bid; it < 256; it += G) gla_chunk_item(p, l, it >> 3, (it >> 1) & 3, it & 1, lds);
            for (int it = bid; it < 512; it += G) hyena_mfma<2048, 8>(p, l, it, false, lds);
            if (l == 0) for (int it = bid; it < 512; it += G) hyena_mfma<256, 1>(p, l, it, true, lds);
            const int npl = l == 0 ? 32768 : 16384;
            for (int it = bid * 8 + wid; it < npl; it += G * 8) { const bool cx = it >= 16384; const int j = it & 16383, ch = j >> 5, b = j & 31, g = ch >> 7;
                bf16_t* base = T + (size_t)(1536 + ch) * TOK + (cx ? (size_t)TOKL + b * 256 : (size_t)b * 2048);
                if (cx) pool1d_wave(base, lane, 2 << g);
                else { if (g == 0) pool2d_wave<2>(base, lane); else if (g == 1) pool2d_wave<4>(base, lane); else if (g == 2) pool2d_wave<8>(base, lane); else pool2d_wave<16>(base, lane); } }
        }
        GBAR();
        TX_MARK();
        {
            WSPTRS
            const bf16_t* OF = (const bf16_t*)(ws + WS_OF); const bf16_t* OB = OF + (size_t)TOK * 512; const float* nw = p.in[I_GNW] + l * 128;
            const int ntok = l == 0 ? TOK : TOKL;
            for (int row = bid * 8 + wid; row < ntok; row += 2 * G * 8) {
                const int rowb = row + G * 8; const bool hb = rowb < ntok; const int rows[2] = {row, hb ? rowb : row};
                u32x4 av[2], bv[2], rv[2];
#pragma unroll
                for (int q = 0; q < 2; ++q) { av[q] = *(const u32x4*)(OF + (size_t)rows[q] * 512 + lane * 8); bv[q] = *(const u32x4*)(OB + (size_t)rows[q] * 512 + lane * 8); rv[q] = *(const u32x4*)(PG + (size_t)rows[q] * NG + 1024 + lane * 8); }
#pragma unroll
                for (int q = 0; q < 2; ++q) { if (q == 1 && !hb) break;
                    const u32x4 a = av[q], bq = bv[q], rr = rv[q];
                    float o[8] = {lo16(a.x) + lo16(bq.x), hi16(a.x) + hi16(bq.x), lo16(a.y) + lo16(bq.y), hi16(a.y) + hi16(bq.y), lo16(a.z) + lo16(bq.z), hi16(a.z) + hi16(bq.z), lo16(a.w) + lo16(bq.w), hi16(a.w) + hi16(bq.w)};
                    float r[8] = {lo16(rr.x), hi16(rr.x), lo16(rr.y), hi16(rr.y), lo16(rr.z), hi16(rr.z), lo16(rr.w), hi16(rr.w)};
                    float ss = 0.f;
#pragma unroll
                    for (int j = 0; j < 8; ++j) ss += o[j] * o[j];
                    ss += __shfl_xor(ss, 1); ss += __shfl_xor(ss, 2); ss += __shfl_xor(ss, 4); ss += __shfl_xor(ss, 8);
                    const float inv = rsqrtf(ss * (1.f / 128.f) + EPS);
                    float y[8];
#pragma unroll
                    for (int j = 0; j < 8; ++j) y[j] = o[j] * inv * nw[(lane & 15) * 8 + j] * (r[j] * sigmoidf_(r[j]));
                    u32x4 w; w.x = cvt_pk_bf16(y[0], y[1]); w.y = cvt_pk_bf16(y[2], y[3]); w.z = cvt_pk_bf16(y[4], y[5]); w.w = cvt_pk_bf16(y[6], y[7]);
                    *(u32x4*)(YG + (size_t)rows[q] * 512 + lane * 8) = w; }
            }
            LAS bf16_t* tl = (LAS bf16_t*)lds;
            const int nit = 2 * (l == 0 ? 288 : 256) * 8;
            for (int it = bid; it < nit; it += G) { const int ctile = it & 7, tt = (it >> 3) % (l == 0 ? 288 : 256), which = (it >> 3) / (l == 0 ? 288 : 256);
                const bf16_t* src = T + (size_t)(which ? 1536 : 0) * TOK + (size_t)tt * 256; bf16_t* dst = (bf16_t*)(ws + (which ? WS_YPL : WS_YHY)) + (size_t)tt * 256 * 512;
                __syncthreads();
#pragma unroll
                for (int i = 0; i < 4; ++i) { const int idx = tid + i * NTHREADS, c = idx >> 5, t8 = (idx & 31) * 8;
                    *(LAS u32x4*)(tl + c * 264 + t8) = *(const u32x4*)(src + (size_t)(ctile * 64 + c) * TOK + t8); }
                __syncthreads();
#pragma unroll
                for (int i = 0; i < 4; ++i) { const int idx = tid + i * NTHREADS, tk = idx >> 3, c8 = (idx & 7) * 8; unsigned w[4];
#pragma unroll
                    for (int j = 0; j < 4; ++j) w[j] = (unsigned)tl[(c8 + 2 * j) * 264 + tk] | ((unsigned)tl[(c8 + 2 * j + 1) * 264 + tk] << 16);
                    *(u32x4*)(dst + (size_t)tk * 512 + ctile * 64 + c8) = (u32x4){w[0], w[1], w[2], w[3]}; }
            }
            __syncthreads();
        }
        GBAR();
        TX_MARK();
        const int ntt = l == 0 ? 288 : 256;
        { WSPTRS
          XMap M; M.init(xj, ntt, 4);
          ProgMix2 P{ws, ws + WS_STASH + (size_t)bid * 524288, p.in[I_BIN] + l * N_IN + GATE_OFF, M, l};
          gemm_stream(lds, 6 * M.rounds(), P); }
        GBAR();
        { WSPTRS
          XMap M; M.init(xj, ntt, 4);
          TileIO io{p.in[I_X], p.in[I_CTX], p.out, CTXS, MOD + (size_t)l * 33 * 6144, l};
          ProgOut2 P{ws, io, M, l};
          gemm_stream(lds, M.rounds(), P); }
        GBAR();
        { WSPTRS
          const float* modl = MOD + (size_t)l * 33 * 6144; const int nrow = ntt * 256;
          for (int row = bid * 8 + wid; row < nrow; row += 2 * G * 8) { const int rb = row + G * 8; const bool hb = rb < nrow; const int rb2 = hb ? rb : row; const bool la = row < TOKL, lb = rb2 < TOKL;
              const float* xa = la ? p.out + (size_t)row * D : CTXS + (size_t)(row - TOKL) * D; const float* xb = lb ? p.out + (size_t)rb2 * D : CTXS + (size_t)(rb2 - TOKL) * D;
              const float* ma = modl + (size_t)(la ? row >> 11 : 32) * 6144; const float* mb = modl + (size_t)(lb ? rb2 >> 11 : 32) * 6144;
              ada_row2(xa, xb, hb, p.in[I_NFFN] + l * D, ma + 3072, ma + 4096, mb + 3072, mb + 4096, HX + (size_t)row * D, HX + (size_t)rb2 * D, nullptr, nullptr, lane); } }
        GBAR();
        { WSPTRS
          XMap M; M.init(xj, ntt, 16);
          ProgUp2 P{ws, M, l};
          gemm_stream(lds, M.rounds(), P); }
        GBAR();
        { WSPTRS
          XMap M; M.init(xj, ntt, 4);
          TileIO io{p.in[I_X], p.in[I_CTX], p.out, CTXS, MOD + (size_t)l * 33 * 6144, l};
          ProgDown2 P{ws, io, M, l};
          gemm_stream(lds, M.rounds(), P); }
        GBAR();
        { WSPTRS
          const int nrow = ntt * 256;
          for (int row = bid * 8 + wid; row < nrow; row += 2 * G * 8) { const int rb = row + G * 8; const bool hb = rb < nrow; const int rb2 = hb ? rb : row; const bool la = row < TOKL, lb = rb2 < TOKL;
              float* xa = la ? p.out + (size_t)row * D : CTXS + (size_t)(row - TOKL) * D; float* xb = lb ? p.out + (size_t)rb2 * D : CTXS + (size_t)(rb2 - TOKL) * D;
              if (l == 0) { const float* ma = MOD + (size_t)33 * 6144 + (size_t)(la ? row >> 11 : 32) * 6144; const float* mb = MOD + (size_t)33 * 6144 + (size_t)(lb ? rb2 >> 11 : 32) * 6144;
                  ada_row2(xa, xb, hb, p.in[I_NMIX] + D, ma, ma + 1024, mb, mb + 1024, HX + (size_t)row * D, HX + (size_t)rb2 * D, nullptr, nullptr, lane); }
              else ada_row2(xa, xb, hb, p.in[I_NFIN], nullptr, nullptr, nullptr, nullptr, nullptr, nullptr, xa, xb, lane); } }
        if (l == 0) GBAR();
        TX_MARK();
    }
#ifdef TIMEX
    if (blockIdx.x == 0 && threadIdx.x == 0) { const unsigned long long t = __builtin_amdgcn_s_memrealtime(); while (__builtin_amdgcn_s_memrealtime() - t < (unsigned long long)TIMEX_MULT * (TIMEX >= 100 ? cxacc : (tx1 - tx0))) __builtin_amdgcn_s_sleep(10); }
#endif
}

extern "C" void kernel_launch(void* const* d_in, const int* in_sizes, int n_in, void* d_out, int out_size,
                              void* d_ws, size_t ws_size, hipStream_t stream) {
    static int grid_blocks = 0;
    if (!grid_blocks) {
        int dev = 0, cus = 0, per_cu = 0;
        (void)hipGetDevice(&dev);
        (void)hipDeviceGetAttribute(&cus, hipDeviceAttributeMultiprocessorCount, dev);
        (void)hipFuncSetAttribute((const void*)mega, hipFuncAttributeMaxDynamicSharedMemorySize, LDS_BYTES);
        (void)hipOccupancyMaxActiveBlocksPerMultiprocessor(&per_cu, (const void*)mega, NTHREADS, LDS_BYTES);
        grid_blocks = cus > 256 ? 256 : cus;
        if (ws_size < WS_END || n_in != 33 || out_size != TOKL * D) { fprintf(stderr, "kernel_launch: unexpected sizes ws=%zu need=%zu n_in=%d out=%d\n", ws_size, (size_t)WS_END, n_in, out_size); grid_blocks = -1; }
    }
    if (grid_blocks < 0) return;
    Params p{};
    for (int i = 0; i < 33; ++i) p.in[i] = (const float*)d_in[i];
    p.out = (float*)d_out; p.ws = (unsigned char*)d_ws;
    (void)hipMemsetAsync((unsigned char*)d_ws + WS_BAR, 0, 8192, stream);
    void* args[] = {&p};
    hipError_t e = hipLaunchCooperativeKernel((const void*)mega, dim3(grid_blocks), dim3(NTHREADS), args, LDS_BYTES, stream);
    if (e != hipSuccess) fprintf(stderr, "cooperative launch failed: %s (grid %d)\n", hipGetErrorString(e), grid_blocks);
}
```

```cpp
#include <hip/hip_runtime.h>
#include <hip/hip_cooperative_groups.h>
#include <cstdio>
#include <cstdint>
namespace cg = cooperative_groups;

#define LAS __attribute__((address_space(3)))
typedef unsigned short bf16_t;
typedef short bf16x8 __attribute__((ext_vector_type(8)));
typedef float f32x4 __attribute__((ext_vector_type(4)));
typedef unsigned u32x2 __attribute__((ext_vector_type(2)));
typedef unsigned u32x4 __attribute__((ext_vector_type(4)));

constexpr int NTHREADS = 512;
constexpr int LDS_BYTES = 147456;
constexpr int D = 1024, NB = 32, SEQ = 2048, CTXL = 256;
constexpr int TOKL = NB * SEQ, TOKC = NB * CTXL, TOK = TOKL + TOKC;
constexpr int N_IN = 6688, GLA_OFF = 1536, POOL_OFF = 3104, GATE_OFF = 3616;
constexpr int NTR = 2048, NG = 1792, NGV = 1568, DFF = 4096;
constexpr float EPS = 1e-6f;

constexpr size_t SZ_WT = (size_t)NTR * D * 2, SZ_WG = (size_t)NG * D * 2, SZ_WGATE = (size_t)3072 * D * 2, SZ_WBR = (size_t)1024 * 512 * 2;
constexpr size_t SZ_WOUT = (size_t)D * D * 2, SZ_WUP = (size_t)DFF * D * 2, SZ_WDN = (size_t)D * DFF * 2;
constexpr size_t WS_WT = 0;
constexpr size_t WS_WG = WS_WT + 2 * SZ_WT;
constexpr size_t WS_WGATE = WS_WG + 2 * SZ_WG;
constexpr size_t WS_WBR = WS_WGATE + 2 * SZ_WGATE;
constexpr size_t WS_WOUT = WS_WBR + 6 * SZ_WBR;
constexpr size_t WS_WUP = WS_WOUT + 2 * SZ_WOUT;
constexpr size_t WS_WDN = WS_WUP + 2 * SZ_WUP;
constexpr size_t WS_BIAS = WS_WDN + 2 * SZ_WDN;
constexpr size_t WS_MOD = WS_BIAS + 32768;
constexpr size_t WS_HFL = WS_MOD + (size_t)2 * 33 * 6144 * 4;
constexpr size_t WS_HFC = WS_HFL + (size_t)2 * 4 * 512 * 2048 * 2;
constexpr size_t WS_CTX = WS_HFC + (size_t)4 * 512 * 256 * 2;
constexpr size_t WS_HX = WS_CTX + (size_t)TOKC * D * 4;
constexpr size_t WS_T = WS_HX + (size_t)TOK * D * 2;
constexpr size_t WS_YG = WS_T + (size_t)NTR * TOK * 2;
constexpr size_t WS_PG = WS_YG + (size_t)TOK * 512 * 2;
constexpr size_t WS_OF = WS_PG + (size_t)TOK * NG * 2;
constexpr size_t WS_BAR = WS_OF + (size_t)2 * TOK * 512 * 2;
constexpr size_t WS_END = WS_BAR + 8192;
constexpr size_t WS_YHY = WS_T + (size_t)512 * TOK * 2;
constexpr size_t WS_YPL = WS_T + (size_t)1024 * TOK * 2;
constexpr size_t WS_STASH = WS_PG;
constexpr size_t WS_MERGED = WS_OF;
constexpr size_t WS_HID = WS_T;
static_assert((size_t)TOK * DFF * 2 <= WS_OF - WS_T, "hidden");
constexpr size_t WS_SCR = WS_PG;
constexpr size_t SCR_PER = 1572864;
constexpr size_t SC_MERGED = 0, SC_TRY = 524288, SC_TRP = 786432, SC_SG = 1048576, SC_ST = 1310720, SC_HID = 524288;
static_assert(WS_END <= (size_t)1073741824, "ws");

struct Params { const float* in[33]; float* out; unsigned char* ws; };
enum { I_X = 0, I_C, I_CTX, I_CCTX, I_WMOD, I_BMOD, I_NMIX, I_NFFN, I_WIN, I_BIN, I_HSW, I_HSB, I_FW1, I_FB1, I_FFREQ, I_FW2, I_FB2, I_FW3, I_HSKIP,
       I_WAF, I_BAF, I_WAB, I_BAB, I_GNW, I_PW, I_PSC, I_WBH, I_WBG, I_WBP, I_WOUT, I_WUP, I_WDN, I_NFIN };

__device__ __forceinline__ float bf2f(bf16_t h) { return __uint_as_float((unsigned)h << 16); }
__device__ __forceinline__ unsigned cvt_pk_bf16(float lo, float hi) { unsigned r; asm volatile("v_cvt_pk_bf16_f32 %0, %1, %2" : "=v"(r) : "v"(lo), "v"(hi)); return r; }
__device__ __forceinline__ bf16_t f2bf(float f) { return (bf16_t)(cvt_pk_bf16(f, 0.f) & 0xffffu); }
__device__ __forceinline__ float lo16(unsigned u) { return __uint_as_float(u << 16); }
__device__ __forceinline__ float hi16(unsigned u) { return __uint_as_float(u & 0xffff0000u); }
__device__ __forceinline__ float sigmoidf_(float v) { return 1.f / (1.f + __expf(-v)); }
__device__ __forceinline__ unsigned char* opq(unsigned char* p) { asm volatile("" : "+s"(p)); return p; }
__device__ __forceinline__ int tidx() { int t = threadIdx.x; asm volatile("" : "+v"(t)); return t; }
__device__ __forceinline__ int opqi(int v) { asm volatile("" : "+s"(v)); return v; }
__device__ __forceinline__ void gbar(unsigned* ctr, unsigned target) {
    asm volatile("s_waitcnt vmcnt(0) lgkmcnt(0)" ::: "memory");
    __syncthreads();
    if (threadIdx.x < 64) {
        if (threadIdx.x == 0) {
            __builtin_amdgcn_fence(__ATOMIC_RELEASE, "agent");
            asm volatile("s_waitcnt vmcnt(0)" ::: "memory");
            __hip_atomic_fetch_add(ctr, 1u, __ATOMIC_RELAXED, __HIP_MEMORY_SCOPE_AGENT);
            while (__hip_atomic_load(ctr, __ATOMIC_RELAXED, __HIP_MEMORY_SCOPE_AGENT) < target) __builtin_amdgcn_s_sleep(1);
        }
        __builtin_amdgcn_fence(__ATOMIC_ACQUIRE, "agent");
        asm volatile("s_waitcnt vmcnt(0)" ::: "memory");
    }
    __syncthreads();
}
__device__ __forceinline__ void gbar_h(unsigned* ctl, unsigned xcc, unsigned nloc, unsigned nx, unsigned k) {
    asm volatile("s_waitcnt vmcnt(0) lgkmcnt(0)" ::: "memory");
    __syncthreads();
    if (threadIdx.x < 64) {
        if (threadIdx.x == 0) {
            unsigned* xsub = ctl + 1024 + 16 * xcc; unsigned* xgen = ctl + 1280 + 16 * xcc; unsigned* top = ctl + 1536; unsigned* topgen = ctl + 1600;
            const unsigned old = __hip_atomic_fetch_add(xsub, 1u, __ATOMIC_RELAXED, __HIP_MEMORY_SCOPE_AGENT);
            if (old + 1u == k * nloc) {
                __builtin_amdgcn_fence(__ATOMIC_RELEASE, "agent");
                asm volatile("s_waitcnt vmcnt(0)" ::: "memory");
                const unsigned og = __hip_atomic_fetch_add(top, 1u, __ATOMIC_RELAXED, __HIP_MEMORY_SCOPE_AGENT);
                if (og + 1u == k * nx) __hip_atomic_fetch_add(topgen, 1u, __ATOMIC_RELAXED, __HIP_MEMORY_SCOPE_AGENT);
                else while (__hip_atomic_load(topgen, __ATOMIC_RELAXED, __HIP_MEMORY_SCOPE_AGENT) < k) __builtin_amdgcn_s_sleep(1);
                __hip_atomic_fetch_add(xgen, 1u, __ATOMIC_RELAXED, __HIP_MEMORY_SCOPE_AGENT);
            } else {
                while (__hip_atomic_load(xgen, __ATOMIC_RELAXED, __HIP_MEMORY_SCOPE_AGENT) < k) __builtin_amdgcn_s_sleep(1);
            }
        }
        __builtin_amdgcn_fence(__ATOMIC_ACQUIRE, "agent");
        asm volatile("s_waitcnt vmcnt(0)" ::: "memory");
    }
    __syncthreads();
}
__device__ __forceinline__ float wave_sum(float v) {
#pragma unroll
    for (int o = 32; o >= 1; o >>= 1) v += __shfl_xor(v, o);
    return v;
}

constexpr int BK = 64, HALF = 128, HTB = HALF * BK * 2;
__device__ __forceinline__ int lds_byte(int r, int c) { const int st = (r >> 4) * 2 + (c >> 5), rr = r & 15, cc = c & 31, ob = rr * 64 + cc * 2; return st * 1024 + (ob ^ (((ob >> 9) & 1) << 5)); }
__device__ __forceinline__ void stage_rc(int b, int& R, int& C) { const int st = b / 1024, sb = b % 1024, swz = sb ^ (((sb >> 9) & 1) << 5); R = (st >> 1) * 16 + swz / 64; C = (st & 1) * 32 + (swz % 64) / 2; }

template <class Epi>
__device__ __forceinline__ void gemm_unit(LAS unsigned char* lds, const bf16_t* A, int lda, const bf16_t* Bt, int ldb, int K, const Epi& E) {
    const int tid = tidx(), wid = __builtin_amdgcn_readfirstlane(tid >> 6), lane = tid & 63, wr = wid >> 2, wc = wid & 3, fr = lane & 15, fq = lane >> 4;
    const int nt = K / BK;
    unsigned voffA[2], voffB[2];
#pragma unroll
    for (int i = 0; i < 2; ++i) { int R, C; stage_rc(tid * 16 + i * 8192, R, C); voffA[i] = (unsigned)(R * lda + C) * 2u; voffB[i] = (unsigned)(R * ldb + C) * 2u; }
    const size_t kstep = (size_t)(BK * 2);
    const size_t hstepA = (size_t)HALF * lda * 2, hstepB = (size_t)HALF * ldb * 2;
    const unsigned ldsw = (unsigned)wid * 1024u;
    const int aoff = lds_byte(wr * 64 + fr, fq * 8), boff = lds_byte(wc * 32 + fr, fq * 8);
#define G_SA(b, h) (((b) * 2 + (h)) * HTB)
#define G_SB(b, h) ((4 + (b) * 2 + (h)) * HTB)
#define G_STAGE(bufoff, gbase, voff) do { _Pragma("unroll") for (int _i = 0; _i < 2; ++_i) \
        __builtin_amdgcn_global_load_lds((const unsigned*)((const char*)(gbase) + (voff)[_i]), (LAS unsigned*)(lds + (bufoff) + ldsw + _i * 8192), 16, 0, 0); } while (0)
#define G_LDA(dst, b, h) do { _Pragma("unroll") for (int m = 0; m < 4; ++m) _Pragma("unroll") for (int k = 0; k < 2; ++k) dst[m][k] = *(const LAS bf16x8*)(lds + G_SA(b, h) + aoff + m * 2048 + k * 1024); } while (0)
#define G_LDB(dst, b, h) do { _Pragma("unroll") for (int n = 0; n < 2; ++n) _Pragma("unroll") for (int k = 0; k < 2; ++k) dst[n][k] = *(const LAS bf16x8*)(lds + G_SB(b, h) + boff + n * 2048 + k * 1024); } while (0)
#define G_MMA(ai, bj, At, Bt_) do { __builtin_amdgcn_s_setprio(1); _Pragma("unroll") for (int m = 0; m < 4; ++m) _Pragma("unroll") for (int n = 0; n < 2; ++n) _Pragma("unroll") for (int k = 0; k < 2; ++k) \
        acc[ai][bj][m][n] = __builtin_amdgcn_mfma_f32_16x16x32_bf16(Bt_[n][k], At[m][k], acc[ai][bj][m][n], 0, 0, 0); __builtin_amdgcn_s_setprio(0); } while (0)
#define G_WAIT_V(n) asm volatile("s_waitcnt vmcnt(" #n ")" ::: "memory")
#define G_WAIT_L(n) asm volatile("s_waitcnt lgkmcnt(" #n ")" ::: "memory")
#define G_BAR __builtin_amdgcn_s_barrier()
#define G_SCHED __builtin_amdgcn_sched_barrier(0)
    __syncthreads();
    f32x4 acc[2][2][4][2];
#pragma unroll
    for (int a = 0; a < 2; ++a)
#pragma unroll
        for (int b = 0; b < 2; ++b)
#pragma unroll
            for (int m = 0; m < 4; ++m)
#pragma unroll
                for (int n = 0; n < 2; ++n) acc[a][b][m][n] = (f32x4){0.f, 0.f, 0.f, 0.f};
    bf16x8 At[4][2], B0[2][2], B1[2][2];
    const char* cA = (const char*)A; const char* cB = (const char*)Bt;
    G_STAGE(G_SB(0, 0), cB, voffB); G_STAGE(G_SA(0, 0), cA, voffA); G_STAGE(G_SB(0, 1), cB + hstepB, voffB); G_STAGE(G_SA(0, 1), cA + hstepA, voffA);
    if (wr == 1) G_BAR;
    G_WAIT_V(4); G_BAR;
    G_STAGE(G_SB(1, 0), cB + kstep, voffB); G_STAGE(G_SA(1, 0), cA + kstep, voffA); G_STAGE(G_SB(1, 1), cB + hstepB + kstep, voffB);
    G_WAIT_V(6); G_BAR;
    for (int t = 0; t < nt; t += 2) {
        const bool last = (t == nt - 2);
        const char* a1 = cA + (size_t)(t + 1) * kstep;
        const char* a2 = last ? cA : cA + (size_t)(t + 2) * kstep; const char* b2 = last ? cB : cB + (size_t)(t + 2) * kstep;
        const char* a3 = a2 + kstep; const char* b3 = b2 + kstep;
        G_LDB(B0, 0, 0); G_SCHED; G_LDA(At, 0, 0); G_STAGE(G_SA(1, 1), a1 + hstepA, voffA);
        G_WAIT_L(8); G_BAR; G_WAIT_L(0); G_MMA(0, 0, At, B0); G_BAR; G_SCHED;
        G_LDB(B1, 0, 1); G_STAGE(G_SB(0, 0), b2, voffB);
        G_BAR; G_WAIT_L(0); G_MMA(0, 1, At, B1); G_BAR;
        G_LDA(At, 0, 1); G_STAGE(G_SA(0, 0), a2, voffA);
        G_BAR; G_WAIT_L(0); G_MMA(1, 0, At, B0); G_BAR; G_SCHED;
        G_STAGE(G_SB(0, 1), b2 + hstepB, voffB);
        G_WAIT_V(6); G_BAR; G_MMA(1, 1, At, B1); G_BAR;
        G_LDB(B0, 1, 0); G_SCHED; G_LDA(At, 1, 0); G_STAGE(G_SA(0, 1), a2 + hstepA, voffA);
        G_WAIT_L(8); G_BAR; G_WAIT_L(0); G_MMA(0, 0, At, B0); G_BAR; G_SCHED;
        G_LDB(B1, 1, 1); G_STAGE(G_SB(1, 0), b3, voffB);
        G_BAR; G_WAIT_L(0); G_MMA(0, 1, At, B1); G_BAR;
        G_LDA(At, 1, 1); G_STAGE(G_SA(1, 0), a3, voffA);
        G_BAR; G_WAIT_L(0); G_MMA(1, 0, At, B0); G_BAR; G_SCHED;
        G_STAGE(G_SB(1, 1), b3 + hstepB, voffB);
        G_WAIT_V(6); G_BAR; G_MMA(1, 1, At, B1); G_BAR;
    }
    E(acc, wr, wc, fr, fq);
    G_WAIT_V(0);
    if (wr == 0) G_BAR;
    G_BAR;
    __syncthreads();
}


__device__ __forceinline__ int perm32(int rho) { const int n = rho >> 4, i = rho & 15; return 8 * (i >> 2) + 4 * n + (i & 3); }
typedef f32x4 AccT[2][2][4][2];
struct UDesc { const char* A; const char* B; int lda, ldb, K; };
template <class Prog, bool SP2 = true, bool ALIGN_EPI = true>
__device__ __forceinline__ void gemm_stream(LAS unsigned char* lds, int nunits, const Prog& P) {
    if (nunits <= 0) return;
    const int tid = tidx(), wid = __builtin_amdgcn_readfirstlane(tid >> 6), lane = tid & 63, wr = wid >> 2, wc = wid & 3, fr = lane & 15, fq = lane >> 4;
    int sR, sRb, sC; { int R, C; stage_rc(tid * 16, R, C); sR = R * 2; sRb = ((R & ~31) + perm32(R & 31)) * 2; sC = C * 2; }
    const unsigned kstep = (unsigned)(BK * 2);
    const unsigned ldsw = (unsigned)wid * 1024u;
    const int aoff = lds_byte(wr * 64 + fr, fq * 8), boff = lds_byte(wc * 32 + fr, fq * 8);
#define S_STAGE(bufoff, gbase, v, q) do { \
        __builtin_amdgcn_global_load_lds((const unsigned*)((const char*)(gbase) + (v)), (LAS unsigned*)(lds + (bufoff) + ldsw), 16, 0, 0); \
        __builtin_amdgcn_global_load_lds((const unsigned*)((const char*)(gbase) + (q) + (v)), (LAS unsigned*)(lds + (bufoff) + ldsw + 8192), 16, 0, 0); } while (0)
    UDesc cur, nxt; P.desc(0, cur);
    unsigned vA = (unsigned)(sR * cur.lda + sC), vB = (unsigned)(sRb * cur.ldb + sC);
    __syncthreads();
    f32x4 acc[2][2][4][2];
#pragma unroll
    for (int a = 0; a < 2; ++a)
#pragma unroll
        for (int b = 0; b < 2; ++b)
#pragma unroll
            for (int m = 0; m < 4; ++m)
#pragma unroll
                for (int n = 0; n < 2; ++n) acc[a][b][m][n] = (f32x4){0.f, 0.f, 0.f, 0.f};
    bf16x8 At[4][2], B0[2][2], B1[2][2];
    { const char* cA = cur.A; const char* cB = cur.B; const unsigned hA = (unsigned)HALF * cur.lda * 2, hB = (unsigned)HALF * cur.ldb * 2, qA = hA >> 1, qB = hB >> 1;
      if constexpr (SP2) {
          S_STAGE(G_SB(0, 0), cB, vB, qB); S_STAGE(G_SB(0, 1), cB + hB, vB, qB); S_STAGE(G_SA(0, 0), cA, vA, qA); S_STAGE(G_SA(0, 1), cA + hA, vA, qA);
          if (wr == 1) G_BAR;
          G_WAIT_V(2); G_BAR;
          S_STAGE(G_SB(1, 0), cB + kstep, vB, qB); S_STAGE(G_SA(1, 0), cA + kstep, vA, qA); S_STAGE(G_SB(1, 1), cB + hB + kstep, vB, qB);
          G_WAIT_V(6); G_BAR;
      } else {
          S_STAGE(G_SB(0, 0), cB, vB, qB); S_STAGE(G_SA(0, 0), cA, vA, qA); S_STAGE(G_SB(0, 1), cB + hB, vB, qB); S_STAGE(G_SA(0, 1), cA + hA, vA, qA);
          if (wr == 1) G_BAR;
          G_WAIT_V(4); G_BAR;
          S_STAGE(G_SB(1, 0), cB + kstep, vB, qB); S_STAGE(G_SA(1, 0), cA + kstep, vA, qA); S_STAGE(G_SB(1, 1), cB + hB + kstep, vB, qB);
          G_WAIT_V(6); G_BAR;
      } }
    for (int ui = 0;; ++ui) {
        const bool has_next = ui + 1 < nunits;
        if (has_next) P.desc(ui + 1, nxt); else nxt = cur;
        const unsigned nA = (unsigned)(sR * nxt.lda + sC), nB = (unsigned)(sRb * nxt.ldb + sC);
        const char* cA = cur.A; const char* cB = cur.B; const unsigned hA = (unsigned)HALF * cur.lda * 2, hB = (unsigned)HALF * cur.ldb * 2;
        const unsigned nhA = (unsigned)HALF * nxt.lda * 2, nhB = (unsigned)HALF * nxt.ldb * 2;
        const int nt = cur.K / BK;
        for (int t = 0; t < nt; t += 2) {
            const bool last = (t == nt - 2);
            const char* a1 = cA + (unsigned)(t + 1) * kstep;
            const char* a2 = last ? nxt.A : cA + (unsigned)(t + 2) * kstep; const char* b2 = last ? nxt.B : cB + (unsigned)(t + 2) * kstep;
            const char* a3 = a2 + kstep; const char* b3 = b2 + kstep;
            const unsigned hA2 = last ? nhA : hA, hB2 = last ? nhB : hB, qA = hA >> 1, qA2 = hA2 >> 1, qB2 = hB2 >> 1;
            const unsigned xA = last ? nA : vA, xB = last ? nB : vB;
            if constexpr (SP2) {
            G_LDB(B0, 0, 0); G_LDB(B1, 0, 1); G_SCHED; G_LDA(At, 0, 0); S_STAGE(G_SA(1, 1), a1 + hA, vA, qA);
            G_WAIT_V(8); G_WAIT_L(0); G_BAR; G_MMA(0, 0, At, B0); G_MMA(0, 1, At, B1); G_BAR; G_SCHED;
            G_LDA(At, 0, 1); S_STAGE(G_SB(0, 0), b2, xB, qB2); S_STAGE(G_SB(0, 1), b2 + hB2, xB, qB2); S_STAGE(G_SA(0, 0), a2, xA, qA2);
            G_WAIT_V(8); G_WAIT_L(0); G_BAR; G_MMA(1, 0, At, B0); G_MMA(1, 1, At, B1); G_BAR; G_SCHED;
            G_LDB(B0, 1, 0); G_LDB(B1, 1, 1); G_SCHED; G_LDA(At, 1, 0); S_STAGE(G_SA(0, 1), a2 + hA2, xA, qA2);
            G_WAIT_V(8); G_WAIT_L(0); G_BAR; G_MMA(0, 0, At, B0); G_MMA(0, 1, At, B1); G_BAR; G_SCHED;
            G_LDA(At, 1, 1); S_STAGE(G_SB(1, 0), b3, xB, qB2); S_STAGE(G_SB(1, 1), b3 + hB2, xB, qB2); S_STAGE(G_SA(1, 0), a3, xA, qA2);
            G_WAIT_V(8); G_WAIT_L(0); G_BAR; G_MMA(1, 0, At, B0); G_MMA(1, 1, At, B1); G_BAR; G_SCHED;
            } else {
            G_LDB(B0, 0, 0); G_SCHED; G_LDA(At, 0, 0); S_STAGE(G_SA(1, 1), a1 + hA, vA, qA);
            G_WAIT_L(8); G_BAR; G_WAIT_L(0); G_MMA(0, 0, At, B0); G_BAR; G_SCHED;
            G_LDB(B1, 0, 1); S_STAGE(G_SB(0, 0), b2, xB, qB2);
            G_BAR; G_WAIT_L(0); G_MMA(0, 1, At, B1); G_BAR;
            G_LDA(At, 0, 1); S_STAGE(G_SA(0, 0), a2, xA, qA2);
            G_BAR; G_WAIT_L(0); G_MMA(1, 0, At, B0); G_BAR; G_SCHED;
            S_STAGE(G_SB(0, 1), b2 + hB2, xB, qB2);
            G_WAIT_V(6); G_BAR; G_MMA(1, 1, At, B1); G_BAR;
            G_LDB(B0, 1, 0); G_SCHED; G_LDA(At, 1, 0); S_STAGE(G_SA(0, 1), a2 + hA2, xA, qA2);
            G_WAIT_L(8); G_BAR; G_WAIT_L(0); G_MMA(0, 0, At, B0); G_BAR; G_SCHED;
            G_LDB(B1, 1, 1); S_STAGE(G_SB(1, 0), b3, xB, qB2);
            G_BAR; G_WAIT_L(0); G_MMA(0, 1, At, B1); G_BAR;
            G_LDA(At, 1, 1); S_STAGE(G_SA(1, 0), a3, xA, qA2);
            G_BAR; G_WAIT_L(0); G_MMA(1, 0, At, B0); G_BAR; G_SCHED;
            S_STAGE(G_SB(1, 1), b3 + hB2, xB, qB2);
            G_WAIT_V(6); G_BAR; G_MMA(1, 1, At, B1); G_BAR;
            }
        }
        if constexpr (ALIGN_EPI) { if (wr == 0) G_BAR; }
        P.epi(ui, acc, wr, wc, fr, fq);
        if (!has_next) break;
#pragma unroll
        for (int a = 0; a < 2; ++a)
#pragma unroll
            for (int b = 0; b < 2; ++b)
#pragma unroll
                for (int m = 0; m < 4; ++m)
#pragma unroll
                    for (int n = 0; n < 2; ++n) acc[a][b][m][n] = (f32x4){0.f, 0.f, 0.f, 0.f};
        cur = nxt; vA = nA; vB = nB;
        if constexpr (ALIGN_EPI) { if (wr == 1) G_BAR; }
    }
    G_WAIT_V(0);
    if constexpr (!ALIGN_EPI) { if (wr == 0) G_BAR; }
    G_BAR;
    __syncthreads();
#undef S_STAGE
}

#define EPI_LOOP _Pragma("unroll") for (int ai = 0; ai < 2; ++ai) _Pragma("unroll") for (int m = 0; m < 4; ++m) _Pragma("unroll") for (int bj = 0; bj < 2; ++bj) _Pragma("unroll") for (int n = 0; n < 2; ++n)
#define EPI_ROW (ai * 128 + wr * 64 + m * 16 + fr)
#define EPI_COL (bj * 128 + wc * 32 + 8 * fq + 4 * n)

#define U4 _Pragma("unroll")
struct EpiStoreBf16 {
    bf16_t* O; size_t ldo; const float* bias; bool rowb;
    __device__ __forceinline__ void operator()(const AccT& acc, int wr, int wc, int fr, int fq) const {
        { const int tq_ = tidx(); wr = (tq_ >> 8) & 1; wc = (tq_ >> 6) & 3; fr = tq_ & 15; fq = (tq_ >> 4) & 3; }
        float br[2][4]; f32x4 bc[2][2];
        U4 for (int ai = 0; ai < 2; ++ai) U4 for (int m = 0; m < 4; ++m) br[ai][m] = rowb ? bias[ai * 128 + wr * 64 + m * 16 + fr] : 0.f;
        U4 for (int bj = 0; bj < 2; ++bj) U4 for (int n = 0; n < 2; ++n) bc[bj][n] = rowb ? (f32x4){0.f, 0.f, 0.f, 0.f} : *(const f32x4*)(bias + EPI_COL);
        U4 for (int ai = 0; ai < 2; ++ai) U4 for (int m = 0; m < 4; ++m) U4 for (int bj = 0; bj < 2; ++bj) { const int n = 0; const int r = EPI_ROW, c = EPI_COL;
            const f32x4 v0 = acc[ai][bj][m][0] + bc[bj][0] + br[ai][m], v1 = acc[ai][bj][m][1] + bc[bj][1] + br[ai][m];
            u32x4 w; w.x = cvt_pk_bf16(v0[0], v0[1]); w.y = cvt_pk_bf16(v0[2], v0[3]); w.z = cvt_pk_bf16(v1[0], v1[1]); w.w = cvt_pk_bf16(v1[2], v1[3]); *(u32x4*)(O + (size_t)r * ldo + c) = w; }
    }
};
__device__ __forceinline__ u32x4 pack8(const f32x4& a, const f32x4& b) { u32x4 w; w.x = cvt_pk_bf16(a[0], a[1]); w.y = cvt_pk_bf16(a[2], a[3]); w.z = cvt_pk_bf16(b[0], b[1]); w.w = cvt_pk_bf16(b[2], b[3]); return w; }
__device__ __forceinline__ f32x4 unpk_lo(const u32x4& w) { return (f32x4){lo16(w.x), hi16(w.x), lo16(w.y), hi16(w.y)}; }
__device__ __forceinline__ f32x4 unpk_hi(const u32x4& w) { return (f32x4){lo16(w.z), hi16(w.z), lo16(w.w), hi16(w.w)}; }
struct EpiGate {
    void* SG; const float* bias;
    __device__ __forceinline__ void operator()(const AccT& acc, int wr, int wc, int fr, int fq) const {
        { const int tq_ = tidx(); wr = (tq_ >> 8) & 1; wc = (tq_ >> 6) & 3; fr = tq_ & 15; fq = (tq_ >> 4) & 3; }
        f32x4 bc[2][2];
        U4 for (int bj = 0; bj < 2; ++bj) U4 for (int n = 0; n < 2; ++n) bc[bj][n] = *(const f32x4*)(bias + EPI_COL);
        u32x4* SGt = (u32x4*)SG + tidx();
        U4 for (int ai = 0; ai < 2; ++ai) U4 for (int m = 0; m < 4; ++m) U4 for (int bj = 0; bj < 2; ++bj) {
            f32x4 v0 = acc[ai][bj][m][0] + bc[bj][0], v1 = acc[ai][bj][m][1] + bc[bj][1];
            U4 for (int j = 0; j < 4; ++j) { v0[j] = sigmoidf_(v0[j]); v1[j] = sigmoidf_(v1[j]); }
            SGt[(ai * 8 + m * 2 + bj) * NTHREADS] = pack8(v0, v1); }
    }
};
struct EpiBranch {
    const void* SG; void* ST; bf16_t* MG; int first, last;
    __device__ __forceinline__ void operator()(const AccT& acc, int wr, int wc, int fr, int fq) const {
        { const int tq_ = tidx(); wr = (tq_ >> 8) & 1; wc = (tq_ >> 6) & 3; fr = tq_ & 15; fq = (tq_ >> 4) & 3; }
        const int tq = tidx(); const u32x4* SGt = (const u32x4*)SG + tq; u32x4* STt = (u32x4*)ST + tq;
        const u32x4 z4 = (u32x4){0u, 0u, 0u, 0u};
        u32x4 g[2][4], t[2][4];
        U4 for (int q = 0; q < 4; ++q) { g[0][q] = SGt[q * NTHREADS]; t[0][q] = first ? z4 : STt[q * NTHREADS]; }
        U4 for (int bt = 0; bt < 4; ++bt) { const int cb = bt & 1, nb = cb ^ 1;
            if (bt + 1 < 4) { U4 for (int q = 0; q < 4; ++q) { const int i2 = (bt + 1) * 4 + q; g[nb][q] = SGt[i2 * NTHREADS]; t[nb][q] = first ? z4 : STt[i2 * NTHREADS]; } }
            U4 for (int q = 0; q < 4; ++q) { const int ai = bt >> 1, m = 2 * (bt & 1) + (q >> 1), bj = q & 1, n = 0, i2 = bt * 4 + q; const int r = EPI_ROW, c = EPI_COL;
                const f32x4 v0 = acc[ai][bj][m][0] * unpk_lo(g[cb][q]) + unpk_lo(t[cb][q]), v1 = acc[ai][bj][m][1] * unpk_hi(g[cb][q]) + unpk_hi(t[cb][q]);
                const u32x4 w = pack8(v0, v1);
                if (last) *(u32x4*)(MG + (size_t)r * 1024 + c) = w; else STt[i2 * NTHREADS] = w; }
        }
    }
};
struct EpiResid {
    const float* xsrc; float* xdst; const float* gate;
    __device__ __forceinline__ void operator()(const AccT& acc, int wr, int wc, int fr, int fq) const {
        { const int tq_ = tidx(); wr = (tq_ >> 8) & 1; wc = (tq_ >> 6) & 3; fr = tq_ & 15; fq = (tq_ >> 4) & 3; }
        f32x4 gc[2][2];
        U4 for (int bj = 0; bj < 2; ++bj) U4 for (int n = 0; n < 2; ++n) gc[bj][n] = *(const f32x4*)(gate + EPI_COL);
        f32x4 xo[2][4];
        { const int ai = 0, m = 0; U4 for (int q = 0; q < 4; ++q) { const int bj = q >> 1, n = q & 1; xo[0][q] = *(const f32x4*)(xsrc + (size_t)EPI_ROW * 1024 + EPI_COL); } }
        U4 for (int bt = 0; bt < 8; ++bt) { const int cb = bt & 1, nb = cb ^ 1;
            if (bt + 1 < 8) { const int ai = (bt + 1) >> 2, m = (bt + 1) & 3; U4 for (int q = 0; q < 4; ++q) { const int bj = q >> 1, n = q & 1; xo[nb][q] = *(const f32x4*)(xsrc + (size_t)EPI_ROW * 1024 + EPI_COL); } }
            { const int ai = bt >> 2, m = bt & 3; U4 for (int q = 0; q < 4; ++q) { const int bj = q >> 1, n = q & 1; *(f32x4*)(xdst + (size_t)EPI_ROW * 1024 + EPI_COL) = xo[cb][q] + gc[bj][n] * acc[ai][bj][m][n]; } }
        }
    }
};
struct EpiSqrelu {
    bf16_t* H; int ldh;
    __device__ __forceinline__ void operator()(const AccT& acc, int wr, int wc, int fr, int fq) const {
        { const int tq_ = tidx(); wr = (tq_ >> 8) & 1; wc = (tq_ >> 6) & 3; fr = tq_ & 15; fq = (tq_ >> 4) & 3; }
        U4 for (int ai = 0; ai < 2; ++ai) U4 for (int m = 0; m < 4; ++m) U4 for (int bj = 0; bj < 2; ++bj) { const int n = 0; const int r = EPI_ROW, c = EPI_COL; f32x4 v0 = acc[ai][bj][m][0], v1 = acc[ai][bj][m][1];
#pragma unroll
            for (int j = 0; j < 4; ++j) { const float t0 = fmaxf(v0[j], 0.f), t1 = fmaxf(v1[j], 0.f); v0[j] = t0 * t0; v1[j] = t1 * t1; }
            u32x4 w; w.x = cvt_pk_bf16(v0[0], v0[1]); w.y = cvt_pk_bf16(v0[2], v0[3]); w.z = cvt_pk_bf16(v1[0], v1[1]); w.w = cvt_pk_bf16(v1[2], v1[3]); *(u32x4*)(H + (size_t)r * ldh + c) = w; }
    }
};

struct XMap { int NT, per_xcd, x, j, bpx;
    __device__ __forceinline__ void init(int xj, int ntt, int nt_) { NT = nt_; per_xcd = (ntt >> 3) * nt_; x = xj & 7; j = xj >> 3; bpx = (int)(gridDim.x >> 3); }
    __device__ __forceinline__ int rounds() const { return j < per_xcd ? (per_xcd - j + bpx - 1) / bpx : 0; }
    __device__ __forceinline__ void get(int i, int& tt, int& nt) const { const int q = i * bpx + j; tt = x + 8 * (q / NT); nt = q % NT; }
};
struct ProgInproj {
    const bf16_t* wt; const bf16_t* wg; const bf16_t* HX; bf16_t* T; bf16_t* PG; const float* biasT; const float* biasG; XMap MA, MB; int rA;
    __device__ __forceinline__ void desc(int i, UDesc& d) const { int tt, nt;
        if (i < rA) { MA.get(i, tt, nt); d.A = (const char*)(wt + (size_t)(nt * 256) * D); d.B = (const char*)(HX + (size_t)(tt * 256) * D); }
        else { MB.get(i - rA, tt, nt); d.A = (const char*)(HX + (size_t)(tt * 256) * D); d.B = (const char*)(wg + (size_t)(nt * 256) * D); }
        d.lda = D; d.ldb = D; d.K = D; }
    __device__ __forceinline__ void epi(int i, const AccT& acc, int wr, int wc, int fr, int fq) const { int tt, nt;
        if (i < rA) { MA.get(i, tt, nt); EpiStoreBf16 E{T + (size_t)(nt * 256) * TOK + (size_t)tt * 256, (size_t)TOK, biasT + nt * 256, true}; E(acc, wr, wc, fr, fq); }
        else { MB.get(i - rA, tt, nt); EpiStoreBf16 E{PG + (size_t)(tt * 256) * NG + nt * 256, (size_t)NG, biasG + nt * 256, false}; E(acc, wr, wc, fr, fq); } }
};
struct ProgMix {
    unsigned char* ws; unsigned char* scr; const float* bgate; unsigned tok0; int l;
    __device__ __forceinline__ void desc(int i, UDesc& d) const { const int nt = i / 6, j = i % 6, X = j >> 1;
        if (!(j & 1)) { d.A = (const char*)(ws + WS_HX) + (size_t)tok0 * D * 2; d.B = (const char*)(ws + WS_WGATE + l * SZ_WGATE) + (size_t)(X * 1024 + nt * 256) * D * 2; d.lda = D; d.ldb = D; d.K = D; }
        else { d.A = X == 0 ? (const char*)(scr + SC_TRY) : (X == 1 ? (const char*)(ws + WS_YG) + (size_t)tok0 * 1024 : (const char*)(scr + SC_TRP));
               d.B = (const char*)(ws + WS_WBR + (size_t)l * 3 * SZ_WBR) + (size_t)X * SZ_WBR + (size_t)(nt * 256) * 1024; d.lda = 512; d.ldb = 512; d.K = 512; } }
    __device__ __forceinline__ void epi(int i, const AccT& acc, int wr, int wc, int fr, int fq) const { const int nt = i / 6, j = i % 6, X = j >> 1;
        if (!(j & 1)) { EpiGate E{(void*)(scr + SC_SG), bgate + X * 1024 + nt * 256}; E(acc, wr, wc, fr, fq); }
        else { EpiBranch E{(const void*)(scr + SC_SG), (void*)(scr + SC_ST), (bf16_t*)(scr + SC_MERGED) + nt * 256, X == 0, X == 2}; E(acc, wr, wc, fr, fq); } }
};
struct ProgResid {
    const bf16_t* A; int lda; const bf16_t* W; int ldw, K; size_t wstep; const float* xsrc; float* xdst; const float* gate;
    __device__ __forceinline__ void desc(int i, UDesc& d) const { d.A = (const char*)A; d.B = (const char*)(W + (size_t)i * wstep); d.lda = lda; d.ldb = ldw; d.K = K; }
    __device__ __forceinline__ void epi(int i, const AccT& acc, int wr, int wc, int fr, int fq) const { EpiResid E{xsrc + i * 256, xdst + i * 256, gate + i * 256}; E(acc, wr, wc, fr, fq); }
};
struct ProgUp {
    const bf16_t* XN; const bf16_t* W; bf16_t* HID;
    __device__ __forceinline__ void desc(int i, UDesc& d) const { d.A = (const char*)XN; d.B = (const char*)(W + (size_t)(i * 256) * D); d.lda = D; d.ldb = D; d.K = D; }
    __device__ __forceinline__ void epi(int i, const AccT& acc, int wr, int wc, int fr, int fq) const { EpiSqrelu E{HID + i * 256, 2048}; E(acc, wr, wc, fr, fq); }
};


struct TileIO { const float* xin; const float* ctxin; float* out; float* ctxs; const float* modl; int l;
    __device__ __forceinline__ const float* src(int tt) const { return tt < 256 ? (l == 0 ? xin : out) + (size_t)tt * 256 * D : ctxin + (size_t)(tt - 256) * 256 * D; }
    __device__ __forceinline__ float* dst(int tt) const { return tt < 256 ? out + (size_t)tt * 256 * D : ctxs + (size_t)(tt - 256) * 256 * D; }
    __device__ __forceinline__ const float* cur(int tt) const { return tt < 256 ? out + (size_t)tt * 256 * D : ctxs + (size_t)(tt - 256) * 256 * D; }
    __device__ __forceinline__ const float* mod(int tt) const { return modl + (size_t)(tt < 256 ? tt >> 3 : 32) * 6144; }
};
struct ProgMix2 {
    unsigned char* ws; unsigned char* stash; const float* bgate; XMap M; int l;
    __device__ __forceinline__ void desc(int ii, UDesc& d) const { int tt, nt; M.get(ii / 6, tt, nt); const int s6 = ii % 6, X = s6 >> 1;
        if (!(s6 & 1)) { d.A = (const char*)(ws + WS_HX) + (size_t)tt * 256 * D * 2; d.B = (const char*)(ws + WS_WGATE + l * SZ_WGATE) + (size_t)(X * 1024 + nt * 256) * D * 2; d.lda = D; d.ldb = D; d.K = D; }
        else { d.A = (const char*)(ws + (X == 0 ? WS_YHY : (X == 1 ? WS_YG : WS_YPL))) + (size_t)tt * 256 * 1024;
               d.B = (const char*)(ws + WS_WBR + (size_t)l * 3 * SZ_WBR) + (size_t)X * SZ_WBR + (size_t)(nt * 256) * 1024; d.lda = 512; d.ldb = 512; d.K = 512; } }
    __device__ __forceinline__ void epi(int ii, const AccT& acc, int wr, int wc, int fr, int fq) const { int tt, nt; M.get(ii / 6, tt, nt); const int s6 = ii % 6, X = s6 >> 1;
        if (!(s6 & 1)) { EpiGate E{(void*)stash, bgate + X * 1024 + nt * 256}; E(acc, wr, wc, fr, fq); }
        else { EpiBranch E{(const void*)stash, (void*)(stash + 262144), (bf16_t*)(ws + WS_MERGED) + (size_t)tt * 256 * 1024 + nt * 256, X == 0, X == 2}; E(acc, wr, wc, fr, fq); } }
};
struct ProgOut2 {
    unsigned char* ws; TileIO io; XMap M; int l;
    __device__ __forceinline__ void desc(int i, UDesc& d) const { int tt, nt; M.get(i, tt, nt);
        d.A = (const char*)(ws + WS_MERGED) + (size_t)tt * 256 * 2048; d.B = (const char*)(ws + WS_WOUT + l * SZ_WOUT) + (size_t)(nt * 256) * D * 2; d.lda = D; d.ldb = D; d.K = D; }
    __device__ __forceinline__ void epi(int i, const AccT& acc, int wr, int wc, int fr, int fq) const { int tt, nt; M.get(i, tt, nt);
        EpiResid E{io.src(tt) + nt * 256, io.dst(tt) + nt * 256, io.mod(tt) + 2048 + nt * 256}; E(acc, wr, wc, fr, fq); }
};
struct ProgUp2 {
    unsigned char* ws; XMap M; int l;
    __device__ __forceinline__ void get(int i, int& tt, int& nt) const { if (M.bpx != 32) { M.get(i, tt, nt); return; }
        const int ttg = i >> 1, ntg = i & 1; tt = M.x + 8 * (ttg * 4 + (M.j >> 3)); nt = ntg * 8 + (M.j & 7); }
    __device__ __forceinline__ void desc(int i, UDesc& d) const { int tt, nt; get(i, tt, nt);
        d.A = (const char*)(ws + WS_HX) + (size_t)tt * 256 * 2048; d.B = (const char*)(ws + WS_WUP + l * SZ_WUP) + (size_t)(nt * 256) * D * 2; d.lda = D; d.ldb = D; d.K = D; }
    __device__ __forceinline__ void epi(int i, const AccT& acc, int wr, int wc, int fr, int fq) const { int tt, nt; get(i, tt, nt);
        EpiSqrelu E{(bf16_t*)(ws + WS_HID) + (size_t)tt * 256 * DFF + nt * 256, DFF}; E(acc, wr, wc, fr, fq); }
};
struct ProgDown2 {
    unsigned char* ws; TileIO io; XMap M; int l;
    __device__ __forceinline__ void desc(int i, UDesc& d) const { int tt, nt; M.get(i, tt, nt);
        d.A = (const char*)(ws + WS_HID) + (size_t)tt * 256 * DFF * 2; d.B = (const char*)(ws + WS_WDN + l * SZ_WDN) + (size_t)(nt * 256) * DFF * 2; d.lda = DFF; d.ldb = DFF; d.K = DFF; }
    __device__ __forceinline__ void epi(int i, const AccT& acc, int wr, int wc, int fr, int fq) const { int tt, nt; M.get(i, tt, nt);
        EpiResid E{io.cur(tt) + nt * 256, io.dst(tt) + nt * 256, io.mod(tt) + 5120 + nt * 256}; E(acc, wr, wc, fr, fq); }
};

__device__ __forceinline__ void tconv(const float* src, int ld, int c0, int nvalid, int ncols, int K, bf16_t* dst, LAS float* tile) {
    const int tid = tidx(), ntn = ncols / 64, ntile = ntn * (K / 64);
    float v[8];
    { const int t = blockIdx.x; if (t < ntile) { const int k0 = (t / ntn) * 64, n0 = (t % ntn) * 64;
#pragma unroll
        for (int i = 0; i < 8; ++i) { const int k = i * 8 + (tid >> 6), n = tid & 63; v[i] = (n0 + n < nvalid) ? src[(size_t)(k0 + k) * ld + c0 + n0 + n] : 0.f; } } }
    for (int t = blockIdx.x; t < ntile; t += gridDim.x) {
        const int k0 = (t / ntn) * 64, n0 = (t % ntn) * 64;
        __syncthreads();
#pragma unroll
        for (int i = 0; i < 8; ++i) { const int k = i * 8 + (tid >> 6), n = tid & 63; tile[k * 65 + n] = v[i]; }
        { const int t2 = t + gridDim.x; if (t2 < ntile) { const int k2 = (t2 / ntn) * 64, n2 = (t2 % ntn) * 64;
#pragma unroll
            for (int i = 0; i < 8; ++i) { const int k = i * 8 + (tid >> 6), n = tid & 63; v[i] = (n2 + n < nvalid) ? src[(size_t)(k2 + k) * ld + c0 + n2 + n] : 0.f; } } }
        __syncthreads();
        const int n = tid >> 3, kc = (tid & 7) * 8;
        u32x4 w;
        w.x = cvt_pk_bf16(tile[(kc + 0) * 65 + n], tile[(kc + 1) * 65 + n]); w.y = cvt_pk_bf16(tile[(kc + 2) * 65 + n], tile[(kc + 3) * 65 + n]);
        w.z = cvt_pk_bf16(tile[(kc + 4) * 65 + n], tile[(kc + 5) * 65 + n]); w.w = cvt_pk_bf16(tile[(kc + 6) * 65 + n], tile[(kc + 7) * 65 + n]);
        *(u32x4*)(dst + (size_t)(n0 + n) * K + k0 + kc) = w;
    }
    __syncthreads();
}

__device__ __forceinline__ void job_poolcomb(const Params& p, int l) {
    const float* pw = p.in[I_PW] + (size_t)l * 4 * 128 * 128; const float* sc = p.in[I_PSC] + l * 512; const float* wb = p.in[I_WBP] + (size_t)l * 512 * 1024;
    bf16_t* dst = (bf16_t*)(p.ws + WS_WBR + (size_t)(l * 3 + 2) * SZ_WBR);
    for (int idx = blockIdx.x * NTHREADS + tidx(); idx < 512 * 256; idx += gridDim.x * NTHREADS) {
        const int n = (idx & 255) * 4, k = idx >> 8, g = k >> 7, c = k & 127;
        f32x4 a = (f32x4){0.f, 0.f, 0.f, 0.f};
#pragma unroll 8
        for (int d = 0; d < 128; ++d) { const float ps = pw[(g * 128 + c) * 128 + d] * sc[g * 128 + d]; a += ps * *(const f32x4*)(wb + (size_t)(g * 128 + d) * 1024 + n); }
        dst[(size_t)n * 512 + k] = f2bf(a[0]); dst[(size_t)(n + 1) * 512 + k] = f2bf(a[1]); dst[(size_t)(n + 2) * 512 + k] = f2bf(a[2]); dst[(size_t)(n + 3) * 512 + k] = f2bf(a[3]);
    }
}

__device__ __forceinline__ void job_bias(const Params& p) {
    float* bias = (float*)(p.ws + WS_BIAS);
    for (int idx = blockIdx.x * NTHREADS + tidx(); idx < 2 * (NTR + NG); idx += gridDim.x * NTHREADS) {
        const int l = idx / (NTR + NG), j = idx % (NTR + NG); const float* b = p.in[I_BIN] + l * N_IN;
        float v;
        if (j < 1536) v = b[j]; else if (j < NTR) v = b[POOL_OFF + (j - 1536)]; else { const int q = j - NTR; v = q < NGV ? b[GLA_OFF + q] : 0.f; }
        bias[idx] = v;
    }
}

__device__ __forceinline__ void job_mod(const Params& p, LAS float* sil) {
    if (blockIdx.x >= 192) return;
    const int tid = tidx(), lane = tid & 63, kg = tid >> 6;
    float* mod = (float*)(p.ws + WS_MOD);
    for (int it = blockIdx.x; it < 192; it += gridDim.x) {
        __syncthreads();
        for (int idx = tid; idx < 33 * 1024; idx += NTHREADS) { const int r = idx >> 10, k = idx & 1023; const float v = r < 32 ? p.in[I_C][r * 1024 + k] : p.in[I_CCTX][k]; sil[idx] = v / (1.f + expf(-v)); }
        __syncthreads();
        const int l = it / 96, n0 = (it % 96) * 64;
        const float* w = p.in[I_WMOD] + (size_t)l * 1024 * 6144 + n0 + lane;
        float acc[33];
#pragma unroll
        for (int r = 0; r < 33; ++r) acc[r] = 0.f;
#pragma unroll 2
        for (int k4 = 0; k4 < 32; ++k4) { const int k = kg * 128 + k4 * 4;
            const float w0 = w[(size_t)k * 6144], w1 = w[(size_t)(k + 1) * 6144], w2 = w[(size_t)(k + 2) * 6144], w3 = w[(size_t)(k + 3) * 6144];
#pragma unroll
            for (int r = 0; r < 33; ++r) { const f32x4 sv = *(const LAS f32x4*)(sil + r * 1024 + k); acc[r] += sv[0] * w0 + sv[1] * w1 + sv[2] * w2 + sv[3] * w3; } }
        __syncthreads();
#pragma unroll
        for (int r = 0; r < 33; ++r) sil[(kg * 33 + r) * 64 + lane] = acc[r];
        __syncthreads();
        const float bm = p.in[I_BMOD][l * 6144 + n0 + lane];
        for (int r = kg; r < 33; r += 8) { float sum = 0.f;
#pragma unroll
            for (int q = 0; q < 8; ++q) sum += sil[(q * 33 + r) * 64 + lane];
            mod[(size_t)l * 33 * 6144 + (size_t)r * 6144 + n0 + lane] = sum + bm; }
    }
    __syncthreads();
}

__device__ __forceinline__ void job_filters(const Params& p, LAS unsigned char* lds) {
    LAS float* a1 = (LAS float*)lds;
    LAS float* a2 = (LAS float*)(lds + 16384);
    LAS bf16_t* oT = (LAS bf16_t*)(lds + 16384 + 16640);
    LAS float* w2L = (LAS float*)(lds + 16384 + 16640 + 73728);
    const int tid = tidx();
    const int nitems = (32 + 4 + 32) * 4;
    const int nrep = gridDim.x == 256 ? 2 : (nitems + (int)gridDim.x - 1) / (int)gridDim.x;
    for (int rep = 0; rep < nrep; ++rep) {
        int it;
        if (gridDim.x == 256) it = rep == 0 ? (int)blockIdx.x : ((blockIdx.x >= 192 && blockIdx.x < 208) ? 256 + (int)blockIdx.x - 192 : -1);
        else it = (int)blockIdx.x + rep * (int)gridDim.x;
        if (it < 0 || it >= nitems) continue;
        const int oc = it & 3; int rt = it >> 2; int l, L, t0; bf16_t* dst;
        if (rt < 32) { l = 0; L = 2048; t0 = rt * 64; dst = (bf16_t*)(p.ws + WS_HFL); }
        else if (rt < 36) { l = 0; L = 256; t0 = (rt - 32) * 64; dst = (bf16_t*)(p.ws + WS_HFC); }
        else { l = 1; L = 2048; t0 = (rt - 36) * 64; dst = (bf16_t*)(p.ws + WS_HFL) + (size_t)4 * 512 * 2048; }
        const float* w1 = p.in[I_FW1] + l * 17 * 64; const float* b1 = p.in[I_FB1] + l * 64; const float* fq = p.in[I_FFREQ] + l * 64;
        const float* w2 = p.in[I_FW2] + l * 64 * 64; const float* b2 = p.in[I_FB2] + l * 64; const float* w3 = p.in[I_FW3] + (size_t)l * 64 * 2048;
        __syncthreads();
#pragma unroll
        for (int q = 0; q < 2; ++q) *(LAS f32x4*)(w2L + (tid + q * NTHREADS) * 4) = *(const f32x4*)(w2 + (tid + q * NTHREADS) * 4);
        { const int row = tid >> 3, jg = (tid & 7) * 8; const float t = (float)(t0 + row); float z[17];
          z[0] = t / (float)L;
#pragma unroll
          for (int bnd = 1; bnd <= 8; ++bnd) { const float ang = (6.283185307179586f / (float)L) * t * (float)bnd; z[bnd] = cosf(ang); z[8 + bnd] = sinf(ang); }
#pragma unroll
          for (int j = 0; j < 8; ++j) { float s_ = b1[jg + j];
#pragma unroll
              for (int i = 0; i < 17; ++i) s_ += z[i] * w1[i * 64 + jg + j];
              a1[row * 64 + jg + j] = sinf(fq[jg + j] * s_); } }
        __syncthreads();
        { const int row = tid >> 3, jg = (tid & 7) * 8; float acc8[8];
#pragma unroll
          for (int j = 0; j < 8; ++j) acc8[j] = b2[jg + j];
#pragma unroll 4
          for (int i4 = 0; i4 < 64; i4 += 4) { const f32x4 av = *(const LAS f32x4*)(a1 + row * 64 + i4);
#pragma unroll
              for (int ii = 0; ii < 4; ++ii) { const f32x4 wa = *(const LAS f32x4*)(w2L + (i4 + ii) * 64 + jg), wb = *(const LAS f32x4*)(w2L + (i4 + ii) * 64 + jg + 4);
                  acc8[0] += av[ii] * wa[0]; acc8[1] += av[ii] * wa[1]; acc8[2] += av[ii] * wa[2]; acc8[3] += av[ii] * wa[3];
                  acc8[4] += av[ii] * wb[0]; acc8[5] += av[ii] * wb[1]; acc8[6] += av[ii] * wb[2]; acc8[7] += av[ii] * wb[3]; } }
#pragma unroll
          for (int j = 0; j < 8; ++j) a2[row * 65 + jg + j] = sinf(fq[jg + j] * acc8[j]); }
        __syncthreads();
        { const int o = oc * 512 + tid, c = o & 511; float wreg[64];
#pragma unroll
          for (int j = 0; j < 64; ++j) wreg[j] = w3[(size_t)j * 2048 + o];
          const float delta = 3.0701134573253943f + (float)c * ((15.350567286626972f - 3.0701134573253943f) / 511.f);
          for (int row = 0; row < 64; ++row) { float s = 0.f;
#pragma unroll
              for (int j = 0; j < 64; ++j) s += a2[row * 65 + j] * wreg[j];
              const float win = expf(-((float)(t0 + row) / (float)L) * delta);
              oT[tid * 72 + row] = f2bf(s * win); } }
        __syncthreads();
        for (int q = tid; q < 4096; q += NTHREADS) { const int ol = q >> 3, ch = (q & 7) * 8; const int o = oc * 512 + ol, dir = o >> 10, ord = (o >> 9) & 1, c = o & 511;
            const u32x4 w = *(const LAS u32x4*)(oT + ol * 72 + ch);
            *(u32x4*)(dst + ((size_t)((ord * 2 + dir) * 512 + c)) * L + t0 + ch) = w; }
    }
    __syncthreads();
}

__device__ __forceinline__ void ada_write(const f32x4 (&v)[4], float inv, const float* g, const float* sh, const float* sc, bf16_t* dst, float* fdst, int lane) {
#pragma unroll
    for (int i = 0; i < 4; ++i) { const int c = i * 256 + lane * 4; const f32x4 gg = *(const f32x4*)(g + c); f32x4 y = v[i] * inv * gg;
        if (sh) { const f32x4 s1 = *(const f32x4*)(sc + c), s0 = *(const f32x4*)(sh + c); y = y * (1.f + s1) + s0;
            u32x2 w; w.x = cvt_pk_bf16(y[0], y[1]); w.y = cvt_pk_bf16(y[2], y[3]); *(u32x2*)(dst + c) = w; }
        else *(f32x4*)(fdst + c) = y; }
}
__device__ __forceinline__ void ada_row2(const float* xa, const float* xb, bool hb, const float* g, const float* sha, const float* sca, const float* shb, const float* scb,
                                         bf16_t* da, bf16_t* db, float* fa, float* fb, int lane) {
    f32x4 va[4], vb[4]; float sa = 0.f, sb = 0.f;
#pragma unroll
    for (int i = 0; i < 4; ++i) va[i] = *(const f32x4*)(xa + i * 256 + lane * 4);
#pragma unroll
    for (int i = 0; i < 4; ++i) vb[i] = hb ? *(const f32x4*)(xb + i * 256 + lane * 4) : (f32x4){0.f, 0.f, 0.f, 0.f};
#pragma unroll
    for (int i = 0; i < 4; ++i) { sa += va[i][0] * va[i][0] + va[i][1] * va[i][1] + va[i][2] * va[i][2] + va[i][3] * va[i][3]; sb += vb[i][0] * vb[i][0] + vb[i][1] * vb[i][1] + vb[i][2] * vb[i][2] + vb[i][3] * vb[i][3]; }
#pragma unroll
    for (int o = 32; o >= 1; o >>= 1) { sa += __shfl_xor(sa, o); sb += __shfl_xor(sb, o); }
    ada_write(va, rsqrtf(sa * (1.f / 1024.f) + EPS), g, sha, sca, da, fa, lane);
    if (hb) ada_write(vb, rsqrtf(sb * (1.f / 1024.f) + EPS), g, shb, scb, db, fb, lane);
}
__device__ __forceinline__ void ada_row(const float* x, const float* g, const float* sh, const float* sc, bf16_t* dst, float* fdst, int lane) {
    f32x4 v[4]; float ss = 0.f;
#pragma unroll
    for (int i = 0; i < 4; ++i) { v[i] = *(const f32x4*)(x + i * 256 + lane * 4); ss += v[i][0] * v[i][0] + v[i][1] * v[i][1] + v[i][2] * v[i][2] + v[i][3] * v[i][3]; }
    ss = wave_sum(ss);
    const float inv = rsqrtf(ss * (1.f / 1024.f) + EPS);
#pragma unroll
    for (int i = 0; i < 4; ++i) { const int c = i * 256 + lane * 4; const f32x4 gg = *(const f32x4*)(g + c); f32x4 y = v[i] * inv * gg;
        if (sh) { const f32x4 s1 = *(const f32x4*)(sc + c), s0 = *(const f32x4*)(sh + c); y = y * (1.f + s1) + s0;
            u32x2 w; w.x = cvt_pk_bf16(y[0], y[1]); w.y = cvt_pk_bf16(y[2], y[3]); *(u32x2*)(dst + c) = w; }
        else *(f32x4*)(fdst + c) = y; }
}

typedef float f32x16 __attribute__((ext_vector_type(16)));
template <int L, int NT>
__device__ __forceinline__ void hyena_mfma(const Params& p, int l, int c, bool ctx, LAS unsigned char* lds) {
    LAS unsigned char* U = lds;
    LAS unsigned* F = (LAS unsigned*)(lds + L * 64);
    LAS bf16_t* F16 = (LAS bf16_t*)F;
    const int tid = tidx(), lane = tid & 63, w = __builtin_amdgcn_readfirstlane(tid >> 6), li = lane & 31, kg = lane >> 5;
    bf16_t* T = (bf16_t*)(p.ws + WS_T);
    const size_t tokb = ctx ? (size_t)TOKL : 0;
    const bf16_t* hf = ctx ? (const bf16_t*)(p.ws + WS_HFC) : (const bf16_t*)(p.ws + WS_HFL) + (size_t)l * 4 * 512 * 2048;
    const float* sw = p.in[I_HSW] + (size_t)l * 3 * 1536; const float* sb = p.in[I_HSB] + l * 1536;
    __syncthreads();
    {
        const int cc = 1024 + c; const bf16_t* row = T + (size_t)cc * TOK + tokb;
        const float w0 = sw[cc], w1 = sw[1536 + cc], w2 = sw[3072 + cc], bb = sb[cc];
        constexpr int ITER = L / 128, BATCH = ITER >= 4 ? 4 : ITER;
        for (int it0 = 0; it0 < ITER; it0 += BATCH) {
            u32x4 rr[BATCH]; bf16_t hm[BATCH], hp[BATCH];
#pragma unroll
            for (int q = 0; q < BATCH; ++q) { const int idx = tid + (it0 + q) * NTHREADS, bq = idx & 31, t8 = idx >> 5; const bf16_t* pr = row + (size_t)bq * L + t8 * 8;
                rr[q] = *(const u32x4*)pr; hm[q] = t8 > 0 ? pr[-1] : (bf16_t)0; hp[q] = t8 < L / 8 - 1 ? pr[8] : (bf16_t)0; }
#pragma unroll
            for (int q = 0; q < BATCH; ++q) { const int idx = tid + (it0 + q) * NTHREADS; const u32x4 r = rr[q];
                float x[10]; x[0] = bf2f(hm[q]); x[9] = bf2f(hp[q]);
                x[1] = lo16(r.x); x[2] = hi16(r.x); x[3] = lo16(r.y); x[4] = hi16(r.y); x[5] = lo16(r.z); x[6] = hi16(r.z); x[7] = lo16(r.w); x[8] = hi16(r.w);
                float y[8];
#pragma unroll
                for (int j = 0; j < 8; ++j) y[j] = w0 * x[j] + w1 * x[j + 1] + w2 * x[j + 2] + bb;
                u32x4 o; o.x = cvt_pk_bf16(y[0], y[1]); o.y = cvt_pk_bf16(y[2], y[3]); o.z = cvt_pk_bf16(y[4], y[5]); o.w = cvt_pk_bf16(y[6], y[7]);
                *(LAS u32x4*)(U + (size_t)idx * 16) = o; }
        }
    }
    const int lane_dw = (li & 1) * L + ((8 * kg - li + L - (li & 1)) >> 1);
#define HY_LOADA(dst, f) do { const LAS unsigned* _q = F + (lane_dw - 8 * (f)); u32x4 _v; _v.x = _q[0]; _v.y = _q[1]; _v.z = _q[2]; _v.w = _q[3]; dst = __builtin_bit_cast(bf16x8, _v); } while (0)
#define HY_LOADB(dst, s0) dst = *(const LAS bf16x8*)(U + ((s0) >> 3) * 512 + lane * 16)
    for (int ord = 0; ord < 2; ++ord) {
        __syncthreads();
        for (int x0 = tid; x0 < 2 * L; x0 += 4 * NTHREADS) {
            bf16_t fv[4];
#pragma unroll
            for (int q = 0; q < 4; ++q) { const int x = x0 + q * NTHREADS; bf16_t v = 0;
                if (x >= 1 && x <= L) v = hf[((size_t)((ord * 2 + 0) * 512 + c)) * L + (L - x)];
                else if (x > L && x < 2 * L) v = hf[((size_t)((ord * 2 + 1) * 512 + c)) * L + (x - L)];
                fv[q] = v; }
#pragma unroll
            for (int q = 0; q < 4; ++q) { const int x = x0 + q * NTHREADS; const bf16_t v = fv[q];
                if (x < 2 * L) { F16[x] = v; if (x >= 1) F16[2 * L + x - 1] = v; if (x == 2 * L - 1) F16[4 * L - 1] = 0; } } }
        if (false) for (int x = tid; x < 0; ++x) {
            bf16_t v = 0;
            if (x >= 1 && x <= L) v = hf[((size_t)((ord * 2 + 0) * 512 + c)) * L + (L - x)];
            else if (x > L) v = hf[((size_t)((ord * 2 + 1) * 512 + c)) * L + (x - L)];
            F16[x] = v; if (x >= 1) F16[2 * L + x - 1] = v; if (x == 2 * L - 1) F16[4 * L - 1] = 0; }
        __syncthreads();
        f32x16 acc[NT];
#pragma unroll
        for (int i = 0; i < NT; ++i)
#pragma unroll
            for (int r = 0; r < 16; ++r) acc[i][r] = 0.f;
        bf16x8 E[NT], O[NT];
#pragma unroll
        for (int i = 1; i < NT; ++i) { HY_LOADA(E[i], 2 * (NT * w + i)); HY_LOADA(O[i], 2 * (NT * w + i) - 1); }
        for (int n8 = 0; n8 < L / 32; n8 += 8) {
#pragma unroll
            for (int u = 0; u < 8; ++u) { const int n = n8 + u; const int fe = 2 * (NT * w - n); bf16x8 Bf;
                HY_LOADA(E[(8 - u) & (NT - 1)], fe); HY_LOADB(Bf, 32 * n);
#pragma unroll
                for (int i = 0; i < NT; ++i) acc[i] = __builtin_amdgcn_mfma_f32_32x32x16_bf16(E[(i - u) & (NT - 1)], Bf, acc[i], 0, 0, 0);
                HY_LOADA(O[(8 - u) & (NT - 1)], fe - 1); HY_LOADB(Bf, 32 * n + 16);
#pragma unroll
                for (int i = 0; i < NT; ++i) acc[i] = __builtin_amdgcn_mfma_f32_32x32x16_bf16(O[(i - u) & (NT - 1)], Bf, acc[i], 0, 0, 0);
            }
        }
        __syncthreads();
        const int lane2 = tidx() & 63, li = lane2 & 31, kg = lane2 >> 5;
        const int xc = ord * 512 + c; const bf16_t* xrow = T + (size_t)xc * TOK + tokb + (size_t)li * L;
        bf16_t* orow = T + (size_t)c * TOK + tokb + (size_t)li * L;
        const float w0 = sw[xc], w1 = sw[1536 + xc], w2 = sw[3072 + xc], bb = sb[xc], sk = p.in[I_HSKIP][(l * 2 + ord) * 512 + c];
#pragma unroll
        for (int i = 0; i < NT; ++i) {
#pragma unroll
            for (int rh = 0; rh < 4; rh += 2) {
            u32x2 xr4[2]; bf16_t hm[2], hp[2];
#pragma unroll
            for (int r2 = 0; r2 < 2; ++r2) { const int rg = rh + r2; const int tb = 32 * (NT * w + i) + 8 * rg + 4 * kg;
                xr4[r2] = *(const u32x2*)(xrow + tb); hm[r2] = tb > 0 ? xrow[tb - 1] : (bf16_t)0; hp[r2] = tb + 4 < L ? xrow[tb + 4] : (bf16_t)0; }
#pragma unroll
            for (int r2 = 0; r2 < 2; ++r2) { const int rg = rh + r2; const int tb = 32 * (NT * w + i) + 8 * rg + 4 * kg; const u32x2 xr = xr4[r2];
                float x[6]; x[0] = bf2f(hm[r2]); x[5] = bf2f(hp[r2]);
                x[1] = lo16(xr.x); x[2] = hi16(xr.x); x[3] = lo16(xr.y); x[4] = hi16(xr.y);
                LAS u32x2* up = (LAS u32x2*)(U + ((tb >> 3) * 32 + li) * 16 + (tb & 7) * 2);
                const u32x2 uv = *up; const float uu[4] = {lo16(uv.x), hi16(uv.x), lo16(uv.y), hi16(uv.y)};
                float z[4];
#pragma unroll
                for (int j = 0; j < 4; ++j) z[j] = (w0 * x[j] + w1 * x[j + 1] + w2 * x[j + 2] + bb) * (acc[i][rg * 4 + j] + sk * uu[j]);
                u32x2 o; o.x = cvt_pk_bf16(z[0], z[1]); o.y = cvt_pk_bf16(z[2], z[3]);
                if (ord == 0) *up = o; else *(u32x2*)(orow + tb) = o; }
            }
        }
    }
#undef HY_LOADA
#undef HY_LOADB
    __syncthreads();
}

__device__ __forceinline__ void gla_item(const Params& p, int l, int b, int h, int dir, LAS float* lf) {
    const int tid = tidx(), qd = tid & 3, dv = tid >> 2;
    LAS float* qL = lf; LAS float* kL = lf + 2048; LAS float* aL = lf + 4096; LAS float* vL = lf + 6144; LAS float* oL = lf + 10240; LAS float* waL = lf + 14336; LAS float* baL = lf + 15360;
    const bf16_t* PG = (const bf16_t*)(p.ws + WS_PG);
    bf16_t* O = (bf16_t*)(p.ws + WS_OF) + (size_t)dir * TOK * 512;
    const float* wa = (dir ? p.in[I_WAB] : p.in[I_WAF]) + l * 16 * 256; const float* ba = (dir ? p.in[I_BAB] : p.in[I_BAF]) + l * 256;
    __syncthreads();
    for (int i = tid; i < 1024; i += NTHREADS) waL[i] = wa[(i >> 6) * 256 + h * 64 + (i & 63)];
    if (tid < 64) baL[tid] = ba[h * 64 + tid];
    float S[16];
#pragma unroll
    for (int i = 0; i < 16; ++i) S[i] = 0.f;
    const int sp = tid >> 4, sc4 = (tid & 15) * 4, sc8 = (tid & 15) * 8;
    for (int ck = 0; ck < 72; ++ck) {
        const int P = ck * 32 + sp; size_t row;
        if (P < 256) row = (size_t)TOKL + b * 256 + (dir ? 255 - P : P); else { const int tl = P - 256; row = (size_t)b * 2048 + (dir ? 2047 - tl : tl); }
        const bf16_t* pr = PG + row * NG;
        __syncthreads();
        { const u32x2 wq = *(const u32x2*)(pr + h * 64 + sc4), wk = *(const u32x2*)(pr + 256 + h * 64 + sc4);
          *(LAS f32x4*)(qL + sp * 64 + sc4) = (f32x4){lo16(wq.x) * 0.125f, hi16(wq.x) * 0.125f, lo16(wq.y) * 0.125f, hi16(wq.y) * 0.125f};
          *(LAS f32x4*)(kL + sp * 64 + sc4) = (f32x4){lo16(wk.x), hi16(wk.x), lo16(wk.y), hi16(wk.y)};
          const u32x4 wv = *(const u32x4*)(pr + 512 + h * 128 + sc8);
          *(LAS f32x4*)(vL + sp * 128 + sc8) = (f32x4){lo16(wv.x), hi16(wv.x), lo16(wv.y), hi16(wv.y)};
          *(LAS f32x4*)(vL + sp * 128 + sc8 + 4) = (f32x4){lo16(wv.z), hi16(wv.z), lo16(wv.w), hi16(wv.w)};
          const u32x4 g0 = *(const u32x4*)(pr + 1536 + dir * 16), g1 = *(const u32x4*)(pr + 1536 + dir * 16 + 8);
          float gt[16] = {lo16(g0.x), hi16(g0.x), lo16(g0.y), hi16(g0.y), lo16(g0.z), hi16(g0.z), lo16(g0.w), hi16(g0.w),
                          lo16(g1.x), hi16(g1.x), lo16(g1.y), hi16(g1.y), lo16(g1.z), hi16(g1.z), lo16(g1.w), hi16(g1.w)};
#pragma unroll
          for (int j = 0; j < 4; ++j) { float z = baL[sc4 + j];
#pragma unroll
              for (int r = 0; r < 16; ++r) z += gt[r] * waL[r * 64 + sc4 + j];
              const float ls = -(fmaxf(-z, 0.f) + log1pf(expf(-fabsf(z))));
              aL[sp * 64 + sc4 + j] = expf(ls * (1.f / 16.f)); } }
        __syncthreads();
        for (int pos = 0; pos < 32; ++pos) {
            const float vv = vL[pos * 128 + dv]; float part = 0.f;
#pragma unroll
            for (int i4 = 0; i4 < 4; ++i4) { const f32x4 aa = *(const LAS f32x4*)(aL + pos * 64 + qd * 16 + i4 * 4), kk = *(const LAS f32x4*)(kL + pos * 64 + qd * 16 + i4 * 4), qq = *(const LAS f32x4*)(qL + pos * 64 + qd * 16 + i4 * 4);
#pragma unroll
                for (int j = 0; j < 4; ++j) { S[i4 * 4 + j] = aa[j] * S[i4 * 4 + j] + kk[j] * vv; part += qq[j] * S[i4 * 4 + j]; } }
            part += __shfl_xor(part, 1); part += __shfl_xor(part, 2);
            if (qd == 0) oL[pos * 128 + dv] = part;
        }
        __syncthreads();
        { const f32x4 o0 = *(const LAS f32x4*)(oL + sp * 128 + sc8), o1 = *(const LAS f32x4*)(oL + sp * 128 + sc8 + 4);
          u32x4 w; w.x = cvt_pk_bf16(o0[0], o0[1]); w.y = cvt_pk_bf16(o0[2], o0[3]); w.z = cvt_pk_bf16(o1[0], o1[1]); w.w = cvt_pk_bf16(o1[2], o1[3]);
          *(u32x4*)(O + row * 512 + h * 128 + sc8) = w; }
    }
    __syncthreads();
}


__device__ __forceinline__ size_t gla_row(int P, int b, int dir) { return P < 256 ? (size_t)TOKL + b * 256 + (dir ? 255 - P : P) : (size_t)b * 2048 + (dir ? 2047 - (P - 256) : (P - 256)); }
__device__ __forceinline__ void gla_chunk_item(const Params& p, int l, int b, int h, int dir, LAS unsigned char* lds) {
    constexpr int RS = 72;
    LAS bf16_t* QD = (LAS bf16_t*)lds; LAS bf16_t* KI = QD + 64 * RS; LAS bf16_t* KET = KI + 64 * RS; LAS bf16_t* PP = KET + 64 * RS;
    LAS bf16_t* VT = PP + 64 * RS; LAS bf16_t* ST = VT + 128 * RS;
    LAS float* TOT = (LAS float*)(ST + 128 * RS); LAS float* DEC = TOT + 512; LAS float* WAL = DEC + 64; LAS float* BAL = WAL + 1024;
    const int tid = tidx(), lane = tid & 63, w = __builtin_amdgcn_readfirstlane(tid >> 6), i = tid >> 3, dg = tid & 7, d0 = dg * 8, l5 = lane & 31, hh = lane >> 5;
    const int ih = w >> 2, vq = w & 3;
    const bf16_t* PG = (const bf16_t*)(p.ws + WS_PG);
    bf16_t* O = (bf16_t*)(p.ws + WS_OF) + (size_t)dir * TOK * 512;
    const float* wa = (dir ? p.in[I_WAB] : p.in[I_WAF]) + l * 16 * 256; const float* ba = (dir ? p.in[I_BAB] : p.in[I_BAF]) + l * 256;
    __syncthreads();
    for (int q = tid; q < 1024; q += NTHREADS) WAL[q] = wa[(q >> 6) * 256 + h * 64 + (q & 63)];
    if (tid < 64) BAL[tid] = ba[h * 64 + tid];
    for (int q = tid; q < 73728 / 16; q += NTHREADS) *(LAS u32x4*)(lds + q * 16) = (u32x4){0u, 0u, 0u, 0u};
    f32x16 accS;
#pragma unroll
    for (int r = 0; r < 16; ++r) accS[r] = 0.f;
    u32x4 rq, rk, rg0, rg1, rv0, rv1;
    { const bf16_t* pr = PG + gla_row(i, b, dir) * NG;
      rq = *(const u32x4*)(pr + h * 64 + d0); rk = *(const u32x4*)(pr + 256 + h * 64 + d0); rg0 = *(const u32x4*)(pr + 1536 + dir * 16); rg1 = *(const u32x4*)(pr + 1536 + dir * 16 + 8);
      rv0 = *(const u32x4*)(pr + 512 + h * 128 + dg * 16); rv1 = *(const u32x4*)(pr + 512 + h * 128 + dg * 16 + 8); }
    __syncthreads();
    for (int ck = 0; ck < 36; ++ck) {
        float qf[8] = {lo16(rq.x), hi16(rq.x), lo16(rq.y), hi16(rq.y), lo16(rq.z), hi16(rq.z), lo16(rq.w), hi16(rq.w)};
        float kf[8] = {lo16(rk.x), hi16(rk.x), lo16(rk.y), hi16(rk.y), lo16(rk.z), hi16(rk.z), lo16(rk.w), hi16(rk.w)};
        float gt[16] = {lo16(rg0.x), hi16(rg0.x), lo16(rg0.y), hi16(rg0.y), lo16(rg0.z), hi16(rg0.z), lo16(rg0.w), hi16(rg0.w),
                        lo16(rg1.x), hi16(rg1.x), lo16(rg1.y), hi16(rg1.y), lo16(rg1.z), hi16(rg1.z), lo16(rg1.w), hi16(rg1.w)};
        float la[8];
#pragma unroll
        for (int j = 0; j < 8; ++j) { float z = BAL[d0 + j];
#pragma unroll
            for (int r = 0; r < 16; ++r) z += gt[r] * WAL[r * 64 + d0 + j];
            la[j] = -(fmaxf(-z, 0.f) + __logf(1.f + __expf(-fabsf(z)))) * (1.f / 16.f); }
#pragma unroll
        for (int st = 8; st < 64; st <<= 1) {
#pragma unroll
            for (int j = 0; j < 8; ++j) { const float y = __shfl_up(la[j], st); if (lane >= st) la[j] += y; } }
        if ((lane >> 3) == 7) { *(LAS f32x4*)(TOT + w * 64 + d0) = (f32x4){la[0], la[1], la[2], la[3]}; *(LAS f32x4*)(TOT + w * 64 + d0 + 4) = (f32x4){la[4], la[5], la[6], la[7]}; }
        __syncthreads();
        {
            float pre[8], bl[8];
#pragma unroll
            for (int j = 0; j < 8; ++j) { pre[j] = 0.f; bl[j] = 0.f; }
#pragma unroll
            for (int ww = 0; ww < 8; ++ww) { const f32x4 t0 = *(const LAS f32x4*)(TOT + ww * 64 + d0), t1 = *(const LAS f32x4*)(TOT + ww * 64 + d0 + 4);
                const float tv[8] = {t0[0], t0[1], t0[2], t0[3], t1[0], t1[1], t1[2], t1[3]};
#pragma unroll
                for (int j = 0; j < 8; ++j) { bl[j] += tv[j]; if (ww < w) pre[j] += tv[j]; } }
            float qd[8], ki[8], ke[8], eb[8];
#pragma unroll
            for (int j = 0; j < 8; ++j) { const float bc = la[j] + pre[j]; const float e1 = __expf(bc), e2 = __builtin_amdgcn_rcpf(e1); eb[j] = __expf(bl[j]);
                qd[j] = qf[j] * 0.125f * e1; ki[j] = kf[j] * e2; ke[j] = kf[j] * (eb[j] * e2); }
            u32x4 wq, wk;
            wq.x = cvt_pk_bf16(qd[0], qd[1]); wq.y = cvt_pk_bf16(qd[2], qd[3]); wq.z = cvt_pk_bf16(qd[4], qd[5]); wq.w = cvt_pk_bf16(qd[6], qd[7]);
            wk.x = cvt_pk_bf16(ki[0], ki[1]); wk.y = cvt_pk_bf16(ki[2], ki[3]); wk.z = cvt_pk_bf16(ki[4], ki[5]); wk.w = cvt_pk_bf16(ki[6], ki[7]);
            *(LAS u32x4*)(QD + i * RS + d0) = wq; *(LAS u32x4*)(KI + i * RS + d0) = wk;
#pragma unroll
            for (int j = 0; j < 8; j += 2) { const unsigned pk = cvt_pk_bf16(ke[j], ke[j + 1]); KET[(d0 + j) * RS + i] = (bf16_t)(pk & 0xffffu); KET[(d0 + j + 1) * RS + i] = (bf16_t)(pk >> 16); }
            const unsigned vv[8] = {rv0.x, rv0.y, rv0.z, rv0.w, rv1.x, rv1.y, rv1.z, rv1.w};
#pragma unroll
            for (int j = 0; j < 8; ++j) { VT[(dg * 16 + 2 * j) * RS + i] = (bf16_t)(vv[j] & 0xffffu); VT[(dg * 16 + 2 * j + 1) * RS + i] = (bf16_t)(vv[j] >> 16); }
            if (i == 0) { *(LAS f32x4*)(DEC + d0) = (f32x4){eb[0], eb[1], eb[2], eb[3]}; *(LAS f32x4*)(DEC + d0 + 4) = (f32x4){eb[4], eb[5], eb[6], eb[7]}; }
        }
        if (ck + 1 < 36) { const bf16_t* pr = PG + gla_row((ck + 1) * 64 + i, b, dir) * NG;
            rq = *(const u32x4*)(pr + h * 64 + d0); rk = *(const u32x4*)(pr + 256 + h * 64 + d0); rg0 = *(const u32x4*)(pr + 1536 + dir * 16); rg1 = *(const u32x4*)(pr + 1536 + dir * 16 + 8);
            rv0 = *(const u32x4*)(pr + 512 + h * 128 + dg * 16); rv1 = *(const u32x4*)(pr + 512 + h * 128 + dg * 16 + 8); }
        __syncthreads();
        f32x16 accO;
#pragma unroll
        for (int r = 0; r < 16; ++r) accO[r] = 0.f;
#pragma unroll
        for (int ks = 0; ks < 4; ++ks) { const bf16x8 A = *(const LAS bf16x8*)(QD + (ih * 32 + l5) * RS + ks * 16 + hh * 8), Bv = *(const LAS bf16x8*)(ST + (vq * 32 + l5) * RS + ks * 16 + hh * 8);
            accO = __builtin_amdgcn_mfma_f32_32x32x16_bf16(A, Bv, accO, 0, 0, 0); }
        if (w < 3) { const int si = w == 0 ? 0 : 1, sj = w == 2 ? 1 : 0; f32x16 accP;
#pragma unroll
            for (int r = 0; r < 16; ++r) accP[r] = 0.f;
#pragma unroll
            for (int ks = 0; ks < 4; ++ks) { const bf16x8 A = *(const LAS bf16x8*)(QD + (si * 32 + l5) * RS + ks * 16 + hh * 8), Bv = *(const LAS bf16x8*)(KI + (sj * 32 + l5) * RS + ks * 16 + hh * 8);
                accP = __builtin_amdgcn_mfma_f32_32x32x16_bf16(A, Bv, accP, 0, 0, 0); }
#pragma unroll
            for (int r = 0; r < 16; ++r) { const int ii = si * 32 + (r & 3) + 8 * (r >> 2) + 4 * hh, jj = sj * 32 + l5; PP[ii * RS + jj] = f2bf(jj <= ii ? accP[r] : 0.f); } }
        __syncthreads();
        { const int nk = ih == 0 ? 2 : 4;
          for (int ks = 0; ks < nk; ++ks) { const bf16x8 A = *(const LAS bf16x8*)(PP + (ih * 32 + l5) * RS + ks * 16 + hh * 8), Bv = *(const LAS bf16x8*)(VT + (vq * 32 + l5) * RS + ks * 16 + hh * 8);
              accO = __builtin_amdgcn_mfma_f32_32x32x16_bf16(A, Bv, accO, 0, 0, 0); } }
#pragma unroll
        for (int rg = 0; rg < 4; ++rg) { const f32x4 dv = *(const LAS f32x4*)(DEC + ih * 32 + 8 * rg + 4 * hh);
#pragma unroll
            for (int j = 0; j < 4; ++j) accS[rg * 4 + j] *= dv[j]; }
#pragma unroll
        for (int ks = 0; ks < 4; ++ks) { const bf16x8 A = *(const LAS bf16x8*)(KET + (ih * 32 + l5) * RS + ks * 16 + hh * 8), Bv = *(const LAS bf16x8*)(VT + (vq * 32 + l5) * RS + ks * 16 + hh * 8);
            accS = __builtin_amdgcn_mfma_f32_32x32x16_bf16(A, Bv, accS, 0, 0, 0); }
#pragma unroll
        for (int r = 0; r < 16; ++r) { const int ii = ih * 32 + (r & 3) + 8 * (r >> 2) + 4 * hh;
            O[gla_row(ck * 64 + ii, b, dir) * 512 + h * 128 + vq * 32 + l5] = f2bf(accO[r]); }
#pragma unroll
        for (int rg = 0; rg < 4; ++rg) { u32x2 o; o.x = cvt_pk_bf16(accS[rg * 4], accS[rg * 4 + 1]); o.y = cvt_pk_bf16(accS[rg * 4 + 2], accS[rg * 4 + 3]);
            *(LAS u32x2*)(ST + (vq * 32 + l5) * RS + ih * 32 + 8 * rg + 4 * hh) = o; }
        __syncthreads();
    }
    __syncthreads();
}

template <int W>
__device__ __forceinline__ void pool2d_wave(bf16_t* base, int lane) {
    float u[32], pv[33];
#pragma unroll
    for (int r = 0; r < 32; ++r) u[r] = bf2f(base[r * 64 + lane]);
    pv[0] = 0.f;
#pragma unroll
    for (int r = 0; r < 32; ++r) pv[r + 1] = pv[r] + u[r];
    const int cl = max(lane - W / 2, 0), chh = min(lane - W / 2 + W, 64);
#pragma unroll
    for (int r = 0; r < 32; ++r) {
        const int rl = (r - W / 2) < 0 ? 0 : (r - W / 2), rh = (r - W / 2 + W) > 32 ? 32 : (r - W / 2 + W);
        float x = pv[rh] - pv[rl];
#pragma unroll
        for (int d = 1; d < 64; d <<= 1) { const float y = __shfl_up(x, d); if (lane >= d) x += y; }
        const float hi = __shfl(x, chh - 1), lo = __shfl(x, cl > 0 ? cl - 1 : 0);
        const float s = hi - (cl > 0 ? lo : 0.f);
        const float cnt = (float)((rh - rl) * (chh - cl));
        base[r * 64 + lane] = f2bf(s / cnt - u[r]);
    }
}
__device__ __forceinline__ void pool1d_wave(bf16_t* base, int lane, int W) {
    float u[4], P[4];
#pragma unroll
    for (int j = 0; j < 4; ++j) u[j] = bf2f(base[j * 64 + lane]);
    float off = 0.f;
#pragma unroll
    for (int j = 0; j < 4; ++j) { float x = u[j];
#pragma unroll
        for (int d = 1; d < 64; d <<= 1) { const float y = __shfl_up(x, d); if (lane >= d) x += y; }
        P[j] = x + off; off += __shfl(x, 63); }
#pragma unroll
    for (int j = 0; j < 4; ++j) { const int t = j * 64 + lane; const int lo = max(t - W / 2, 0), hi = min(t - W / 2 + W, 256);
        const int ih = hi - 1, il = lo > 0 ? lo - 1 : 0;
        float vh = 0.f, vl = 0.f;
#pragma unroll
        for (int s = 0; s < 4; ++s) { const float a = __shfl(P[s], ih & 63), bq = __shfl(P[s], il & 63); if ((ih >> 6) == s) vh = a; if ((il >> 6) == s) vl = bq; }
        const float sum = vh - (lo > 0 ? vl : 0.f);
        u[j] = sum / (float)(hi - lo) - u[j]; }
#pragma unroll
    for (int j = 0; j < 4; ++j) base[j * 64 + lane] = f2bf(u[j]);
}

__global__ void __launch_bounds__(NTHREADS, 2) mega(Params p) {
    extern __shared__ __attribute__((aligned(16))) unsigned char lds_raw[];
    LAS unsigned char* lds = (LAS unsigned char*)lds_raw;
    LAS float* lf = (LAS float*)lds;
    cg::grid_group grid = cg::this_grid();
    unsigned bar_n = 0; unsigned* bar_ctr = (unsigned*)(p.ws + WS_BAR);
unsigned hb_k = 0, hb_xcc = 0, hb_nloc = 0, hb_nx = 0;
#define GBAR() do { if (hb_nloc == 0u) { bar_n += gridDim.x; gbar(bar_ctr, bar_n); } else { ++hb_k; gbar_h(bar_ctr, hb_xcc, hb_nloc, hb_nx, hb_k); } } while (0)
    const int G = gridDim.x, bid = blockIdx.x;
#define WSPTRS const int tid = tidx(), lane = tid & 63, wid = tid >> 6; (void)lane; (void)wid; unsigned char* ws = opq(p.ws); bf16_t* HX = (bf16_t*)(ws + WS_HX); bf16_t* T = (bf16_t*)(ws + WS_T); bf16_t* YG = (bf16_t*)(ws + WS_YG); bf16_t* PG = (bf16_t*)(ws + WS_PG); \
    float* CTXS = (float*)(ws + WS_CTX); const float* MOD = (const float*)(ws + WS_MOD); const float* BIAS = (const float*)(ws + WS_BIAS); (void)HX; (void)T; (void)YG; (void)PG; (void)CTXS; (void)MOD; (void)BIAS;

#ifdef TIMEX
    unsigned long long tx0 = 0, tx1 = 0; int txn = 0;
#define TX_MARK() do { if (txn == TIMEX) tx0 = __builtin_amdgcn_s_memrealtime(); if (txn == TIMEX + 1) tx1 = __builtin_amdgcn_s_memrealtime(); ++txn; } while (0)
    unsigned long long cx0 = 0, cxacc = 0;
#define CX_BEGIN(k) do { if (TIMEX == 100 + (k) && l == 1) { __syncthreads(); cx0 = __builtin_amdgcn_s_memrealtime(); } } while (0)
#define CX_END(k) do { if (TIMEX == 100 + (k) && l == 1) { __syncthreads(); cxacc += __builtin_amdgcn_s_memrealtime() - cx0; } } while (0)
#else
#define TX_MARK() do {} while (0)
#define CX_BEGIN(k) do {} while (0)
#define CX_END(k) do {} while (0)
#endif
    if (threadIdx.x == 0) { unsigned* ctl = (unsigned*)(p.ws + WS_BAR); const unsigned xcc = (unsigned)__builtin_amdgcn_s_getreg((3 << 11) | 20) & 7u;
        const unsigned rank = __hip_atomic_fetch_add(ctl + 16 + xcc, 1u, __ATOMIC_RELAXED, __HIP_MEMORY_SCOPE_AGENT);
        __hip_atomic_store(ctl + 256 + 2 * blockIdx.x, xcc, __ATOMIC_RELAXED, __HIP_MEMORY_SCOPE_AGENT); __hip_atomic_store(ctl + 257 + 2 * blockIdx.x, rank, __ATOMIC_RELAXED, __HIP_MEMORY_SCOPE_AGENT); }
    int xj = (int)blockIdx.x;
    TX_MARK();
    for (int l = 0; l < 2; ++l) {
        unsigned char* ws = opq(p.ws);
        const float* win = p.in[I_WIN] + (size_t)l * D * N_IN;
        bf16_t* wt = (bf16_t*)(ws + WS_WT + l * SZ_WT);
        tconv(win, N_IN, 0, 1536, 1536, D, wt, lf);
        tconv(win, N_IN, POOL_OFF, 512, 512, D, wt + (size_t)1536 * D, lf);
        tconv(win, N_IN, GLA_OFF, NGV, NG, D, (bf16_t*)(ws + WS_WG + l * SZ_WG), lf);
        tconv(win, N_IN, GATE_OFF, 3072, 3072, D, (bf16_t*)(ws + WS_WGATE + l * SZ_WGATE), lf);
        tconv(p.in[I_WBH] + (size_t)l * 512 * 1024, 1024, 0, 1024, 1024, 512, (bf16_t*)(ws + WS_WBR + (size_t)(l * 3 + 0) * SZ_WBR), lf);
        tconv(p.in[I_WBG] + (size_t)l * 512 * 1024, 1024, 0, 1024, 1024, 512, (bf16_t*)(ws + WS_WBR + (size_t)(l * 3 + 1) * SZ_WBR), lf);
        tconv(p.in[I_WOUT] + (size_t)l * D * D, D, 0, D, D, D, (bf16_t*)(ws + WS_WOUT + l * SZ_WOUT), lf);
        tconv(p.in[I_WUP] + (size_t)l * D * DFF, DFF, 0, DFF, DFF, D, (bf16_t*)(ws + WS_WUP + l * SZ_WUP), lf);
        tconv(p.in[I_WDN] + (size_t)l * DFF * D, D, 0, D, D, DFF, (bf16_t*)(ws + WS_WDN + l * SZ_WDN), lf);
        job_poolcomb(p, l);
    }
    job_bias(p);
    job_mod(p, lf);
    job_filters(p, lds);
    if (p.ws == nullptr) grid.sync();
    GBAR();
    { unsigned* ctl = (unsigned*)(p.ws + WS_BAR); bool ok = (gridDim.x & 7u) == 0u;
      for (int q = 0; q < 8; ++q) ok = ok && (__hip_atomic_load(ctl + 16 + q, __ATOMIC_RELAXED, __HIP_MEMORY_SCOPE_AGENT) == (gridDim.x >> 3));
      const unsigned mx = __hip_atomic_load(ctl + 256 + 2 * blockIdx.x, __ATOMIC_RELAXED, __HIP_MEMORY_SCOPE_AGENT), mr = __hip_atomic_load(ctl + 257 + 2 * blockIdx.x, __ATOMIC_RELAXED, __HIP_MEMORY_SCOPE_AGENT);
      if (ok) xj = __builtin_amdgcn_readfirstlane((int)((mr << 3) | mx));
      unsigned sum = 0u, nxc = 0u;
      for (int q = 0; q < 8; ++q) { const unsigned cq = __hip_atomic_load(ctl + 16 + q, __ATOMIC_RELAXED, __HIP_MEMORY_SCOPE_AGENT); sum += cq; nxc += cq ? 1u : 0u; }
      if (sum == gridDim.x) { hb_xcc = (unsigned)__builtin_amdgcn_readfirstlane((int)mx); hb_nloc = (unsigned)__builtin_amdgcn_readfirstlane((int)__hip_atomic_load(ctl + 16 + mx, __ATOMIC_RELAXED, __HIP_MEMORY_SCOPE_AGENT)); hb_nx = nxc; } }

    { WSPTRS
    for (int row = bid * 8 + wid; row < TOK; row += 2 * G * 8) {
        const int rb = row + G * 8; const bool hb = rb < TOK; const int rb2 = hb ? rb : row;
        const bool la = row < TOKL, lb = rb2 < TOKL;
        const float* xa = la ? p.in[I_X] + (size_t)row * D : p.in[I_CTX] + (size_t)(row - TOKL) * D; const float* xb = lb ? p.in[I_X] + (size_t)rb2 * D : p.in[I_CTX] + (size_t)(rb2 - TOKL) * D;
        const float* ma = MOD + (size_t)(la ? row >> 11 : 32) * 6144; const float* mb = MOD + (size_t)(lb ? rb2 >> 11 : 32) * 6144;
        ada_row2(xa, xb, hb, p.in[I_NMIX], ma, ma + 1024, mb, mb + 1024, HX + (size_t)row * D, HX + (size_t)rb2 * D, nullptr, nullptr, lane);
    } }
    GBAR();
    TX_MARK();

    for (int l_ = 0; l_ < 2; ++l_) {
        const int l = opqi(l_);
        { WSPTRS
            const int ntokt = l == 0 ? 288 : 256;
            const int nA = ntokt * 8, nB = 288 * 7;
            const bf16_t* wt = (const bf16_t*)(ws + WS_WT + l * SZ_WT); const bf16_t* wg = (const bf16_t*)(ws + WS_WG + l * SZ_WG);
            const float* biasT = BIAS + l * (NTR + NG); const float* biasG = biasT + NTR;
            XMap MA, MB; MA.init(xj, ntokt, 8); MB.init(xj, 288, 7);
            ProgInproj P{wt, wg, HX, T, PG, biasT, biasG, MA, MB, MA.rounds()};
            gemm_stream(lds, MA.rounds() + MB.rounds(), P);
        }
        GBAR();
        TX_MARK();
        { WSPTRS
            for (int it = bid; it < 256; it += G) gla_chunk_item(p, l, it >> 3, (it >> 1) & 3, it & 1, lds);
            for (int it = bid; it < 512; it += G) hyena_mfma<2048, 8>(p, l, it, false, lds);
            if (l == 0) for (int it = bid; it < 512; it += G) hyena_mfma<256, 1>(p, l, it, true, lds);
            const int npl = l == 0 ? 32768 : 16384;
            for (int it = bid * 8 + wid; it < npl; it += G * 8) { const bool cx = it >= 16384; const int j = it & 16383, ch = j >> 5, b = j & 31, g = ch >> 7;
                bf16_t* base = T + (size_t)(1536 + ch) * TOK + (cx ? (size_t)TOKL + b * 256 : (size_t)b * 2048);
                if (cx) pool1d_wave(base, lane, 2 << g);
                else { if (g == 0) pool2d_wave<2>(base, lane); else if (g == 1) pool2d_wave<4>(base, lane); else if (g == 2) pool2d_wave<8>(base, lane); else pool2d_wave<16>(base, lane); } }
        }
        GBAR();
        TX_MARK();
        {
            WSPTRS
            const bf16_t* OF = (const bf16_t*)(ws + WS_OF); const bf16_t* OB = OF + (size_t)TOK * 512; const float* nw = p.in[I_GNW] + l * 128;
            const int ntok = l == 0 ? TOK : TOKL;
            for (int row = bid * 8 + wid; row < ntok; row += 2 * G * 8) {
                const int rowb = row + G * 8; const bool hb = rowb < ntok; const int rows[2] = {row, hb ? rowb : row};
                u32x4 av[2], bv[2], rv[2];
#pragma unroll
                for (int q = 0; q < 2; ++q) { av[q] = *(const u32x4*)(OF + (size_t)rows[q] * 512 + lane * 8); bv[q] = *(const u32x4*)(OB + (size_t)rows[q] * 512 + lane * 8); rv[q] = *(const u32x4*)(PG + (size_t)rows[q] * NG + 1024 + lane * 8); }
#pragma unroll
                for (int q = 0; q < 2; ++q) { if (q == 1 && !hb) break;
                    const u32x4 a = av[q], bq = bv[q], rr = rv[q];
                    float o[8] = {lo16(a.x) + lo16(bq.x), hi16(a.x) + hi16(bq.x), lo16(a.y) + lo16(bq.y), hi16(a.y) + hi16(bq.y), lo16(a.z) + lo16(bq.z), hi16(a.z) + hi16(bq.z), lo16(a.w) + lo16(bq.w), hi16(a.w) + hi16(bq.w)};
                    float r[8] = {lo16(rr.x), hi16(rr.x), lo16(rr.y), hi16(rr.y), lo16(rr.z), hi16(rr.z), lo16(rr.w), hi16(rr.w)};
                    float ss = 0.f;
#pragma unroll
                    for (int j = 0; j < 8; ++j) ss += o[j] * o[j];
                    ss += __shfl_xor(ss, 1); ss += __shfl_xor(ss, 2); ss += __shfl_xor(ss, 4); ss += __shfl_xor(ss, 8);
                    const float inv = rsqrtf(ss * (1.f / 128.f) + EPS);
                    float y[8];
#pragma unroll
                    for (int j = 0; j < 8; ++j) y[j] = o[j] * inv * nw[(lane & 15) * 8 + j] * (r[j] * sigmoidf_(r[j]));
                    u32x4 w; w.x = cvt_pk_bf16(y[0], y[1]); w.y = cvt_pk_bf16(y[2], y[3]); w.z = cvt_pk_bf16(y[4], y[5]); w.w = cvt_pk_bf16(y[6], y[7]);
                    *(u32x4*)(YG + (size_t)rows[q] * 512 + lane * 8) = w; }
            }
            LAS bf16_t* tl = (LAS bf16_t*)lds;
            const int nit = 2 * (l == 0 ? 288 : 256) * 8;
            for (int it = bid; it < nit; it += G) { const int ctile = it & 7, tt = (it >> 3) % (l == 0 ? 288 : 256), which = (it >> 3) / (l == 0 ? 288 : 256);
                const bf16_t* src = T + (size_t)(which ? 1536 : 0) * TOK + (size_t)tt * 256; bf16_t* dst = (bf16_t*)(ws + (which ? WS_YPL : WS_YHY)) + (size_t)tt * 256 * 512;
                __syncthreads();
#pragma unroll
                for (int i = 0; i < 4; ++i) { const int idx = tid + i * NTHREADS, c = idx >> 5, t8 = (idx & 31) * 8;
                    *(LAS u32x4*)(tl + c * 264 + t8) = *(const u32x4*)(src + (size_t)(ctile * 64 + c) * TOK + t8); }
                __syncthreads();
#pragma unroll
                for (int i = 0; i < 4; ++i) { const int idx = tid + i * NTHREADS, tk = idx >> 3, c8 = (idx & 7) * 8; unsigned w[4];
#pragma unroll
                    for (int j = 0; j < 4; ++j) w[j] = (unsigned)tl[(c8 + 2 * j) * 264 + tk] | ((unsigned)tl[(c8 + 2 * j + 1) * 264 + tk] << 16);
                    *(u32x4*)(dst + (size_t)tk * 512 + ctile * 64 + c8) = (u32x4){w[0], w[1], w[2], w[3]}; }
            }
            __syncthreads();
        }
        GBAR();
        TX_MARK();
        const int ntt = l == 0 ? 288 : 256;
        { WSPTRS
          XMap M; M.init(xj, ntt, 4);
          ProgMix2 P{ws, ws + WS_STASH + (size_t)bid * 524288, p.in[I_BIN] + l * N_IN + GATE_OFF, M, l};
          gemm_stream(lds, 6 * M.rounds(), P); }
        GBAR();
        { WSPTRS
          XMap M; M.init(xj, ntt, 4);
          TileIO io{p.in[I_X], p.in[I_CTX], p.out, CTXS, MOD + (size_t)l * 33 * 6144, l};
          ProgOut2 P{ws, io, M, l};
          gemm_stream(lds, M.rounds(), P); }
        GBAR();
        { WSPTRS
          const float* modl = MOD + (size_t)l * 33 * 6144; const int nrow = ntt * 256;
          for (int row = bid * 8 + wid; row < nrow; row += 2 * G * 8) { const int rb = row + G * 8; const bool hb = rb < nrow; const int rb2 = hb ? rb : row; const bool la = row < TOKL, lb = rb2 < TOKL;
              const float* xa = la ? p.out + (size_t)row * D : CTXS + (size_t)(row - TOKL) * D; const float* xb = lb ? p.out + (size_t)rb2 * D : CTXS + (size_t)(rb2 - TOKL) * D;
              const float* ma = modl + (size_t)(la ? row >> 11 : 32) * 6144; const float* mb = modl + (size_t)(lb ? rb2 >> 11 : 32) * 6144;
              ada_row2(xa, xb, hb, p.in[I_NFFN] + l * D, ma + 3072, ma + 4096, mb + 3072, mb + 4096, HX + (size_t)row * D, HX + (size_t)rb2 * D, nullptr, nullptr, lane); } }
        GBAR();
        { WSPTRS
          XMap M; M.init(xj, ntt, 16);
          ProgUp2 P{ws, M, l};
          gemm_stream(lds, M.rounds(), P); }
        GBAR();
        { WSPTRS
          XMap M; M.init(xj, ntt, 4);
          TileIO io{p.in[I_X], p.in[I_CTX], p.out, CTXS, MOD + (size_t)l * 33 * 6144, l};
          ProgDown2 P{ws, io, M, l};
          gemm_stream(lds, M.rounds(), P); }
        GBAR();
        { WSPTRS
          const int nrow = ntt * 256;
          for (int row = bid * 8 + wid; row < nrow; row += 2 * G * 8) { const int rb = row + G * 8; const bool hb = rb < nrow; const int rb2 = hb ? rb : row; const bool la = row < TOKL, lb = rb2 < TOKL;
              float* xa = la ? p.out + (size_t)row * D : CTXS + (size_t)(row - TOKL) * D; float* xb = lb ? p.out + (size_t)rb2 * D : CTXS + (size_t)(rb2 - TOKL) * D;
              if (l == 0) { const float* ma = MOD + (size_t)33 * 6144 + (size_t)(la ? row >> 11 : 32) * 6144; const float* mb = MOD + (size_t)33 * 6144 + (size_t)(lb ? rb2 >> 11 : 32) * 6144;
                  ada_row2(xa, xb, hb, p.in[I_NMIX] + D, ma, ma + 1024, mb, mb + 1024, HX + (size_t)row * D, HX + (size_t)rb2 * D, nullptr, nullptr, lane); }
              else ada_row2(xa, xb, hb, p.in[I_NFIN], nullptr, nullptr, nullptr, nullptr, nullptr, nullptr, xa, xb, lane); } }
        if (l == 0) GBAR();
        TX_MARK();
    }
#ifdef TIMEX
    if (blockIdx.x == 0 && threadIdx.x == 0) { const unsigned long long t = __builtin_amdgcn_s_memrealtime(); while (__builtin_amdgcn_s_memrealtime() - t < (unsigned long long)TIMEX_MULT * (TIMEX >= 100 ? cxacc : (tx1 - tx0))) __builtin_amdgcn_s_sleep(10); }
#endif
}

extern "C" void kernel_launch(void* const* d_in, const int* in_sizes, int n_in, void* d_out, int out_size,
                              void* d_ws, size_t ws_size, hipStream_t stream) {
    static int grid_blocks = 0;
    if (!grid_blocks) {
        int dev = 0, cus = 0, per_cu = 0;
        (void)hipGetDevice(&dev);
        (void)hipDeviceGetAttribute(&cus, hipDeviceAttributeMultiprocessorCount, dev);
        (void)hipFuncSetAttribute((const void*)mega, hipFuncAttributeMaxDynamicSharedMemorySize, LDS_BYTES);
        (void)hipOccupancyMaxActiveBlocksPerMultiprocessor(&per_cu, (const void*)mega, NTHREADS, LDS_BYTES);
        grid_blocks = cus > 256 ? 256 : cus;
        if (ws_size < WS_END || n_in != 33 || out_size != TOKL * D) { fprintf(stderr, "kernel_launch: unexpected sizes ws=%zu need=%zu n_in=%d out=%d\n", ws_size, (size_t)WS_END, n_in, out_size); grid_blocks = -1; }
    }
    if (grid_blocks < 0) return;
    Params p{};
    for (int i = 0; i < 33; ++i) p.in[i] = (const float*)d_in[i];
    p.out = (float*)d_out; p.ws = (unsigned char*)d_ws;
    (void)hipMemsetAsync((unsigned char*)d_ws + WS_BAR, 0, 8192, stream);
    void* args[] = {&p};
    hipError_t e = hipLaunchCooperativeKernel((const void*)mega, dim3(grid_blocks), dim3(NTHREADS), args, LDS_BYTES, stream);
    if (e != hipSuccess) fprintf(stderr, "cooperative launch failed: %s (grid %d)\n", hipGetErrorString(e), grid_blocks);
}
```

```cpp
#include <hip/hip_runtime.h>
#include <hip/hip_cooperative_groups.h>
#include <cstdio>
#include <cstdint>
namespace cg = cooperative_groups;

#define LAS __attribute__((address_space(3)))
typedef unsigned short bf16_t;
typedef short bf16x8 __attribute__((ext_vector_type(8)));
typedef float f32x4 __attribute__((ext_vector_type(4)));
typedef unsigned u32x2 __attribute__((ext_vector_type(2)));
typedef unsigned u32x4 __attribute__((ext_vector_type(4)));

constexpr int NTHREADS = 512;
constexpr int LDS_BYTES = 147456;
constexpr int D = 1024, NB = 32, SEQ = 2048, CTXL = 256;
constexpr int TOKL = NB * SEQ, TOKC = NB * CTXL, TOK = TOKL + TOKC;
constexpr int N_IN = 6688, GLA_OFF = 1536, POOL_OFF = 3104, GATE_OFF = 3616;
constexpr int NTR = 2048, NG = 1792, NGV = 1568, DFF = 4096;
constexpr float EPS = 1e-6f;

constexpr size_t SZ_WT = (size_t)NTR * D * 2, SZ_WG = (size_t)NG * D * 2, SZ_WGATE = (size_t)3072 * D * 2, SZ_WBR = (size_t)1024 * 512 * 2;
constexpr size_t SZ_WOUT = (size_t)D * D * 2, SZ_WUP = (size_t)DFF * D * 2, SZ_WDN = (size_t)D * DFF * 2;
constexpr size_t WS_WT = 0;
constexpr size_t WS_WG = WS_WT + 2 * SZ_WT;
constexpr size_t WS_WGATE = WS_WG + 2 * SZ_WG;
constexpr size_t WS_WBR = WS_WGATE + 2 * SZ_WGATE;
constexpr size_t WS_WOUT = WS_WBR + 6 * SZ_WBR;
constexpr size_t WS_WUP = WS_WOUT + 2 * SZ_WOUT;
constexpr size_t WS_WDN = WS_WUP + 2 * SZ_WUP;
constexpr size_t WS_BIAS = WS_WDN + 2 * SZ_WDN;
constexpr size_t WS_MOD = WS_BIAS + 32768;
constexpr size_t WS_HFL = WS_MOD + (size_t)2 * 33 * 6144 * 4;
constexpr size_t WS_HFC = WS_HFL + (size_t)2 * 4 * 512 * 2048 * 2;
constexpr size_t WS_CTX = WS_HFC + (size_t)4 * 512 * 256 * 2;
constexpr size_t WS_HX = WS_CTX + (size_t)TOKC * D * 4;
constexpr size_t WS_T = WS_HX + (size_t)TOK * D * 2;
constexpr size_t WS_YG = WS_T + (size_t)NTR * TOK * 2;
constexpr size_t WS_PG = WS_YG + (size_t)TOK * 512 * 2;
constexpr size_t WS_OF = WS_PG + (size_t)TOK * NG * 2;
constexpr size_t WS_BAR = WS_OF + (size_t)2 * TOK * 512 * 2;
constexpr size_t WS_END = WS_BAR + 8192;
constexpr size_t WS_YHY = WS_T + (size_t)512 * TOK * 2;
constexpr size_t WS_YPL = WS_T + (size_t)1024 * TOK * 2;
constexpr size_t WS_STASH = WS_PG;
constexpr size_t WS_MERGED = WS_OF;
constexpr size_t WS_HID = WS_T;
static_assert((size_t)TOK * DFF * 2 <= WS_OF - WS_T, "hidden");
constexpr size_t WS_SCR = WS_PG;
constexpr size_t SCR_PER = 1572864;
constexpr size_t SC_MERGED = 0, SC_TRY = 524288, SC_TRP = 786432, SC_SG = 1048576, SC_ST = 1310720, SC_HID = 524288;
static_assert(WS_END <= (size_t)1073741824, "ws");

struct Params { const float* in[33]; float* out; unsigned char* ws; };
enum { I_X = 0, I_C, I_CTX, I_CCTX, I_WMOD, I_BMOD, I_NMIX, I_NFFN, I_WIN, I_BIN, I_HSW, I_HSB, I_FW1, I_FB1, I_FFREQ, I_FW2, I_FB2, I_FW3, I_HSKIP,
       I_WAF, I_BAF, I_WAB, I_BAB, I_GNW, I_PW, I_PSC, I_WBH, I_WBG, I_WBP, I_WOUT, I_WUP, I_WDN, I_NFIN };

__device__ __forceinline__ float bf2f(bf16_t h) { return __uint_as_float((unsigned)h << 16); }
typedef float f32x2_t __attribute__((ext_vector_type(2)));
typedef __bf16 bf16x2_t __attribute__((ext_vector_type(2)));
__device__ __forceinline__ unsigned cvt_pk_bf16(float lo, float hi) { const f32x2_t v = {lo, hi}; const bf16x2_t b = __builtin_convertvector(v, bf16x2_t); return __builtin_bit_cast(unsigned, b); }
__device__ __forceinline__ bf16_t f2bf(float f) { return (bf16_t)(cvt_pk_bf16(f, 0.f) & 0xffffu); }
__device__ __forceinline__ float lo16(unsigned u) { return __uint_as_float(u << 16); }
__device__ __forceinline__ float hi16(unsigned u) { return __uint_as_float(u & 0xffff0000u); }
__device__ __forceinline__ float sigmoidf_(float v) { return __builtin_amdgcn_rcpf(1.f + __expf(-v)); }
__device__ __forceinline__ unsigned char* opq(unsigned char* p) { asm volatile("" : "+s"(p)); return p; }
__device__ __forceinline__ int tidx() { int t = threadIdx.x; asm volatile("" : "+v"(t)); return t; }
__device__ __forceinline__ int opqi(int v) { asm volatile("" : "+s"(v)); return v; }
__device__ __forceinline__ void gbar(unsigned* ctr, unsigned target) {
    asm volatile("s_waitcnt vmcnt(0) lgkmcnt(0)" ::: "memory");
    __syncthreads();
    if (threadIdx.x < 64) {
        if (threadIdx.x == 0) {
            __builtin_amdgcn_fence(__ATOMIC_RELEASE, "agent");
            asm volatile("s_waitcnt vmcnt(0)" ::: "memory");
            __hip_atomic_fetch_add(ctr, 1u, __ATOMIC_RELAXED, __HIP_MEMORY_SCOPE_AGENT);
            while (__hip_atomic_load(ctr, __ATOMIC_RELAXED, __HIP_MEMORY_SCOPE_AGENT) < target) __builtin_amdgcn_s_sleep(1);
        }
        __builtin_amdgcn_fence(__ATOMIC_ACQUIRE, "agent");
        asm volatile("s_waitcnt vmcnt(0)" ::: "memory");
    }
    __syncthreads();
}
__device__ __forceinline__ void gbar_h(unsigned* ctl, unsigned xcc, unsigned nloc, unsigned nx, unsigned k) {
    asm volatile("s_waitcnt vmcnt(0) lgkmcnt(0)" ::: "memory");
    __syncthreads();
    if (threadIdx.x < 64) {
        if (threadIdx.x == 0) {
            unsigned* xsub = ctl + 1024 + 16 * xcc; unsigned* xgen = ctl + 1280 + 16 * xcc; unsigned* top = ctl + 1536; unsigned* topgen = ctl + 1600;
            const unsigned old = __hip_atomic_fetch_add(xsub, 1u, __ATOMIC_RELAXED, __HIP_MEMORY_SCOPE_AGENT);
            if (old + 1u == k * nloc) {
                __builtin_amdgcn_fence(__ATOMIC_RELEASE, "agent");
                asm volatile("s_waitcnt vmcnt(0)" ::: "memory");
                const unsigned og = __hip_atomic_fetch_add(top, 1u, __ATOMIC_RELAXED, __HIP_MEMORY_SCOPE_AGENT);
                if (og + 1u == k * nx) __hip_atomic_fetch_add(topgen, 1u, __ATOMIC_RELAXED, __HIP_MEMORY_SCOPE_AGENT);
                else while (__hip_atomic_load(topgen, __ATOMIC_RELAXED, __HIP_MEMORY_SCOPE_AGENT) < k) __builtin_amdgcn_s_sleep(1);
                __hip_atomic_fetch_add(xgen, 1u, __ATOMIC_RELAXED, __HIP_MEMORY_SCOPE_AGENT);
            } else {
                while (__hip_atomic_load(xgen, __ATOMIC_RELAXED, __HIP_MEMORY_SCOPE_AGENT) < k) __builtin_amdgcn_s_sleep(1);
            }
        }
        __builtin_amdgcn_fence(__ATOMIC_ACQUIRE, "agent");
        asm volatile("s_waitcnt vmcnt(0)" ::: "memory");
    }
    __syncthreads();
}
__device__ __forceinline__ float wave_sum(float v) {
#pragma unroll
    for (int o = 32; o >= 1; o >>= 1) v += __shfl_xor(v, o);
    return v;
}

constexpr int BK = 64, HALF = 128, HTB = HALF * BK * 2;
__device__ __forceinline__ int lds_byte(int r, int c) { const int st = (r >> 4) * 2 + (c >> 5), rr = r & 15, cc = c & 31, ob = rr * 64 + cc * 2; return st * 1024 + (ob ^ (((ob >> 9) & 1) << 5)); }
__device__ __forceinline__ void stage_rc(int b, int& R, int& C) { const int st = b / 1024, sb = b % 1024, swz = sb ^ (((sb >> 9) & 1) << 5); R = (st >> 1) * 16 + swz / 64; C = (st & 1) * 32 + (swz % 64) / 2; }

template <class Epi>
__device__ __forceinline__ void gemm_unit(LAS unsigned char* lds, const bf16_t* A, int lda, const bf16_t* Bt, int ldb, int K, const Epi& E) {
    const int tid = tidx(), wid = __builtin_amdgcn_readfirstlane(tid >> 6), lane = tid & 63, wr = wid >> 2, wc = wid & 3, fr = lane & 15, fq = lane >> 4;
    const int nt = K / BK;
    unsigned voffA[2], voffB[2];
#pragma unroll
    for (int i = 0; i < 2; ++i) { int R, C; stage_rc(tid * 16 + i * 8192, R, C); voffA[i] = (unsigned)(R * lda + C) * 2u; voffB[i] = (unsigned)(R * ldb + C) * 2u; }
    const size_t kstep = (size_t)(BK * 2);
    const size_t hstepA = (size_t)HALF * lda * 2, hstepB = (size_t)HALF * ldb * 2;
    const unsigned ldsw = (unsigned)wid * 1024u;
    const int aoff = lds_byte(wr * 64 + fr, fq * 8), boff = lds_byte(wc * 32 + fr, fq * 8);
#define G_SA(b, h) (((b) * 2 + (h)) * HTB)
#define G_SB(b, h) ((4 + (b) * 2 + (h)) * HTB)
#define G_STAGE(bufoff, gbase, voff) do { _Pragma("unroll") for (int _i = 0; _i < 2; ++_i) \
        __builtin_amdgcn_global_load_lds((const unsigned*)((const char*)(gbase) + (voff)[_i]), (LAS unsigned*)(lds + (bufoff) + ldsw + _i * 8192), 16, 0, 0); } while (0)
#define G_LDA(dst, b, h) do { _Pragma("unroll") for (int m = 0; m < 4; ++m) _Pragma("unroll") for (int k = 0; k < 2; ++k) dst[m][k] = *(const LAS bf16x8*)(lds + G_SA(b, h) + aoff + m * 2048 + k * 1024); } while (0)
#define G_LDB(dst, b, h) do { _Pragma("unroll") for (int n = 0; n < 2; ++n) _Pragma("unroll") for (int k = 0; k < 2; ++k) dst[n][k] = *(const LAS bf16x8*)(lds + G_SB(b, h) + boff + n * 2048 + k * 1024); } while (0)
#define G_MMA(ai, bj, At, Bt_) do { __builtin_amdgcn_s_setprio(1); _Pragma("unroll") for (int m = 0; m < 4; ++m) _Pragma("unroll") for (int n = 0; n < 2; ++n) _Pragma("unroll") for (int k = 0; k < 2; ++k) \
        acc[ai][bj][m][n] = __builtin_amdgcn_mfma_f32_16x16x32_bf16(Bt_[n][k], At[m][k], acc[ai][bj][m][n], 0, 0, 0); __builtin_amdgcn_s_setprio(0); } while (0)
#define G_WAIT_V(n) asm volatile("s_waitcnt vmcnt(" #n ")" ::: "memory")
#define G_WAIT_L(n) asm volatile("s_waitcnt lgkmcnt(" #n ")" ::: "memory")
#define G_BAR __builtin_amdgcn_s_barrier()
#define G_SCHED __builtin_amdgcn_sched_barrier(0)
    __syncthreads();
    f32x4 acc[2][2][4][2];
#pragma unroll
    for (int a = 0; a < 2; ++a)
#pragma unroll
        for (int b = 0; b < 2; ++b)
#pragma unroll
            for (int m = 0; m < 4; ++m)
#pragma unroll
                for (int n = 0; n < 2; ++n) acc[a][b][m][n] = (f32x4){0.f, 0.f, 0.f, 0.f};
    bf16x8 At[4][2], B0[2][2], B1[2][2];
    const char* cA = (const char*)A; const char* cB = (const char*)Bt;
    G_STAGE(G_SB(0, 0), cB, voffB); G_STAGE(G_SA(0, 0), cA, voffA); G_STAGE(G_SB(0, 1), cB + hstepB, voffB); G_STAGE(G_SA(0, 1), cA + hstepA, voffA);
    if (wr == 1) G_BAR;
    G_WAIT_V(4); G_BAR;
    G_STAGE(G_SB(1, 0), cB + kstep, voffB); G_STAGE(G_SA(1, 0), cA + kstep, voffA); G_STAGE(G_SB(1, 1), cB + hstepB + kstep, voffB);
    G_WAIT_V(6); G_BAR;
    for (int t = 0; t < nt; t += 2) {
        const bool last = (t == nt - 2);
        const char* a1 = cA + (size_t)(t + 1) * kstep;
        const char* a2 = last ? cA : cA + (size_t)(t + 2) * kstep; const char* b2 = last ? cB : cB + (size_t)(t + 2) * kstep;
        const char* a3 = a2 + kstep; const char* b3 = b2 + kstep;
        G_LDB(B0, 0, 0); G_SCHED; G_LDA(At, 0, 0); G_STAGE(G_SA(1, 1), a1 + hstepA, voffA);
        G_WAIT_L(8); G_BAR; G_WAIT_L(0); G_MMA(0, 0, At, B0); G_BAR; G_SCHED;
        G_LDB(B1, 0, 1); G_STAGE(G_SB(0, 0), b2, voffB);
        G_BAR; G_WAIT_L(0); G_MMA(0, 1, At, B1); G_BAR;
        G_LDA(At, 0, 1); G_STAGE(G_SA(0, 0), a2, voffA);
        G_BAR; G_WAIT_L(0); G_MMA(1, 0, At, B0); G_BAR; G_SCHED;
        G_STAGE(G_SB(0, 1), b2 + hstepB, voffB);
        G_WAIT_V(6); G_BAR; G_MMA(1, 1, At, B1); G_BAR;
        G_LDB(B0, 1, 0); G_SCHED; G_LDA(At, 1, 0); G_STAGE(G_SA(0, 1), a2 + hstepA, voffA);
        G_WAIT_L(8); G_BAR; G_WAIT_L(0); G_MMA(0, 0, At, B0); G_BAR; G_SCHED;
        G_LDB(B1, 1, 1); G_STAGE(G_SB(1, 0), b3, voffB);
        G_BAR; G_WAIT_L(0); G_MMA(0, 1, At, B1); G_BAR;
        G_LDA(At, 1, 1); G_STAGE(G_SA(1, 0), a3, voffA);
        G_BAR; G_WAIT_L(0); G_MMA(1, 0, At, B0); G_BAR; G_SCHED;
        G_STAGE(G_SB(1, 1), b3 + hstepB, voffB);
        G_WAIT_V(6); G_BAR; G_MMA(1, 1, At, B1); G_BAR;
    }
    E(acc, wr, wc, fr, fq);
    G_WAIT_V(0);
    if (wr == 0) G_BAR;
    G_BAR;
    __syncthreads();
}


__device__ __forceinline__ int perm32(int rho) { const int n = rho >> 4, i = rho & 15; return 8 * (i >> 2) + 4 * n + (i & 3); }
typedef f32x4 AccT[2][2][4][2];
struct UDesc { const char* A; const char* B; int lda, ldb, K; };
template <class Prog, bool SP2 = true, bool ALIGN_EPI = true>
__device__ __forceinline__ void gemm_stream(LAS unsigned char* lds, int nunits, const Prog& P) {
    if (nunits <= 0) return;
    const int tid = tidx(), wid = __builtin_amdgcn_readfirstlane(tid >> 6), lane = tid & 63, wr = wid >> 2, wc = wid & 3, fr = lane & 15, fq = lane >> 4;
    int sR, sRb, sC; { int R, C; stage_rc(tid * 16, R, C); sR = R * 2; sRb = ((R & ~31) + perm32(R & 31)) * 2; sC = C * 2; }
    const unsigned kstep = (unsigned)(BK * 2);
    const unsigned ldsw = (unsigned)wid * 1024u;
    const int aoff = lds_byte(wr * 64 + fr, fq * 8), boff = lds_byte(wc * 32 + fr, fq * 8);
#define S_STAGE(bufoff, gbase, v, q) do { \
        __builtin_amdgcn_global_load_lds((const unsigned*)((const char*)(gbase) + (v)), (LAS unsigned*)(lds + (bufoff) + ldsw), 16, 0, 0); \
        __builtin_amdgcn_global_load_lds((const unsigned*)((const char*)(gbase) + (q) + (v)), (LAS unsigned*)(lds + (bufoff) + ldsw + 8192), 16, 0, 0); } while (0)
    UDesc cur, nxt; P.desc(0, cur);
    unsigned vA = (unsigned)(sR * cur.lda + sC), vB = (unsigned)(sRb * cur.ldb + sC);
    __syncthreads();
    f32x4 acc[2][2][4][2];
#pragma unroll
    for (int a = 0; a < 2; ++a)
#pragma unroll
        for (int b = 0; b < 2; ++b)
#pragma unroll
            for (int m = 0; m < 4; ++m)
#pragma unroll
                for (int n = 0; n < 2; ++n) acc[a][b][m][n] = (f32x4){0.f, 0.f, 0.f, 0.f};
    bf16x8 At[4][2], B0[2][2], B1[2][2];
    { const char* cA = cur.A; const char* cB = cur.B; const unsigned hA = (unsigned)HALF * cur.lda * 2, hB = (unsigned)HALF * cur.ldb * 2, qA = hA >> 1, qB = hB >> 1;
      if constexpr (SP2) {
          S_STAGE(G_SB(0, 0), cB, vB, qB); S_STAGE(G_SB(0, 1), cB + hB, vB, qB); S_STAGE(G_SA(0, 0), cA, vA, qA); S_STAGE(G_SA(0, 1), cA + hA, vA, qA);
          if (wr == 1) G_BAR;
          G_WAIT_V(2); G_BAR;
          S_STAGE(G_SB(1, 0), cB + kstep, vB, qB); S_STAGE(G_SA(1, 0), cA + kstep, vA, qA); S_STAGE(G_SB(1, 1), cB + hB + kstep, vB, qB);
          G_WAIT_V(6); G_BAR;
      } else {
          S_STAGE(G_SB(0, 0), cB, vB, qB); S_STAGE(G_SA(0, 0), cA, vA, qA); S_STAGE(G_SB(0, 1), cB + hB, vB, qB); S_STAGE(G_SA(0, 1), cA + hA, vA, qA);
          if (wr == 1) G_BAR;
          G_WAIT_V(4); G_BAR;
          S_STAGE(G_SB(1, 0), cB + kstep, vB, qB); S_STAGE(G_SA(1, 0), cA + kstep, vA, qA); S_STAGE(G_SB(1, 1), cB + hB + kstep, vB, qB);
          G_WAIT_V(6); G_BAR;
      } }
    for (int ui = 0;; ++ui) {
        const bool has_next = ui + 1 < nunits;
        if (has_next) P.desc(ui + 1, nxt); else nxt = cur;
        const unsigned nA = (unsigned)(sR * nxt.lda + sC), nB = (unsigned)(sRb * nxt.ldb + sC);
        const char* cA = cur.A; const char* cB = cur.B; const unsigned hA = (unsigned)HALF * cur.lda * 2, hB = (unsigned)HALF * cur.ldb * 2;
        const unsigned nhA = (unsigned)HALF * nxt.lda * 2, nhB = (unsigned)HALF * nxt.ldb * 2;
        const int nt = cur.K / BK;
        for (int t = 0; t < nt; t += 2) {
            const bool last = (t == nt - 2);
            const char* a1 = cA + (unsigned)(t + 1) * kstep;
            const char* a2 = last ? nxt.A : cA + (unsigned)(t + 2) * kstep; const char* b2 = last ? nxt.B : cB + (unsigned)(t + 2) * kstep;
            const char* a3 = a2 + kstep; const char* b3 = b2 + kstep;
            const unsigned hA2 = last ? nhA : hA, hB2 = last ? nhB : hB, qA = hA >> 1, qA2 = hA2 >> 1, qB2 = hB2 >> 1;
            const unsigned xA = last ? nA : vA, xB = last ? nB : vB;
            if constexpr (SP2) {
            G_LDB(B0, 0, 0); G_LDB(B1, 0, 1); G_SCHED; G_LDA(At, 0, 0); S_STAGE(G_SA(1, 1), a1 + hA, vA, qA);
            G_WAIT_V(8); G_WAIT_L(0); G_BAR; G_MMA(0, 0, At, B0); G_MMA(0, 1, At, B1); G_BAR; G_SCHED;
            G_LDA(At, 0, 1); S_STAGE(G_SB(0, 0), b2, xB, qB2); S_STAGE(G_SB(0, 1), b2 + hB2, xB, qB2); S_STAGE(G_SA(0, 0), a2, xA, qA2);
            G_WAIT_V(8); G_WAIT_L(0); G_BAR; G_MMA(1, 0, At, B0); G_MMA(1, 1, At, B1); G_BAR; G_SCHED;
            G_LDB(B0, 1, 0); G_LDB(B1, 1, 1); G_SCHED; G_LDA(At, 1, 0); S_STAGE(G_SA(0, 1), a2 + hA2, xA, qA2);
            G_WAIT_V(8); G_WAIT_L(0); G_BAR; G_MMA(0, 0, At, B0); G_MMA(0, 1, At, B1); G_BAR; G_SCHED;
            G_LDA(At, 1, 1); S_STAGE(G_SB(1, 0), b3, xB, qB2); S_STAGE(G_SB(1, 1), b3 + hB2, xB, qB2); S_STAGE(G_SA(1, 0), a3, xA, qA2);
            G_WAIT_V(8); G_WAIT_L(0); G_BAR; G_MMA(1, 0, At, B0); G_MMA(1, 1, At, B1); G_BAR; G_SCHED;
            } else {
            G_LDB(B0, 0, 0); G_SCHED; G_LDA(At, 0, 0); S_STAGE(G_SA(1, 1), a1 + hA, vA, qA);
            G_WAIT_L(8); G_BAR; G_WAIT_L(0); G_MMA(0, 0, At, B0); G_BAR; G_SCHED;
            G_LDB(B1, 0, 1); S_STAGE(G_SB(0, 0), b2, xB, qB2);
            G_BAR; G_WAIT_L(0); G_MMA(0, 1, At, B1); G_BAR;
            G_LDA(At, 0, 1); S_STAGE(G_SA(0, 0), a2, xA, qA2);
            G_BAR; G_WAIT_L(0); G_MMA(1, 0, At, B0); G_BAR; G_SCHED;
            S_STAGE(G_SB(0, 1), b2 + hB2, xB, qB2);
            G_WAIT_V(6); G_BAR; G_MMA(1, 1, At, B1); G_BAR;
            G_LDB(B0, 1, 0); G_SCHED; G_LDA(At, 1, 0); S_STAGE(G_SA(0, 1), a2 + hA2, xA, qA2);
            G_WAIT_L(8); G_BAR; G_WAIT_L(0); G_MMA(0, 0, At, B0); G_BAR; G_SCHED;
            G_LDB(B1, 1, 1); S_STAGE(G_SB(1, 0), b3, xB, qB2);
            G_BAR; G_WAIT_L(0); G_MMA(0, 1, At, B1); G_BAR;
            G_LDA(At, 1, 1); S_STAGE(G_SA(1, 0), a3, xA, qA2);
            G_BAR; G_WAIT_L(0); G_MMA(1, 0, At, B0); G_BAR; G_SCHED;
            S_STAGE(G_SB(1, 1), b3 + hB2, xB, qB2);
            G_WAIT_V(6); G_BAR; G_MMA(1, 1, At, B1); G_BAR;
            }
        }
        if constexpr (ALIGN_EPI) { if (wr == 0) G_BAR; }
        P.epi(ui, acc, wr, wc, fr, fq);
        if (!has_next) break;
#pragma unroll
        for (int a = 0; a < 2; ++a)
#pragma unroll
            for (int b = 0; b < 2; ++b)
#pragma unroll
                for (int m = 0; m < 4; ++m)
#pragma unroll
                    for (int n = 0; n < 2; ++n) acc[a][b][m][n] = (f32x4){0.f, 0.f, 0.f, 0.f};
        cur = nxt; vA = nA; vB = nB;
        if constexpr (ALIGN_EPI) { if (wr == 1) G_BAR; }
    }
    G_WAIT_V(0);
    if constexpr (!ALIGN_EPI) { if (wr == 0) G_BAR; }
    G_BAR;
    __syncthreads();
#undef S_STAGE
}

#define EPI_LOOP _Pragma("unroll") for (int ai = 0; ai < 2; ++ai) _Pragma("unroll") for (int m = 0; m < 4; ++m) _Pragma("unroll") for (int bj = 0; bj < 2; ++bj) _Pragma("unroll") for (int n = 0; n < 2; ++n)
#define EPI_ROW (ai * 128 + wr * 64 + m * 16 + fr)
#define EPI_COL (bj * 128 + wc * 32 + 8 * fq + 4 * n)

#define U4 _Pragma("unroll")
struct EpiStoreBf16 {
    bf16_t* O; size_t ldo; const float* bias; bool rowb;
    __device__ __forceinline__ void operator()(const AccT& acc, int wr, int wc, int fr, int fq) const {
        { const int tq_ = tidx(); wr = (tq_ >> 8) & 1; wc = (tq_ >> 6) & 3; fr = tq_ & 15; fq = (tq_ >> 4) & 3; }
        float br[2][4]; f32x4 bc[2][2];
        U4 for (int ai = 0; ai < 2; ++ai) U4 for (int m = 0; m < 4; ++m) br[ai][m] = rowb ? bias[ai * 128 + wr * 64 + m * 16 + fr] : 0.f;
        U4 for (int bj = 0; bj < 2; ++bj) U4 for (int n = 0; n < 2; ++n) bc[bj][n] = rowb ? (f32x4){0.f, 0.f, 0.f, 0.f} : *(const f32x4*)(bias + EPI_COL);
        U4 for (int ai = 0; ai < 2; ++ai) U4 for (int m = 0; m < 4; ++m) U4 for (int bj = 0; bj < 2; ++bj) { const int n = 0; const int r = EPI_ROW, c = EPI_COL;
            const f32x4 v0 = acc[ai][bj][m][0] + bc[bj][0] + br[ai][m], v1 = acc[ai][bj][m][1] + bc[bj][1] + br[ai][m];
            u32x4 w; w.x = cvt_pk_bf16(v0[0], v0[1]); w.y = cvt_pk_bf16(v0[2], v0[3]); w.z = cvt_pk_bf16(v1[0], v1[1]); w.w = cvt_pk_bf16(v1[2], v1[3]); *(u32x4*)(O + (size_t)r * ldo + c) = w; }
    }
};
__device__ __forceinline__ u32x4 pack8(const f32x4& a, const f32x4& b) { u32x4 w; w.x = cvt_pk_bf16(a[0], a[1]); w.y = cvt_pk_bf16(a[2], a[3]); w.z = cvt_pk_bf16(b[0], b[1]); w.w = cvt_pk_bf16(b[2], b[3]); return w; }
__device__ __forceinline__ f32x4 unpk_lo(const u32x4& w) { return (f32x4){lo16(w.x), hi16(w.x), lo16(w.y), hi16(w.y)}; }
__device__ __forceinline__ f32x4 unpk_hi(const u32x4& w) { return (f32x4){lo16(w.z), hi16(w.z), lo16(w.w), hi16(w.w)}; }
struct EpiGate {
    void* SG; const float* bias;
    __device__ __forceinline__ void operator()(const AccT& acc, int wr, int wc, int fr, int fq) const {
        { const int tq_ = tidx(); wr = (tq_ >> 8) & 1; wc = (tq_ >> 6) & 3; fr = tq_ & 15; fq = (tq_ >> 4) & 3; }
        f32x4 bc[2][2];
        U4 for (int bj = 0; bj < 2; ++bj) U4 for (int n = 0; n < 2; ++n) bc[bj][n] = *(const f32x4*)(bias + EPI_COL);
        u32x4* SGt = (u32x4*)SG + tidx();
        U4 for (int ai = 0; ai < 2; ++ai) U4 for (int m = 0; m < 4; ++m) U4 for (int bj = 0; bj < 2; ++bj) {
            f32x4 v0 = acc[ai][bj][m][0] + bc[bj][0], v1 = acc[ai][bj][m][1] + bc[bj][1];
            U4 for (int j = 0; j < 4; ++j) { v0[j] = sigmoidf_(v0[j]); v1[j] = sigmoidf_(v1[j]); }
            SGt[(ai * 8 + m * 2 + bj) * NTHREADS] = pack8(v0, v1); }
    }
};
struct EpiBranch {
    const void* SG; void* ST; bf16_t* MG; int first, last;
    __device__ __forceinline__ void operator()(const AccT& acc, int wr, int wc, int fr, int fq) const {
        { const int tq_ = tidx(); wr = (tq_ >> 8) & 1; wc = (tq_ >> 6) & 3; fr = tq_ & 15; fq = (tq_ >> 4) & 3; }
        const int tq = tidx(); const u32x4* SGt = (const u32x4*)SG + tq; u32x4* STt = (u32x4*)ST + tq;
        const u32x4 z4 = (u32x4){0u, 0u, 0u, 0u};
        u32x4 g[2][4], t[2][4];
        U4 for (int q = 0; q < 4; ++q) { g[0][q] = SGt[q * NTHREADS]; t[0][q] = first ? z4 : STt[q * NTHREADS]; }
        U4 for (int bt = 0; bt < 4; ++bt) { const int cb = bt & 1, nb = cb ^ 1;
            if (bt + 1 < 4) { U4 for (int q = 0; q < 4; ++q) { const int i2 = (bt + 1) * 4 + q; g[nb][q] = SGt[i2 * NTHREADS]; t[nb][q] = first ? z4 : STt[i2 * NTHREADS]; } }
            U4 for (int q = 0; q < 4; ++q) { const int ai = bt >> 1, m = 2 * (bt & 1) + (q >> 1), bj = q & 1, n = 0, i2 = bt * 4 + q; const int r = EPI_ROW, c = EPI_COL;
                const f32x4 v0 = acc[ai][bj][m][0] * unpk_lo(g[cb][q]) + unpk_lo(t[cb][q]), v1 = acc[ai][bj][m][1] * unpk_hi(g[cb][q]) + unpk_hi(t[cb][q]);
                const u32x4 w = pack8(v0, v1);
                if (last) *(u32x4*)(MG + (size_t)r * 1024 + c) = w; else STt[i2 * NTHREADS] = w; }
        }
    }
};
struct EpiResid {
    const float* xsrc; float* xdst; const float* gate;
    __device__ __forceinline__ void operator()(const AccT& acc, int wr, int wc, int fr, int fq) const {
        { const int tq_ = tidx(); wr = (tq_ >> 8) & 1; wc = (tq_ >> 6) & 3; fr = tq_ & 15; fq = (tq_ >> 4) & 3; }
        f32x4 gc[2][2];
        U4 for (int bj = 0; bj < 2; ++bj) U4 for (int n = 0; n < 2; ++n) gc[bj][n] = *(const f32x4*)(gate + EPI_COL);
        f32x4 xo[2][4];
        { const int ai = 0, m = 0; U4 for (int q = 0; q < 4; ++q) { const int bj = q >> 1, n = q & 1; xo[0][q] = *(const f32x4*)(xsrc + (size_t)EPI_ROW * 1024 + EPI_COL); } }
        U4 for (int bt = 0; bt < 8; ++bt) { const int cb = bt & 1, nb = cb ^ 1;
            if (bt + 1 < 8) { const int ai = (bt + 1) >> 2, m = (bt + 1) & 3; U4 for (int q = 0; q < 4; ++q) { const int bj = q >> 1, n = q & 1; xo[nb][q] = *(const f32x4*)(xsrc + (size_t)EPI_ROW * 1024 + EPI_COL); } }
            { const int ai = bt >> 2, m = bt & 3; U4 for (int q = 0; q < 4; ++q) { const int bj = q >> 1, n = q & 1; *(f32x4*)(xdst + (size_t)EPI_ROW * 1024 + EPI_COL) = xo[cb][q] + gc[bj][n] * acc[ai][bj][m][n]; } }
        }
    }
};
struct EpiSqrelu {
    bf16_t* H; int ldh;
    __device__ __forceinline__ void operator()(const AccT& acc, int wr, int wc, int fr, int fq) const {
        { const int tq_ = tidx(); wr = (tq_ >> 8) & 1; wc = (tq_ >> 6) & 3; fr = tq_ & 15; fq = (tq_ >> 4) & 3; }
        U4 for (int ai = 0; ai < 2; ++ai) U4 for (int m = 0; m < 4; ++m) U4 for (int bj = 0; bj < 2; ++bj) { const int n = 0; const int r = EPI_ROW, c = EPI_COL; f32x4 v0 = acc[ai][bj][m][0], v1 = acc[ai][bj][m][1];
#pragma unroll
            for (int j = 0; j < 4; ++j) { const float t0 = fmaxf(v0[j], 0.f), t1 = fmaxf(v1[j], 0.f); v0[j] = t0 * t0; v1[j] = t1 * t1; }
            u32x4 w; w.x = cvt_pk_bf16(v0[0], v0[1]); w.y = cvt_pk_bf16(v0[2], v0[3]); w.z = cvt_pk_bf16(v1[0], v1[1]); w.w = cvt_pk_bf16(v1[2], v1[3]); *(u32x4*)(H + (size_t)r * ldh + c) = w; }
    }
};

struct XMap { int NT, per_xcd, x, j, bpx;
    __device__ __forceinline__ void init(int xj, int ntt, int nt_) { NT = nt_; per_xcd = (ntt >> 3) * nt_; x = xj & 7; j = xj >> 3; bpx = (int)(gridDim.x >> 3); }
    __device__ __forceinline__ int rounds() const { return j < per_xcd ? (per_xcd - j + bpx - 1) / bpx : 0; }
    __device__ __forceinline__ void get(int i, int& tt, int& nt) const { const int q = i * bpx + j; tt = x + 8 * (q / NT); nt = q % NT; }
};
struct ProgInproj {
    const bf16_t* wt; const bf16_t* wg; const bf16_t* HX; bf16_t* T; bf16_t* PG; const float* biasT; const float* biasG; XMap MA, MB; int rA;
    __device__ __forceinline__ void desc(int i, UDesc& d) const { int tt, nt;
        if (i < rA) { MA.get(i, tt, nt); d.A = (const char*)(wt + (size_t)(nt * 256) * D); d.B = (const char*)(HX + (size_t)(tt * 256) * D); }
        else { MB.get(i - rA, tt, nt); d.A = (const char*)(HX + (size_t)(tt * 256) * D); d.B = (const char*)(wg + (size_t)(nt * 256) * D); }
        d.lda = D; d.ldb = D; d.K = D; }
    __device__ __forceinline__ void epi(int i, const AccT& acc, int wr, int wc, int fr, int fq) const { int tt, nt;
        if (i < rA) { MA.get(i, tt, nt); EpiStoreBf16 E{T + (size_t)(nt * 256) * TOK + (size_t)tt * 256, (size_t)TOK, biasT + nt * 256, true}; E(acc, wr, wc, fr, fq); }
        else { MB.get(i - rA, tt, nt); EpiStoreBf16 E{PG + (size_t)(tt * 256) * NG + nt * 256, (size_t)NG, biasG + nt * 256, false}; E(acc, wr, wc, fr, fq); } }
};
struct ProgMix {
    unsigned char* ws; unsigned char* scr; const float* bgate; unsigned tok0; int l;
    __device__ __forceinline__ void desc(int i, UDesc& d) const { const int nt = i / 6, j = i % 6, X = j >> 1;
        if (!(j & 1)) { d.A = (const char*)(ws + WS_HX) + (size_t)tok0 * D * 2; d.B = (const char*)(ws + WS_WGATE + l * SZ_WGATE) + (size_t)(X * 1024 + nt * 256) * D * 2; d.lda = D; d.ldb = D; d.K = D; }
        else { d.A = X == 0 ? (const char*)(scr + SC_TRY) : (X == 1 ? (const char*)(ws + WS_YG) + (size_t)tok0 * 1024 : (const char*)(scr + SC_TRP));
               d.B = (const char*)(ws + WS_WBR + (size_t)l * 3 * SZ_WBR) + (size_t)X * SZ_WBR + (size_t)(nt * 256) * 1024; d.lda = 512; d.ldb = 512; d.K = 512; } }
    __device__ __forceinline__ void epi(int i, const AccT& acc, int wr, int wc, int fr, int fq) const { const int nt = i / 6, j = i % 6, X = j >> 1;
        if (!(j & 1)) { EpiGate E{(void*)(scr + SC_SG), bgate + X * 1024 + nt * 256}; E(acc, wr, wc, fr, fq); }
        else { EpiBranch E{(const void*)(scr + SC_SG), (void*)(scr + SC_ST), (bf16_t*)(scr + SC_MERGED) + nt * 256, X == 0, X == 2}; E(acc, wr, wc, fr, fq); } }
};
struct ProgResid {
    const bf16_t* A; int lda; const bf16_t* W; int ldw, K; size_t wstep; const float* xsrc; float* xdst; const float* gate;
    __device__ __forceinline__ void desc(int i, UDesc& d) const { d.A = (const char*)A; d.B = (const char*)(W + (size_t)i * wstep); d.lda = lda; d.ldb = ldw; d.K = K; }
    __device__ __forceinline__ void epi(int i, const AccT& acc, int wr, int wc, int fr, int fq) const { EpiResid E{xsrc + i * 256, xdst + i * 256, gate + i * 256}; E(acc, wr, wc, fr, fq); }
};
struct ProgUp {
    const bf16_t* XN; const bf16_t* W; bf16_t* HID;
    __device__ __forceinline__ void desc(int i, UDesc& d) const { d.A = (const char*)XN; d.B = (const char*)(W + (size_t)(i * 256) * D); d.lda = D; d.ldb = D; d.K = D; }
    __device__ __forceinline__ void epi(int i, const AccT& acc, int wr, int wc, int fr, int fq) const { EpiSqrelu E{HID + i * 256, 2048}; E(acc, wr, wc, fr, fq); }
};


struct TileIO { const float* xin; const float* ctxin; float* out; float* ctxs; const float* modl; int l;
    __device__ __forceinline__ const float* src(int tt) const { return tt < 256 ? (l == 0 ? xin : out) + (size_t)tt * 256 * D : ctxin + (size_t)(tt - 256) * 256 * D; }
    __device__ __forceinline__ float* dst(int tt) const { return tt < 256 ? out + (size_t)tt * 256 * D : ctxs + (size_t)(tt - 256) * 256 * D; }
    __device__ __forceinline__ const float* cur(int tt) const { return tt < 256 ? out + (size_t)tt * 256 * D : ctxs + (size_t)(tt - 256) * 256 * D; }
    __device__ __forceinline__ const float* mod(int tt) const { return modl + (size_t)(tt < 256 ? tt >> 3 : 32) * 6144; }
};
struct ProgMix2 {
    unsigned char* ws; unsigned char* stash; const float* bgate; XMap M; int l;
    __device__ __forceinline__ void desc(int ii, UDesc& d) const { int tt, nt; M.get(ii / 6, tt, nt); const int s6 = ii % 6, X = s6 >> 1;
        if (!(s6 & 1)) { d.A = (const char*)(ws + WS_HX) + (size_t)tt * 256 * D * 2; d.B = (const char*)(ws + WS_WGATE + l * SZ_WGATE) + (size_t)(X * 1024 + nt * 256) * D * 2; d.lda = D; d.ldb = D; d.K = D; }
        else { d.A = (const char*)(ws + (X == 0 ? WS_YHY : (X == 1 ? WS_YG : WS_YPL))) + (size_t)tt * 256 * 1024;
               d.B = (const char*)(ws + WS_WBR + (size_t)l * 3 * SZ_WBR) + (size_t)X * SZ_WBR + (size_t)(nt * 256) * 1024; d.lda = 512; d.ldb = 512; d.K = 512; } }
    __device__ __forceinline__ void epi(int ii, const AccT& acc, int wr, int wc, int fr, int fq) const { int tt, nt; M.get(ii / 6, tt, nt); const int s6 = ii % 6, X = s6 >> 1;
        if (!(s6 & 1)) { EpiGate E{(void*)stash, bgate + X * 1024 + nt * 256}; E(acc, wr, wc, fr, fq); }
        else { EpiBranch E{(const void*)stash, (void*)(stash + 262144), (bf16_t*)(ws + WS_MERGED) + (size_t)tt * 256 * 1024 + nt * 256, X == 0, X == 2}; E(acc, wr, wc, fr, fq); } }
};
struct ProgOut2 {
    unsigned char* ws; TileIO io; XMap M; int l;
    __device__ __forceinline__ void desc(int i, UDesc& d) const { int tt, nt; M.get(i, tt, nt);
        d.A = (const char*)(ws + WS_MERGED) + (size_t)tt * 256 * 2048; d.B = (const char*)(ws + WS_WOUT + l * SZ_WOUT) + (size_t)(nt * 256) * D * 2; d.lda = D; d.ldb = D; d.K = D; }
    __device__ __forceinline__ void epi(int i, const AccT& acc, int wr, int wc, int fr, int fq) const { int tt, nt; M.get(i, tt, nt);
        EpiResid E{io.src(tt) + nt * 256, io.dst(tt) + nt * 256, io.mod(tt) + 2048 + nt * 256}; E(acc, wr, wc, fr, fq); }
};
struct ProgUp2 {
    unsigned char* ws; XMap M; int l;
    __device__ __forceinline__ void get(int i, int& tt, int& nt) const { if (M.bpx != 32) { M.get(i, tt, nt); return; }
        const int ttg = i >> 1, ntg = i & 1; tt = M.x + 8 * (ttg * 4 + (M.j >> 3)); nt = ntg * 8 + (M.j & 7); }
    __device__ __forceinline__ void desc(int i, UDesc& d) const { int tt, nt; get(i, tt, nt);
        d.A = (const char*)(ws + WS_HX) + (size_t)tt * 256 * 2048; d.B = (const char*)(ws + WS_WUP + l * SZ_WUP) + (size_t)(nt * 256) * D * 2; d.lda = D; d.ldb = D; d.K = D; }
    __device__ __forceinline__ void epi(int i, const AccT& acc, int wr, int wc, int fr, int fq) const { int tt, nt; get(i, tt, nt);
        EpiSqrelu E{(bf16_t*)(ws + WS_HID) + (size_t)tt * 256 * DFF + nt * 256, DFF}; E(acc, wr, wc, fr, fq); }
};
struct ProgDown2 {
    unsigned char* ws; TileIO io; XMap M; int l;
    __device__ __forceinline__ void desc(int i, UDesc& d) const { int tt, nt; M.get(i, tt, nt);
        d.A = (const char*)(ws + WS_HID) + (size_t)tt * 256 * DFF * 2; d.B = (const char*)(ws + WS_WDN + l * SZ_WDN) + (size_t)(nt * 256) * DFF * 2; d.lda = DFF; d.ldb = DFF; d.K = DFF; }
    __device__ __forceinline__ void epi(int i, const AccT& acc, int wr, int wc, int fr, int fq) const { int tt, nt; M.get(i, tt, nt);
        EpiResid E{io.cur(tt) + nt * 256, io.dst(tt) + nt * 256, io.mod(tt) + 5120 + nt * 256}; E(acc, wr, wc, fr, fq); }
};

__device__ __forceinline__ void tconv(const float* src, int ld, int c0, int nvalid, int ncols, int K, bf16_t* dst, LAS float* tile) {
    const int tid = tidx(), ntn = ncols / 64, ntile = ntn * (K / 64);
    float v[8];
    { const int t = blockIdx.x; if (t < ntile) { const int k0 = (t / ntn) * 64, n0 = (t % ntn) * 64;
#pragma unroll
        for (int i = 0; i < 8; ++i) { const int k = i * 8 + (tid >> 6), n = tid & 63; v[i] = (n0 + n < nvalid) ? src[(size_t)(k0 + k) * ld + c0 + n0 + n] : 0.f; } } }
    for (int t = blockIdx.x; t < ntile; t += gridDim.x) {
        const int k0 = (t / ntn) * 64, n0 = (t % ntn) * 64;
        __syncthreads();
#pragma unroll
        for (int i = 0; i < 8; ++i) { const int k = i * 8 + (tid >> 6), n = tid & 63; tile[k * 65 + n] = v[i]; }
        { const int t2 = t + gridDim.x; if (t2 < ntile) { const int k2 = (t2 / ntn) * 64, n2 = (t2 % ntn) * 64;
#pragma unroll
            for (int i = 0; i < 8; ++i) { const int k = i * 8 + (tid >> 6), n = tid & 63; v[i] = (n2 + n < nvalid) ? src[(size_t)(k2 + k) * ld + c0 + n2 + n] : 0.f; } } }
        __syncthreads();
        const int n = tid >> 3, kc = (tid & 7) * 8;
        u32x4 w;
        w.x = cvt_pk_bf16(tile[(kc + 0) * 65 + n], tile[(kc + 1) * 65 + n]); w.y = cvt_pk_bf16(tile[(kc + 2) * 65 + n], tile[(kc + 3) * 65 + n]);
        w.z = cvt_pk_bf16(tile[(kc + 4) * 65 + n], tile[(kc + 5) * 65 + n]); w.w = cvt_pk_bf16(tile[(kc + 6) * 65 + n], tile[(kc + 7) * 65 + n]);
        *(u32x4*)(dst + (size_t)(n0 + n) * K + k0 + kc) = w;
    }
    __syncthreads();
}

__device__ __forceinline__ void job_poolcomb(const Params& p, int l) {
    const float* pw = p.in[I_PW] + (size_t)l * 4 * 128 * 128; const float* sc = p.in[I_PSC] + l * 512; const float* wb = p.in[I_WBP] + (size_t)l * 512 * 1024;
    bf16_t* dst = (bf16_t*)(p.ws + WS_WBR + (size_t)(l * 3 + 2) * SZ_WBR);
    for (int idx = blockIdx.x * NTHREADS + tidx(); idx < 512 * 256; idx += gridDim.x * NTHREADS) {
        const int n = (idx & 255) * 4, k = idx >> 8, g = k >> 7, c = k & 127;
        f32x4 a = (f32x4){0.f, 0.f, 0.f, 0.f};
#pragma unroll 8
        for (int d = 0; d < 128; ++d) { const float ps = pw[(g * 128 + c) * 128 + d] * sc[g * 128 + d]; a += ps * *(const f32x4*)(wb + (size_t)(g * 128 + d) * 1024 + n); }
        dst[(size_t)n * 512 + k] = f2bf(a[0]); dst[(size_t)(n + 1) * 512 + k] = f2bf(a[1]); dst[(size_t)(n + 2) * 512 + k] = f2bf(a[2]); dst[(size_t)(n + 3) * 512 + k] = f2bf(a[3]);
    }
}

__device__ __forceinline__ void job_bias(const Params& p) {
    float* bias = (float*)(p.ws + WS_BIAS);
    for (int idx = blockIdx.x * NTHREADS + tidx(); idx < 2 * (NTR + NG); idx += gridDim.x * NTHREADS) {
        const int l = idx / (NTR + NG), j = idx % (NTR + NG); const float* b = p.in[I_BIN] + l * N_IN;
        float v;
        if (j < 1536) v = b[j]; else if (j < NTR) v = b[POOL_OFF + (j - 1536)]; else { const int q = j - NTR; v = q < NGV ? b[GLA_OFF + q] : 0.f; }
        bias[idx] = v;
    }
}

__device__ __forceinline__ void job_mod(const Params& p, LAS float* sil) {
    if (blockIdx.x >= 192) return;
    const int tid = tidx(), lane = tid & 63, kg = tid >> 6;
    float* mod = (float*)(p.ws + WS_MOD);
    for (int it = blockIdx.x; it < 192; it += gridDim.x) {
        __syncthreads();
        for (int idx = tid; idx < 33 * 1024; idx += NTHREADS) { const int r = idx >> 10, k = idx & 1023; const float v = r < 32 ? p.in[I_C][r * 1024 + k] : p.in[I_CCTX][k]; sil[idx] = v / (1.f + expf(-v)); }
        __syncthreads();
        const int l = it / 96, n0 = (it % 96) * 64;
        const float* w = p.in[I_WMOD] + (size_t)l * 1024 * 6144 + n0 + lane;
        float acc[33];
#pragma unroll
        for (int r = 0; r < 33; ++r) acc[r] = 0.f;
#pragma unroll 2
        for (int k4 = 0; k4 < 32; ++k4) { const int k = kg * 128 + k4 * 4;
            const float w0 = w[(size_t)k * 6144], w1 = w[(size_t)(k + 1) * 6144], w2 = w[(size_t)(k + 2) * 6144], w3 = w[(size_t)(k + 3) * 6144];
#pragma unroll
            for (int r = 0; r < 33; ++r) { const f32x4 sv = *(const LAS f32x4*)(sil + r * 1024 + k); acc[r] += sv[0] * w0 + sv[1] * w1 + sv[2] * w2 + sv[3] * w3; } }
        __syncthreads();
#pragma unroll
        for (int r = 0; r < 33; ++r) sil[(kg * 33 + r) * 64 + lane] = acc[r];
        __syncthreads();
        const float bm = p.in[I_BMOD][l * 6144 + n0 + lane];
        for (int r = kg; r < 33; r += 8) { float sum = 0.f;
#pragma unroll
            for (int q = 0; q < 8; ++q) sum += sil[(q * 33 + r) * 64 + lane];
            mod[(size_t)l * 33 * 6144 + (size_t)r * 6144 + n0 + lane] = sum + bm; }
    }
    __syncthreads();
}

__device__ __forceinline__ void job_filters(const Params& p, LAS unsigned char* lds) {
    LAS float* a1 = (LAS float*)lds;
    LAS float* a2 = (LAS float*)(lds + 16384);
    LAS bf16_t* oT = (LAS bf16_t*)(lds + 16384 + 16640);
    LAS float* w2L = (LAS float*)(lds + 16384 + 16640 + 73728);
    const int tid = tidx();
    const int nitems = (32 + 4 + 32) * 4;
    const int nrep = gridDim.x == 256 ? 2 : (nitems + (int)gridDim.x - 1) / (int)gridDim.x;
    for (int rep = 0; rep < nrep; ++rep) {
        int it;
        if (gridDim.x == 256) it = rep == 0 ? (int)blockIdx.x : ((blockIdx.x >= 192 && blockIdx.x < 208) ? 256 + (int)blockIdx.x - 192 : -1);
        else it = (int)blockIdx.x + rep * (int)gridDim.x;
        if (it < 0 || it >= nitems) continue;
        const int oc = it & 3; int rt = it >> 2; int l, L, t0; bf16_t* dst;
        if (rt < 32) { l = 0; L = 2048; t0 = rt * 64; dst = (bf16_t*)(p.ws + WS_HFL); }
        else if (rt < 36) { l = 0; L = 256; t0 = (rt - 32) * 64; dst = (bf16_t*)(p.ws + WS_HFC); }
        else { l = 1; L = 2048; t0 = (rt - 36) * 64; dst = (bf16_t*)(p.ws + WS_HFL) + (size_t)4 * 512 * 2048; }
        const float* w1 = p.in[I_FW1] + l * 17 * 64; const float* b1 = p.in[I_FB1] + l * 64; const float* fq = p.in[I_FFREQ] + l * 64;
        const float* w2 = p.in[I_FW2] + l * 64 * 64; const float* b2 = p.in[I_FB2] + l * 64; const float* w3 = p.in[I_FW3] + (size_t)l * 64 * 2048;
        __syncthreads();
#pragma unroll
        for (int q = 0; q < 2; ++q) *(LAS f32x4*)(w2L + (tid + q * NTHREADS) * 4) = *(const f32x4*)(w2 + (tid + q * NTHREADS) * 4);
        { const int row = tid >> 3, jg = (tid & 7) * 8; const float t = (float)(t0 + row); float z[17];
          z[0] = t / (float)L;
#pragma unroll
          for (int bnd = 1; bnd <= 8; ++bnd) { const float ang = (6.283185307179586f / (float)L) * t * (float)bnd; z[bnd] = cosf(ang); z[8 + bnd] = sinf(ang); }
#pragma unroll
          for (int j = 0; j < 8; ++j) { float s_ = b1[jg + j];
#pragma unroll
              for (int i = 0; i < 17; ++i) s_ += z[i] * w1[i * 64 + jg + j];
              a1[row * 64 + jg + j] = sinf(fq[jg + j] * s_); } }
        __syncthreads();
        { const int row = tid >> 3, jg = (tid & 7) * 8; float acc8[8];
#pragma unroll
          for (int j = 0; j < 8; ++j) acc8[j] = b2[jg + j];
#pragma unroll 4
          for (int i4 = 0; i4 < 64; i4 += 4) { const f32x4 av = *(const LAS f32x4*)(a1 + row * 64 + i4);
#pragma unroll
              for (int ii = 0; ii < 4; ++ii) { const f32x4 wa = *(const LAS f32x4*)(w2L + (i4 + ii) * 64 + jg), wb = *(const LAS f32x4*)(w2L + (i4 + ii) * 64 + jg + 4);
                  acc8[0] += av[ii] * wa[0]; acc8[1] += av[ii] * wa[1]; acc8[2] += av[ii] * wa[2]; acc8[3] += av[ii] * wa[3];
                  acc8[4] += av[ii] * wb[0]; acc8[5] += av[ii] * wb[1]; acc8[6] += av[ii] * wb[2]; acc8[7] += av[ii] * wb[3]; } }
#pragma unroll
          for (int j = 0; j < 8; ++j) a2[row * 65 + jg + j] = sinf(fq[jg + j] * acc8[j]); }
        __syncthreads();
        { const int o = oc * 512 + tid, c = o & 511; float wreg[64];
#pragma unroll
          for (int j = 0; j < 64; ++j) wreg[j] = w3[(size_t)j * 2048 + o];
          const float delta = 3.0701134573253943f + (float)c * ((15.350567286626972f - 3.0701134573253943f) / 511.f);
          for (int row = 0; row < 64; ++row) { float s = 0.f;
#pragma unroll
              for (int j = 0; j < 64; ++j) s += a2[row * 65 + j] * wreg[j];
              const float win = expf(-((float)(t0 + row) / (float)L) * delta);
              oT[tid * 72 + row] = f2bf(s * win); } }
        __syncthreads();
        for (int q = tid; q < 4096; q += NTHREADS) { const int ol = q >> 3, ch = (q & 7) * 8; const int o = oc * 512 + ol, dir = o >> 10, ord = (o >> 9) & 1, c = o & 511;
            const u32x4 w = *(const LAS u32x4*)(oT + ol * 72 + ch);
            *(u32x4*)(dst + ((size_t)((ord * 2 + dir) * 512 + c)) * L + t0 + ch) = w; }
    }
    __syncthreads();
}

__device__ __forceinline__ void ada_write(const f32x4 (&v)[4], float inv, const float* g, const float* sh, const float* sc, bf16_t* dst, float* fdst, int lane) {
#pragma unroll
    for (int i = 0; i < 4; ++i) { const int c = i * 256 + lane * 4; const f32x4 gg = *(const f32x4*)(g + c); f32x4 y = v[i] * inv * gg;
        if (sh) { const f32x4 s1 = *(const f32x4*)(sc + c), s0 = *(const f32x4*)(sh + c); y = y * (1.f + s1) + s0;
            u32x2 w; w.x = cvt_pk_bf16(y[0], y[1]); w.y = cvt_pk_bf16(y[2], y[3]); *(u32x2*)(dst + c) = w; }
        else *(f32x4*)(fdst + c) = y; }
}
__device__ __forceinline__ void ada_row2(const float* xa, const float* xb, bool hb, const float* g, const float* sha, const float* sca, const float* shb, const float* scb,
                                         bf16_t* da, bf16_t* db, float* fa, float* fb, int lane) {
    f32x4 va[4], vb[4]; float sa = 0.f, sb = 0.f;
#pragma unroll
    for (int i = 0; i < 4; ++i) va[i] = *(const f32x4*)(xa + i * 256 + lane * 4);
#pragma unroll
    for (int i = 0; i < 4; ++i) vb[i] = hb ? *(const f32x4*)(xb + i * 256 + lane * 4) : (f32x4){0.f, 0.f, 0.f, 0.f};
#pragma unroll
    for (int i = 0; i < 4; ++i) { sa += va[i][0] * va[i][0] + va[i][1] * va[i][1] + va[i][2] * va[i][2] + va[i][3] * va[i][3]; sb += vb[i][0] * vb[i][0] + vb[i][1] * vb[i][1] + vb[i][2] * vb[i][2] + vb[i][3] * vb[i][3]; }
#pragma unroll
    for (int o = 32; o >= 1; o >>= 1) { sa += __shfl_xor(sa, o); sb += __shfl_xor(sb, o); }
    ada_write(va, rsqrtf(sa * (1.f / 1024.f) + EPS), g, sha, sca, da, fa, lane);
    if (hb) ada_write(vb, rsqrtf(sb * (1.f / 1024.f) + EPS), g, shb, scb, db, fb, lane);
}
__device__ __forceinline__ void ada_row(const float* x, const float* g, const float* sh, const float* sc, bf16_t* dst, float* fdst, int lane) {
    f32x4 v[4]; float ss = 0.f;
#pragma unroll
    for (int i = 0; i < 4; ++i) { v[i] = *(const f32x4*)(x + i * 256 + lane * 4); ss += v[i][0] * v[i][0] + v[i][1] * v[i][1] + v[i][2] * v[i][2] + v[i][3] * v[i][3]; }
    ss = wave_sum(ss);
    const float inv = rsqrtf(ss * (1.f / 1024.f) + EPS);
#pragma unroll
    for (int i = 0; i < 4; ++i) { const int c = i * 256 + lane * 4; const f32x4 gg = *(const f32x4*)(g + c); f32x4 y = v[i] * inv * gg;
        if (sh) { const f32x4 s1 = *(const f32x4*)(sc + c), s0 = *(const f32x4*)(sh + c); y = y * (1.f + s1) + s0;
            u32x2 w; w.x = cvt_pk_bf16(y[0], y[1]); w.y = cvt_pk_bf16(y[2], y[3]); *(u32x2*)(dst + c) = w; }
        else *(f32x4*)(fdst + c) = y; }
}

typedef float f32x16 __attribute__((ext_vector_type(16)));
template <int L, int NT>
__device__ __forceinline__ void hyena_mfma(const Params& p, int l, int c, bool ctx, LAS unsigned char* lds) {
    LAS unsigned char* U = lds;
    LAS unsigned* F = (LAS unsigned*)(lds + L * 64);
    LAS bf16_t* F16 = (LAS bf16_t*)F;
    const int tid = tidx(), lane = tid & 63, w = __builtin_amdgcn_readfirstlane(tid >> 6), li = lane & 31, kg = lane >> 5;
    bf16_t* T = (bf16_t*)(p.ws + WS_T);
    const size_t tokb = ctx ? (size_t)TOKL : 0;
    const bf16_t* hf = ctx ? (const bf16_t*)(p.ws + WS_HFC) : (const bf16_t*)(p.ws + WS_HFL) + (size_t)l * 4 * 512 * 2048;
    const float* sw = p.in[I_HSW] + (size_t)l * 3 * 1536; const float* sb = p.in[I_HSB] + l * 1536;
    __syncthreads();
    {
        const int cc = 1024 + c; const bf16_t* row = T + (size_t)cc * TOK + tokb;
        const float w0 = sw[cc], w1 = sw[1536 + cc], w2 = sw[3072 + cc], bb = sb[cc];
        constexpr int ITER = L / 128, BATCH = ITER >= 4 ? 4 : ITER;
        for (int it0 = 0; it0 < ITER; it0 += BATCH) {
            u32x4 rr[BATCH]; bf16_t hm[BATCH], hp[BATCH];
#pragma unroll
            for (int q = 0; q < BATCH; ++q) { const int idx = tid + (it0 + q) * NTHREADS, bq = idx & 31, t8 = idx >> 5; const bf16_t* pr = row + (size_t)bq * L + t8 * 8;
                rr[q] = *(const u32x4*)pr; hm[q] = t8 > 0 ? pr[-1] : (bf16_t)0; hp[q] = t8 < L / 8 - 1 ? pr[8] : (bf16_t)0; }
#pragma unroll
            for (int q = 0; q < BATCH; ++q) { const int idx = tid + (it0 + q) * NTHREADS; const u32x4 r = rr[q];
                float x[10]; x[0] = bf2f(hm[q]); x[9] = bf2f(hp[q]);
                x[1] = lo16(r.x); x[2] = hi16(r.x); x[3] = lo16(r.y); x[4] = hi16(r.y); x[5] = lo16(r.z); x[6] = hi16(r.z); x[7] = lo16(r.w); x[8] = hi16(r.w);
                float y[8];
#pragma unroll
                for (int j = 0; j < 8; ++j) y[j] = w0 * x[j] + w1 * x[j + 1] + w2 * x[j + 2] + bb;
                u32x4 o; o.x = cvt_pk_bf16(y[0], y[1]); o.y = cvt_pk_bf16(y[2], y[3]); o.z = cvt_pk_bf16(y[4], y[5]); o.w = cvt_pk_bf16(y[6], y[7]);
                *(LAS u32x4*)(U + (size_t)idx * 16) = o; }
        }
    }
    const int lane_dw = (li & 1) * L + ((8 * kg - li + L - (li & 1)) >> 1);
#define HY_LOADA(dst, f) do { const LAS unsigned* _q = F + (lane_dw - 8 * (f)); u32x4 _v; _v.x = _q[0]; _v.y = _q[1]; _v.z = _q[2]; _v.w = _q[3]; dst = __builtin_bit_cast(bf16x8, _v); } while (0)
#define HY_LOADB(dst, s0) dst = *(const LAS bf16x8*)(U + ((s0) >> 3) * 512 + lane * 16)
    for (int ord = 0; ord < 2; ++ord) {
        __syncthreads();
        for (int x0 = tid; x0 < 2 * L; x0 += 4 * NTHREADS) {
            bf16_t fv[4];
#pragma unroll
            for (int q = 0; q < 4; ++q) { const int x = x0 + q * NTHREADS; bf16_t v = 0;
                if (x >= 1 && x <= L) v = hf[((size_t)((ord * 2 + 0) * 512 + c)) * L + (L - x)];
                else if (x > L && x < 2 * L) v = hf[((size_t)((ord * 2 + 1) * 512 + c)) * L + (x - L)];
                fv[q] = v; }
#pragma unroll
            for (int q = 0; q < 4; ++q) { const int x = x0 + q * NTHREADS; const bf16_t v = fv[q];
                if (x < 2 * L) { F16[x] = v; if (x >= 1) F16[2 * L + x - 1] = v; if (x == 2 * L - 1) F16[4 * L - 1] = 0; } } }
        if (false) for (int x = tid; x < 0; ++x) {
            bf16_t v = 0;
            if (x >= 1 && x <= L) v = hf[((size_t)((ord * 2 + 0) * 512 + c)) * L + (L - x)];
            else if (x > L) v = hf[((size_t)((ord * 2 + 1) * 512 + c)) * L + (x - L)];
            F16[x] = v; if (x >= 1) F16[2 * L + x - 1] = v; if (x == 2 * L - 1) F16[4 * L - 1] = 0; }
        __syncthreads();
        f32x16 acc[NT];
#pragma unroll
        for (int i = 0; i < NT; ++i)
#pragma unroll
            for (int r = 0; r < 16; ++r) acc[i][r] = 0.f;
        bf16x8 E[NT], O[NT];
#pragma unroll
        for (int i = 1; i < NT; ++i) { HY_LOADA(E[i], 2 * (NT * w + i)); HY_LOADA(O[i], 2 * (NT * w + i) - 1); }
        for (int n8 = 0; n8 < L / 32; n8 += 8) {
#pragma unroll
            for (int u = 0; u < 8; ++u) { const int n = n8 + u; const int fe = 2 * (NT * w - n); bf16x8 Bf;
                HY_LOADA(E[(8 - u) & (NT - 1)], fe); HY_LOADB(Bf, 32 * n);
#pragma unroll
                for (int i = 0; i < NT; ++i) acc[i] = __builtin_amdgcn_mfma_f32_32x32x16_bf16(E[(i - u) & (NT - 1)], Bf, acc[i], 0, 0, 0);
                HY_LOADA(O[(8 - u) & (NT - 1)], fe - 1); HY_LOADB(Bf, 32 * n + 16);
#pragma unroll
                for (int i = 0; i < NT; ++i) acc[i] = __builtin_amdgcn_mfma_f32_32x32x16_bf16(O[(i - u) & (NT - 1)], Bf, acc[i], 0, 0, 0);
            }
        }
        __syncthreads();
        const int lane2 = tidx() & 63, li = lane2 & 31, kg = lane2 >> 5;
        const int xc = ord * 512 + c; const bf16_t* xrow = T + (size_t)xc * TOK + tokb + (size_t)li * L;
        bf16_t* orow = T + (size_t)c * TOK + tokb + (size_t)li * L;
        const float w0 = sw[xc], w1 = sw[1536 + xc], w2 = sw[3072 + xc], bb = sb[xc], sk = p.in[I_HSKIP][(l * 2 + ord) * 512 + c];
#pragma unroll
        for (int i = 0; i < NT; ++i) {
#pragma unroll
            for (int rh = 0; rh < 4; rh += 2) {
            u32x2 xr4[2]; bf16_t hm[2], hp[2];
#pragma unroll
            for (int r2 = 0; r2 < 2; ++r2) { const int rg = rh + r2; const int tb = 32 * (NT * w + i) + 8 * rg + 4 * kg;
                xr4[r2] = *(const u32x2*)(xrow + tb); hm[r2] = tb > 0 ? xrow[tb - 1] : (bf16_t)0; hp[r2] = tb + 4 < L ? xrow[tb + 4] : (bf16_t)0; }
#pragma unroll
            for (int r2 = 0; r2 < 2; ++r2) { const int rg = rh + r2; const int tb = 32 * (NT * w + i) + 8 * rg + 4 * kg; const u32x2 xr = xr4[r2];
                float x[6]; x[0] = bf2f(hm[r2]); x[5] = bf2f(hp[r2]);
                x[1] = lo16(xr.x); x[2] = hi16(xr.x); x[3] = lo16(xr.y); x[4] = hi16(xr.y);
                LAS u32x2* up = (LAS u32x2*)(U + ((tb >> 3) * 32 + li) * 16 + (tb & 7) * 2);
                const u32x2 uv = *up; const float uu[4] = {lo16(uv.x), hi16(uv.x), lo16(uv.y), hi16(uv.y)};
                float z[4];
#pragma unroll
                for (int j = 0; j < 4; ++j) z[j] = (w0 * x[j] + w1 * x[j + 1] + w2 * x[j + 2] + bb) * (acc[i][rg * 4 + j] + sk * uu[j]);
                u32x2 o; o.x = cvt_pk_bf16(z[0], z[1]); o.y = cvt_pk_bf16(z[2], z[3]);
                if (ord == 0) *up = o; else *(u32x2*)(orow + tb) = o; }
            }
        }
    }
#undef HY_LOADA
#undef HY_LOADB
    __syncthreads();
}

__device__ __forceinline__ void gla_item(const Params& p, int l, int b, int h, int dir, LAS float* lf) {
    const int tid = tidx(), qd = tid & 3, dv = tid >> 2;
    LAS float* qL = lf; LAS float* kL = lf + 2048; LAS float* aL = lf + 4096; LAS float* vL = lf + 6144; LAS float* oL = lf + 10240; LAS float* waL = lf + 14336; LAS float* baL = lf + 15360;
    const bf16_t* PG = (const bf16_t*)(p.ws + WS_PG);
    bf16_t* O = (bf16_t*)(p.ws + WS_OF) + (size_t)dir * TOK * 512;
    const float* wa = (dir ? p.in[I_WAB] : p.in[I_WAF]) + l * 16 * 256; const float* ba = (dir ? p.in[I_BAB] : p.in[I_BAF]) + l * 256;
    __syncthreads();
    for (int i = tid; i < 1024; i += NTHREADS) waL[i] = wa[(i >> 6) * 256 + h * 64 + (i & 63)];
    if (tid < 64) baL[tid] = ba[h * 64 + tid];
    float S[16];
#pragma unroll
    for (int i = 0; i < 16; ++i) S[i] = 0.f;
    const int sp = tid >> 4, sc4 = (tid & 15) * 4, sc8 = (tid & 15) * 8;
    for (int ck = 0; ck < 72; ++ck) {
        const int P = ck * 32 + sp; size_t row;
        if (P < 256) row = (size_t)TOKL + b * 256 + (dir ? 255 - P : P); else { const int tl = P - 256; row = (size_t)b * 2048 + (dir ? 2047 - tl : tl); }
        const bf16_t* pr = PG + row * NG;
        __syncthreads();
        { const u32x2 wq = *(const u32x2*)(pr + h * 64 + sc4), wk = *(const u32x2*)(pr + 256 + h * 64 + sc4);
          *(LAS f32x4*)(qL + sp * 64 + sc4) = (f32x4){lo16(wq.x) * 0.125f, hi16(wq.x) * 0.125f, lo16(wq.y) * 0.125f, hi16(wq.y) * 0.125f};
          *(LAS f32x4*)(kL + sp * 64 + sc4) = (f32x4){lo16(wk.x), hi16(wk.x), lo16(wk.y), hi16(wk.y)};
          const u32x4 wv = *(const u32x4*)(pr + 512 + h * 128 + sc8);
          *(LAS f32x4*)(vL + sp * 128 + sc8) = (f32x4){lo16(wv.x), hi16(wv.x), lo16(wv.y), hi16(wv.y)};
          *(LAS f32x4*)(vL + sp * 128 + sc8 + 4) = (f32x4){lo16(wv.z), hi16(wv.z), lo16(wv.w), hi16(wv.w)};
          const u32x4 g0 = *(const u32x4*)(pr + 1536 + dir * 16), g1 = *(const u32x4*)(pr + 1536 + dir * 16 + 8);
          float gt[16] = {lo16(g0.x), hi16(g0.x), lo16(g0.y), hi16(g0.y), lo16(g0.z), hi16(g0.z), lo16(g0.w), hi16(g0.w),
                          lo16(g1.x), hi16(g1.x), lo16(g1.y), hi16(g1.y), lo16(g1.z), hi16(g1.z), lo16(g1.w), hi16(g1.w)};
#pragma unroll
          for (int j = 0; j < 4; ++j) { float z = baL[sc4 + j];
#pragma unroll
              for (int r = 0; r < 16; ++r) z += gt[r] * waL[r * 64 + sc4 + j];
              const float ls = -(fmaxf(-z, 0.f) + log1pf(expf(-fabsf(z))));
              aL[sp * 64 + sc4 + j] = expf(ls * (1.f / 16.f)); } }
        __syncthreads();
        for (int pos = 0; pos < 32; ++pos) {
            const float vv = vL[pos * 128 + dv]; float part = 0.f;
#pragma unroll
            for (int i4 = 0; i4 < 4; ++i4) { const f32x4 aa = *(const LAS f32x4*)(aL + pos * 64 + qd * 16 + i4 * 4), kk = *(const LAS f32x4*)(kL + pos * 64 + qd * 16 + i4 * 4), qq = *(const LAS f32x4*)(qL + pos * 64 + qd * 16 + i4 * 4);
#pragma unroll
                for (int j = 0; j < 4; ++j) { S[i4 * 4 + j] = aa[j] * S[i4 * 4 + j] + kk[j] * vv; part += qq[j] * S[i4 * 4 + j]; } }
            part += __shfl_xor(part, 1); part += __shfl_xor(part, 2);
            if (qd == 0) oL[pos * 128 + dv] = part;
        }
        __syncthreads();
        { const f32x4 o0 = *(const LAS f32x4*)(oL + sp * 128 + sc8), o1 = *(const LAS f32x4*)(oL + sp * 128 + sc8 + 4);
          u32x4 w; w.x = cvt_pk_bf16(o0[0], o0[1]); w.y = cvt_pk_bf16(o0[2], o0[3]); w.z = cvt_pk_bf16(o1[0], o1[1]); w.w = cvt_pk_bf16(o1[2], o1[3]);
          *(u32x4*)(O + row * 512 + h * 128 + sc8) = w; }
    }
    __syncthreads();
}


__device__ __forceinline__ size_t gla_row(int P, int b, int dir) { return P < 256 ? (size_t)TOKL + b * 256 + (dir ? 255 - P : P) : (size_t)b * 2048 + (dir ? 2047 - (P - 256) : (P - 256)); }
__device__ __forceinline__ void gla_chunk_item(const Params& p, int l, int b, int h, int dir, LAS unsigned char* lds) {
    constexpr int RS = 72;
    LAS bf16_t* QD = (LAS bf16_t*)lds; LAS bf16_t* KI = QD + 64 * RS; LAS bf16_t* KET = KI + 64 * RS; LAS bf16_t* PP = KET + 64 * RS;
    LAS bf16_t* VT = PP + 64 * RS; LAS bf16_t* ST = VT + 128 * RS;
    LAS float* TOT = (LAS float*)(ST + 128 * RS); LAS float* DEC = TOT + 512; LAS float* WAL = DEC + 64; LAS float* BAL = WAL + 1024;
    const int tid = tidx(), lane = tid & 63, w = __builtin_amdgcn_readfirstlane(tid >> 6), i = tid >> 3, dg = tid & 7, d0 = dg * 8, l5 = lane & 31, hh = lane >> 5;
    const int ih = w >> 2, vq = w & 3;
    const bf16_t* PG = (const bf16_t*)(p.ws + WS_PG);
    bf16_t* O = (bf16_t*)(p.ws + WS_OF) + (size_t)dir * TOK * 512;
    const float* wa = (dir ? p.in[I_WAB] : p.in[I_WAF]) + l * 16 * 256; const float* ba = (dir ? p.in[I_BAB] : p.in[I_BAF]) + l * 256;
    __syncthreads();
    for (int q = tid; q < 1024; q += NTHREADS) WAL[q] = wa[(q >> 6) * 256 + h * 64 + (q & 63)];
    if (tid < 64) BAL[tid] = ba[h * 64 + tid];
    for (int q = tid; q < 73728 / 16; q += NTHREADS) *(LAS u32x4*)(lds + q * 16) = (u32x4){0u, 0u, 0u, 0u};
    f32x16 accS;
#pragma unroll
    for (int r = 0; r < 16; ++r) accS[r] = 0.f;
    u32x4 rq, rk, rg0, rg1, rv0, rv1;
    { const bf16_t* pr = PG + gla_row(i, b, dir) * NG;
      rq = *(const u32x4*)(pr + h * 64 + d0); rk = *(const u32x4*)(pr + 256 + h * 64 + d0); rg0 = *(const u32x4*)(pr + 1536 + dir * 16); rg1 = *(const u32x4*)(pr + 1536 + dir * 16 + 8);
      rv0 = *(const u32x4*)(pr + 512 + h * 128 + dg * 16); rv1 = *(const u32x4*)(pr + 512 + h * 128 + dg * 16 + 8); }
    __syncthreads();
    for (int ck = 0; ck < 36; ++ck) {
        float qf[8] = {lo16(rq.x), hi16(rq.x), lo16(rq.y), hi16(rq.y), lo16(rq.z), hi16(rq.z), lo16(rq.w), hi16(rq.w)};
        float kf[8] = {lo16(rk.x), hi16(rk.x), lo16(rk.y), hi16(rk.y), lo16(rk.z), hi16(rk.z), lo16(rk.w), hi16(rk.w)};
        float gt[16] = {lo16(rg0.x), hi16(rg0.x), lo16(rg0.y), hi16(rg0.y), lo16(rg0.z), hi16(rg0.z), lo16(rg0.w), hi16(rg0.w),
                        lo16(rg1.x), hi16(rg1.x), lo16(rg1.y), hi16(rg1.y), lo16(rg1.z), hi16(rg1.z), lo16(rg1.w), hi16(rg1.w)};
        float la[8];
#pragma unroll
        for (int j = 0; j < 8; ++j) { float z = BAL[d0 + j];
#pragma unroll
            for (int r = 0; r < 16; ++r) z += gt[r] * WAL[r * 64 + d0 + j];
            la[j] = -(fmaxf(-z, 0.f) + __logf(1.f + __expf(-fabsf(z)))) * (1.f / 16.f); }
#pragma unroll
        for (int st = 8; st < 64; st <<= 1) {
#pragma unroll
            for (int j = 0; j < 8; ++j) { const float y = __shfl_up(la[j], st); if (lane >= st) la[j] += y; } }
        if ((lane >> 3) == 7) { *(LAS f32x4*)(TOT + w * 64 + d0) = (f32x4){la[0], la[1], la[2], la[3]}; *(LAS f32x4*)(TOT + w * 64 + d0 + 4) = (f32x4){la[4], la[5], la[6], la[7]}; }
        __syncthreads();
        {
            float pre[8], bl[8];
#pragma unroll
            for (int j = 0; j < 8; ++j) { pre[j] = 0.f; bl[j] = 0.f; }
#pragma unroll
            for (int ww = 0; ww < 8; ++ww) { const f32x4 t0 = *(const LAS f32x4*)(TOT + ww * 64 + d0), t1 = *(const LAS f32x4*)(TOT + ww * 64 + d0 + 4);
                const float tv[8] = {t0[0], t0[1], t0[2], t0[3], t1[0], t1[1], t1[2], t1[3]};
#pragma unroll
                for (int j = 0; j < 8; ++j) { bl[j] += tv[j]; if (ww < w) pre[j] += tv[j]; } }
            float qd[8], ki[8], ke[8], eb[8];
#pragma unroll
            for (int j = 0; j < 8; ++j) { const float bc = la[j] + pre[j]; const float e1 = __expf(bc), e2 = __builtin_amdgcn_rcpf(e1); eb[j] = __expf(bl[j]);
                qd[j] = qf[j] * 0.125f * e1; ki[j] = kf[j] * e2; ke[j] = kf[j] * (eb[j] * e2); }
            u32x4 wq, wk;
            wq.x = cvt_pk_bf16(qd[0], qd[1]); wq.y = cvt_pk_bf16(qd[2], qd[3]); wq.z = cvt_pk_bf16(qd[4], qd[5]); wq.w = cvt_pk_bf16(qd[6], qd[7]);
            wk.x = cvt_pk_bf16(ki[0], ki[1]); wk.y = cvt_pk_bf16(ki[2], ki[3]); wk.z = cvt_pk_bf16(ki[4], ki[5]); wk.w = cvt_pk_bf16(ki[6], ki[7]);
            *(LAS u32x4*)(QD + i * RS + d0) = wq; *(LAS u32x4*)(KI + i * RS + d0) = wk;
#pragma unroll
            for (int j = 0; j < 8; j += 2) { const unsigned pk = cvt_pk_bf16(ke[j], ke[j + 1]); KET[(d0 + j) * RS + i] = (bf16_t)(pk & 0xffffu); KET[(d0 + j + 1) * RS + i] = (bf16_t)(pk >> 16); }
            const unsigned vv[8] = {rv0.x, rv0.y, rv0.z, rv0.w, rv1.x, rv1.y, rv1.z, rv1.w};
#pragma unroll
            for (int j = 0; j < 8; ++j) { VT[(dg * 16 + 2 * j) * RS + i] = (bf16_t)(vv[j] & 0xffffu); VT[(dg * 16 + 2 * j + 1) * RS + i] = (bf16_t)(vv[j] >> 16); }
            if (i == 0) { *(LAS f32x4*)(DEC + d0) = (f32x4){eb[0], eb[1], eb[2], eb[3]}; *(LAS f32x4*)(DEC + d0 + 4) = (f32x4){eb[4], eb[5], eb[6], eb[7]}; }
        }
        if (ck + 1 < 36) { const bf16_t* pr = PG + gla_row((ck + 1) * 64 + i, b, dir) * NG;
            rq = *(const u32x4*)(pr + h * 64 + d0); rk = *(const u32x4*)(pr + 256 + h * 64 + d0); rg0 = *(const u32x4*)(pr + 1536 + dir * 16); rg1 = *(const u32x4*)(pr + 1536 + dir * 16 + 8);
            rv0 = *(const u32x4*)(pr + 512 + h * 128 + dg * 16); rv1 = *(const u32x4*)(pr + 512 + h * 128 + dg * 16 + 8); }
        __syncthreads();
        f32x16 accO;
#pragma unroll
        for (int r = 0; r < 16; ++r) accO[r] = 0.f;
#pragma unroll
        for (int ks = 0; ks < 4; ++ks) { const bf16x8 A = *(const LAS bf16x8*)(QD + (ih * 32 + l5) * RS + ks * 16 + hh * 8), Bv = *(const LAS bf16x8*)(ST + (vq * 32 + l5) * RS + ks * 16 + hh * 8);
            accO = __builtin_amdgcn_mfma_f32_32x32x16_bf16(A, Bv, accO, 0, 0, 0); }
        if (w < 3) { const int si = w == 0 ? 0 : 1, sj = w == 2 ? 1 : 0; f32x16 accP;
#pragma unroll
            for (int r = 0; r < 16; ++r) accP[r] = 0.f;
#pragma unroll
            for (int ks = 0; ks < 4; ++ks) { const bf16x8 A = *(const LAS bf16x8*)(QD + (si * 32 + l5) * RS + ks * 16 + hh * 8), Bv = *(const LAS bf16x8*)(KI + (sj * 32 + l5) * RS + ks * 16 + hh * 8);
                accP = __builtin_amdgcn_mfma_f32_32x32x16_bf16(A, Bv, accP, 0, 0, 0); }
#pragma unroll
            for (int r = 0; r < 16; ++r) { const int ii = si * 32 + (r & 3) + 8 * (r >> 2) + 4 * hh, jj = sj * 32 + l5; PP[ii * RS + jj] = f2bf(jj <= ii ? accP[r] : 0.f); } }
        __syncthreads();
        { const int nk = ih == 0 ? 2 : 4;
          for (int ks = 0; ks < nk; ++ks) { const bf16x8 A = *(const LAS bf16x8*)(PP + (ih * 32 + l5) * RS + ks * 16 + hh * 8), Bv = *(const LAS bf16x8*)(VT + (vq * 32 + l5) * RS + ks * 16 + hh * 8);
              accO = __builtin_amdgcn_mfma_f32_32x32x16_bf16(A, Bv, accO, 0, 0, 0); } }
#pragma unroll
        for (int rg = 0; rg < 4; ++rg) { const f32x4 dv = *(const LAS f32x4*)(DEC + ih * 32 + 8 * rg + 4 * hh);
#pragma unroll
            for (int j = 0; j < 4; ++j) accS[rg * 4 + j] *= dv[j]; }
#pragma unroll
        for (int ks = 0; ks < 4; ++ks) { const bf16x8 A = *(const LAS bf16x8*)(KET + (ih * 32 + l5) * RS + ks * 16 + hh * 8), Bv = *(const LAS bf16x8*)(VT + (vq * 32 + l5) * RS + ks * 16 + hh * 8);
            accS = __builtin_amdgcn_mfma_f32_32x32x16_bf16(A, Bv, accS, 0, 0, 0); }
#pragma unroll
        for (int r = 0; r < 16; ++r) { const int ii = ih * 32 + (r & 3) + 8 * (r >> 2) + 4 * hh;
            O[gla_row(ck * 64 + ii, b, dir) * 512 + h * 128 + vq * 32 + l5] = f2bf(accO[r]); }
#pragma unroll
        for (int rg = 0; rg < 4; ++rg) { u32x2 o; o.x = cvt_pk_bf16(accS[rg * 4], accS[rg * 4 + 1]); o.y = cvt_pk_bf16(accS[rg * 4 + 2], accS[rg * 4 + 3]);
            *(LAS u32x2*)(ST + (vq * 32 + l5) * RS + ih * 32 + 8 * rg + 4 * hh) = o; }
        __syncthreads();
    }
    __syncthreads();
}

template <int W>
__device__ __forceinline__ void pool2d_wave(bf16_t* base, int lane) {
    float u[32], pv[33];
#pragma unroll
    for (int r = 0; r < 32; ++r) u[r] = bf2f(base[r * 64 + lane]);
    pv[0] = 0.f;
#pragma unroll
    for (int r = 0; r < 32; ++r) pv[r + 1] = pv[r] + u[r];
    const int cl = max(lane - W / 2, 0), chh = min(lane - W / 2 + W, 64);
#pragma unroll
    for (int r = 0; r < 32; ++r) {
        const int rl = (r - W / 2) < 0 ? 0 : (r - W / 2), rh = (r - W / 2 + W) > 32 ? 32 : (r - W / 2 + W);
        float x = pv[rh] - pv[rl];
#pragma unroll
        for (int d = 1; d < 64; d <<= 1) { const float y = __shfl_up(x, d); if (lane >= d) x += y; }
        const float hi = __shfl(x, chh - 1), lo = __shfl(x, cl > 0 ? cl - 1 : 0);
        const float s = hi - (cl > 0 ? lo : 0.f);
        const float cnt = (float)((rh - rl) * (chh - cl));
        base[r * 64 + lane] = f2bf(s / cnt - u[r]);
    }
}
__device__ __forceinline__ void pool1d_wave(bf16_t* base, int lane, int W) {
    float u[4], P[4];
#pragma unroll
    for (int j = 0; j < 4; ++j) u[j] = bf2f(base[j * 64 + lane]);
    float off = 0.f;
#pragma unroll
    for (int j = 0; j < 4; ++j) { float x = u[j];
#pragma unroll
        for (int d = 1; d < 64; d <<= 1) { const float y = __shfl_up(x, d); if (lane >= d) x += y; }
        P[j] = x + off; off += __shfl(x, 63); }
#pragma unroll
    for (int j = 0; j < 4; ++j) { const int t = j * 64 + lane; const int lo = max(t - W / 2, 0), hi = min(t - W / 2 + W, 256);
        const int ih = hi - 1, il = lo > 0 ? lo - 1 : 0;
        float vh = 0.f, vl = 0.f;
#pragma unroll
        for (int s = 0; s < 4; ++s) { const float a = __shfl(P[s], ih & 63), bq = __shfl(P[s], il & 63); if ((ih >> 6) == s) vh = a; if ((il >> 6) == s) vl = bq; }
        const float sum = vh - (lo > 0 ? vl : 0.f);
        u[j] = sum / (float)(hi - lo) - u[j]; }
#pragma unroll
    for (int j = 0; j < 4; ++j) base[j * 64 + lane] = f2bf(u[j]);
}

__global__ void __launch_bounds__(NTHREADS, 2) mega(Params p) {
    extern __shared__ __attribute__((aligned(16))) unsigned char lds_raw[];
    LAS unsigned char* lds = (LAS unsigned char*)lds_raw;
    LAS float* lf = (LAS float*)lds;
    cg::grid_group grid = cg::this_grid();
    unsigned bar_n = 0; unsigned* bar_ctr = (unsigned*)(p.ws + WS_BAR);
unsigned hb_k = 0, hb_xcc = 0, hb_nloc = 0, hb_nx = 0;
#define GBAR() do { if (hb_nloc == 0u) { bar_n += gridDim.x; gbar(bar_ctr, bar_n); } else { ++hb_k; gbar_h(bar_ctr, hb_xcc, hb_nloc, hb_nx, hb_k); } } while (0)
    const int G = gridDim.x, bid = blockIdx.x;
#define WSPTRS const int tid = tidx(), lane = tid & 63, wid = tid >> 6; (void)lane; (void)wid; unsigned char* ws = opq(p.ws); bf16_t* HX = (bf16_t*)(ws + WS_HX); bf16_t* T = (bf16_t*)(ws + WS_T); bf16_t* YG = (bf16_t*)(ws + WS_YG); bf16_t* PG = (bf16_t*)(ws + WS_PG); \
    float* CTXS = (float*)(ws + WS_CTX); const float* MOD = (const float*)(ws + WS_MOD); const float* BIAS = (const float*)(ws + WS_BIAS); (void)HX; (void)T; (void)YG; (void)PG; (void)CTXS; (void)MOD; (void)BIAS;

#ifdef TIMEX
    unsigned long long tx0 = 0, tx1 = 0; int txn = 0;
#define TX_MARK() do { if (txn == TIMEX) tx0 = __builtin_amdgcn_s_memrealtime(); if (txn == TIMEX + 1) tx1 = __builtin_amdgcn_s_memrealtime(); ++txn; } while (0)
    unsigned long long cx0 = 0, cxacc = 0;
#define CX_BEGIN(k) do { if (TIMEX == 100 + (k) && l == 1) { __syncthreads(); cx0 = __builtin_amdgcn_s_memrealtime(); } } while (0)
#define CX_END(k) do { if (TIMEX == 100 + (k) && l == 1) { __syncthreads(); cxacc += __builtin_amdgcn_s_memrealtime() - cx0; } } while (0)
#else
#define TX_MARK() do {} while (0)
#define CX_BEGIN(k) do {} while (0)
#define CX_END(k) do {} while (0)
#endif
    if (threadIdx.x == 0) { unsigned* ctl = (unsigned*)(p.ws + WS_BAR); const unsigned xcc = (unsigned)__builtin_amdgcn_s_getreg((3 << 11) | 20) & 7u;
        const unsigned rank = __hip_atomic_fetch_add(ctl + 16 + xcc, 1u, __ATOMIC_RELAXED, __HIP_MEMORY_SCOPE_AGENT);
        __hip_atomic_store(ctl + 256 + 2 * blockIdx.x, xcc, __ATOMIC_RELAXED, __HIP_MEMORY_SCOPE_AGENT); __hip_atomic_store(ctl + 257 + 2 * blockIdx.x, rank, __ATOMIC_RELAXED, __HIP_MEMORY_SCOPE_AGENT); }
    int xj = (int)blockIdx.x;
    TX_MARK();
    for (int l = 0; l < 2; ++l) {
        unsigned char* ws = opq(p.ws);
        const float* win = p.in[I_WIN] + (size_t)l * D * N_IN;
        bf16_t* wt = (bf16_t*)(ws + WS_WT + l * SZ_WT);
        tconv(win, N_IN, 0, 1536, 1536, D, wt, lf);
        tconv(win, N_IN, POOL_OFF, 512, 512, D, wt + (size_t)1536 * D, lf);
        tconv(win, N_IN, GLA_OFF, NGV, NG, D, (bf16_t*)(ws + WS_WG + l * SZ_WG), lf);
        tconv(win, N_IN, GATE_OFF, 3072, 3072, D, (bf16_t*)(ws + WS_WGATE + l * SZ_WGATE), lf);
        tconv(p.in[I_WBH] + (size_t)l * 512 * 1024, 1024, 0, 1024, 1024, 512, (bf16_t*)(ws + WS_WBR + (size_t)(l * 3 + 0) * SZ_WBR), lf);
        tconv(p.in[I_WBG] + (size_t)l * 512 * 1024, 1024, 0, 1024, 1024, 512, (bf16_t*)(ws + WS_WBR + (size_t)(l * 3 + 1) * SZ_WBR), lf);
        tconv(p.in[I_WOUT] + (size_t)l * D * D, D, 0, D, D, D, (bf16_t*)(ws + WS_WOUT + l * SZ_WOUT), lf);
        tconv(p.in[I_WUP] + (size_t)l * D * DFF, DFF, 0, DFF, DFF, D, (bf16_t*)(ws + WS_WUP + l * SZ_WUP), lf);
        tconv(p.in[I_WDN] + (size_t)l * DFF * D, D, 0, D, D, DFF, (bf16_t*)(ws + WS_WDN + l * SZ_WDN), lf);
        job_poolcomb(p, l);
    }
    job_bias(p);
    job_mod(p, lf);
    job_filters(p, lds);
    if (p.ws == nullptr) grid.sync();
    GBAR();
    { unsigned* ctl = (unsigned*)(p.ws + WS_BAR); bool ok = (gridDim.x & 7u) == 0u;
      for (int q = 0; q < 8; ++q) ok = ok && (__hip_atomic_load(ctl + 16 + q, __ATOMIC_RELAXED, __HIP_MEMORY_SCOPE_AGENT) == (gridDim.x >> 3));
      const unsigned mx = __hip_atomic_load(ctl + 256 + 2 * blockIdx.x, __ATOMIC_RELAXED, __HIP_MEMORY_SCOPE_AGENT), mr = __hip_atomic_load(ctl + 257 + 2 * blockIdx.x, __ATOMIC_RELAXED, __HIP_MEMORY_SCOPE_AGENT);
      if (ok) xj = __builtin_amdgcn_readfirstlane((int)((mr << 3) | mx));
      unsigned sum = 0u, nxc = 0u;
      for (int q = 0; q < 8; ++q) { const unsigned cq = __hip_atomic_load(ctl + 16 + q, __ATOMIC_RELAXED, __HIP_MEMORY_SCOPE_AGENT); sum += cq; nxc += cq ? 1u : 0u; }
      if (sum == gridDim.x) { hb_xcc = (unsigned)__builtin_amdgcn_readfirstlane((int)mx); hb_nloc = (unsigned)__builtin_amdgcn_readfirstlane((int)__hip_atomic_load(ctl + 16 + mx, __ATOMIC_RELAXED, __HIP_MEMORY_SCOPE_AGENT)); hb_nx = nxc; } }

    { WSPTRS
    for (int row = bid * 8 + wid; row < TOK; row += 2 * G * 8) {
        const int rb = row + G * 8; const bool hb = rb < TOK; const int rb2 = hb ? rb : row;
        const bool la = row < TOKL, lb = rb2 < TOKL;
        const float* xa = la ? p.in[I_X] + (size_t)row * D : p.in[I_CTX] + (size_t)(row - TOKL) * D; const float* xb = lb ? p.in[I_X] + (size_t)rb2 * D : p.in[I_CTX] + (size_t)(rb2 - TOKL) * D;
        const float* ma = MOD + (size_t)(la ? row >> 11 : 32) * 6144; const float* mb = MOD + (size_t)(lb ? rb2 >> 11 : 32) * 6144;
        ada_row2(xa, xb, hb, p.in[I_NMIX], ma, ma + 1024, mb, mb + 1024, HX + (size_t)row * D, HX + (size_t)rb2 * D, nullptr, nullptr, lane);
    } }
    GBAR();
    TX_MARK();

    for (int l_ = 0; l_ < 2; ++l_) {
        const int l = opqi(l_);
        { WSPTRS
            const int ntokt = l == 0 ? 288 : 256;
            const int nA = ntokt * 8, nB = 288 * 7;
            const bf16_t* wt = (const bf16_t*)(ws + WS_WT + l * SZ_WT); const bf16_t* wg = (const bf16_t*)(ws + WS_WG + l * SZ_WG);
            const float* biasT = BIAS + l * (NTR + NG); const float* biasG = biasT + NTR;
            XMap MA, MB; MA.init(xj, ntokt, 8); MB.init(xj, 288, 7);
            ProgInproj P{wt, wg, HX, T, PG, biasT, biasG, MA, MB, MA.rounds()};
            gemm_stream(lds, MA.rounds() + MB.rounds(), P);
        }
        GBAR();
        TX_MARK();
        { WSPTRS
            for (int it = bid; it < 256; it += G) gla_chunk_item(p, l, it >> 3, (it >> 1) & 3, it & 1, lds);
            for (int it = bid; it < 512; it += G) hyena_mfma<2048, 8>(p, l, it, false, lds);
            if (l == 0) for (int it = bid; it < 512; it += G) hyena_mfma<256, 1>(p, l, it, true, lds);
            const int npl = l == 0 ? 32768 : 16384;
            for (int it = bid * 8 + wid; it < npl; it += G * 8) { const bool cx = it >= 16384; const int j = it & 16383, ch = j >> 5, b = j & 31, g = ch >> 7;
                bf16_t* base = T + (size_t)(1536 + ch) * TOK + (cx ? (size_t)TOKL + b * 256 : (size_t)b * 2048);
                if (cx) pool1d_wave(base, lane, 2 << g);
                else { if (g == 0) pool2d_wave<2>(base, lane); else if (g == 1) pool2d_wave<4>(base, lane); else if (g == 2) pool2d_wave<8>(base, lane); else pool2d_wave<16>(base, lane); } }
        }
        GBAR();
        TX_MARK();
        {
            WSPTRS
            const bf16_t* OF = (const bf16_t*)(ws + WS_OF); const bf16_t* OB = OF + (size_t)TOK * 512; const float* nw = p.in[I_GNW] + l * 128;
            const int ntok = l == 0 ? TOK : TOKL;
            for (int row = bid * 8 + wid; row < ntok; row += 2 * G * 8) {
                const int rowb = row + G * 8; const bool hb = rowb < ntok; const int rows[2] = {row, hb ? rowb : row};
                u32x4 av[2], bv[2], rv[2];
#pragma unroll
                for (int q = 0; q < 2; ++q) { av[q] = *(const u32x4*)(OF + (size_t)rows[q] * 512 + lane * 8); bv[q] = *(const u32x4*)(OB + (size_t)rows[q] * 512 + lane * 8); rv[q] = *(const u32x4*)(PG + (size_t)rows[q] * NG + 1024 + lane * 8); }
#pragma unroll
                for (int q = 0; q < 2; ++q) { if (q == 1 && !hb) break;
                    const u32x4 a = av[q], bq = bv[q], rr = rv[q];
                    float o[8] = {lo16(a.x) + lo16(bq.x), hi16(a.x) + hi16(bq.x), lo16(a.y) + lo16(bq.y), hi16(a.y) + hi16(bq.y), lo16(a.z) + lo16(bq.z), hi16(a.z) + hi16(bq.z), lo16(a.w) + lo16(bq.w), hi16(a.w) + hi16(bq.w)};
                    float r[8] = {lo16(rr.x), hi16(rr.x), lo16(rr.y), hi16(rr.y), lo16(rr.z), hi16(rr.z), lo16(rr.w), hi16(rr.w)};
                    float ss = 0.f;
#pragma unroll
                    for (int j = 0; j < 8; ++j) ss += o[j] * o[j];
                    ss += __shfl_xor(ss, 1); ss += __shfl_xor(ss, 2); ss += __shfl_xor(ss, 4); ss += __shfl_xor(ss, 8);
                    const float inv = rsqrtf(ss * (1.f / 128.f) + EPS);
                    float y[8];
#pragma unroll
                    for (int j = 0; j < 8; ++j) y[j] = o[j] * inv * nw[(lane & 15) * 8 + j] * (r[j] * sigmoidf_(r[j]));
                    u32x4 w; w.x = cvt_pk_bf16(y[0], y[1]); w.y = cvt_pk_bf16(y[2], y[3]); w.z = cvt_pk_bf16(y[4], y[5]); w.w = cvt_pk_bf16(y[6], y[7]);
                    *(u32x4*)(YG + (size_t)rows[q] * 512 + lane * 8) = w; }
            }
            LAS bf16_t* tl = (LAS bf16_t*)lds;
            const int nit = 2 * (l == 0 ? 288 : 256) * 8;
            for (int it = bid; it < nit; it += G) { const int ctile = it & 7, tt = (it >> 3) % (l == 0 ? 288 : 256), which = (it >> 3) / (l == 0 ? 288 : 256);
                const bf16_t* src = T + (size_t)(which ? 1536 : 0) * TOK + (size_t)tt * 256; bf16_t* dst = (bf16_t*)(ws + (which ? WS_YPL : WS_YHY)) + (size_t)tt * 256 * 512;
                __syncthreads();
#pragma unroll
                for (int i = 0; i < 4; ++i) { const int idx = tid + i * NTHREADS, c = idx >> 5, t8 = (idx & 31) * 8;
                    *(LAS u32x4*)(tl + c * 264 + t8) = *(const u32x4*)(src + (size_t)(ctile * 64 + c) * TOK + t8); }
                __syncthreads();
#pragma unroll
                for (int i = 0; i < 4; ++i) { const int idx = tid + i * NTHREADS, tk = idx >> 3, c8 = (idx & 7) * 8; unsigned w[4];
#pragma unroll
                    for (int j = 0; j < 4; ++j) w[j] = (unsigned)tl[(c8 + 2 * j) * 264 + tk] | ((unsigned)tl[(c8 + 2 * j + 1) * 264 + tk] << 16);
                    *(u32x4*)(dst + (size_t)tk * 512 + ctile * 64 + c8) = (u32x4){w[0], w[1], w[2], w[3]}; }
            }
            __syncthreads();
        }
        GBAR();
        TX_MARK();
        const int ntt = l == 0 ? 288 : 256;
        { WSPTRS
          XMap M; M.init(xj, ntt, 4);
          ProgMix2 P{ws, ws + WS_STASH + (size_t)bid * 524288, p.in[I_BIN] + l * N_IN + GATE_OFF, M, l};
          gemm_stream(lds, 6 * M.rounds(), P); }
        GBAR();
        { WSPTRS
          XMap M; M.init(xj, ntt, 4);
          TileIO io{p.in[I_X], p.in[I_CTX], p.out, CTXS, MOD + (size_t)l * 33 * 6144, l};
          ProgOut2 P{ws, io, M, l};
          gemm_stream(lds, M.rounds(), P); }
        GBAR();
        { WSPTRS
          const float* modl = MOD + (size_t)l * 33 * 6144; const int nrow = ntt * 256;
          for (int row = bid * 8 + wid; row < nrow; row += 2 * G * 8) { const int rb = row + G * 8; const bool hb = rb < nrow; const int rb2 = hb ? rb : row; const bool la = row < TOKL, lb = rb2 < TOKL;
              const float* xa = la ? p.out + (size_t)row * D : CTXS + (size_t)(row - TOKL) * D; const float* xb = lb ? p.out + (size_t)rb2 * D : CTXS + (size_t)(rb2 - TOKL) * D;
              const float* ma = modl + (size_t)(la ? row >> 11 : 32) * 6144; const float* mb = modl + (size_t)(lb ? rb2 >> 11 : 32) * 6144;
              ada_row2(xa, xb, hb, p.in[I_NFFN] + l * D, ma + 3072, ma + 4096, mb + 3072, mb + 4096, HX + (size_t)row * D, HX + (size_t)rb2 * D, nullptr, nullptr, lane); } }
        GBAR();
        { WSPTRS
          XMap M; M.init(xj, ntt, 16);
          ProgUp2 P{ws, M, l};
          gemm_stream(lds, M.rounds(), P); }
        GBAR();
        { WSPTRS
          XMap M; M.init(xj, ntt, 4);
          TileIO io{p.in[I_X], p.in[I_CTX], p.out, CTXS, MOD + (size_t)l * 33 * 6144, l};
          ProgDown2 P{ws, io, M, l};
          gemm_stream(lds, M.rounds(), P); }
        GBAR();
        { WSPTRS
          const int nrow = ntt * 256;
          for (int row = bid * 8 + wid; row < nrow; row += 2 * G * 8) { const int rb = row + G * 8; const bool hb = rb < nrow; const int rb2 = hb ? rb : row; const bool la = row < TOKL, lb = rb2 < TOKL;
              float* xa = la ? p.out + (size_t)row * D : CTXS + (size_t)(row - TOKL) * D; float* xb = lb ? p.out + (size_t)rb2 * D : CTXS + (size_t)(rb2 - TOKL) * D;
              if (l == 0) { const float* ma = MOD + (size_t)33 * 6144 + (size_t)(la ? row >> 11 : 32) * 6144; const float* mb = MOD + (size_t)33 * 6144 + (size_t)(lb ? rb2 >> 11 : 32) * 6144;
                  ada_row2(xa, xb, hb, p.in[I_NMIX] + D, ma, ma + 1024, mb, mb + 1024, HX + (size_t)row * D, HX + (size_t)rb2 * D, nullptr, nullptr, lane); }
              else ada_row2(xa, xb, hb, p.in[I_NFIN], nullptr, nullptr, nullptr, nullptr, nullptr, nullptr, xa, xb, lane); } }
        if (l == 0) GBAR();
        TX_MARK();
    }
#ifdef TIMEX
    if (blockIdx.x == 0 && threadIdx.x == 0) { const unsigned long long t = __builtin_amdgcn_s_memrealtime(); while (__builtin_amdgcn_s_memrealtime() - t < (unsigned long long)TIMEX_MULT * (TIMEX >= 100 ? cxacc : (tx1 - tx0))) __builtin_amdgcn_s_sleep(10); }
#endif
}

extern "C" void kernel_launch(void* const* d_in, const int* in_sizes, int n_in, void* d_out, int out_size,
                              void* d_ws, size_t ws_size, hipStream_t stream) {
    static int grid_blocks = 0;
    if (!grid_blocks) {
        int dev = 0, cus = 0, per_cu = 0;
        (void)hipGetDevice(&dev);
        (void)hipDeviceGetAttribute(&cus, hipDeviceAttributeMultiprocessorCount, dev);
        (void)hipFuncSetAttribute((const void*)mega, hipFuncAttributeMaxDynamicSharedMemorySize, LDS_BYTES);
        (void)hipOccupancyMaxActiveBlocksPerMultiprocessor(&per_cu, (const void*)mega, NTHREADS, LDS_BYTES);
        grid_blocks = cus > 256 ? 256 : cus;
        if (ws_size < WS_END || n_in != 33 || out_size != TOKL * D) { fprintf(stderr, "kernel_launch: unexpected sizes ws=%zu need=%zu n_in=%d out=%d\n", ws_size, (size_t)WS_END, n_in, out_size); grid_blocks = -1; }
    }
    if (grid_blocks < 0) return;
    Params p{};
    for (int i = 0; i < 33; ++i) p.in[i] = (const float*)d_in[i];
    p.out = (float*)d_out; p.ws = (unsigned char*)d_ws;
    (void)hipMemsetAsync((unsigned char*)d_ws + WS_BAR, 0, 8192, stream);
    void* args[] = {&p};
    hipError_t e = hipLaunchCooperativeKernel((const void*)mega, dim3(grid_blocks), dim3(NTHREADS), args, LDS_BYTES, stream);
    if (e != hipSuccess) fprintf(stderr, "cooperative launch failed: %s (grid %d)\n", hipGetErrorString(e), grid_blocks);
}
```
